# Optimizing an MI355X kernel written in HIP

```python
import math
import jax, jax.numpy as jnp
from jax import lax
import numpy as np

D_MODEL = 1024
BATCH = 2
SEQ = 8192
DEPTH = 2

CHUNK = 64
N_META = 16
META_PAD = (-N_META) % CHUNK
N_MIXERS = 2
N_A_LAYERS = (DEPTH + N_MIXERS - 1) // N_MIXERS
N_B_LAYERS = DEPTH // N_MIXERS
RMS_EPS = 1e-6
L2_EPS = 1e-6

GDN_HEADS = 8
GDN_DK = 128
GDN_DV = 128
GDN_CONV = 4
GDN_QK_DIM = GDN_HEADS * GDN_DK
GDN_V_DIM = GDN_HEADS * GDN_DV
GDN_CONV_DIM = 2 * GDN_QK_DIM + GDN_V_DIM
GDN_IN_DIM = GDN_CONV_DIM + GDN_V_DIM + 2 * GDN_HEADS

ATT_HEADS = 8
ATT_KV_HEADS = 2
ATT_GROUP = ATT_HEADS // ATT_KV_HEADS
ATT_HD = 128
ATT_Q_DIM = ATT_HEADS * ATT_HD
ATT_KV_DIM = ATT_KV_HEADS * ATT_HD
IDX_HEADS = 8
IDX_HD = 64
IDX_Q_DIM = IDX_HEADS * IDX_HD
TOPK_MAX = 256
Q_BLOCK = 128
DSA_IN_DIM = ATT_Q_DIM + 2 * ATT_KV_DIM + IDX_Q_DIM + IDX_HD + IDX_HEADS

REL_BUCKETS = 32
REL_MAX_DIST = 128

N_GROUPS = 4
EXPERTS_PER_GROUP = 8
N_EXPERTS = N_GROUPS * EXPERTS_PER_GROUP
EXPERT_FF = 256
TOPK_IN_GROUP = 2

kernel_name = 'hybrid_gdn_dsa_hmoe_stream'


def rms_norm(x, gain):
    xf = x.astype(jnp.float32)
    y = xf * lax.rsqrt(jnp.mean(xf * xf, axis=-1, keepdims=True) + RMS_EPS)
    return (y * gain.astype(jnp.float32)).astype(x.dtype)


def layer_norm(x, gain, bias):
    xf = x.astype(jnp.float32)
    mu = jnp.mean(xf, axis=-1, keepdims=True)
    xc = xf - mu
    y = xc * lax.rsqrt(jnp.mean(xc * xc, axis=-1, keepdims=True) + RMS_EPS)
    return (y * gain.astype(jnp.float32) + bias.astype(jnp.float32)).astype(x.dtype)


def l2_normalize(x):
    return x * lax.rsqrt(jnp.sum(x * x, axis=-1, keepdims=True) + L2_EPS)


def causal_conv(u, w):
    K = w.shape[0]
    L = u.shape[1]
    up = jnp.pad(u, ((0, 0), (K - 1, 0), (0, 0)))
    out = up[:, 0:L] * w[0]
    for j in range(1, K):
        out = out + up[:, j:j + L] * w[j]
    return out


def gated_delta_rule(q, k, v, beta, g):
    B, L, H, dk = q.shape
    n = L // CHUNK

    def chunks(t):
        t = t.reshape((B, n, CHUNK, H) + t.shape[3:])
        return jnp.moveaxis(t, 3, 1)

    q = chunks(q) * (dk ** -0.5)
    k = chunks(k)
    v = chunks(v)
    beta = chunks(beta)
    g = jnp.cumsum(chunks(g), axis=-1)
    causal = jnp.tril(jnp.ones((CHUNK, CHUNK), dtype=bool))
    strict = jnp.tril(jnp.ones((CHUNK, CHUNK), dtype=bool), k=-1)
    decay = jnp.exp(jnp.where(causal, g[..., :, None] - g[..., None, :], -jnp.inf))
    k_beta = k * beta[..., None]
    v_beta = v * beta[..., None]
    lower = jnp.where(strict, jnp.einsum('bhncd,bhnsd->bhncs', k_beta, k) * decay, 0.0)
    m = lower + jnp.eye(CHUNK, dtype=q.dtype)
    u = lax.linalg.triangular_solve(m, v_beta, left_side=True, lower=True, unit_diagonal=True)
    w = lax.linalg.triangular_solve(m, k_beta * jnp.exp(g)[..., None], left_side=True, lower=True,
                                    unit_diagonal=True)
    qk = jnp.where(causal, jnp.einsum('bhncd,bhnsd->bhncs', q, k) * decay, 0.0)
    q_decay = q * jnp.exp(g)[..., None]
    k_decay = k * jnp.exp(g[..., -1:] - g)[..., None]
    chunk_decay = jnp.exp(g[..., -1])

    def step(S, inp):
        qk_i, qd_i, kd_i, u_i, w_i, cd_i = inp
        v_new = u_i - jnp.einsum('bhck,bhkv->bhcv', w_i, S)
        o = jnp.einsum('bhck,bhkv->bhcv', qd_i, S) + jnp.einsum('bhcs,bhsv->bhcv', qk_i, v_new)
        S = S * cd_i[..., None, None] + jnp.einsum('bhck,bhcv->bhkv', kd_i, v_new)
        return S, o

    xs = tuple(jnp.moveaxis(t, 2, 0) for t in (qk, q_decay, k_decay, u, w, chunk_decay))
    S0 = jnp.zeros((B, H, dk, v.shape[-1]), q.dtype)
    _, o = lax.scan(step, S0, xs)
    return jnp.transpose(o, (1, 0, 3, 2, 4)).reshape(B, L, H, v.shape[-1])


def gated_deltanet(hn, w_in, conv_w, a_log, dt_bias, o_gain, w_out):
    B, L, _ = hn.shape
    Lp = L + META_PAD
    f32 = jnp.float32
    proj = jnp.pad(hn @ w_in, ((0, 0), (META_PAD, 0), (0, 0)))
    qkv = jax.nn.silu(causal_conv(proj[..., :GDN_CONV_DIM], conv_w)).astype(f32)
    q = l2_normalize(qkv[..., :GDN_QK_DIM].reshape(B, Lp, GDN_HEADS, GDN_DK))
    k = l2_normalize(qkv[..., GDN_QK_DIM:2 * GDN_QK_DIM].reshape(B, Lp, GDN_HEADS, GDN_DK))
    v = qkv[..., 2 * GDN_QK_DIM:].reshape(B, Lp, GDN_HEADS, GDN_DV)
    z = proj[:, META_PAD:, GDN_CONV_DIM:GDN_CONV_DIM + GDN_V_DIM].reshape(B, L, GDN_HEADS, GDN_DV)
    b = proj[..., GDN_CONV_DIM + GDN_V_DIM:GDN_CONV_DIM + GDN_V_DIM + GDN_HEADS].astype(f32)
    a = proj[..., GDN_CONV_DIM + GDN_V_DIM + GDN_HEADS:].astype(f32)
    beta = jax.nn.sigmoid(b)
    g = -jnp.exp(a_log.astype(f32)) * jax.nn.softplus(a + dt_bias.astype(f32))
    o = gated_delta_rule(q, k, v, beta, g)[:, META_PAD:]
    o = rms_norm(o, o_gain) * jax.nn.silu(z.astype(f32))
    return o.reshape(B, L, GDN_V_DIM).astype(hn.dtype) @ w_out


def t5_bucket(rel):
    nb = REL_BUCKETS // 2
    max_exact = nb // 2
    ret = jnp.where(rel > 0, nb, 0)
    n = jnp.abs(rel)
    nf = jnp.maximum(n, 1).astype(jnp.float32)
    large = max_exact + (jnp.log(nf / max_exact) / math.log(REL_MAX_DIST / max_exact)
                         * (nb - max_exact)).astype(jnp.int32)
    large = jnp.minimum(large, nb - 1)
    return ret + jnp.where(n < max_exact, n, large)


def dsa_attention(hn, w_in, q_gain, k_gain, idx_gain, idx_bias, rel_bias, w_out, n_select):
    B, L, _ = hn.shape
    f32 = jnp.float32
    proj = hn @ w_in
    cuts = [ATT_Q_DIM, ATT_Q_DIM + ATT_KV_DIM, ATT_Q_DIM + 2 * ATT_KV_DIM,
            ATT_Q_DIM + 2 * ATT_KV_DIM + IDX_Q_DIM, ATT_Q_DIM + 2 * ATT_KV_DIM + IDX_Q_DIM + IDX_HD]
    q, k, v, qi, ki, wi = jnp.split(proj, cuts, axis=-1)
    q = rms_norm(q.reshape(B, L, ATT_HEADS, ATT_HD), q_gain)
    k = rms_norm(k.reshape(B, L, ATT_KV_HEADS, ATT_HD), k_gain)
    v = v.reshape(B, L, ATT_KV_HEADS, ATT_HD)
    qi = qi.reshape(B, L, IDX_HEADS, IDX_HD).astype(f32)
    ki = layer_norm(ki, idx_gain, idx_bias).astype(f32)
    wi = wi.astype(f32) * (IDX_HEADS ** -0.5 * IDX_HD ** -0.5)
    key_chunk = (jnp.arange(L) + META_PAD) // CHUNK
    n_blk = -(-L // Q_BLOCK)
    Lq = n_blk * Q_BLOCK

    def to_blocks(t):
        t = jnp.pad(t, [(0, 0), (0, Lq - L)] + [(0, 0)] * (t.ndim - 2))
        return jnp.moveaxis(t.reshape((B, n_blk, Q_BLOCK) + t.shape[2:]), 1, 0)

    qpos = jnp.arange(Lq).reshape(n_blk, Q_BLOCK)
    gather = jax.vmap(lambda t, i: t[i])

    def block(args):
        qb, qib, wib, pb = args
        qchunk = (pb + META_PAD) // CHUNK
        admissible = key_chunk[None, :] <= qchunk[:, None]
        scores = jnp.einsum('bqh,bqhs->bqs', wib,
                            jax.nn.relu(jnp.einsum('bqhd,bsd->bqhs', qib, ki)))
        scores = jnp.where(admissible[None], scores, -jnp.inf)
        top_val, top_idx = lax.top_k(scores, n_select)
        valid = top_val > -jnp.inf
        k_sel = gather(k, top_idx).astype(f32)
        v_sel = gather(v, top_idx).astype(f32)
        qg = qb.astype(f32).reshape(B, Q_BLOCK, ATT_KV_HEADS, ATT_GROUP, ATT_HD)
        logits = jnp.einsum('bqngd,bqsnd->bqngs', qg, k_sel) * (ATT_HD ** -0.5)
        bias = rel_bias.astype(f32)[t5_bucket(top_idx - pb[None, :, None])]
        bias = jnp.transpose(bias.reshape(B, Q_BLOCK, n_select, ATT_KV_HEADS, ATT_GROUP), (0, 1, 3, 4, 2))
        logits = jnp.where(valid[:, :, None, None, :], logits + bias, -jnp.inf)
        p = jax.nn.softmax(logits, axis=-1)
        o = jnp.einsum('bqngs,bqsnd->bqngd', p, v_sel)
        return o.reshape(B, Q_BLOCK, ATT_Q_DIM).astype(hn.dtype)

    out = lax.map(block, (to_blocks(q), to_blocks(qi), to_blocks(wi), qpos))
    out = jnp.moveaxis(out, 0, 1).reshape(B, Lq, ATT_Q_DIM)[:, :L]
    return out @ w_out


def hier_moe(hn, w_group, b_group, w_expert, b_expert, w_gate_up, w_down):
    B, L, D = hn.shape
    f32 = jnp.float32
    t = hn.reshape(B * L, D)
    g_logits = (t @ w_group).astype(f32) + b_group.astype(f32)
    g_prob = jax.nn.softmax(g_logits, axis=-1)
    g_sel = jnp.argmax(g_logits, axis=-1)
    g_w = jnp.take_along_axis(g_prob, g_sel[:, None], axis=-1)
    e_logits = ((t @ w_expert).astype(f32) + b_expert.astype(f32)).reshape(B * L, N_GROUPS, EXPERTS_PER_GROUP)
    e_logits = jnp.take_along_axis(e_logits, g_sel[:, None, None], axis=1)[:, 0]
    top_p, top_i = lax.top_k(jax.nn.softmax(e_logits, axis=-1), TOPK_IN_GROUP)
    top_p = top_p / jnp.sum(top_p, axis=-1, keepdims=True)
    in_group = jnp.sum(jax.nn.one_hot(top_i, EXPERTS_PER_GROUP, dtype=f32) * top_p[..., None], axis=1)
    combine = (jax.nn.one_hot(g_sel, N_GROUPS, dtype=f32)[:, :, None]
               * (g_w * in_group)[:, None, :]).astype(t.dtype)
    y = jnp.zeros_like(t)
    for gi in range(N_GROUPS):
        h = jnp.einsum('td,edf->tef', t, w_gate_up[gi])
        act = jax.nn.silu(h[..., :EXPERT_FF]) * h[..., EXPERT_FF:] * combine[:, gi, :, None]
        y = y + jnp.einsum('tef,efd->td', act, w_down[gi])
    return y.reshape(B, L, D)


def setup_inputs(seed: int = 0) -> dict:
    key = jax.random.key(seed)
    ks = jax.random.split(key, 24)
    f32 = jnp.float32
    D = D_MODEL

    def nrm(k, shape, scale):
        return jax.random.normal(k, shape, f32) * scale

    dt = jnp.exp(jax.random.uniform(ks[8], (N_A_LAYERS, GDN_HEADS), f32, math.log(1e-3), math.log(1e-1)))
    return {
        'x': nrm(ks[0], (BATCH, SEQ, D), 1.0),
        'meta_tokens': nrm(ks[1], (N_META, D), 1.0),
        'norm_mix': 1.0 + nrm(ks[2], (DEPTH, D), 0.02),
        'norm_ffn': 1.0 + nrm(ks[3], (DEPTH, D), 0.02),
        'rel_bias': nrm(ks[4], (REL_BUCKETS, ATT_HEADS), 0.5),
        'gdn_w_in': nrm(ks[5], (N_A_LAYERS, D, GDN_IN_DIM), D ** -0.5),
        'gdn_conv': nrm(ks[6], (N_A_LAYERS, GDN_CONV, GDN_CONV_DIM), GDN_CONV ** -0.5),
        'gdn_a_log': jnp.log(jax.random.uniform(ks[7], (N_A_LAYERS, GDN_HEADS), f32, 1.0, 16.0)),
        'gdn_dt_bias': dt + jnp.log(-jnp.expm1(-dt)),
        'gdn_o_norm': 1.0 + nrm(ks[9], (N_A_LAYERS, GDN_DV), 0.02),
        'gdn_w_out': nrm(ks[10], (N_A_LAYERS, GDN_V_DIM, D), GDN_V_DIM ** -0.5),
        'dsa_w_in': nrm(ks[11], (N_B_LAYERS, D, DSA_IN_DIM), D ** -0.5),
        'dsa_q_norm': 1.0 + nrm(ks[12], (N_B_LAYERS, ATT_HD), 0.02),
        'dsa_k_norm': 1.0 + nrm(ks[13], (N_B_LAYERS, ATT_HD), 0.02),
        'dsa_idx_ln_g': 1.0 + nrm(ks[14], (N_B_LAYERS, IDX_HD), 0.02),
        'dsa_idx_ln_b': nrm(ks[15], (N_B_LAYERS, IDX_HD), 0.02),
        'dsa_w_out': nrm(ks[16], (N_B_LAYERS, ATT_Q_DIM, D), ATT_Q_DIM ** -0.5),
        'moe_w_group': nrm(ks[17], (DEPTH, D, N_GROUPS), D ** -0.5),
        'moe_b_group': nrm(ks[18], (DEPTH, N_GROUPS), 0.01),
        'moe_w_expert': nrm(ks[19], (DEPTH, D, N_EXPERTS), D ** -0.5),
        'moe_b_expert': nrm(ks[20], (DEPTH, N_EXPERTS), 0.01),
        'moe_w_gate_up': nrm(ks[21], (DEPTH, N_GROUPS, EXPERTS_PER_GROUP, D, 2 * EXPERT_FF), D ** -0.5),
        'moe_w_down': nrm(ks[22], (DEPTH, N_GROUPS, EXPERTS_PER_GROUP, EXPERT_FF, D), EXPERT_FF ** -0.5),
    }


def reference(x, meta_tokens, norm_mix, norm_ffn, rel_bias,
              gdn_w_in, gdn_conv, gdn_a_log, gdn_dt_bias, gdn_o_norm, gdn_w_out,
              dsa_w_in, dsa_q_norm, dsa_k_norm, dsa_idx_ln_g, dsa_idx_ln_b, dsa_w_out,
              moe_w_group, moe_b_group, moe_w_expert, moe_b_expert, moe_w_gate_up, moe_w_down):
    B, S, D = x.shape
    n_select = min(TOPK_MAX, S // 4)
    meta = jnp.broadcast_to(meta_tokens.astype(x.dtype)[None], (B, N_META, D))
    h = jnp.concatenate([meta, x], axis=1)
    for i in range(DEPTH):
        j = i // N_MIXERS
        hn = rms_norm(h, norm_mix[i])
        if i % N_MIXERS == 0:
            mix = gated_deltanet(hn, gdn_w_in[j], gdn_conv[j], gdn_a_log[j], gdn_dt_bias[j],
                                 gdn_o_norm[j], gdn_w_out[j])
        else:
            mix = dsa_attention(hn, dsa_w_in[j], dsa_q_norm[j], dsa_k_norm[j], dsa_idx_ln_g[j],
                                dsa_idx_ln_b[j], rel_bias, dsa_w_out[j], n_select)
        h = h + mix
        h = h + hier_moe(rms_norm(h, norm_ffn[i]), moe_w_group[i], moe_b_group[i], moe_w_expert[i],
                         moe_b_expert[i], moe_w_gate_up[i], moe_w_down[i])
    return h[:, N_META:]
```

```cpp
#include <hip/hip_runtime.h>
#include <stdint.h>
#include <stdio.h>

#define DI __device__ __forceinline__
#define LAS __attribute__((address_space(3)))
typedef unsigned short u16;
typedef unsigned int u32;
typedef short bf16x8 __attribute__((ext_vector_type(8)));
typedef _Float16 f16x8 __attribute__((ext_vector_type(8)));
typedef float f32x4 __attribute__((ext_vector_type(4)));
typedef float f32x16 __attribute__((ext_vector_type(16)));
typedef u32 u32x4 __attribute__((ext_vector_type(4)));
typedef u32 u32x2 __attribute__((ext_vector_type(2)));

constexpr int DM = 1024, SEQ = 8192, LP = 8256, TP = 16512, TPA = 16640, NCH = 129;
constexpr int NTHREADS = 512;
constexpr int LDS_BYTES = 155648;
constexpr int LDS_BAR = LDS_BYTES - 16;
constexpr float RMS_EPS = 1e-6f;

constexpr size_t WS_CTL = 0, CTL_BYTES = 1u << 20;
constexpr size_t WS_W_IN0 = CTL_BYTES;
constexpr size_t WS_W_OUT0 = WS_W_IN0 + (size_t)4224 * 1024 * 2;
constexpr size_t WS_W_IN1 = WS_W_OUT0 + (size_t)1024 * 1024 * 2;
constexpr size_t WS_W_OUT1 = WS_W_IN1 + (size_t)2176 * 1024 * 2;
constexpr size_t WS_BA = WS_W_OUT1 + (size_t)1024 * 1024 * 2;
constexpr size_t WS_LIST = WS_BA + (size_t)TPA * 16 * 4;
constexpr size_t WS_CW = WS_LIST + (size_t)32 * TP * 4;
constexpr size_t WS_H = WS_CW + (size_t)2 * TP * 4;
constexpr size_t WS_NS = WS_H + (size_t)TPA * 1024 * 4;
constexpr size_t WS_HN = WS_NS;
constexpr size_t WS_P0 = WS_NS + (size_t)16 * 129 * 128 * 128 * 2;
constexpr size_t WS_END = WS_P0 + (size_t)TPA * 4096 * 2;
constexpr size_t P0_WGU = 0;
constexpr size_t P0_WDN = P0_WGU + (size_t)32 * 512 * 1024 * 2;
constexpr size_t P0_ACT = P0_WDN + (size_t)32 * 1024 * 256 * 2;
constexpr size_t P0_Y = P0_ACT + (size_t)2 * TP * 256 * 2;
constexpr size_t P0_QRAW = P0_ACT;
constexpr size_t P0_KRAW = P0_QRAW + (size_t)TP * 1024 * 2;
constexpr size_t P0_VN = P0_KRAW + (size_t)TP * 256 * 4;
constexpr size_t P0_QI = P0_VN + (size_t)TP * 256 * 2;
static_assert(P0_Y + (size_t)2 * TP * 1024 * 2 <= (size_t)TPA * 4096 * 2, "P0 map");
static_assert(P0_QI + (size_t)TP * 512 * 2 <= (size_t)TPA * 4096 * 2, "P0 map 2");
constexpr size_t DO_M = 0;
constexpr size_t DO_OG = 0;
constexpr size_t DO_SEL = (size_t)TPA * 1024 * 2;
constexpr size_t DO_KN = DO_SEL + (size_t)TP * 256 * 2;
constexpr size_t DO_KI = DO_KN + (size_t)TP * 256 * 2;
constexpr size_t DO_WI = DO_KI + (size_t)TP * 64 * 2;
constexpr size_t DO_KIRAW = DO_WI + (size_t)TP * 8 * 4;
static_assert(DO_KIRAW + (size_t)TP * 64 * 4 <= (size_t)2 * SEQ * 1024 * 4, "d_out map");
constexpr int CW_BAR = 0;
constexpr int CW_CNT = 4096;

struct Params {
    const float *x, *meta, *norm_mix, *norm_ffn, *rel_bias, *gdn_w_in, *gdn_conv, *gdn_a_log, *gdn_dt_bias, *gdn_o_norm, *gdn_w_out,
        *dsa_w_in, *dsa_q_norm, *dsa_k_norm, *dsa_ln_g, *dsa_ln_b, *dsa_w_out, *moe_w_group, *moe_b_group, *moe_w_expert, *moe_b_expert,
        *moe_w_gu, *moe_w_down;
    float* out;
    unsigned char* ws;
};

DI u16 f2bf(float f) { return __builtin_bit_cast(u16, (__bf16)f); }
DI float bf2f(u16 h) { return __uint_as_float(((u32)h) << 16); }
DI u32 pk2(float a, float b) { return (u32)f2bf(a) | ((u32)f2bf(b) << 16); }
DI float bflo(u32 w) { return __uint_as_float(w << 16); }
DI float bfhi(u32 w) { return __uint_as_float(w & 0xffff0000u); }
DI float wave_sum(float v) {
#pragma unroll
    for (int o = 32; o >= 1; o >>= 1) v += __shfl_xor(v, o);
    return v;
}
DI int tid_opaque() { int t = threadIdx.x; asm volatile("" : "+v"(t)); return t; }
DI float silu(float x) { return x / (1.f + __expf(-x)); }
DI f32x4 mfma16(bf16x8 a, bf16x8 b, f32x4 c) { return __builtin_amdgcn_mfma_f32_16x16x32_bf16(a, b, c, 0, 0, 0); }
DI bf16x8 ldsfrag(const unsigned char* base, int row, int strideB, int kel) { return *(const bf16x8*)(base + row * strideB + kel * 2); }

#define XB_TMO      128
#define XB_XCNT(j)  (256  + 64 * (j))
#define XB_XSUB(j)  (1280 + 64 * (j))
#define XB_XGEN(j)  (2304 + 64 * (j))
#define XB_TOP      3328
#define XB_TOPGEN   3392
#define XCD_BAR_WORDS 3456
#define XB_SPIN_CAP (1u << 21)
DI unsigned xb_ld(unsigned* p) { return __hip_atomic_load(p, __ATOMIC_RELAXED, __HIP_MEMORY_SCOPE_AGENT); }
DI unsigned xb_add(unsigned* p, unsigned v) { return __hip_atomic_fetch_add(p, v, __ATOMIC_RELAXED, __HIP_MEMORY_SCOPE_AGENT); }
DI unsigned xb_xcc_id() { return (unsigned)__builtin_amdgcn_s_getreg((3 << 11) | 20) & 0xFu; }
#define XB_SPIN(cond, bar) do { unsigned _sp = 0; while (cond) { __builtin_amdgcn_s_sleep(1); \
    if ((++_sp & 255u) == 0u) { if (xb_ld(&(bar)[XB_TMO])) break; if (_sp > XB_SPIN_CAP) { atomicAdd(&(bar)[XB_TMO], 1u); break; } } } } while (0)
struct XcdBarrier { unsigned* bar; unsigned x; volatile LAS unsigned* st; };
DI XcdBarrier xcd_barrier_post(unsigned* bar, volatile LAS unsigned* st) {
    XcdBarrier b; b.bar = bar; b.x = xb_xcc_id(); b.st = st;
    if (threadIdx.x == 0) (void)xb_add(&bar[XB_XCNT(b.x)], 1u);
    return b;
}
DI void xcd_barrier_complete(unsigned* bar, unsigned x, unsigned& nloc, unsigned& nx) {
    const unsigned G = gridDim.x * gridDim.y * gridDim.z;
    unsigned sum, cnt, mine, sp = 0u;
    for (;;) {
        sum = 0u; cnt = 0u; mine = 0u;
#pragma unroll
        for (unsigned j = 0; j < 16; ++j) { const unsigned c = xb_ld(&bar[XB_XCNT(j)]); sum += c; cnt += (c > 0u) ? 1u : 0u; mine = (j == x) ? c : mine; }
        if (sum == G) break;
        __builtin_amdgcn_s_sleep(1);
        if ((++sp & 255u) == 0u) { if (xb_ld(&bar[XB_TMO])) break; if (sp > XB_SPIN_CAP) { atomicAdd(&bar[XB_TMO], 1u); break; } }
    }
    nloc = mine > 0u ? mine : 1u; nx = cnt > 0u ? cnt : 1u;
}
DI void xcd_barrier(const XcdBarrier& b) {
    asm volatile("s_waitcnt vmcnt(0)" ::: "memory");
    __syncthreads();
    if (threadIdx.x == 0) {
        unsigned* bar = b.bar;
        __builtin_amdgcn_s_waitcnt(0);
        unsigned nloc = b.st[0], nx = b.st[1];
        if (nloc == 0u) { xcd_barrier_complete(bar, b.x, nloc, nx); b.st[0] = nloc; b.st[1] = nx; }
        const unsigned old = xb_add(&bar[XB_XSUB(b.x)], 1u);
        const unsigned gen = old / nloc;
        if (old + 1u == (gen + 1u) * nloc) {
            __builtin_amdgcn_fence(__ATOMIC_RELEASE, "agent");
            asm volatile("s_waitcnt vmcnt(0)" ::: "memory");
            const unsigned og = xb_add(&bar[XB_TOP], 1u);
            const unsigned tg = og / nx;
            if (og + 1u == (tg + 1u) * nx) xb_add(&bar[XB_TOPGEN], 1u);
            else XB_SPIN(xb_ld(&bar[XB_TOPGEN]) == tg, bar);
            __builtin_amdgcn_fence(__ATOMIC_ACQUIRE, "agent");
            xb_add(&bar[XB_XGEN(b.x)], 1u);
            asm volatile("s_waitcnt vmcnt(0)" ::: "memory");
        } else {
            XB_SPIN(xb_ld(&bar[XB_XGEN(b.x)]) == gen, bar);
            __builtin_amdgcn_fence(__ATOMIC_ACQUIRE, "agent");
            asm volatile("s_waitcnt vmcnt(0)" ::: "memory");
        }
    }
    __syncthreads();
}

DI void convT_unit(const float* __restrict__ src, int K, int N, u16* __restrict__ dst, int kt, int nt, unsigned char* lds) {
    float* tile = (float*)lds;
    const int tid = tid_opaque();
    const int k0 = kt * 64, n0 = nt * 64;
    {
        const int nn = tid & 63, kb = tid >> 6;
#pragma unroll
        for (int i = 0; i < 8; ++i) {
            const int kk = kb + 8 * i;
            const int n = n0 + nn;
            tile[kk * 65 + nn] = (n < N) ? src[(size_t)(k0 + kk) * N + n] : 0.f;
        }
    }
    __syncthreads();
    {
        const int kk2 = (tid & 31) * 2, nb = tid >> 5;
#pragma unroll
        for (int i = 0; i < 4; ++i) {
            const int nn = nb + 16 * i;
            const u32 w = pk2(tile[kk2 * 65 + nn], tile[(kk2 + 1) * 65 + nn]);
            *(u32*)(dst + (size_t)(n0 + nn) * K + k0 + kk2) = w;
        }
    }
    __syncthreads();
}

template <int NI> struct GemmAcc { f32x4 a[4][NI]; };
template <int NI, class PF, class QF>
DI void gemm_tile(const u16* __restrict__ Pb, const u16* __restrict__ Qb, int KT, PF pf, QF qf, GemmAcc<NI>& acc, unsigned char* lds) {
    constexpr int TN = 64 * NI, QC = TN * 8 / NTHREADS, BUF = (128 + TN) * 144;
    const int tid = tid_opaque(), lane = tid & 63, wid = tid >> 6, c = lane & 15, g = lane >> 4, wm = wid >> 2, wn = wid & 3;
    u32 poff[2], qoff[QC];
#pragma unroll
    for (int i = 0; i < 2; ++i) { const int id = tid + NTHREADS * i; poff[i] = pf(id >> 3) + (id & 7) * 8; }
#pragma unroll
    for (int i = 0; i < QC; ++i) { const int id = tid + NTHREADS * i; qoff[i] = qf(id >> 3) + (id & 7) * 8; }
    u32x4 pr[2], qr[QC];
#pragma unroll
    for (int mi = 0; mi < 4; ++mi)
#pragma unroll
        for (int ni = 0; ni < NI; ++ni) acc.a[mi][ni] = (f32x4){0.f, 0.f, 0.f, 0.f};
#pragma unroll
    for (int i = 0; i < 2; ++i) pr[i] = *(const u32x4*)(Pb + poff[i]);
#pragma unroll
    for (int i = 0; i < QC; ++i) qr[i] = *(const u32x4*)(Qb + qoff[i]);
#pragma unroll
    for (int i = 0; i < 2; ++i) { const int id = tid + NTHREADS * i; *(u32x4*)(lds + (id >> 3) * 144 + (id & 7) * 16) = pr[i]; }
#pragma unroll
    for (int i = 0; i < QC; ++i) { const int id = tid + NTHREADS * i; *(u32x4*)(lds + 128 * 144 + (id >> 3) * 144 + (id & 7) * 16) = qr[i]; }
    __syncthreads();
    for (int kt = 0; kt < KT; ++kt) {
        const unsigned char* cur = lds + (kt & 1) * BUF;
        unsigned char* nxt = lds + ((kt + 1) & 1) * BUF;
        if (kt + 1 < KT) {
#pragma unroll
            for (int i = 0; i < 2; ++i) pr[i] = *(const u32x4*)(Pb + poff[i] + (kt + 1) * 64);
#pragma unroll
            for (int i = 0; i < QC; ++i) qr[i] = *(const u32x4*)(Qb + qoff[i] + (kt + 1) * 64);
        }
#pragma unroll
        for (int ks = 0; ks < 2; ++ks) {
            bf16x8 af[4], bfr[NI];
#pragma unroll
            for (int mi = 0; mi < 4; ++mi) af[mi] = ldsfrag(cur, wm * 64 + 16 * mi + c, 144, 32 * ks + 8 * g);
#pragma unroll
            for (int ni = 0; ni < NI; ++ni) bfr[ni] = ldsfrag(cur + 128 * 144, wn * 16 * NI + 16 * ni + c, 144, 32 * ks + 8 * g);
#pragma unroll
            for (int mi = 0; mi < 4; ++mi)
#pragma unroll
                for (int ni = 0; ni < NI; ++ni) acc.a[mi][ni] = mfma16(af[mi], bfr[ni], acc.a[mi][ni]);
        }
        if (kt + 1 < KT) {
#pragma unroll
            for (int i = 0; i < 2; ++i) { const int id = tid + NTHREADS * i; *(u32x4*)(nxt + (id >> 3) * 144 + (id & 7) * 16) = pr[i]; }
#pragma unroll
            for (int i = 0; i < QC; ++i) { const int id = tid + NTHREADS * i; *(u32x4*)(nxt + 128 * 144 + (id >> 3) * 144 + (id & 7) * 16) = qr[i]; }
        }
        __syncthreads();
    }
}
struct LinRow { u32 base, ld; DI u32 operator()(int r) const { return base + (u32)r * ld; } };

DI void conv_small_weights(const Params& p, unsigned char* lds) {
    const int n0 = 16 * 66, n1 = 16 * 16, n2 = 16 * 34, n3 = 16 * 16;
    for (int u = blockIdx.x; u < n0 + n1 + n2 + n3; u += gridDim.x) {
        if (u < n0) convT_unit(p.gdn_w_in, 1024, 4112, (u16*)(p.ws + WS_W_IN0), u & 15, u >> 4, lds);
        else if (u < n0 + n1) { const int v = u - n0; convT_unit(p.gdn_w_out, 1024, 1024, (u16*)(p.ws + WS_W_OUT0), v & 15, v >> 4, lds); }
        else if (u < n0 + n1 + n2) { const int v = u - n0 - n1; convT_unit(p.dsa_w_in, 1024, 2120, (u16*)(p.ws + WS_W_IN1), v & 15, v >> 4, lds); }
        else { const int v = u - n0 - n1 - n2; convT_unit(p.dsa_w_out, 1024, 1024, (u16*)(p.ws + WS_W_OUT1), v & 15, v >> 4, lds); }
    }
}
DI void conv_moe_weights(const Params& p, int layer, unsigned char* lds) {
    const int ngu = 32 * 128, ndn = 32 * 64;
    for (int u = blockIdx.x; u < ngu + ndn; u += gridDim.x) {
        if (u < ngu) {
            const int e = u >> 7, v = u & 127;
            convT_unit(p.moe_w_gu + ((size_t)layer * 32 + e) * 1024 * 512, 1024, 512, (u16*)(p.ws + WS_P0 + P0_WGU) + (size_t)e * 512 * 1024, v & 15, v >> 4, lds);
        } else {
            const int w = u - ngu, e = w >> 6, v = w & 63;
            convT_unit(p.moe_w_down + ((size_t)layer * 32 + e) * 256 * 1024, 256, 1024, (u16*)(p.ws + WS_P0 + P0_WDN) + (size_t)e * 1024 * 256, v & 3, v >> 2, lds);
        }
    }
}
DI void phase_prep(const Params& p, unsigned char* lds) {
    conv_small_weights(p, lds);
    const int lane = tid_opaque() & 63, wid = tid_opaque() >> 6;
    float* H = (float*)(p.ws + WS_H);
    u16* HN = (u16*)(p.ws + WS_HN);
    for (int row = blockIdx.x * 8 + wid; row < TPA; row += gridDim.x * 8) {
        const int b = row / LP, pp = row - b * LP;
        const bool real = row < TP && pp >= 48;
        const float* src = real ? (pp < 64 ? p.meta + (size_t)(pp - 48) * DM : p.x + ((size_t)b * SEQ + (pp - 64)) * DM) : nullptr;
        f32x4 v[4];
        float ss = 0.f;
#pragma unroll
        for (int i = 0; i < 4; ++i) {
            v[i] = real ? *(const f32x4*)(src + 4 * lane + 256 * i) : (f32x4){0.f, 0.f, 0.f, 0.f};
            ss += v[i][0] * v[i][0] + v[i][1] * v[i][1] + v[i][2] * v[i][2] + v[i][3] * v[i][3];
        }
        ss = wave_sum(ss);
        const float rstd = rsqrtf(ss * (1.f / DM) + RMS_EPS);
#pragma unroll
        for (int i = 0; i < 4; ++i) {
            const int col = 4 * lane + 256 * i;
            *(f32x4*)(H + (size_t)row * DM + col) = v[i];
            const f32x4 gn = *(const f32x4*)(p.norm_mix + col);
            u32x2 w; w.x = pk2(v[i][0] * rstd * gn[0], v[i][1] * rstd * gn[1]); w.y = pk2(v[i][2] * rstd * gn[2], v[i][3] * rstd * gn[3]);
            *(u32x2*)(HN + (size_t)row * DM + col) = w;
        }
    }
}

DI void phase_gemm_in0(const Params& p, unsigned char* lds) {
    const u16* W = (const u16*)(p.ws + WS_W_IN0);
    const u16* X = (const u16*)(p.ws + WS_HN);
    u16* P0 = (u16*)(p.ws + WS_P0);
    float* BA = (float*)(p.ws + WS_BA);
    const int lane = tid_opaque() & 63, wid = tid_opaque() >> 6, c = lane & 15, g = lane >> 4, wm = wid >> 2, wn = wid & 3;
    for (int t = blockIdx.x; t < 33 * 65; t += gridDim.x) {
        const int nt = t / 33, mt = t - nt * 33;
        GemmAcc<4> acc;
        gemm_tile<4>(W, X, 16, LinRow{(u32)(mt * 128) * 1024u, 1024u}, LinRow{(u32)(nt * 256) * 1024u, 1024u}, acc, lds);
#pragma unroll
        for (int mi = 0; mi < 4; ++mi) {
            const int f = mt * 128 + wm * 64 + 16 * mi + 4 * g;
#pragma unroll
            for (int ni = 0; ni < 4; ++ni) {
                const int tok = nt * 256 + wn * 64 + 16 * ni + c;
                const f32x4 v = acc.a[mi][ni];
                if (f < 4096) { u32x2 w; w.x = pk2(v[0], v[1]); w.y = pk2(v[2], v[3]); *(u32x2*)(P0 + (size_t)tok * 4096 + f) = w; }
                else if (f < 4112) *(f32x4*)(BA + (size_t)tok * 16 + (f - 4096)) = v;
            }
        }
    }
}
DI void phase_gemm_out(const Params& p, const u16* W, const u16* X, unsigned char* lds) {
    float* H = (float*)(p.ws + WS_H);
    const int lane = tid_opaque() & 63, wid = tid_opaque() >> 6, c = lane & 15, g = lane >> 4, wm = wid >> 2, wn = wid & 3;
    for (int t = blockIdx.x; t < 8 * 130; t += gridDim.x) {
        const int nt = t >> 3, mt = t & 7;
        GemmAcc<2> acc;
        gemm_tile<2>(W, X, 16, LinRow{(u32)(mt * 128) * 1024u, 1024u}, LinRow{(u32)(nt * 128) * 1024u, 1024u}, acc, lds);
#pragma unroll
        for (int mi = 0; mi < 4; ++mi) {
            const int f = mt * 128 + wm * 64 + 16 * mi + 4 * g;
#pragma unroll
            for (int ni = 0; ni < 2; ++ni) {
                const int tok = nt * 128 + wn * 32 + 16 * ni + c;
                if (tok < TP) { f32x4* hp = (f32x4*)(H + (size_t)tok * DM + f); *hp = *hp + acc.a[mi][ni]; }
            }
        }
    }
}
DI void phase_gemm_in1(const Params& p, unsigned char* lds) {
    const u16* W = (const u16*)(p.ws + WS_W_IN1);
    const u16* X = (const u16*)(p.ws + WS_HN);
    u16* QRAW = (u16*)(p.ws + WS_P0 + P0_QRAW);
    float* KRAW = (float*)(p.ws + WS_P0 + P0_KRAW);
    u16* VN = (u16*)(p.ws + WS_P0 + P0_VN);
    _Float16* QI = (_Float16*)(p.ws + WS_P0 + P0_QI);
    float* KIRAW = (float*)((unsigned char*)p.out + DO_KIRAW);
    float* WI = (float*)((unsigned char*)p.out + DO_WI);
    const int lane = tid_opaque() & 63, wid = tid_opaque() >> 6, c = lane & 15, g = lane >> 4, wm = wid >> 2, wn = wid & 3;
    for (int t = blockIdx.x; t < 17 * 65; t += gridDim.x) {
        const int nt = t / 17, mt = t - nt * 17;
        GemmAcc<4> acc;
        gemm_tile<4>(W, X, 16, LinRow{(u32)(mt * 128) * 1024u, 1024u}, LinRow{(u32)(nt * 256) * 1024u, 1024u}, acc, lds);
#pragma unroll
        for (int mi = 0; mi < 4; ++mi) {
            const int f = mt * 128 + wm * 64 + 16 * mi + 4 * g;
#pragma unroll
            for (int ni = 0; ni < 4; ++ni) {
                const int tok = nt * 256 + wn * 64 + 16 * ni + c;
                if (tok >= TP) continue;
                const f32x4 v = acc.a[mi][ni];
                if (f < 1024) { u32x2 w; w.x = pk2(v[0], v[1]); w.y = pk2(v[2], v[3]); *(u32x2*)(QRAW + (size_t)tok * 1024 + f) = w; }
                else if (f < 1280) *(f32x4*)(KRAW + (size_t)tok * 256 + (f - 1024)) = v;
                else if (f < 1536) { u32x2 w; w.x = pk2(v[0], v[1]); w.y = pk2(v[2], v[3]); *(u32x2*)(VN + (size_t)tok * 256 + (f - 1280)) = w; }
                else if (f < 2048) {
                    _Float16* q = QI + (size_t)tok * 512 + (f - 1536);
                    q[0] = (_Float16)v[0]; q[1] = (_Float16)v[1]; q[2] = (_Float16)v[2]; q[3] = (_Float16)v[3];
                }
                else if (f < 2112) *(f32x4*)(KIRAW + (size_t)tok * 64 + (f - 2048)) = v;
                else if (f < 2120) *(f32x4*)(WI + (size_t)tok * 8 + (f - 2112)) = v * 0.04419417382415922f;
            }
        }
    }
}

constexpr int G_KT = 0, G_QT = 17408, G_KRT = 34816, G_VRT = 53248, G_LF = 71680, G_TF = 88320, G_TMP = 104960, G_TTW = 109184, G_TTU = 118400,
              G_QKT = 127616, G_SC = 136832;
constexpr int G_WT = G_LF, G_UT = G_LF + 18432;
constexpr int G_ST = G_KRT;
static_assert(G_UT + 18432 <= G_TTW, "WT/UT alias");
template <int MODE>
DI void gdn_chunk_unit(const Params& p, int bh, int ch, unsigned char* lds) {
    const int tid = tid_opaque(), lane = tid & 63, wid = tid >> 6, c = lane & 15, g = lane >> 4;
    const int b = bh >> 3, h = bh & 7;
    const size_t row0 = (size_t)b * LP + (size_t)ch * 64;
    const u16* P0 = (const u16*)(p.ws + WS_P0);
    float* SC = (float*)(lds + G_SC);
    u32x4 streg[4];
    if (MODE == 1 && ch > 0) {
        const u16* ST = (const u16*)(p.ws + WS_NS) + ((size_t)bh * NCH + (ch - 1)) * 16384;
#pragma unroll
        for (int i = 0; i < 4; ++i) { const int id = tid + NTHREADS * i; streg[i] = *(const u32x4*)(ST + (size_t)(id >> 4) * 128 + (id & 15) * 8); }
    }
    if (wid == 0) {
        const float* BA = (const float*)(p.ws + WS_BA);
        const float bb = BA[(row0 + lane) * 16 + h], aa = BA[(row0 + lane) * 16 + 8 + h];
        const float beta = 1.f / (1.f + __expf(-bb));
        const float xs = aa + p.gdn_dt_bias[h];
        const float sp = xs > 20.f ? xs : log1pf(__expf(xs));
        const float gg = -__expf(p.gdn_a_log[h]) * sp;
        float gc = gg;
#pragma unroll
        for (int o = 1; o < 64; o <<= 1) { const float t = __shfl_up(gc, o); if (lane >= o) gc += t; }
        const float glast = __shfl(gc, 63);
        SC[lane] = gc; SC[64 + lane] = beta; SC[128 + lane] = __expf(gc); SC[192 + lane] = __expf(glast - gc);
        if (lane == 0) SC[384] = __expf(glast);
    }
    {
        const int chn = tid & 127, part = tid >> 7;
#pragma unroll 1
        for (int X = 0; X < 3; ++X) {
            const int col = X * 1024 + h * 128 + chn;
            const float w0 = p.gdn_conv[col], w1 = p.gdn_conv[3072 + col], w2 = p.gdn_conv[2 * 3072 + col], w3 = p.gdn_conv[3 * 3072 + col];
            float u[19];
#pragma unroll
            for (int i = 0; i < 19; ++i) {
                const int rr = 16 * part - 3 + i;
                u[i] = (ch == 0 && rr < 0) ? 0.f : bf2f(P0[(row0 + rr) * 4096 + col]);
            }
            u16 o[16];
#pragma unroll
            for (int i = 0; i < 16; ++i) o[i] = f2bf(silu(w0 * u[i] + w1 * u[i + 1] + w2 * u[i + 2] + w3 * u[i + 3]));
            if (X < 2) {
                u16* T = (u16*)(lds + (X == 0 ? G_QT : G_KT));
#pragma unroll
                for (int i = 0; i < 16; ++i) T[(16 * part + i) * 136 + chn] = o[i];
            }
            if (X >= 1) {
                u16* T = (u16*)(lds + (X == 1 ? G_KRT : G_VRT));
                u32x4 a, b2;
                a.x = o[0] | ((u32)o[1] << 16); a.y = o[2] | ((u32)o[3] << 16); a.z = o[4] | ((u32)o[5] << 16); a.w = o[6] | ((u32)o[7] << 16);
                b2.x = o[8] | ((u32)o[9] << 16); b2.y = o[10] | ((u32)o[11] << 16); b2.z = o[12] | ((u32)o[13] << 16); b2.w = o[14] | ((u32)o[15] << 16);
                *(u32x4*)(T + chn * 72 + 16 * part) = a; *(u32x4*)(T + chn * 72 + 16 * part + 8) = b2;
            }
        }
    }
    { float* TF = (float*)(lds + G_TF); for (int i = tid; i < 64 * 65; i += NTHREADS) TF[i] = 0.f; }
    __syncthreads();
    {
        const int rt = wid & 3;
        const unsigned char* Arow = lds + (wid < 4 ? G_KT : G_QT);
        f32x4 acc[4], qq = (f32x4){0.f, 0.f, 0.f, 0.f};
#pragma unroll
        for (int ni = 0; ni < 4; ++ni) acc[ni] = (f32x4){0.f, 0.f, 0.f, 0.f};
#pragma unroll
        for (int ks = 0; ks < 4; ++ks) {
            const bf16x8 a = ldsfrag(Arow, 16 * rt + c, 272, 32 * ks + 8 * g);
#pragma unroll
            for (int ni = 0; ni < 4; ++ni) acc[ni] = mfma16(a, ldsfrag(lds + G_KT, 16 * ni + c, 272, 32 * ks + 8 * g), acc[ni]);
            if (wid >= 4) qq = mfma16(a, a, qq);
        }
        {
            const f32x4 kd_ = rt == 0 ? acc[0] : (rt == 1 ? acc[1] : (rt == 2 ? acc[2] : acc[3]));
            const f32x4 d = (wid < 4) ? kd_ : qq;
            if (g == (c >> 2)) {
                const int r = c & 3;
                const float dv = r == 0 ? d[0] : (r == 1 ? d[1] : (r == 2 ? d[2] : d[3]));
                SC[(wid < 4 ? 256 : 320) + 16 * rt + c] = rsqrtf(dv + 1e-6f);
            }
        }
        __syncthreads();
        float* LF = (float*)(lds + G_LF);
        u16* QKT = (u16*)(lds + G_QKT);
#pragma unroll
        for (int ni = 0; ni < 4; ++ni) {
            const int j = 16 * ni + c;
            const float gcj = SC[j], rkj = SC[256 + j];
#pragma unroll
            for (int r = 0; r < 4; ++r) {
                const int i = 16 * rt + 4 * g + r;
                const float gci = SC[i];
                if (wid < 4) {
                    const float v = (i > j) ? SC[64 + i] * SC[256 + i] * rkj * acc[ni][r] * __expf(gci - gcj) : 0.f;
                    LF[i * 65 + j] = v;
                } else {
                    const float v = (i >= j) ? SC[320 + i] * 0.08838834764831845f * rkj * acc[ni][r] * __expf(gci - gcj) : 0.f;
                    QKT[i * 72 + j] = f2bf(v);
                }
            }
        }
    }
    __syncthreads();
    {
        const float* LF = (const float*)(lds + G_LF);
        float* TF = (float*)(lds + G_TF);
        float* TMP = (float*)(lds + G_TMP);
        if (wid == 0) {
            const int b4 = lane >> 4, j = lane & 15;
            float t[16];
#pragma unroll
            for (int i = 0; i < 16; ++i) {
                float s = (i == j) ? 1.f : 0.f;
#pragma unroll
                for (int m = 0; m < i; ++m) s -= LF[(16 * b4 + i) * 65 + 16 * b4 + m] * t[m];
                t[i] = s;
            }
#pragma unroll
            for (int i = 0; i < 16; ++i) TF[(16 * b4 + i) * 65 + 16 * b4 + j] = t[i];
        }
        __syncthreads();
        {
            const int pp = tid >> 8, i = (tid >> 4) & 15, j = tid & 15;
            float s = 0.f;
#pragma unroll
            for (int m = 0; m < 16; ++m) s += LF[(16 * (2 * pp + 1) + i) * 65 + 32 * pp + m] * TF[(32 * pp + m) * 65 + 32 * pp + j];
            TMP[pp * 256 + i * 16 + j] = s;
            __syncthreads();
            float x = 0.f;
#pragma unroll
            for (int m = 0; m < 16; ++m) x -= TF[(16 * (2 * pp + 1) + i) * 65 + 16 * (2 * pp + 1) + m] * TMP[pp * 256 + m * 16 + j];
            TF[(16 * (2 * pp + 1) + i) * 65 + 32 * pp + j] = x;
        }
        __syncthreads();
        {
            const int i = tid >> 4, j0 = tid & 15;
            float s0 = 0.f, s1 = 0.f;
            for (int m = 0; m < 32; ++m) { const float l = LF[(32 + i) * 65 + m]; s0 += l * TF[m * 65 + j0]; s1 += l * TF[m * 65 + j0 + 16]; }
            __syncthreads();
            TMP[i * 33 + j0] = s0; TMP[i * 33 + j0 + 16] = s1;
            __syncthreads();
            float x0 = 0.f, x1 = 0.f;
            for (int m = 0; m < 32; ++m) { const float tt = TF[(32 + i) * 65 + 32 + m]; x0 -= tt * TMP[m * 33 + j0]; x1 -= tt * TMP[m * 33 + j0 + 16]; }
            TF[(32 + i) * 65 + j0] = x0; TF[(32 + i) * 65 + j0 + 16] = x1;
        }
        __syncthreads();
        u16* TTW = (u16*)(lds + G_TTW);
        u16* TTU = (u16*)(lds + G_TTU);
#pragma unroll
        for (int i = 0; i < 8; ++i) {
            const int e = tid + NTHREADS * i, t = e >> 6, s = e & 63;
            const float tv = (s <= t) ? TF[t * 65 + s] : 0.f;
            const float bs = SC[64 + s];
            TTW[t * 72 + s] = f2bf(tv * bs * SC[256 + s] * SC[128 + s]);
            TTU[t * 72 + s] = f2bf(tv * bs);
        }
    }
    __syncthreads();
    {
        const int tt = wid & 3, isu = wid >> 2;
        f32x4 acc[8];
#pragma unroll
        for (int ni = 0; ni < 8; ++ni) acc[ni] = (f32x4){0.f, 0.f, 0.f, 0.f};
        const unsigned char* A = lds + (isu ? G_TTU : G_TTW);
        const unsigned char* Bt = lds + (isu ? G_VRT : G_KRT);
#pragma unroll
        for (int ks = 0; ks < 2; ++ks) {
            const bf16x8 a = ldsfrag(A, 16 * tt + c, 144, 32 * ks + 8 * g);
#pragma unroll
            for (int ni = 0; ni < 8; ++ni) acc[ni] = mfma16(a, ldsfrag(Bt, 16 * ni + c, 144, 32 * ks + 8 * g), acc[ni]);
        }
        __syncthreads();
        u16* WU = (u16*)(lds + (isu ? G_UT : G_WT));
        const int t0 = 16 * tt + 4 * g;
        float sc[4];
#pragma unroll
        for (int r = 0; r < 4; ++r) sc[r] = (MODE == 0) ? SC[256 + t0 + r] * SC[192 + t0 + r] : 1.f;
#pragma unroll
        for (int ni = 0; ni < 8; ++ni) {
            u32x2 w; w.x = pk2(acc[ni][0] * sc[0], acc[ni][1] * sc[1]); w.y = pk2(acc[ni][2] * sc[2], acc[ni][3] * sc[3]);
            *(u32x2*)(WU + (16 * ni + c) * 72 + t0) = w;
        }
        if (MODE == 1 && ch > 0) {
#pragma unroll
            for (int i = 0; i < 4; ++i) { const int id = tid + NTHREADS * i; *(u32x4*)(lds + G_ST + (id >> 4) * 272 + (id & 15) * 16) = streg[i]; }
        }
    }
    __syncthreads();
    if (MODE == 0) {
        {
            f32x4 acc[8];
#pragma unroll
            for (int ni = 0; ni < 8; ++ni) acc[ni] = (f32x4){0.f, 0.f, 0.f, 0.f};
#pragma unroll
            for (int ks = 0; ks < 2; ++ks) {
                const bf16x8 a = ldsfrag(lds + G_WT, 16 * wid + c, 144, 32 * ks + 8 * g);
#pragma unroll
                for (int ni = 0; ni < 8; ++ni) acc[ni] = mfma16(a, ldsfrag(lds + G_KRT, 16 * ni + c, 144, 32 * ks + 8 * g), acc[ni]);
            }
            if (ch > 0) {
                u16* Mg = (u16*)((unsigned char*)p.out + DO_M) + ((size_t)bh * 128 + (ch - 1)) * 16384;
                const float cd = SC[384];
                const int gp = ((g & 1) << 1) | (g >> 1);
#pragma unroll
                for (int ni = 0; ni < 8; ++ni) {
                    const int i = 16 * ni + c, j0 = 16 * wid + 4 * g;
                    float v[4];
#pragma unroll
                    for (int r = 0; r < 4; ++r) v[r] = ((i == j0 + r) ? cd : 0.f) - acc[ni][r];
                    u32x2 w; w.x = pk2(v[0], v[1]); w.y = pk2(v[2], v[3]);
                    *(u32x2*)(Mg + (size_t)i * 128 + 16 * wid + 4 * gp) = w;
                }
            }
        }
        {
            f32x4 acc[8];
#pragma unroll
            for (int ni = 0; ni < 8; ++ni) acc[ni] = (f32x4){0.f, 0.f, 0.f, 0.f};
#pragma unroll
            for (int ks = 0; ks < 2; ++ks) {
                const bf16x8 a = ldsfrag(lds + G_KRT, 16 * wid + c, 144, 32 * ks + 8 * g);
#pragma unroll
                for (int ni = 0; ni < 8; ++ni) acc[ni] = mfma16(a, ldsfrag(lds + G_UT, 16 * ni + c, 144, 32 * ks + 8 * g), acc[ni]);
            }
            u16* NT = (u16*)(p.ws + WS_NS) + ((size_t)bh * NCH + ch) * 16384;
#pragma unroll
            for (int ni = 0; ni < 8; ++ni) {
                u32x2 w; w.x = pk2(acc[ni][0], acc[ni][1]); w.y = pk2(acc[ni][2], acc[ni][3]);
                *(u32x2*)(NT + (size_t)(16 * ni + c) * 128 + 16 * wid + 4 * g) = w;
            }
        }
    } else {
        {
            f32x4 acc[4];
#pragma unroll
            for (int ni = 0; ni < 4; ++ni) acc[ni] = (f32x4){0.f, 0.f, 0.f, 0.f};
#pragma unroll
            for (int ks = 0; ks < 2; ++ks) {
                const bf16x8 a = ldsfrag(lds + G_WT, 16 * wid + c, 144, 32 * ks + 8 * g);
#pragma unroll
                for (int ni = 0; ni < 4; ++ni) acc[ni] = mfma16(a, ldsfrag(lds + G_QKT, 16 * ni + c, 144, 32 * ks + 8 * g), acc[ni]);
            }
            u16* QT = (u16*)(lds + G_QT);
#pragma unroll
            for (int ni = 0; ni < 4; ++ni) {
                const int t = 16 * ni + c, j0 = 16 * wid + 4 * g;
                const float qs = SC[320 + t] * 0.08838834764831845f * SC[128 + t];
                u32x2* qp = (u32x2*)(QT + t * 136 + j0);
                const u32x2 q = *qp;
                u32x2 w;
                w.x = pk2(bflo(q.x) * qs - acc[ni][0], bfhi(q.x) * qs - acc[ni][1]);
                w.y = pk2(bflo(q.y) * qs - acc[ni][2], bfhi(q.y) * qs - acc[ni][3]);
                *qp = w;
            }
        }
        __syncthreads();
        {
            const int tt = wid & 3, dvh = wid >> 2;
            f32x4 acc[4];
#pragma unroll
            for (int ni = 0; ni < 4; ++ni) acc[ni] = (f32x4){0.f, 0.f, 0.f, 0.f};
#pragma unroll
            for (int ks = 0; ks < 2; ++ks) {
                const bf16x8 a = ldsfrag(lds + G_QKT, 16 * tt + c, 144, 32 * ks + 8 * g);
#pragma unroll
                for (int ni = 0; ni < 4; ++ni) acc[ni] = mfma16(a, ldsfrag(lds + G_UT, 16 * (4 * dvh + ni) + c, 144, 32 * ks + 8 * g), acc[ni]);
            }
            if (ch > 0) {
#pragma unroll
                for (int ks = 0; ks < 4; ++ks) {
                    const bf16x8 a = ldsfrag(lds + G_QT, 16 * tt + c, 272, 32 * ks + 8 * g);
#pragma unroll
                    for (int ni = 0; ni < 4; ++ni) acc[ni] = mfma16(a, ldsfrag(lds + G_ST, 16 * (4 * dvh + ni) + c, 272, 32 * ks + 8 * g), acc[ni]);
                }
            }
            float ss[4];
#pragma unroll
            for (int r = 0; r < 4; ++r) {
                float s = 0.f;
#pragma unroll
                for (int ni = 0; ni < 4; ++ni) s += acc[ni][r] * acc[ni][r];
                s += __shfl_xor(s, 1); s += __shfl_xor(s, 2); s += __shfl_xor(s, 4); s += __shfl_xor(s, 8);
                ss[r] = s;
            }
            if (c == 0) {
#pragma unroll
                for (int r = 0; r < 4; ++r) SC[400 + dvh * 64 + 16 * tt + 4 * g + r] = ss[r];
            }
            __syncthreads();
            u16* OG = (u16*)((unsigned char*)p.out + DO_OG);
#pragma unroll
            for (int r = 0; r < 4; ++r) {
                const int t = 16 * tt + 4 * g + r;
                const float rstd = rsqrtf((SC[400 + t] + SC[464 + t]) * (1.f / 128.f) + RMS_EPS);
#pragma unroll
                for (int ni = 0; ni < 4; ++ni) {
                    const int dv = 16 * (4 * dvh + ni) + c;
                    const float z = bf2f(P0[(row0 + t) * 4096 + 3072 + h * 128 + dv]);
                    OG[(row0 + t) * 1024 + h * 128 + dv] = f2bf(acc[ni][r] * rstd * p.gdn_o_norm[dv] * silu(z));
                }
            }
        }
    }
    __syncthreads();
}
template <int MODE> DI void phase_gdn_chunks(const Params& p, unsigned char* lds) {
    for (int u = blockIdx.x; u < 16 * NCH; u += gridDim.x) gdn_chunk_unit<MODE>(p, u / NCH, u % NCH, lds);
}

DI void phase_gdn_scan(const Params& p, unsigned char* lds) {
    if (blockIdx.x >= 16) return;
    const int bh = blockIdx.x, tid = tid_opaque(), lane = tid & 63, wid = tid >> 6, col = lane & 31, hh = lane >> 5;
    const u16* Mg = (const u16*)((unsigned char*)p.out + DO_M) + (size_t)bh * 128 * 16384;
    u16* NS = (u16*)(p.ws + WS_NS) + (size_t)bh * NCH * 16384;
    u32x4 mr[4];
    f32x16 acc[4];
#pragma unroll
    for (int i = 0; i < 4; ++i) { const int id = tid + NTHREADS * i; mr[i] = *(const u32x4*)(Mg + (size_t)(id >> 4) * 128 + (id & 15) * 8); }
#pragma unroll
    for (int i = 0; i < 4; ++i) { const int id = tid + NTHREADS * i; *(u32x4*)(lds + (id >> 4) * 272 + (id & 15) * 16) = mr[i]; }
    if (wid < 4) {
        const u16* s0 = NS + (size_t)(32 * wid + col) * 128;
#pragma unroll
        for (int blk = 0; blk < 4; ++blk)
#pragma unroll
            for (int q = 0; q < 4; ++q) {
                const u32x2 w = *(const u32x2*)(s0 + 32 * blk + 8 * q + 4 * hh);
                acc[blk][4 * q + 0] = bflo(w.x); acc[blk][4 * q + 1] = bfhi(w.x); acc[blk][4 * q + 2] = bflo(w.y); acc[blk][4 * q + 3] = bfhi(w.y);
            }
    }
    __syncthreads();
    for (int cc = 1; cc < 128; ++cc) {
        const unsigned char* cur = lds + ((cc - 1) & 1) * 34816;
        unsigned char* nxt = lds + (cc & 1) * 34816;
        if (cc < 127) {
            const u16* Mn = Mg + (size_t)cc * 16384;
#pragma unroll
            for (int i = 0; i < 4; ++i) { const int id = tid + NTHREADS * i; mr[i] = *(const u32x4*)(Mn + (size_t)(id >> 4) * 128 + (id & 15) * 8); }
        }
        if (wid < 4) {
            u16* slot = NS + (size_t)cc * 16384 + (size_t)(32 * wid + col) * 128;
            f32x16 nw[4];
#pragma unroll
            for (int blk = 0; blk < 4; ++blk)
#pragma unroll
                for (int q = 0; q < 4; ++q) {
                    const u32x2 w = *(const u32x2*)(slot + 32 * blk + 8 * q + 4 * hh);
                    nw[blk][4 * q + 0] = bflo(w.x); nw[blk][4 * q + 1] = bfhi(w.x); nw[blk][4 * q + 2] = bflo(w.y); nw[blk][4 * q + 3] = bfhi(w.y);
                }
            bf16x8 bfr[8];
#pragma unroll
            for (int ks = 0; ks < 8; ++ks) {
                const int blk = ks >> 1, s = ks & 1;
#pragma unroll
                for (int j = 0; j < 8; ++j) bfr[ks][j] = (short)f2bf(acc[blk][8 * s + j]);
            }
#pragma unroll
            for (int ob = 0; ob < 4; ++ob)
#pragma unroll
                for (int ks = 0; ks < 8; ++ks) {
                    const bf16x8 a = *(const bf16x8*)(cur + (32 * ob + col) * 272 + (16 * ks + 8 * hh) * 2);
                    nw[ob] = __builtin_amdgcn_mfma_f32_32x32x16_bf16(a, bfr[ks], nw[ob], 0, 0, 0);
                }
#pragma unroll
            for (int blk = 0; blk < 4; ++blk) {
#pragma unroll
                for (int q = 0; q < 4; ++q) {
                    u32x2 w; w.x = pk2(nw[blk][4 * q], nw[blk][4 * q + 1]); w.y = pk2(nw[blk][4 * q + 2], nw[blk][4 * q + 3]);
                    *(u32x2*)(slot + 32 * blk + 8 * q + 4 * hh) = w;
                }
                acc[blk] = nw[blk];
            }
        }
        if (cc < 127) {
#pragma unroll
            for (int i = 0; i < 4; ++i) { const int id = tid + NTHREADS * i; *(u32x4*)(nxt + (id >> 4) * 272 + (id & 15) * 16) = mr[i]; }
        }
        __syncthreads();
    }
}

template <bool ADDY, bool ROUTE>
DI void phase_norm(const Params& p, const float* gain, int layer, unsigned char* lds) {
    const int tid = tid_opaque(), lane = tid & 63, wid = tid >> 6;
    float* H = (float*)(p.ws + WS_H);
    u16* HN = (u16*)(p.ws + WS_HN);
    const u16* Y = (const u16*)(p.ws + WS_P0 + P0_Y);
    float* xs = (float*)lds;
    float* part = (float*)(lds + 32768);
    float* logit = (float*)(lds + 32768 + 9216);
    const float* wg = p.moe_w_group + (size_t)layer * 1024 * 4;
    const float* we = p.moe_w_expert + (size_t)layer * 1024 * 32;
    for (int base = blockIdx.x * 8; base < TP; base += gridDim.x * 8) {
        const int row = base + wid;
        {
            f32x4 v[4];
            float ss = 0.f;
#pragma unroll
            for (int i = 0; i < 4; ++i) {
                const int col = 4 * lane + 256 * i;
                v[i] = *(const f32x4*)(H + (size_t)row * DM + col);
                if (ADDY) {
                    const u32x2 y0 = *(const u32x2*)(Y + (size_t)(2 * row) * DM + col), y1 = *(const u32x2*)(Y + (size_t)(2 * row + 1) * DM + col);
                    const int pp = row % LP;
                    if (pp >= 48) {
                        v[i][0] += bflo(y0.x) + bflo(y1.x); v[i][1] += bfhi(y0.x) + bfhi(y1.x); v[i][2] += bflo(y0.y) + bflo(y1.y); v[i][3] += bfhi(y0.y) + bfhi(y1.y);
                        *(f32x4*)(H + (size_t)row * DM + col) = v[i];
                    }
                }
                ss += v[i][0] * v[i][0] + v[i][1] * v[i][1] + v[i][2] * v[i][2] + v[i][3] * v[i][3];
            }
            ss = wave_sum(ss);
            const float rstd = rsqrtf(ss * (1.f / DM) + RMS_EPS);
#pragma unroll
            for (int i = 0; i < 4; ++i) {
                const int col = 4 * lane + 256 * i;
                const f32x4 gn = *(const f32x4*)(gain + col);
                const f32x4 o = (f32x4){v[i][0] * rstd * gn[0], v[i][1] * rstd * gn[1], v[i][2] * rstd * gn[2], v[i][3] * rstd * gn[3]};
                u32x2 w; w.x = pk2(o[0], o[1]); w.y = pk2(o[2], o[3]);
                *(u32x2*)(HN + (size_t)row * DM + col) = w;
                if (ROUTE) *(f32x4*)(xs + wid * 1024 + col) = o;
            }
        }
        if (ROUTE) {
            __syncthreads();
            {
                float a8[8];
#pragma unroll
                for (int r = 0; r < 8; ++r) a8[r] = 0.f;
                if (lane < 36) {
                    const float* wp = lane < 4 ? wg + lane : we + (lane - 4);
                    const int ws = lane < 4 ? 4 : 32;
                    for (int k = 128 * wid; k < 128 * wid + 128; k += 4) {
                        const float w0 = wp[(size_t)k * ws], w1 = wp[(size_t)(k + 1) * ws], w2 = wp[(size_t)(k + 2) * ws], w3 = wp[(size_t)(k + 3) * ws];
#pragma unroll
                        for (int r = 0; r < 8; ++r) {
                            const f32x4 x4 = *(const f32x4*)(xs + r * 1024 + k);
                            a8[r] += x4[0] * w0 + x4[1] * w1 + x4[2] * w2 + x4[3] * w3;
                        }
                    }
#pragma unroll
                    for (int r = 0; r < 8; ++r) part[(wid * 8 + r) * 36 + lane] = a8[r];
                }
            }
            __syncthreads();
            if (tid < 288) {
                const int r = tid / 36, n = tid - r * 36;
                float s = 0.f;
#pragma unroll
                for (int w = 0; w < 8; ++w) s += part[(w * 8 + r) * 36 + n];
                s += (n < 4) ? p.moe_b_group[layer * 4 + n] : p.moe_b_expert[layer * 32 + n - 4];
                logit[r * 36 + n] = s;
            }
            __syncthreads();
            if (tid < 8) {
                const int rr = base + tid, pp = rr % LP;
                if (pp >= 48) {
                    const float* lg = logit + tid * 36;
                    int gs = 0; float gm = lg[0];
#pragma unroll
                    for (int i = 1; i < 4; ++i) if (lg[i] > gm) { gm = lg[i]; gs = i; }
                    float gsum = 0.f;
#pragma unroll
                    for (int i = 0; i < 4; ++i) gsum += __expf(lg[i] - gm);
                    const float gw = 1.f / gsum;
                    const float* el = lg + 4 + 8 * gs;
                    int i0 = 0; float m0 = el[0];
#pragma unroll
                    for (int i = 1; i < 8; ++i) if (el[i] > m0) { m0 = el[i]; i0 = i; }
                    int i1 = -1; float m1 = -3.0e38f;
#pragma unroll
                    for (int i = 0; i < 8; ++i) if (i != i0 && el[i] > m1) { m1 = el[i]; i1 = i; }
                    const float e1 = __expf(m1 - m0);
                    const float c0 = gw / (1.f + e1), c1 = gw * e1 / (1.f + e1);
                    unsigned* cnt = (unsigned*)(p.ws + WS_CTL) + CW_CNT + layer * 32;
                    u32* list = (u32*)(p.ws + WS_LIST);
                    float* cw = (float*)(p.ws + WS_CW);
                    const int ea = 8 * gs + i0, eb = 8 * gs + i1;
                    const unsigned pa = atomicAdd(&cnt[ea], 1u);
                    list[(size_t)ea * TP + pa] = 2 * rr; cw[2 * rr] = c0;
                    const unsigned pb = atomicAdd(&cnt[eb], 1u);
                    list[(size_t)eb * TP + pb] = 2 * rr + 1; cw[2 * rr + 1] = c1;
                }
            }
            __syncthreads();
        }
    }
}

template <int STAGE>
DI void phase_moe(const Params& p, int layer, unsigned char* lds) {
    const int tid = tid_opaque(), lane = tid & 63, wid = tid >> 6, c = lane & 15, g = lane >> 4, wm = wid >> 2, wn = wid & 3;
    int* tl = (int*)(lds + 2 * (128 + 256) * 144);
    int* pre = tl + 256;
    const unsigned* cnt = (const unsigned*)(p.ws + WS_CTL) + CW_CNT + layer * 32;
    if (tid < 32) pre[64 + tid] = (int)cnt[tid];
    __syncthreads();
    if (tid == 0) { int s = 0; for (int e = 0; e < 32; ++e) { pre[e] = s; s += (pre[64 + e] + 255) >> 8; } pre[32] = s; }
    __syncthreads();
    constexpr int FT = STAGE == 0 ? 4 : 8;
    const int ntiles = pre[32] * FT;
    const u32* list = (const u32*)(p.ws + WS_LIST);
    const float* cw = (const float*)(p.ws + WS_CW);
    const u16* HN = (const u16*)(p.ws + WS_HN);
    u16* ACT = (u16*)(p.ws + WS_P0 + P0_ACT);
    u16* Y = (u16*)(p.ws + WS_P0 + P0_Y);
    for (int t = blockIdx.x; t < ntiles; t += gridDim.x) {
        const int rtile = t / FT, ft = t - rtile * FT;
        int e = 0;
        for (int i = 1; i < 32; ++i) if (pre[i] <= rtile) e = i;
        const int rt = rtile - pre[e], ne = pre[64 + e];
        if (tid < 256) { const int gi = rt * 256 + tid; tl[tid] = gi < ne ? (int)list[(size_t)e * TP + gi] : -1; }
        __syncthreads();
        GemmAcc<4> acc;
        if (STAGE == 0) {
            const u16* W = (const u16*)(p.ws + WS_P0 + P0_WGU) + (size_t)e * 512 * 1024;
            const int f0 = ft * 64;
            auto pf = [=](int lr) -> u32 { const int x = lr & 63, w = lr >> 6; return (u32)((x < 32 ? f0 + w * 32 + x : 256 + f0 + w * 32 + (x - 32)) * 1024); };
            auto qf = [=](int n) -> u32 { const int a = tl[n]; return (u32)((a < 0 ? (tl[0] >> 1) : (a >> 1)) * 1024); };
            gemm_tile<4>(W, HN, 16, pf, qf, acc, lds);
#pragma unroll
            for (int ni = 0; ni < 4; ++ni) {
                const int a = tl[wn * 64 + 16 * ni + c];
                if (a < 0) continue;
                const float cwa = cw[a];
#pragma unroll
                for (int mi = 0; mi < 2; ++mi) {
                    const f32x4 gt = acc.a[mi][ni], up = acc.a[mi + 2][ni];
                    u32x2 w;
                    w.x = pk2(silu(gt[0]) * up[0] * cwa, silu(gt[1]) * up[1] * cwa);
                    w.y = pk2(silu(gt[2]) * up[2] * cwa, silu(gt[3]) * up[3] * cwa);
                    *(u32x2*)(ACT + (size_t)a * 256 + f0 + wm * 32 + 16 * mi + 4 * g) = w;
                }
            }
        } else {
            const u16* W = (const u16*)(p.ws + WS_P0 + P0_WDN) + (size_t)e * 1024 * 256;
            auto qf = [=](int n) -> u32 { const int a = tl[n]; return (u32)((a < 0 ? tl[0] : a) * 256); };
            gemm_tile<4>(W, ACT, 4, LinRow{(u32)(ft * 128) * 256u, 256u}, qf, acc, lds);
#pragma unroll
            for (int ni = 0; ni < 4; ++ni) {
                const int a = tl[wn * 64 + 16 * ni + c];
                if (a < 0) continue;
#pragma unroll
                for (int mi = 0; mi < 4; ++mi) {
                    const f32x4 v = acc.a[mi][ni];
                    u32x2 w; w.x = pk2(v[0], v[1]); w.y = pk2(v[2], v[3]);
                    *(u32x2*)(Y + (size_t)a * 1024 + ft * 128 + wm * 64 + 16 * mi + 4 * g) = w;
                }
            }
        }
        __syncthreads();
    }
}

DI void phase_post1(const Params& p, unsigned char* lds) {
    const int lane = tid_opaque() & 63, wid = tid_opaque() >> 6;
    const float* KRAW = (const float*)(p.ws + WS_P0 + P0_KRAW);
    const float* KIRAW = (const float*)((unsigned char*)p.out + DO_KIRAW);
    u16* KN = (u16*)((unsigned char*)p.out + DO_KN);
    _Float16* KI = (_Float16*)((unsigned char*)p.out + DO_KI);
    for (int row = blockIdx.x * 8 + wid; row < TP; row += gridDim.x * 8) {
        const f32x4 k = *(const f32x4*)(KRAW + (size_t)row * 256 + 4 * lane);
        float ss = k[0] * k[0] + k[1] * k[1] + k[2] * k[2] + k[3] * k[3];
#pragma unroll
        for (int o = 16; o >= 1; o >>= 1) ss += __shfl_xor(ss, o);
        const float rstd = rsqrtf(ss * (1.f / 128.f) + RMS_EPS);
        const int d = (4 * lane) & 127;
        const f32x4 kg = *(const f32x4*)(p.dsa_k_norm + d), qg = *(const f32x4*)(p.dsa_q_norm + d);
        u32x2 w; w.x = pk2(k[0] * rstd * kg[0] * qg[0], k[1] * rstd * kg[1] * qg[1]); w.y = pk2(k[2] * rstd * kg[2] * qg[2], k[3] * rstd * kg[3] * qg[3]);
        *(u32x2*)(KN + (size_t)row * 256 + 4 * lane) = w;
        const float x = KIRAW[(size_t)row * 64 + lane];
        const float mu = wave_sum(x) * (1.f / 64.f);
        const float xc = x - mu;
        const float var = wave_sum(xc * xc) * (1.f / 64.f);
        KI[(size_t)row * 64 + lane] = (_Float16)(xc * rsqrtf(var + RMS_EPS) * p.dsa_ln_g[lane] + p.dsa_ln_b[lane]);
    }
}

constexpr int IX_HIST = 0;
constexpr int IX_SEL = 65536;
constexpr int IX_CV = IX_SEL + 16384;
constexpr int IX_CI = IX_CV + 16384;
constexpr int IX_CNT = IX_CI + 8192;
constexpr int IX_QI = IX_CNT + 512;
DI int score_bin(float s) { return (int)fminf(fmaxf((s + 8.f) * 64.f, 0.f), 1023.f); }
template <int PASS>
DI void index_pass(const _Float16* __restrict__ KIb, int ktiles, int wid, int lane, const float (&w8)[8], unsigned char* lds) {
    const int q = lane & 31, hh = lane >> 5;
    u32* hist = (u32*)(lds + IX_HIST);
    u16* sell = (u16*)(lds + IX_SEL);
    float* cv = (float*)(lds + IX_CV);
    u16* ci = (u16*)(lds + IX_CI);
    int* cn = (int*)(lds + IX_CNT);
    const int tbq = (PASS == 1) ? cn[64 + q] : 0;
    for (int kt = 1 + wid; kt < ktiles; kt += 8) {
        f16x8 a[4];
#pragma unroll
        for (int s = 0; s < 4; ++s) a[s] = *(const f16x8*)(KIb + (size_t)(32 * kt + q) * 64 + 16 * s + 8 * hh);
        float sc[16];
#pragma unroll
        for (int r = 0; r < 16; ++r) sc[r] = 0.f;
#pragma unroll
        for (int hd = 0; hd < 8; ++hd) {
            f32x16 d;
#pragma unroll
            for (int r = 0; r < 16; ++r) d[r] = 0.f;
#pragma unroll
            for (int s = 0; s < 4; ++s) d = __builtin_amdgcn_mfma_f32_32x32x16_f16(a[s], *(const f16x8*)(lds + IX_QI + q * 1040 + hd * 128 + s * 32 + hh * 16), d, 0, 0, 0);
#pragma unroll
            for (int r = 0; r < 16; ++r) sc[r] += w8[hd] * fmaxf(d[r], 0.f);
            if (hd & 1) __builtin_amdgcn_sched_barrier(0);
        }
#pragma unroll
        for (int r = 0; r < 16; ++r) {
            const int kr = (r & 3) + 8 * (r >> 2) + 4 * hh;
            const int key = 32 * kt + kr;
            if (key < 48) continue;
            const int bin = score_bin(sc[r]);
            if (PASS == 0) atomicAdd(&hist[q * 512 + (bin >> 1)], 1u << (16 * (bin & 1)));
            else {
                if (bin > tbq) { const int pos = atomicAdd(&cn[q], 1); if (pos < 256) sell[q * 256 + pos] = (u16)key; }
                else if (bin == tbq) { const int pos = atomicAdd(&cn[32 + q], 1); if (pos < 128) { cv[q * 128 + pos] = sc[r]; ci[q * 128 + pos] = (u16)key; } }
            }
        }
    }
}
DI void index_unit(const Params& p, int b, int ch, int half, unsigned char* lds) {
    const int tid = tid_opaque(), lane = tid & 63, wid = tid >> 6;
    u16* SEL = (u16*)((unsigned char*)p.out + DO_SEL);
    const int qrow0 = b * LP + 64 * ch + 32 * half;
    const int nkeys = 64 * (ch + 1) - 48;
    if (nkeys <= 256) {
        for (int i = tid; i < 32 * 256; i += NTHREADS) { const int qq = i >> 8, s = i & 255; SEL[(size_t)(qrow0 + qq) * 256 + s] = (u16)(s < nkeys ? 48 + s : 48); }
        return;
    }
    u32* hist = (u32*)(lds + IX_HIST);
    int* cn = (int*)(lds + IX_CNT);
    for (int i = tid; i < 32 * 512; i += NTHREADS) hist[i] = 0u;
    if (tid < 128) cn[tid] = 0;
    { u16* sell0 = (u16*)(lds + IX_SEL); for (int i = tid; i < 32 * 256; i += NTHREADS) sell0[i] = 48; }
    const _Float16* QI = (const _Float16*)(p.ws + WS_P0 + P0_QI);
    const float* WI = (const float*)((unsigned char*)p.out + DO_WI);
    const _Float16* KIb = (const _Float16*)((unsigned char*)p.out + DO_KI) + (size_t)b * LP * 64;
    const int q = lane & 31;
    float w8[8];
#pragma unroll
    for (int hd = 0; hd < 8; ++hd) w8[hd] = WI[(size_t)(qrow0 + q) * 8 + hd];
#pragma unroll
    for (int i = 0; i < 4; ++i) { const int id = tid + NTHREADS * i, rr = id >> 6, cc = id & 63; *(u32x4*)(lds + IX_QI + rr * 1040 + cc * 16) = *(const u32x4*)(QI + (size_t)(qrow0 + rr) * 512 + cc * 8); }
    const int ktiles = 2 * (ch + 1);
    __syncthreads();
    index_pass<0>(KIb, ktiles, wid, lane, w8, lds);
    __syncthreads();
    for (int qi = 0; qi < 4; ++qi) {
        const int qq = 4 * wid + qi;
        u32 hw[8];
        int cl = 0;
#pragma unroll
        for (int i = 0; i < 8; ++i) { hw[i] = hist[qq * 512 + 8 * lane + i]; cl += (int)(hw[i] & 0xffffu) + (int)(hw[i] >> 16); }
        int suf = cl;
#pragma unroll
        for (int o = 1; o < 64; o <<= 1) { const int t = __shfl_down(suf, o); if (lane + o < 64) suf += t; }
        const int above = suf - cl;
        if (above < 256 && above + cl >= 256) {
            int acc = above, tb = 16 * lane, na = above;
#pragma unroll
            for (int i = 15; i >= 0; --i) {
                const int cb = (int)((hw[i >> 1] >> (16 * (i & 1))) & 0xffffu);
                if (acc < 256 && acc + cb >= 256) { tb = 16 * lane + i; na = acc; }
                acc += cb;
            }
            cn[64 + qq] = tb; cn[96 + qq] = na;
        }
    }
    __syncthreads();
    index_pass<1>(KIb, ktiles, wid, lane, w8, lds);
    __syncthreads();
    {
        u16* sell = (u16*)(lds + IX_SEL);
        const float* cv = (const float*)(lds + IX_CV);
        const u16* ci = (const u16*)(lds + IX_CI);
        for (int qi = 0; qi < 4; ++qi) {
            const int qq = 4 * wid + qi;
            const int na = cn[96 + qq], need = 256 - na;
            int nc = cn[32 + qq]; nc = nc < 128 ? nc : 128;
#pragma unroll
            for (int half2 = 0; half2 < 2; ++half2) {
                const int i = lane + 64 * half2;
                if (i < nc) {
                    const float vi = cv[qq * 128 + i]; const int ki = ci[qq * 128 + i];
                    int rank = 0;
                    for (int j = 0; j < nc; ++j) { const float vj = cv[qq * 128 + j]; const int kj = ci[qq * 128 + j]; rank += (vj > vi || (vj == vi && kj < ki)) ? 1 : 0; }
                    if (rank < need) sell[qq * 256 + na + rank] = (u16)ki;
                }
            }
        }
    }
    __syncthreads();
    {
        const u32x4* src = (const u32x4*)(lds + IX_SEL);
        u32x4* dst = (u32x4*)(SEL + (size_t)qrow0 * 256);
        for (int i = tid; i < 1024; i += NTHREADS) dst[i] = src[i];
    }
    __syncthreads();
}
DI void phase_index(const Params& p, unsigned char* lds) {
    const int G = gridDim.x;
    for (int r = 0;; ++r) {
        const int u = (r & 1) ? r * G + (G - 1 - (int)blockIdx.x) : r * G + (int)blockIdx.x;
        if (r * G >= 516) break;
        if (u < 516) index_unit(p, (u >> 1) & 1, 128 - (u >> 2), u & 1, lds);
    }
}

DI int t5_bucket(int rel) {
    const int n = rel < 0 ? -rel : rel;
    const int base = rel > 0 ? 16 : 0;
    const int lg = 8 + (n >= 12) + (n >= 16) + (n >= 23) + (n >= 32) + (n >= 46) + (n >= 64) + (n >= 91);
    return base + (n < 8 ? n : lg);
}
DI void phase_attn(const Params& p, unsigned char* lds) {
    const int tid = tid_opaque(), lane = tid & 63, wid = tid >> 6, c = lane & 15, g = lane >> 4;
    u16* widx = (u16*)(lds + wid * 4608);
    float* Pl = (float*)(lds + wid * 4608 + 512);
    const u16* SEL = (const u16*)((unsigned char*)p.out + DO_SEL);
    const u16* QRAW = (const u16*)(p.ws + WS_P0 + P0_QRAW);
    const u16* KN = (const u16*)((unsigned char*)p.out + DO_KN);
    const u16* VN = (const u16*)(p.ws + WS_P0 + P0_VN);
    u16* OA = (u16*)((unsigned char*)p.out + DO_OG);
    for (int row = blockIdx.x * 8 + wid; row < TP; row += gridDim.x * 8) {
        const int b = row / LP, pq = row - b * LP;
        if (pq < 48) {
#pragma unroll
            for (int i = 0; i < 2; ++i) *(u32x4*)(OA + (size_t)row * 1024 + 8 * lane + 512 * i) = (u32x4){0u, 0u, 0u, 0u};
            continue;
        }
        const int chq = pq >> 6, nkeys = 64 * (chq + 1) - 48, nsel = nkeys < 256 ? nkeys : 256;
        *(u32x2*)(widx + 4 * lane) = *(const u32x2*)(SEL + (size_t)row * 256 + 4 * lane);
        const size_t kb = (size_t)b * LP;
        for (int n = 0; n < 2; ++n) {
            bf16x8 qf[4];
            float ssq = 0.f;
#pragma unroll
            for (int s = 0; s < 4; ++s) {
                if (c < 4) {
                    const u32x4 w = *(const u32x4*)(QRAW + (size_t)row * 1024 + (4 * n + c) * 128 + 32 * s + 8 * g);
                    qf[s] = __builtin_bit_cast(bf16x8, w);
                    ssq += bflo(w.x) * bflo(w.x) + bfhi(w.x) * bfhi(w.x) + bflo(w.y) * bflo(w.y) + bfhi(w.y) * bfhi(w.y)
                         + bflo(w.z) * bflo(w.z) + bfhi(w.z) * bfhi(w.z) + bflo(w.w) * bflo(w.w) + bfhi(w.w) * bfhi(w.w);
                } else qf[s] = (bf16x8){0, 0, 0, 0, 0, 0, 0, 0};
            }
            ssq += __shfl_xor(ssq, 16); ssq += __shfl_xor(ssq, 32);
            const float qscale = rsqrtf(ssq * (1.f / 128.f) + RMS_EPS) * 0.08838834764831845f;
            f32x4 lg[16];
#pragma unroll
            for (int kt = 0; kt < 16; ++kt) {
                const int kid = widx[16 * kt + c];
                const u16* kp = KN + (kb + kid) * 256 + n * 128 + 8 * g;
                f32x4 a4 = (f32x4){0.f, 0.f, 0.f, 0.f};
#pragma unroll
                for (int s = 0; s < 4; ++s) a4 = mfma16(*(const bf16x8*)(kp + 32 * s), qf[s], a4);
                lg[kt] = a4;
                if ((kt & 1) == 1) __builtin_amdgcn_sched_barrier(0);
            }
            float mx = -3.0e38f;
#pragma unroll
            for (int kt = 0; kt < 16; ++kt)
#pragma unroll
                for (int r = 0; r < 4; ++r) {
                    const int s = 16 * kt + 4 * g + r;
                    const int kid = widx[s];
                    const float bias = p.rel_bias[t5_bucket(kid - pq) * 8 + 4 * n + (c & 3)];
                    const float l = (s < nsel) ? lg[kt][r] * qscale + bias : -3.0e38f;
                    lg[kt][r] = l;
                    mx = fmaxf(mx, l);
                }
            mx = fmaxf(mx, __shfl_xor(mx, 16)); mx = fmaxf(mx, __shfl_xor(mx, 32));
            float sum = 0.f;
#pragma unroll
            for (int kt = 0; kt < 16; ++kt)
#pragma unroll
                for (int r = 0; r < 4; ++r) {
                    const int s = 16 * kt + 4 * g + r;
                    const float e = (s < nsel) ? __expf(lg[kt][r] - mx) : 0.f;
                    sum += e;
                    if (c < 4) Pl[s * 4 + c] = e;
                }
            sum += __shfl_xor(sum, 16); sum += __shfl_xor(sum, 32);
            float inv[4];
#pragma unroll
            for (int hd = 0; hd < 4; ++hd) inv[hd] = 1.f / __shfl(sum, hd);
            float o[4][2];
#pragma unroll
            for (int hd = 0; hd < 4; ++hd) { o[hd][0] = 0.f; o[hd][1] = 0.f; }
            const u16* vb = VN + kb * 256 + n * 128 + 2 * lane;
#pragma unroll 4
            for (int s = 0; s < nsel; ++s) {
                const int kid = widx[s];
                const u32 v2 = *(const u32*)(vb + (size_t)kid * 256);
                const f32x4 p4 = *(const f32x4*)(Pl + s * 4);
                const float v0 = bflo(v2), v1 = bfhi(v2);
#pragma unroll
                for (int hd = 0; hd < 4; ++hd) { o[hd][0] += p4[hd] * v0; o[hd][1] += p4[hd] * v1; }
            }
#pragma unroll
            for (int hd = 0; hd < 4; ++hd)
                *(u32*)(OA + (size_t)row * 1024 + (4 * n + hd) * 128 + 2 * lane) = pk2(o[hd][0] * inv[hd], o[hd][1] * inv[hd]);
        }
    }
}

DI void phase_final(const Params& p) {
    const float* H = (const float*)(p.ws + WS_H);
    const u16* Y = (const u16*)(p.ws + WS_P0 + P0_Y);
    for (size_t i = (size_t)blockIdx.x * NTHREADS + tid_opaque(); i < (size_t)2 * SEQ * 256; i += (size_t)gridDim.x * NTHREADS) {
        const size_t orow = i >> 8; const int col = (int)(i & 255) * 4;
        const int b = (int)(orow >> 13), s = (int)(orow & 8191);
        const size_t row = (size_t)b * LP + 64 + s;
        f32x4 v = *(const f32x4*)(H + row * DM + col);
        const u32x2 y0 = *(const u32x2*)(Y + (2 * row) * DM + col), y1 = *(const u32x2*)(Y + (2 * row + 1) * DM + col);
        v[0] += bflo(y0.x) + bflo(y1.x); v[1] += bfhi(y0.x) + bfhi(y1.x); v[2] += bflo(y0.y) + bflo(y1.y); v[3] += bfhi(y0.y) + bfhi(y1.y);
        *(f32x4*)(p.out + orow * DM + col) = v;
    }
}

__global__ void __launch_bounds__(NTHREADS, 2) mega(Params p) {
    extern __shared__ __attribute__((aligned(16))) unsigned char lds[];
    if (threadIdx.x < 4) ((volatile LAS unsigned*)(lds + LDS_BAR))[threadIdx.x] = 0u;
    __syncthreads();
    XcdBarrier bar = xcd_barrier_post((unsigned*)(p.ws + WS_CTL) + CW_BAR, (volatile LAS unsigned*)(lds + LDS_BAR));
    phase_prep(p, lds);                                                   xcd_barrier(bar);
    phase_gemm_in0(p, lds);                                               xcd_barrier(bar);
    phase_gdn_chunks<0>(p, lds);                                          xcd_barrier(bar);
    phase_gdn_scan(p, lds);                                               xcd_barrier(bar);
    phase_gdn_chunks<1>(p, lds);                                          xcd_barrier(bar);
    phase_gemm_out(p, (const u16*)(p.ws + WS_W_OUT0), (const u16*)((unsigned char*)p.out + DO_OG), lds);   xcd_barrier(bar);
    phase_norm<false, true>(p, p.norm_ffn, 0, lds);
    conv_moe_weights(p, 0, lds);                                          xcd_barrier(bar);
    phase_moe<0>(p, 0, lds);                                              xcd_barrier(bar);
    phase_moe<1>(p, 0, lds);                                              xcd_barrier(bar);
    phase_norm<true, false>(p, p.norm_mix + DM, 0, lds);
    conv_moe_weights(p, 1, lds);                                          xcd_barrier(bar);
    phase_gemm_in1(p, lds);                                               xcd_barrier(bar);
    phase_post1(p, lds);                                                  xcd_barrier(bar);
    phase_index(p, lds);                                                  xcd_barrier(bar);
    phase_attn(p, lds);                                                   xcd_barrier(bar);
    phase_gemm_out(p, (const u16*)(p.ws + WS_W_OUT1), (const u16*)((unsigned char*)p.out + DO_OG), lds);   xcd_barrier(bar);
    phase_norm<false, true>(p, p.norm_ffn + DM, 1, lds);                  xcd_barrier(bar);
    phase_moe<0>(p, 1, lds);                                              xcd_barrier(bar);
    phase_moe<1>(p, 1, lds);                                              xcd_barrier(bar);
    phase_final(p);
}

extern "C" void kernel_launch(void* const* d_in, const int* in_sizes, int n_in, void* d_out, int out_size, void* d_ws, size_t ws_size, hipStream_t stream) {
    static int grid = 0;
    if (grid == 0) {
        if (n_in != 23 || out_size != 2 * SEQ * DM || ws_size < WS_END) { fprintf(stderr, "kernel_launch: unexpected sizes (n_in %d out %d ws %zu need %zu)\n", n_in, out_size, ws_size, (size_t)WS_END); grid = -1; return; }
        int dev = 0, cus = 0;
        if (hipGetDevice(&dev) != hipSuccess || hipDeviceGetAttribute(&cus, hipDeviceAttributeMultiprocessorCount, dev) != hipSuccess) { grid = -1; return; }
        if (hipFuncSetAttribute((const void*)mega, hipFuncAttributeMaxDynamicSharedMemorySize, LDS_BYTES) != hipSuccess) { fprintf(stderr, "kernel_launch: hipFuncSetAttribute failed\n"); grid = -1; return; }
        grid = cus > 256 ? 256 : cus;
        if (grid < 16) { grid = -1; return; }
    }
    if (grid < 0) return;
    (void)hipMemsetAsync((unsigned char*)d_ws + WS_CTL, 0, CTL_BYTES, stream);
    Params p{};
    const float** f = (const float**)&p;
    for (int i = 0; i < 23; ++i) f[i] = (const float*)d_in[i];
    p.out = (float*)d_out; p.ws = (unsigned char*)d_ws;
    hipLaunchKernelGGL(mega, dim3(grid), dim3(NTHREADS), LDS_BYTES, stream, p);
}
```

```cpp
#include <hip/hip_runtime.h>
#include <stdint.h>
#include <stdio.h>

#define DI __device__ __forceinline__
#define LAS __attribute__((address_space(3)))
typedef unsigned short u16;
typedef unsigned int u32;
typedef short bf16x8 __attribute__((ext_vector_type(8)));
typedef _Float16 f16x8 __attribute__((ext_vector_type(8)));
typedef float f32x4 __attribute__((ext_vector_type(4)));
typedef float f32x16 __attribute__((ext_vector_type(16)));
typedef u32 u32x4 __attribute__((ext_vector_type(4)));
typedef u32 u32x2 __attribute__((ext_vector_type(2)));

constexpr int DM = 1024, SEQ = 8192, LP = 8256, TP = 16512, TPA = 16640, NCH = 129;
constexpr int NTHREADS = 512;
constexpr int LDS_BYTES = 155648;
constexpr int LDS_BAR = LDS_BYTES - 16;
constexpr float RMS_EPS = 1e-6f;

constexpr size_t WS_CTL = 0, CTL_BYTES = 1u << 20;
constexpr size_t WS_W_IN0 = CTL_BYTES;
constexpr size_t WS_W_OUT0 = WS_W_IN0 + (size_t)4224 * 1024 * 2;
constexpr size_t WS_W_IN1 = WS_W_OUT0 + (size_t)1024 * 1024 * 2;
constexpr size_t WS_W_OUT1 = WS_W_IN1 + (size_t)2176 * 1024 * 2;
constexpr size_t WS_BA = WS_W_OUT1 + (size_t)1024 * 1024 * 2;
constexpr size_t WS_LIST = WS_BA + (size_t)TPA * 16 * 4;
constexpr size_t WS_CW = WS_LIST + (size_t)32 * TP * 4;
constexpr size_t WS_H = WS_CW + (size_t)2 * TP * 4;
constexpr size_t WS_NS = WS_H + (size_t)TPA * 1024 * 4;
constexpr size_t WS_HN = WS_NS;
constexpr size_t WS_P0 = WS_NS + (size_t)16 * 129 * 128 * 128 * 2;
constexpr size_t WS_HALO = WS_P0 + (size_t)TPA * 4096 * 2;
constexpr size_t WS_END = WS_HALO + (size_t)2 * 129 * 3 * 3072 * 2;
constexpr size_t P0_WGU = 0;
constexpr size_t P0_WDN = P0_WGU + (size_t)32 * 512 * 1024 * 2;
constexpr size_t P0_ACT = P0_WDN + (size_t)32 * 1024 * 256 * 2;
constexpr size_t P0_Y = P0_ACT + (size_t)2 * TP * 256 * 2;
constexpr size_t P0_QRAW = P0_ACT;
constexpr size_t P0_KRAW = P0_QRAW + (size_t)TP * 1024 * 2;
constexpr size_t P0_VN = P0_KRAW + (size_t)TP * 256 * 4;
constexpr size_t P0_QI = P0_VN + (size_t)TP * 256 * 2;
static_assert(P0_Y + (size_t)2 * TP * 1024 * 2 <= (size_t)TPA * 4096 * 2, "P0 map");
static_assert(P0_QI + (size_t)TP * 512 * 2 <= (size_t)TPA * 4096 * 2, "P0 map 2");
constexpr size_t DO_M = 0;
constexpr size_t DO_OG = 0;
constexpr size_t DO_SEL = (size_t)TPA * 1024 * 2;
constexpr size_t DO_KN = DO_SEL + (size_t)TP * 256 * 2;
constexpr size_t DO_KI = DO_KN + (size_t)TP * 256 * 2;
constexpr size_t DO_WI = DO_KI + (size_t)TP * 64 * 2;
constexpr size_t DO_KIRAW = DO_WI + (size_t)TP * 8 * 4;
static_assert(DO_KIRAW + (size_t)TP * 64 * 4 <= (size_t)2 * SEQ * 1024 * 4, "d_out map");
constexpr int CW_BAR = 0;
constexpr int CW_CNT = 4096;
constexpr int CW_AQ = 4352;

struct Params {
    const float *x, *meta, *norm_mix, *norm_ffn, *rel_bias, *gdn_w_in, *gdn_conv, *gdn_a_log, *gdn_dt_bias, *gdn_o_norm, *gdn_w_out,
        *dsa_w_in, *dsa_q_norm, *dsa_k_norm, *dsa_ln_g, *dsa_ln_b, *dsa_w_out, *moe_w_group, *moe_b_group, *moe_w_expert, *moe_b_expert,
        *moe_w_gu, *moe_w_down;
    float* out;
    unsigned char* ws;
};

DI u16 f2bf(float f) { return __builtin_bit_cast(u16, (__bf16)f); }
DI float bf2f(u16 h) { return __uint_as_float(((u32)h) << 16); }
DI u32 pk2(float a, float b) { return (u32)f2bf(a) | ((u32)f2bf(b) << 16); }
DI float bflo(u32 w) { return __uint_as_float(w << 16); }
DI float bfhi(u32 w) { return __uint_as_float(w & 0xffff0000u); }
DI float wave_sum(float v) {
#pragma unroll
    for (int o = 32; o >= 1; o >>= 1) v += __shfl_xor(v, o);
    return v;
}
DI int tid_opaque() { int t = threadIdx.x; asm volatile("" : "+v"(t)); return t; }
DI float silu(float x) { return x / (1.f + __expf(-x)); }
DI f32x4 mfma16(bf16x8 a, bf16x8 b, f32x4 c) { return __builtin_amdgcn_mfma_f32_16x16x32_bf16(a, b, c, 0, 0, 0); }
DI bf16x8 ldsfrag(const unsigned char* base, int row, int strideB, int kel) { return *(const bf16x8*)(base + row * strideB + kel * 2); }

#define XB_TMO      128
#define XB_XCNT(j)  (256  + 64 * (j))
#define XB_XSUB(j)  (1280 + 64 * (j))
#define XB_XGEN(j)  (2304 + 64 * (j))
#define XB_TOP      3328
#define XB_TOPGEN   3392
#define XCD_BAR_WORDS 3456
#define XB_SPIN_CAP (1u << 21)
DI unsigned xb_ld(unsigned* p) { return __hip_atomic_load(p, __ATOMIC_RELAXED, __HIP_MEMORY_SCOPE_AGENT); }
DI unsigned xb_add(unsigned* p, unsigned v) { return __hip_atomic_fetch_add(p, v, __ATOMIC_RELAXED, __HIP_MEMORY_SCOPE_AGENT); }
DI unsigned xb_xcc_id() { return (unsigned)__builtin_amdgcn_s_getreg((3 << 11) | 20) & 0xFu; }
#define XB_SPIN(cond, bar) do { unsigned _sp = 0; while (cond) { __builtin_amdgcn_s_sleep(1); \
    if ((++_sp & 255u) == 0u) { if (xb_ld(&(bar)[XB_TMO])) break; if (_sp > XB_SPIN_CAP) { atomicAdd(&(bar)[XB_TMO], 1u); break; } } } } while (0)
struct XcdBarrier { unsigned* bar; unsigned x; volatile LAS unsigned* st; };
DI XcdBarrier xcd_barrier_post(unsigned* bar, volatile LAS unsigned* st) {
    XcdBarrier b; b.bar = bar; b.x = xb_xcc_id(); b.st = st;
    if (threadIdx.x == 0) (void)xb_add(&bar[XB_XCNT(b.x)], 1u);
    return b;
}
DI void xcd_barrier_complete(unsigned* bar, unsigned x, unsigned& nloc, unsigned& nx) {
    const unsigned G = gridDim.x * gridDim.y * gridDim.z;
    unsigned sum, cnt, mine, sp = 0u;
    for (;;) {
        sum = 0u; cnt = 0u; mine = 0u;
#pragma unroll
        for (unsigned j = 0; j < 16; ++j) { const unsigned c = xb_ld(&bar[XB_XCNT(j)]); sum += c; cnt += (c > 0u) ? 1u : 0u; mine = (j == x) ? c : mine; }
        if (sum == G) break;
        __builtin_amdgcn_s_sleep(1);
        if ((++sp & 255u) == 0u) { if (xb_ld(&bar[XB_TMO])) break; if (sp > XB_SPIN_CAP) { atomicAdd(&bar[XB_TMO], 1u); break; } }
    }
    nloc = mine > 0u ? mine : 1u; nx = cnt > 0u ? cnt : 1u;
}
DI void xcd_barrier(const XcdBarrier& b) {
    asm volatile("s_waitcnt vmcnt(0)" ::: "memory");
    __syncthreads();
    if (threadIdx.x == 0) {
        unsigned* bar = b.bar;
        __builtin_amdgcn_s_waitcnt(0);
        unsigned nloc = b.st[0], nx = b.st[1];
        if (nloc == 0u) { xcd_barrier_complete(bar, b.x, nloc, nx); b.st[0] = nloc; b.st[1] = nx; }
        const unsigned old = xb_add(&bar[XB_XSUB(b.x)], 1u);
        const unsigned gen = old / nloc;
        if (old + 1u == (gen + 1u) * nloc) {
            __builtin_amdgcn_fence(__ATOMIC_RELEASE, "agent");
            asm volatile("s_waitcnt vmcnt(0)" ::: "memory");
            const unsigned og = xb_add(&bar[XB_TOP], 1u);
            const unsigned tg = og / nx;
            if (og + 1u == (tg + 1u) * nx) xb_add(&bar[XB_TOPGEN], 1u);
            else XB_SPIN(xb_ld(&bar[XB_TOPGEN]) == tg, bar);
            __builtin_amdgcn_fence(__ATOMIC_ACQUIRE, "agent");
            xb_add(&bar[XB_XGEN(b.x)], 1u);
            asm volatile("s_waitcnt vmcnt(0)" ::: "memory");
        } else {
            XB_SPIN(xb_ld(&bar[XB_XGEN(b.x)]) == gen, bar);
            __builtin_amdgcn_fence(__ATOMIC_ACQUIRE, "agent");
            asm volatile("s_waitcnt vmcnt(0)" ::: "memory");
        }
    }
    __syncthreads();
}

DI void convT_unit(const float* __restrict__ src, int K, int N, u16* __restrict__ dst, int kt, int nt, unsigned char* lds) {
    float* tile = (float*)lds;
    const int tid = tid_opaque();
    const int k0 = kt * 64, n0 = nt * 64;
    {
        const int nn = tid & 63, kb = tid >> 6;
#pragma unroll
        for (int i = 0; i < 8; ++i) {
            const int kk = kb + 8 * i;
            const int n = n0 + nn;
            tile[kk * 65 + nn] = (n < N) ? src[(size_t)(k0 + kk) * N + n] : 0.f;
        }
    }
    __syncthreads();
    {
        const int kk2 = (tid & 31) * 2, nb = tid >> 5;
#pragma unroll
        for (int i = 0; i < 4; ++i) {
            const int nn = nb + 16 * i;
            const u32 w = pk2(tile[kk2 * 65 + nn], tile[(kk2 + 1) * 65 + nn]);
            *(u32*)(dst + (size_t)(n0 + nn) * K + k0 + kk2) = w;
        }
    }
    __syncthreads();
}

template <int NI> struct GemmAcc { f32x4 a[4][NI]; };
template <int NI, class PF, class QF>
DI void gemm_tile(const u16* __restrict__ Pb, const u16* __restrict__ Qb, int KT, PF pf, QF qf, GemmAcc<NI>& acc, unsigned char* lds) {
    constexpr int TN = 64 * NI, QC = TN * 8 / NTHREADS, BUF = (128 + TN) * 144;
    const int tid = tid_opaque(), lane = tid & 63, wid = tid >> 6, c = lane & 15, g = lane >> 4, wm = wid >> 2, wn = wid & 3;
    u32 poff[2], qoff[QC];
#pragma unroll
    for (int i = 0; i < 2; ++i) { const int id = tid + NTHREADS * i; poff[i] = pf(id >> 3) + (id & 7) * 8; }
#pragma unroll
    for (int i = 0; i < QC; ++i) { const int id = tid + NTHREADS * i; qoff[i] = qf(id >> 3) + (id & 7) * 8; }
    u32x4 pr[2], qr[QC];
#pragma unroll
    for (int mi = 0; mi < 4; ++mi)
#pragma unroll
        for (int ni = 0; ni < NI; ++ni) acc.a[mi][ni] = (f32x4){0.f, 0.f, 0.f, 0.f};
#pragma unroll
    for (int i = 0; i < 2; ++i) pr[i] = *(const u32x4*)(Pb + poff[i]);
#pragma unroll
    for (int i = 0; i < QC; ++i) qr[i] = *(const u32x4*)(Qb + qoff[i]);
#pragma unroll
    for (int i = 0; i < 2; ++i) { const int id = tid + NTHREADS * i; *(u32x4*)(lds + (id >> 3) * 144 + (id & 7) * 16) = pr[i]; }
#pragma unroll
    for (int i = 0; i < QC; ++i) { const int id = tid + NTHREADS * i; *(u32x4*)(lds + 128 * 144 + (id >> 3) * 144 + (id & 7) * 16) = qr[i]; }
    __syncthreads();
    for (int kt = 0; kt < KT; ++kt) {
        const unsigned char* cur = lds + (kt & 1) * BUF;
        unsigned char* nxt = lds + ((kt + 1) & 1) * BUF;
        if (kt + 1 < KT) {
#pragma unroll
            for (int i = 0; i < 2; ++i) pr[i] = *(const u32x4*)(Pb + poff[i] + (kt + 1) * 64);
#pragma unroll
            for (int i = 0; i < QC; ++i) qr[i] = *(const u32x4*)(Qb + qoff[i] + (kt + 1) * 64);
        }
#pragma unroll
        for (int ks = 0; ks < 2; ++ks) {
            bf16x8 af[4], bfr[NI];
#pragma unroll
            for (int mi = 0; mi < 4; ++mi) af[mi] = ldsfrag(cur, wm * 64 + 16 * mi + c, 144, 32 * ks + 8 * g);
#pragma unroll
            for (int ni = 0; ni < NI; ++ni) bfr[ni] = ldsfrag(cur + 128 * 144, wn * 16 * NI + 16 * ni + c, 144, 32 * ks + 8 * g);
#pragma unroll
            for (int mi = 0; mi < 4; ++mi)
#pragma unroll
                for (int ni = 0; ni < NI; ++ni) acc.a[mi][ni] = mfma16(af[mi], bfr[ni], acc.a[mi][ni]);
        }
        if (kt + 1 < KT) {
#pragma unroll
            for (int i = 0; i < 2; ++i) { const int id = tid + NTHREADS * i; *(u32x4*)(nxt + (id >> 3) * 144 + (id & 7) * 16) = pr[i]; }
#pragma unroll
            for (int i = 0; i < QC; ++i) { const int id = tid + NTHREADS * i; *(u32x4*)(nxt + 128 * 144 + (id >> 3) * 144 + (id & 7) * 16) = qr[i]; }
        }
        __syncthreads();
    }
}
struct LinRow { u32 base, ld; DI u32 operator()(int r) const { return base + (u32)r * ld; } };

DI void conv_small_weights(const Params& p, unsigned char* lds) {
    const int n0 = 16 * 66, n1 = 16 * 16, n2 = 16 * 34, n3 = 16 * 16;
    for (int u = blockIdx.x; u < n0 + n1 + n2 + n3; u += gridDim.x) {
        if (u < n0) convT_unit(p.gdn_w_in, 1024, 4112, (u16*)(p.ws + WS_W_IN0), u & 15, u >> 4, lds);
        else if (u < n0 + n1) { const int v = u - n0; convT_unit(p.gdn_w_out, 1024, 1024, (u16*)(p.ws + WS_W_OUT0), v & 15, v >> 4, lds); }
        else if (u < n0 + n1 + n2) { const int v = u - n0 - n1; convT_unit(p.dsa_w_in, 1024, 2120, (u16*)(p.ws + WS_W_IN1), v & 15, v >> 4, lds); }
        else { const int v = u - n0 - n1 - n2; convT_unit(p.dsa_w_out, 1024, 1024, (u16*)(p.ws + WS_W_OUT1), v & 15, v >> 4, lds); }
    }
}
DI void conv_moe_weights(const Params& p, int layer, unsigned char* lds) {
    const int ngu = 32 * 128, ndn = 32 * 64;
    for (int u = blockIdx.x; u < ngu + ndn; u += gridDim.x) {
        if (u < ngu) {
            const int e = u >> 7, v = u & 127;
            convT_unit(p.moe_w_gu + ((size_t)layer * 32 + e) * 1024 * 512, 1024, 512, (u16*)(p.ws + WS_P0 + P0_WGU) + (size_t)e * 512 * 1024, v & 15, v >> 4, lds);
        } else {
            const int w = u - ngu, e = w >> 6, v = w & 63;
            convT_unit(p.moe_w_down + ((size_t)layer * 32 + e) * 256 * 1024, 256, 1024, (u16*)(p.ws + WS_P0 + P0_WDN) + (size_t)e * 1024 * 256, v & 3, v >> 2, lds);
        }
    }
}
DI void phase_prep(const Params& p, unsigned char* lds) {
    conv_small_weights(p, lds);
    const int lane = tid_opaque() & 63, wid = tid_opaque() >> 6;
    float* H = (float*)(p.ws + WS_H);
    u16* HN = (u16*)(p.ws + WS_HN);
    for (int row = blockIdx.x * 8 + wid; row < TPA; row += gridDim.x * 8) {
        const int b = row / LP, pp = row - b * LP;
        const bool real = row < TP && pp >= 48;
        const float* src = real ? (pp < 64 ? p.meta + (size_t)(pp - 48) * DM : p.x + ((size_t)b * SEQ + (pp - 64)) * DM) : nullptr;
        f32x4 v[4];
        float ss = 0.f;
#pragma unroll
        for (int i = 0; i < 4; ++i) {
            v[i] = real ? *(const f32x4*)(src + 4 * lane + 256 * i) : (f32x4){0.f, 0.f, 0.f, 0.f};
            ss += v[i][0] * v[i][0] + v[i][1] * v[i][1] + v[i][2] * v[i][2] + v[i][3] * v[i][3];
        }
        ss = wave_sum(ss);
        const float rstd = rsqrtf(ss * (1.f / DM) + RMS_EPS);
#pragma unroll
        for (int i = 0; i < 4; ++i) {
            const int col = 4 * lane + 256 * i;
            *(f32x4*)(H + (size_t)row * DM + col) = v[i];
            const f32x4 gn = *(const f32x4*)(p.norm_mix + col);
            u32x2 w; w.x = pk2(v[i][0] * rstd * gn[0], v[i][1] * rstd * gn[1]); w.y = pk2(v[i][2] * rstd * gn[2], v[i][3] * rstd * gn[3]);
            *(u32x2*)(HN + (size_t)row * DM + col) = w;
        }
    }
}

DI void phase_gemm_in0(const Params& p, unsigned char* lds) {
    const u16* W = (const u16*)(p.ws + WS_W_IN0);
    const u16* X = (const u16*)(p.ws + WS_HN);
    u16* P0 = (u16*)(p.ws + WS_P0);
    float* BA = (float*)(p.ws + WS_BA);
    u16* HALO = (u16*)(p.ws + WS_HALO);
    const int lane = tid_opaque() & 63, wid = tid_opaque() >> 6, c = lane & 15, g = lane >> 4, wm = wid >> 2, wn = wid & 3;
    for (int t = blockIdx.x; t < 33 * 65; t += gridDim.x) {
        const int nt = t / 33, mt = t - nt * 33;
        GemmAcc<4> acc;
        gemm_tile<4>(W, X, 16, LinRow{(u32)(mt * 128) * 1024u, 1024u}, LinRow{(u32)(nt * 256) * 1024u, 1024u}, acc, lds);
#pragma unroll
        for (int mi = 0; mi < 4; ++mi) {
            const int f = mt * 128 + wm * 64 + 16 * mi + 4 * g;
#pragma unroll
            for (int ni = 0; ni < 4; ++ni) {
                const int tok = nt * 256 + wn * 64 + 16 * ni + c;
                const f32x4 v = acc.a[mi][ni];
                if (f < 4096) { u32x2 w; w.x = pk2(v[0], v[1]); w.y = pk2(v[2], v[3]); *(u32x2*)(P0 + (size_t)tok * 4096 + f) = w;
                    if (f < 3072 && tok < TP) { const int bb = tok / LP, pp = tok - bb * LP;
                        if ((pp & 63) >= 61 && (pp >> 6) < 128) *(u32x2*)(HALO + ((size_t)(bb * 129 + (pp >> 6) + 1) * 3 + ((pp & 63) - 61)) * 3072 + f) = w; } }
                else if (f < 4112) *(f32x4*)(BA + (size_t)tok * 16 + (f - 4096)) = v;
            }
        }
    }
}
DI void phase_gemm_out(const Params& p, const u16* W, const u16* X, unsigned char* lds) {
    float* H = (float*)(p.ws + WS_H);
    const int lane = tid_opaque() & 63, wid = tid_opaque() >> 6, c = lane & 15, g = lane >> 4, wm = wid >> 2, wn = wid & 3;
    for (int t = blockIdx.x; t < 8 * 130; t += gridDim.x) {
        const int nt = t >> 3, mt = t & 7;
        GemmAcc<2> acc;
        gemm_tile<2>(W, X, 16, LinRow{(u32)(mt * 128) * 1024u, 1024u}, LinRow{(u32)(nt * 128) * 1024u, 1024u}, acc, lds);
#pragma unroll
        for (int mi = 0; mi < 4; ++mi) {
            const int f = mt * 128 + wm * 64 + 16 * mi + 4 * g;
#pragma unroll
            for (int ni = 0; ni < 2; ++ni) {
                const int tok = nt * 128 + wn * 32 + 16 * ni + c;
                if (tok < TP) { f32x4* hp = (f32x4*)(H + (size_t)tok * DM + f); *hp = *hp + acc.a[mi][ni]; }
            }
        }
    }
}
DI void phase_gemm_in1(const Params& p, unsigned char* lds) {
    const u16* W = (const u16*)(p.ws + WS_W_IN1);
    const u16* X = (const u16*)(p.ws + WS_HN);
    u16* QRAW = (u16*)(p.ws + WS_P0 + P0_QRAW);
    float* KRAW = (float*)(p.ws + WS_P0 + P0_KRAW);
    u16* VN = (u16*)(p.ws + WS_P0 + P0_VN);
    _Float16* QI = (_Float16*)(p.ws + WS_P0 + P0_QI);
    float* KIRAW = (float*)((unsigned char*)p.out + DO_KIRAW);
    float* WI = (float*)((unsigned char*)p.out + DO_WI);
    const int lane = tid_opaque() & 63, wid = tid_opaque() >> 6, c = lane & 15, g = lane >> 4, wm = wid >> 2, wn = wid & 3;
    for (int t = blockIdx.x; t < 17 * 65; t += gridDim.x) {
        const int nt = t / 17, mt = t - nt * 17;
        GemmAcc<4> acc;
        gemm_tile<4>(W, X, 16, LinRow{(u32)(mt * 128) * 1024u, 1024u}, LinRow{(u32)(nt * 256) * 1024u, 1024u}, acc, lds);
#pragma unroll
        for (int mi = 0; mi < 4; ++mi) {
            const int f = mt * 128 + wm * 64 + 16 * mi + 4 * g;
#pragma unroll
            for (int ni = 0; ni < 4; ++ni) {
                const int tok = nt * 256 + wn * 64 + 16 * ni + c;
                if (tok >= TP) continue;
                const f32x4 v = acc.a[mi][ni];
                if (f < 1024) { u32x2 w; w.x = pk2(v[0], v[1]); w.y = pk2(v[2], v[3]); *(u32x2*)(QRAW + (size_t)tok * 1024 + f) = w; }
                else if (f < 1280) *(f32x4*)(KRAW + (size_t)tok * 256 + (f - 1024)) = v;
                else if (f < 1536) { u32x2 w; w.x = pk2(v[0], v[1]); w.y = pk2(v[2], v[3]); *(u32x2*)(VN + (size_t)tok * 256 + (f - 1280)) = w; }
                else if (f < 2048) {
                    _Float16* q = QI + (size_t)tok * 512 + (f - 1536);
                    q[0] = (_Float16)v[0]; q[1] = (_Float16)v[1]; q[2] = (_Float16)v[2]; q[3] = (_Float16)v[3];
                }
                else if (f < 2112) *(f32x4*)(KIRAW + (size_t)tok * 64 + (f - 2048)) = v;
                else if (f < 2120) *(f32x4*)(WI + (size_t)tok * 8 + (f - 2112)) = v * 0.04419417382415922f;
            }
        }
    }
}

constexpr int G_KT = 0, G_QT = 17408, G_KRT = 34816, G_VRT = 53248, G_LF = 71680, G_TF = 88320, G_TMP = 104960, G_TTW = 109184, G_TTU = 118400,
              G_QKT = 127616, G_SC = 136832;
constexpr int G_WT = G_LF, G_UT = G_LF + 18432;
constexpr int G_ST = G_KRT;
static_assert(G_UT + 18432 <= G_TTW, "WT/UT alias");
DI void gdn_prep_unit(const Params& p, int bh, int ch, unsigned char* lds) {
    const int tid = tid_opaque(), lane = tid & 63, wid = tid >> 6, c = lane & 15, g = lane >> 4;
    const int b = bh >> 3, h = bh & 7;
    const size_t row0 = (size_t)b * LP + (size_t)ch * 64;
    u16* P0 = (u16*)(p.ws + WS_P0);
    const u16* HALO = (const u16*)(p.ws + WS_HALO);
    float* SC = (float*)(lds + G_SC);
    float bb = 0.f, aa = 0.f;
    if (wid == 7) { const float* BA = (const float*)(p.ws + WS_BA); bb = BA[(row0 + lane) * 16 + h]; aa = BA[(row0 + lane) * 16 + 8 + h]; }
    {
        const int cp = tid & 63, part = tid >> 6;
        u32 raw[3][11];
        f32x4 wlo[3], whi[3];
#pragma unroll
        for (int X = 0; X < 3; ++X) {
            const int col = X * 1024 + h * 128 + 2 * cp;
#pragma unroll
            for (int i = 0; i < 11; ++i) {
                const int rr = 8 * part - 3 + i;
                raw[X][i] = rr < 0 ? (ch == 0 ? 0u : *(const u32*)(HALO + ((size_t)(b * 129 + ch) * 3 + (rr + 3)) * 3072 + col)) : *(const u32*)(P0 + (row0 + rr) * 4096 + col);
            }
#pragma unroll
            for (int j = 0; j < 4; ++j) { const float* wp = p.gdn_conv + j * 3072 + col; wlo[X][j] = wp[0]; whi[X][j] = wp[1]; }
        }
        if (wid == 7) {
            const float beta = 1.f / (1.f + __expf(-bb));
            const float xs = aa + p.gdn_dt_bias[h];
            const float sp = xs > 20.f ? xs : log1pf(__expf(xs));
            const float gg = -__expf(p.gdn_a_log[h]) * sp;
            float gc = gg;
#pragma unroll
            for (int o = 1; o < 64; o <<= 1) { const float t = __shfl_up(gc, o); if (lane >= o) gc += t; }
            const float glast = __shfl(gc, 63);
            SC[lane] = gc; SC[64 + lane] = beta; SC[128 + lane] = __expf(gc); SC[192 + lane] = __expf(glast - gc);
            if (lane == 0) SC[384] = __expf(glast);
        }
#pragma unroll
        for (int X = 0; X < 3; ++X) {
            u32 o[8];
#pragma unroll
            for (int i = 0; i < 8; ++i) {
                const float a0 = wlo[X][0] * bflo(raw[X][i]) + wlo[X][1] * bflo(raw[X][i + 1]) + wlo[X][2] * bflo(raw[X][i + 2]) + wlo[X][3] * bflo(raw[X][i + 3]);
                const float a1 = whi[X][0] * bfhi(raw[X][i]) + whi[X][1] * bfhi(raw[X][i + 1]) + whi[X][2] * bfhi(raw[X][i + 2]) + whi[X][3] * bfhi(raw[X][i + 3]);
                o[i] = pk2(silu(a0), silu(a1));
            }
            if (X < 2) {
                u16* T = (u16*)(lds + (X == 0 ? G_QT : G_KT));
#pragma unroll
                for (int i = 0; i < 8; ++i) *(u32*)(T + (8 * part + i) * 136 + 2 * cp) = o[i];
            }
            if (X >= 1) {
                u16* T = (u16*)(lds + (X == 1 ? G_KRT : G_VRT));
                u32x4 lo, hi;
                lo.x = (o[0] & 0xffffu) | (o[1] << 16); lo.y = (o[2] & 0xffffu) | (o[3] << 16); lo.z = (o[4] & 0xffffu) | (o[5] << 16); lo.w = (o[6] & 0xffffu) | (o[7] << 16);
                hi.x = (o[0] >> 16) | (o[1] & 0xffff0000u); hi.y = (o[2] >> 16) | (o[3] & 0xffff0000u); hi.z = (o[4] >> 16) | (o[5] & 0xffff0000u); hi.w = (o[6] >> 16) | (o[7] & 0xffff0000u);
                *(u32x4*)(T + (2 * cp) * 72 + 8 * part) = lo; *(u32x4*)(T + (2 * cp + 1) * 72 + 8 * part) = hi;
            }
        }
    }
    { float* TF = (float*)(lds + G_TF); for (int i = tid; i < 64 * 65; i += NTHREADS) TF[i] = 0.f; }
    __syncthreads();
    {
        const int rt = wid & 3;
        const unsigned char* Arow = lds + (wid < 4 ? G_KT : G_QT);
        f32x4 acc[4], qq = (f32x4){0.f, 0.f, 0.f, 0.f};
#pragma unroll
        for (int ni = 0; ni < 4; ++ni) acc[ni] = (f32x4){0.f, 0.f, 0.f, 0.f};
#pragma unroll
        for (int ks = 0; ks < 4; ++ks) {
            const bf16x8 a = ldsfrag(Arow, 16 * rt + c, 272, 32 * ks + 8 * g);
#pragma unroll
            for (int ni = 0; ni < 4; ++ni) acc[ni] = mfma16(a, ldsfrag(lds + G_KT, 16 * ni + c, 272, 32 * ks + 8 * g), acc[ni]);
            if (wid >= 4) qq = mfma16(a, a, qq);
        }
        {
            const f32x4 kd_ = rt == 0 ? acc[0] : (rt == 1 ? acc[1] : (rt == 2 ? acc[2] : acc[3]));
            const f32x4 d = (wid < 4) ? kd_ : qq;
            if (g == (c >> 2)) {
                const int r = c & 3;
                const float dv = r == 0 ? d[0] : (r == 1 ? d[1] : (r == 2 ? d[2] : d[3]));
                SC[(wid < 4 ? 256 : 320) + 16 * rt + c] = rsqrtf(dv + 1e-6f);
            }
        }
        __syncthreads();
        float* LF = (float*)(lds + G_LF);
        u16* QKT = (u16*)(lds + G_QKT);
#pragma unroll
        for (int ni = 0; ni < 4; ++ni) {
            const int j = 16 * ni + c;
            const float gcj = SC[j], rkj = SC[256 + j];
#pragma unroll
            for (int r = 0; r < 4; ++r) {
                const int i = 16 * rt + 4 * g + r;
                const float gci = SC[i];
                if (wid < 4) {
                    const float v = (i > j) ? SC[64 + i] * SC[256 + i] * rkj * acc[ni][r] * __expf(gci - gcj) : 0.f;
                    LF[i * 65 + j] = v;
                } else {
                    const float v = (i >= j) ? SC[320 + i] * 0.08838834764831845f * rkj * acc[ni][r] * __expf(gci - gcj) : 0.f;
                    QKT[i * 72 + j] = f2bf(v);
                }
            }
        }
    }
    __syncthreads();
    {
        const float* LF = (const float*)(lds + G_LF);
        float* TF = (float*)(lds + G_TF);
        float* TMP = (float*)(lds + G_TMP);
        if (wid == 0) {
            const int b4 = lane >> 4, j = lane & 15;
            float t[16];
#pragma unroll
            for (int i = 0; i < 16; ++i) {
                float s = (i == j) ? 1.f : 0.f;
#pragma unroll
                for (int m = 0; m < i; ++m) s -= LF[(16 * b4 + i) * 65 + 16 * b4 + m] * t[m];
                t[i] = s;
            }
#pragma unroll
            for (int i = 0; i < 16; ++i) TF[(16 * b4 + i) * 65 + 16 * b4 + j] = t[i];
        }
        __syncthreads();
        {
            const int pp = tid >> 8, i = (tid >> 4) & 15, j = tid & 15;
            float s = 0.f;
#pragma unroll
            for (int m = 0; m < 16; ++m) s += LF[(16 * (2 * pp + 1) + i) * 65 + 32 * pp + m] * TF[(32 * pp + m) * 65 + 32 * pp + j];
            TMP[pp * 256 + i * 16 + j] = s;
            __syncthreads();
            float x = 0.f;
#pragma unroll
            for (int m = 0; m < 16; ++m) x -= TF[(16 * (2 * pp + 1) + i) * 65 + 16 * (2 * pp + 1) + m] * TMP[pp * 256 + m * 16 + j];
            TF[(16 * (2 * pp + 1) + i) * 65 + 32 * pp + j] = x;
        }
        __syncthreads();
        {
            const int i = tid >> 4, j0 = tid & 15;
            float s0 = 0.f, s1 = 0.f;
            for (int m = 0; m < 32; ++m) { const float l = LF[(32 + i) * 65 + m]; s0 += l * TF[m * 65 + j0]; s1 += l * TF[m * 65 + j0 + 16]; }
            __syncthreads();
            TMP[i * 33 + j0] = s0; TMP[i * 33 + j0 + 16] = s1;
            __syncthreads();
            float x0 = 0.f, x1 = 0.f;
            for (int m = 0; m < 32; ++m) { const float tt = TF[(32 + i) * 65 + 32 + m]; x0 -= tt * TMP[m * 33 + j0]; x1 -= tt * TMP[m * 33 + j0 + 16]; }
            TF[(32 + i) * 65 + j0] = x0; TF[(32 + i) * 65 + j0 + 16] = x1;
        }
        __syncthreads();
        u16* TTW = (u16*)(lds + G_TTW);
        u16* TTU = (u16*)(lds + G_TTU);
#pragma unroll
        for (int i = 0; i < 8; ++i) {
            const int e = tid + NTHREADS * i, t = e >> 6, s = e & 63;
            const float tv = (s <= t) ? TF[t * 65 + s] : 0.f;
            const float bs = SC[64 + s];
            TTW[t * 72 + s] = f2bf(tv * bs * SC[256 + s] * SC[128 + s]);
            TTU[t * 72 + s] = f2bf(tv * bs);
        }
    }
    __syncthreads();
    {
        const int tt = wid & 3, isu = wid >> 2;
        f32x4 acc[8];
#pragma unroll
        for (int ni = 0; ni < 8; ++ni) acc[ni] = (f32x4){0.f, 0.f, 0.f, 0.f};
        const unsigned char* A = lds + (isu ? G_TTU : G_TTW);
        const unsigned char* Bt = lds + (isu ? G_VRT : G_KRT);
#pragma unroll
        for (int ks = 0; ks < 2; ++ks) {
            const bf16x8 a = ldsfrag(A, 16 * tt + c, 144, 32 * ks + 8 * g);
#pragma unroll
            for (int ni = 0; ni < 8; ++ni) acc[ni] = mfma16(a, ldsfrag(Bt, 16 * ni + c, 144, 32 * ks + 8 * g), acc[ni]);
        }
        __syncthreads();
        u16* WU = (u16*)(lds + (isu ? G_UT : G_WT));
        const int t0 = 16 * tt + 4 * g;
#pragma unroll
        for (int ni = 0; ni < 8; ++ni) {
            u32x2 w; w.x = pk2(acc[ni][0], acc[ni][1]); w.y = pk2(acc[ni][2], acc[ni][3]);
            *(u32x2*)(WU + (16 * ni + c) * 72 + t0) = w;
        }
    }
    __syncthreads();
    {
        f32x4 acc[4];
#pragma unroll
        for (int ni = 0; ni < 4; ++ni) acc[ni] = (f32x4){0.f, 0.f, 0.f, 0.f};
#pragma unroll
        for (int ks = 0; ks < 2; ++ks) {
            const bf16x8 a = ldsfrag(lds + G_WT, 16 * wid + c, 144, 32 * ks + 8 * g);
#pragma unroll
            for (int ni = 0; ni < 4; ++ni) acc[ni] = mfma16(a, ldsfrag(lds + G_QKT, 16 * ni + c, 144, 32 * ks + 8 * g), acc[ni]);
        }
        u16* QT = (u16*)(lds + G_QT);
#pragma unroll
        for (int ni = 0; ni < 4; ++ni) {
            const int t = 16 * ni + c, j0 = 16 * wid + 4 * g;
            const float qs = SC[320 + t] * 0.08838834764831845f * SC[128 + t];
            u32x2* qp = (u32x2*)(QT + t * 136 + j0);
            const u32x2 q = *qp;
            u32x2 w;
            w.x = pk2(bflo(q.x) * qs - acc[ni][0], bfhi(q.x) * qs - acc[ni][1]);
            w.y = pk2(bflo(q.y) * qs - acc[ni][2], bfhi(q.y) * qs - acc[ni][3]);
            *qp = w;
        }
    }
    {
        const int tt = wid & 3, dvh = wid >> 2;
        f32x4 acc[4];
#pragma unroll
        for (int ni = 0; ni < 4; ++ni) acc[ni] = (f32x4){0.f, 0.f, 0.f, 0.f};
#pragma unroll
        for (int ks = 0; ks < 2; ++ks) {
            const bf16x8 a = ldsfrag(lds + G_QKT, 16 * tt + c, 144, 32 * ks + 8 * g);
#pragma unroll
            for (int ni = 0; ni < 4; ++ni) acc[ni] = mfma16(a, ldsfrag(lds + G_UT, 16 * (4 * dvh + ni) + c, 144, 32 * ks + 8 * g), acc[ni]);
        }
        u16* KT = (u16*)(lds + G_KT);
#pragma unroll
        for (int ni = 0; ni < 4; ++ni)
#pragma unroll
            for (int r = 0; r < 4; ++r) KT[(16 * tt + 4 * g + r) * 136 + 16 * (4 * dvh + ni) + c] = f2bf(acc[ni][r]);
    }
    __syncthreads();
    {
#pragma unroll
        for (int i = 0; i < 2; ++i) {
            const int id = tid + NTHREADS * i, t = id >> 4, ck = id & 15;
            *(u32x4*)(P0 + (row0 + t) * 4096 + h * 128 + 8 * ck) = *(const u32x4*)(lds + G_QT + t * 272 + ck * 16);
            *(u32x4*)(P0 + (row0 + t) * 4096 + 1024 + h * 128 + 8 * ck) = *(const u32x4*)(lds + G_KT + t * 272 + ck * 16);
        }
        const int dim = tid >> 2, s0 = (tid & 3) * 16;
        float sc[16];
#pragma unroll
        for (int i = 0; i < 16; ++i) sc[i] = SC[256 + s0 + i] * SC[192 + s0 + i];
#pragma unroll
        for (int X = 0; X < 2; ++X) {
            u32x4* tp = (u32x4*)(lds + (X ? G_UT : G_WT) + dim * 144 + s0 * 2);
#pragma unroll
            for (int hf = 0; hf < 2; ++hf) {
                u32x4 w = tp[hf];
                w.x = pk2(bflo(w.x) * sc[8 * hf + 0], bfhi(w.x) * sc[8 * hf + 1]); w.y = pk2(bflo(w.y) * sc[8 * hf + 2], bfhi(w.y) * sc[8 * hf + 3]);
                w.z = pk2(bflo(w.z) * sc[8 * hf + 4], bfhi(w.z) * sc[8 * hf + 5]); w.w = pk2(bflo(w.w) * sc[8 * hf + 6], bfhi(w.w) * sc[8 * hf + 7]);
                tp[hf] = w;
            }
        }
    }
    __syncthreads();
    {
        {
            f32x4 acc[8];
#pragma unroll
            for (int ni = 0; ni < 8; ++ni) acc[ni] = (f32x4){0.f, 0.f, 0.f, 0.f};
#pragma unroll
            for (int ks = 0; ks < 2; ++ks) {
                const bf16x8 a = ldsfrag(lds + G_WT, 16 * wid + c, 144, 32 * ks + 8 * g);
#pragma unroll
                for (int ni = 0; ni < 8; ++ni) acc[ni] = mfma16(a, ldsfrag(lds + G_KRT, 16 * ni + c, 144, 32 * ks + 8 * g), acc[ni]);
            }
            if (ch > 0) {
                u16* Mg = (u16*)((unsigned char*)p.out + DO_M) + ((size_t)bh * 128 + (ch - 1)) * 16384;
                const float cd = SC[384];
                const int gp = ((g & 1) << 1) | (g >> 1);
#pragma unroll
                for (int ni = 0; ni < 8; ++ni) {
                    const int i = 16 * ni + c, j0 = 16 * wid + 4 * g;
                    float v[4];
#pragma unroll
                    for (int r = 0; r < 4; ++r) v[r] = ((i == j0 + r) ? cd : 0.f) - acc[ni][r];
                    u32x2 w; w.x = pk2(v[0], v[1]); w.y = pk2(v[2], v[3]);
                    *(u32x2*)(Mg + (size_t)i * 128 + 16 * wid + 4 * gp) = w;
                }
            }
        }
        {
            f32x4 acc[8];
#pragma unroll
            for (int ni = 0; ni < 8; ++ni) acc[ni] = (f32x4){0.f, 0.f, 0.f, 0.f};
#pragma unroll
            for (int ks = 0; ks < 2; ++ks) {
                const bf16x8 a = ldsfrag(lds + G_KRT, 16 * wid + c, 144, 32 * ks + 8 * g);
#pragma unroll
                for (int ni = 0; ni < 8; ++ni) acc[ni] = mfma16(a, ldsfrag(lds + G_UT, 16 * ni + c, 144, 32 * ks + 8 * g), acc[ni]);
            }
            u16* NT = (u16*)(p.ws + WS_NS) + ((size_t)bh * NCH + ch) * 16384;
#pragma unroll
            for (int ni = 0; ni < 8; ++ni) {
                u32x2 w; w.x = pk2(acc[ni][0], acc[ni][1]); w.y = pk2(acc[ni][2], acc[ni][3]);
                *(u32x2*)(NT + ((size_t)(4 * wid + g) * 128 + 16 * ni + c) * 4) = w;
            }
        }
    }
    __syncthreads();
}
constexpr int GO_QE = 0, GO_O0 = 17408, GO_ST = 34816, GO_SC = 69632;
DI void gdn_out_unit(const Params& p, int bh, int ch, unsigned char* lds) {
    const int tid = tid_opaque(), lane = tid & 63, wid = tid >> 6, c = lane & 15, g = lane >> 4;
    const int b = bh >> 3, h = bh & 7;
    const size_t row0 = (size_t)b * LP + (size_t)ch * 64;
    const u16* P0 = (const u16*)(p.ws + WS_P0);
    float* SC = (float*)(lds + GO_SC);
#pragma unroll
    for (int i = 0; i < 2; ++i) {
        const int id = tid + NTHREADS * i, t = id >> 4, ck = id & 15;
        *(u32x4*)(lds + GO_QE + t * 272 + ck * 16) = *(const u32x4*)(P0 + (row0 + t) * 4096 + h * 128 + 8 * ck);
        *(u32x4*)(lds + GO_O0 + t * 272 + ck * 16) = *(const u32x4*)(P0 + (row0 + t) * 4096 + 1024 + h * 128 + 8 * ck);
    }
    if (ch > 0) {
        const u16* ST = (const u16*)(p.ws + WS_NS) + ((size_t)bh * NCH + (ch - 1)) * 16384;
#pragma unroll
        for (int i = 0; i < 4; ++i) { const int id = tid + NTHREADS * i, i4 = id >> 6, dvp = id & 63;
            const u32x4 w = *(const u32x4*)(ST + (size_t)id * 8);
            *(u32x2*)(lds + GO_ST + (2 * dvp) * 272 + i4 * 8) = (u32x2){w.x, w.y};
            *(u32x2*)(lds + GO_ST + (2 * dvp + 1) * 272 + i4 * 8) = (u32x2){w.z, w.w}; }
    }
    __syncthreads();
    const int tt = wid & 3, dvh = wid >> 2;
    f32x4 acc[4];
    const u16* O0 = (const u16*)(lds + GO_O0);
#pragma unroll
    for (int ni = 0; ni < 4; ++ni)
#pragma unroll
        for (int r = 0; r < 4; ++r) acc[ni][r] = bf2f(O0[(16 * tt + 4 * g + r) * 136 + 16 * (4 * dvh + ni) + c]);
    if (ch > 0) {
#pragma unroll
        for (int ks = 0; ks < 4; ++ks) {
            const bf16x8 a = ldsfrag(lds + GO_QE, 16 * tt + c, 272, 32 * ks + 8 * g);
#pragma unroll
            for (int ni = 0; ni < 4; ++ni) acc[ni] = mfma16(a, ldsfrag(lds + GO_ST, 16 * (4 * dvh + ni) + c, 272, 32 * ks + 8 * g), acc[ni]);
        }
    }
    float ss[4];
#pragma unroll
    for (int r = 0; r < 4; ++r) {
        float s = 0.f;
#pragma unroll
        for (int ni = 0; ni < 4; ++ni) s += acc[ni][r] * acc[ni][r];
        s += __shfl_xor(s, 1); s += __shfl_xor(s, 2); s += __shfl_xor(s, 4); s += __shfl_xor(s, 8);
        ss[r] = s;
    }
    if (c == 0) {
#pragma unroll
        for (int r = 0; r < 4; ++r) SC[dvh * 64 + 16 * tt + 4 * g + r] = ss[r];
    }
    __syncthreads();
    u16* OG = (u16*)((unsigned char*)p.out + DO_OG);
#pragma unroll
    for (int r = 0; r < 4; ++r) {
        const int t = 16 * tt + 4 * g + r;
        const float rstd = rsqrtf((SC[t] + SC[64 + t]) * (1.f / 128.f) + RMS_EPS);
#pragma unroll
        for (int ni = 0; ni < 4; ++ni) {
            const int dv = 16 * (4 * dvh + ni) + c;
            const float z = bf2f(P0[(row0 + t) * 4096 + 3072 + h * 128 + dv]);
            OG[(row0 + t) * 1024 + h * 128 + dv] = f2bf(acc[ni][r] * rstd * p.gdn_o_norm[dv] * silu(z));
        }
    }
    __syncthreads();
}
DI void phase_gdn_prep(const Params& p, unsigned char* lds) {
    for (int u = blockIdx.x; u < 16 * NCH; u += gridDim.x) gdn_prep_unit(p, u / NCH, u % NCH, lds);
}
DI void phase_gdn_out(const Params& p, unsigned char* lds) {
    for (int u = blockIdx.x; u < 16 * NCH; u += gridDim.x) gdn_out_unit(p, u / NCH, u % NCH, lds);
}

DI void scan_loadM(u32x4 (&r)[8], const u16* Mg, int j, int t4) {
    if (j <= 127) {
        const u16* src = Mg + (size_t)(j - 1) * 16384;
#pragma unroll
        for (int i = 0; i < 8; ++i) { const int id = t4 + 256 * i; r[i] = *(const u32x4*)(src + (size_t)(id >> 4) * 128 + (id & 15) * 8); }
    }
}
DI void scan_storeM(const u32x4 (&r)[8], unsigned char* slot, int t4) {
#pragma unroll
    for (int i = 0; i < 8; ++i) { const int id = t4 + 256 * i; *(u32x4*)(slot + (id >> 4) * 272 + (id & 15) * 16) = r[i]; }
}
DI void scan_loadNq(u32x4 (&r)[8], const u16* NSb, int j, int lane) {
    if (j <= 127) {
        const u16* s0 = NSb + (size_t)j * 16384;
#pragma unroll
        for (int k = 0; k < 8; ++k) { const int id = lane + 64 * k; r[k] = *(const u32x4*)(s0 + (id >> 4) * 512 + (id & 15) * 8); }
    }
}
#define SCAN_BAR() do { asm volatile("s_waitcnt lgkmcnt(0)" ::: "memory"); __builtin_amdgcn_s_barrier(); asm volatile("" ::: "memory"); } while (0)
DI void scan_loadM2(u32x4 (&r)[16], const u16* Mg, int j, int t2) {
    if (j <= 127) {
        const u16* src = Mg + (size_t)(j - 1) * 16384;
#pragma unroll
        for (int i = 0; i < 16; ++i) { const int id = t2 + 128 * i; r[i] = *(const u32x4*)(src + (size_t)(id >> 4) * 128 + (id & 15) * 8); }
    }
}
DI void scan_storeM2(const u32x4 (&r)[16], unsigned char* slot, int t2) {
#pragma unroll
    for (int i = 0; i < 16; ++i) { const int id = t2 + 128 * i; *(u32x4*)(slot + (id >> 4) * 272 + (id & 15) * 16) = r[i]; }
}
DI void phase_gdn_scan(const Params& p, unsigned char* lds) {
    if (blockIdx.x >= 64) return;
    const int bh = blockIdx.x & 15, dvq = blockIdx.x >> 4;
    const int tid = tid_opaque(), lane = tid & 63, wid = __builtin_amdgcn_readfirstlane(tid >> 6), col = lane & 31, hh = lane >> 5;
    const u16* Mg = (const u16*)((unsigned char*)p.out + DO_M) + (size_t)bh * 128 * 16384;
    u16* NSb = (u16*)(p.ws + WS_NS) + (size_t)bh * NCH * 16384 + (size_t)(32 * dvq) * 4;
    unsigned char* slot0 = lds, *slot1 = lds + 34816;
    unsigned char* nb0 = lds + 69632, *nb1 = nb0 + 8192, *sb0 = nb1 + 8192, *sb1 = sb0 + 8192, *fb0 = sb1 + 8192, *fb1 = fb0 + 8192;
    if (wid >= 6) {
        const int t2 = tid - 384;
        u32x4 r0[16], r1[16], r2[16];
        scan_loadM2(r0, Mg, 1, t2); scan_storeM2(r0, slot1, t2); scan_loadM2(r0, Mg, 2, t2); scan_loadM2(r1, Mg, 3, t2); scan_loadM2(r2, Mg, 4, t2);
        SCAN_BAR();
#define SCAN_LD(cc, R) do { if ((cc) <= 127) { if ((cc) + 1 <= 127) scan_storeM2(R, ((cc) + 1) & 1 ? slot1 : slot0, t2); scan_loadM2(R, Mg, (cc) + 4, t2); SCAN_BAR(); } } while (0)
#pragma unroll 1
        for (int c0 = 1; c0 <= 127; c0 += 3) { SCAN_LD(c0, r0); SCAN_LD(c0 + 1, r1); SCAN_LD(c0 + 2, r2); }
#undef SCAN_LD
    } else if (wid == 4) {
        u32x4 r0[8], r1[8], r2[8];
#define SCAN_STN(R, buf) do { _Pragma("unroll") for (int k = 0; k < 8; ++k) *(u32x4*)((buf) + (lane + 64 * k) * 16) = R[k]; } while (0)
        scan_loadNq(r0, NSb, 1, lane); SCAN_STN(r0, nb1); scan_loadNq(r0, NSb, 2, lane); scan_loadNq(r1, NSb, 3, lane); scan_loadNq(r2, NSb, 4, lane);
        SCAN_BAR();
#define SCAN_LN(cc, R) do { if ((cc) <= 127) { if ((cc) + 1 <= 127) SCAN_STN(R, ((cc) + 1) & 1 ? nb1 : nb0); scan_loadNq(R, NSb, (cc) + 4, lane); SCAN_BAR(); } } while (0)
#pragma unroll 1
        for (int c0 = 1; c0 <= 127; c0 += 3) { SCAN_LN(c0, r0); SCAN_LN(c0 + 1, r1); SCAN_LN(c0 + 2, r2); }
#undef SCAN_LN
#undef SCAN_STN
    } else if (wid == 5) {
        SCAN_BAR();
#pragma unroll 1
        for (int cc = 1; cc <= 128; ++cc) {
            if (cc >= 2) {
                const unsigned char* sb = ((cc - 1) & 1) ? sb1 : sb0;
                u16* dst = NSb + (size_t)(cc - 1) * 16384;
#pragma unroll
                for (int k = 0; k < 8; ++k) { const int id = lane + 64 * k; *(u32x4*)(dst + (id >> 4) * 512 + (id & 15) * 8) = *(const u32x4*)(sb + id * 16); }
            }
            if (cc <= 127) SCAN_BAR();
        }
    } else {
        const int ob = wid;
        f32x16 acc;
#pragma unroll
        for (int q = 0; q < 4; ++q) {
            const u32x2 w = *(const u32x2*)(NSb + ((8 * ob + 2 * q + hh) * 128 + col) * 4);
            acc[4 * q + 0] = bflo(w.x); acc[4 * q + 1] = bfhi(w.x); acc[4 * q + 2] = bflo(w.y); acc[4 * q + 3] = bfhi(w.y);
        }
#define SCAN_PUBF(buf) do { _Pragma("unroll") for (int s_ = 0; s_ < 2; ++s_) { bf16x8 f_; _Pragma("unroll") for (int j = 0; j < 8; ++j) f_[j] = (short)f2bf(acc[8 * s_ + j]); \
            *(bf16x8*)((buf) + ((2 * ob + s_) * 64 + lane) * 16) = f_; } } while (0)
        SCAN_PUBF(fb1);
        SCAN_BAR();
        const int apo = (32 * ob + col) * 272 + hh * 16;
#pragma unroll 1
        for (int cc = 1; cc <= 127; ++cc) {
            const unsigned char* cur = (cc & 1) ? slot1 : slot0;
            const unsigned char* nbuf = (cc & 1) ? nb1 : nb0;
            unsigned char* sbuf = (cc & 1) ? sb1 : sb0;
            const unsigned char* fin = (cc & 1) ? fb1 : fb0;
            unsigned char* fout = (cc & 1) ? fb0 : fb1;
            bf16x8 fa[8], fbq[8];
#pragma unroll
            for (int ks = 0; ks < 8; ++ks) { fbq[ks] = *(const bf16x8*)(fin + (ks * 64 + lane) * 16); fa[ks] = *(const bf16x8*)(cur + apo + ks * 32); }
            f32x16 nw;
#pragma unroll
            for (int q = 0; q < 4; ++q) {
                const u32x2 w = *(const u32x2*)(nbuf + ((8 * ob + 2 * q + hh) * 32 + col) * 8);
                nw[4 * q + 0] = bflo(w.x); nw[4 * q + 1] = bfhi(w.x); nw[4 * q + 2] = bflo(w.y); nw[4 * q + 3] = bfhi(w.y);
            }
#pragma unroll
            for (int ks = 0; ks < 8; ++ks) nw = __builtin_amdgcn_mfma_f32_32x32x16_bf16(fa[ks], fbq[ks], nw, 0, 0, 0);
            acc = nw;
#pragma unroll
            for (int q = 0; q < 4; ++q) {
                u32x2 w; w.x = pk2(acc[4 * q], acc[4 * q + 1]); w.y = pk2(acc[4 * q + 2], acc[4 * q + 3]);
                *(u32x2*)(sbuf + ((8 * ob + 2 * q + hh) * 32 + col) * 8) = w;
            }
            SCAN_PUBF(fout);
            SCAN_BAR();
        }
#undef SCAN_PUBF
    }
}
#undef SCAN_BAR

template <bool ADDY, bool ROUTE>
DI void phase_norm(const Params& p, const float* gain, int layer, unsigned char* lds) {
    const int tid = tid_opaque(), lane = tid & 63, wid = tid >> 6;
    float* H = (float*)(p.ws + WS_H);
    u16* HN = (u16*)(p.ws + WS_HN);
    const u16* Y = (const u16*)(p.ws + WS_P0 + P0_Y);
    float* xs = (float*)lds;
    float* part = (float*)(lds + 32768);
    float* logit = (float*)(lds + 32768 + 9216);
    int* asg = (int*)(lds + 32768 + 9216 + 1152);
    int iter = 0;
    const float* wg = p.moe_w_group + (size_t)layer * 1024 * 4;
    const float* we = p.moe_w_expert + (size_t)layer * 1024 * 32;
    float wr[128];
    if (ROUTE) {
        const float* wp = lane < 4 ? wg + lane : we + ((lane < 36 ? lane : 35) - 4);
        const int wst = lane < 4 ? 4 : 32;
#pragma unroll
        for (int k = 0; k < 128; ++k) wr[k] = wp[(size_t)(128 * wid + k) * wst];
    }
    for (int base = blockIdx.x * 8; base < TP; base += gridDim.x * 8) {
        const int row = base + wid;
        {
            f32x4 v[4];
            float ss = 0.f;
#pragma unroll
            for (int i = 0; i < 4; ++i) {
                const int col = 4 * lane + 256 * i;
                v[i] = *(const f32x4*)(H + (size_t)row * DM + col);
                if (ADDY) {
                    const u32x2 y0 = *(const u32x2*)(Y + (size_t)(2 * row) * DM + col), y1 = *(const u32x2*)(Y + (size_t)(2 * row + 1) * DM + col);
                    const int pp = row % LP;
                    if (pp >= 48) {
                        v[i][0] += bflo(y0.x) + bflo(y1.x); v[i][1] += bfhi(y0.x) + bfhi(y1.x); v[i][2] += bflo(y0.y) + bflo(y1.y); v[i][3] += bfhi(y0.y) + bfhi(y1.y);
                        *(f32x4*)(H + (size_t)row * DM + col) = v[i];
                    }
                }
                ss += v[i][0] * v[i][0] + v[i][1] * v[i][1] + v[i][2] * v[i][2] + v[i][3] * v[i][3];
            }
            ss = wave_sum(ss);
            const float rstd = rsqrtf(ss * (1.f / DM) + RMS_EPS);
#pragma unroll
            for (int i = 0; i < 4; ++i) {
                const int col = 4 * lane + 256 * i;
                const f32x4 gn = *(const f32x4*)(gain + col);
                const f32x4 o = (f32x4){v[i][0] * rstd * gn[0], v[i][1] * rstd * gn[1], v[i][2] * rstd * gn[2], v[i][3] * rstd * gn[3]};
                u32x2 w; w.x = pk2(o[0], o[1]); w.y = pk2(o[2], o[3]);
                *(u32x2*)(HN + (size_t)row * DM + col) = w;
                if (ROUTE) *(f32x4*)(xs + wid * 1024 + col) = o;
            }
        }
        if (ROUTE) {
            __syncthreads();
            {
                float a8[8];
#pragma unroll
                for (int r = 0; r < 8; ++r) a8[r] = 0.f;
                if (lane < 36) {
#pragma unroll
                    for (int k4 = 0; k4 < 32; ++k4) {
#pragma unroll
                        for (int r = 0; r < 8; ++r) {
                            const f32x4 x4 = *(const f32x4*)(xs + r * 1024 + 128 * wid + 4 * k4);
                            a8[r] += x4[0] * wr[4 * k4] + x4[1] * wr[4 * k4 + 1] + x4[2] * wr[4 * k4 + 2] + x4[3] * wr[4 * k4 + 3];
                        }
                    }
#pragma unroll
                    for (int r = 0; r < 8; ++r) part[(wid * 8 + r) * 36 + lane] = a8[r];
                }
            }
            __syncthreads();
            if (tid < 288) {
                const int r = tid / 36, n = tid - r * 36;
                float s = 0.f;
#pragma unroll
                for (int w = 0; w < 8; ++w) s += part[(w * 8 + r) * 36 + n];
                s += (n < 4) ? p.moe_b_group[layer * 4 + n] : p.moe_b_expert[layer * 32 + n - 4];
                logit[r * 36 + n] = s;
            }
            __syncthreads();
            if (tid < 8) {
                const int rr = base + tid, pp = rr % LP;
                if (pp >= 48) {
                    const float* lg = logit + tid * 36;
                    int gs = 0; float gm = lg[0];
#pragma unroll
                    for (int i = 1; i < 4; ++i) if (lg[i] > gm) { gm = lg[i]; gs = i; }
                    float gsum = 0.f;
#pragma unroll
                    for (int i = 0; i < 4; ++i) gsum += __expf(lg[i] - gm);
                    const float gw = 1.f / gsum;
                    const float* el = lg + 4 + 8 * gs;
                    int i0 = 0; float m0 = el[0];
#pragma unroll
                    for (int i = 1; i < 8; ++i) if (el[i] > m0) { m0 = el[i]; i0 = i; }
                    int i1 = -1; float m1 = -3.0e38f;
#pragma unroll
                    for (int i = 0; i < 8; ++i) if (i != i0 && el[i] > m1) { m1 = el[i]; i1 = i; }
                    const float e1 = __expf(m1 - m0);
                    const float c0 = gw / (1.f + e1), c1 = gw * e1 / (1.f + e1);
                    float* cw = (float*)(p.ws + WS_CW);
                    cw[2 * rr] = c0; cw[2 * rr + 1] = c1;
                    const int slot = 16 * iter + 2 * tid;
                    asg[slot] = ((8 * gs + i0) << 24) | (2 * rr); asg[slot + 1] = ((8 * gs + i1) << 24) | (2 * rr + 1);
                } else {
                    const int slot = 16 * iter + 2 * tid;
                    asg[slot] = -1; asg[slot + 1] = -1;
                }
            }
            __syncthreads();
        }
        ++iter;
    }
    if (ROUTE) {
        const int n = 16 * iter;
        unsigned* cnt = (unsigned*)(p.ws + WS_CTL) + CW_CNT + layer * 32;
        u32* list = (u32*)(p.ws + WS_LIST);
        int* ebase = asg + 256;
        if (tid < 32) {
            int cn = 0;
            for (int i = 0; i < n; ++i) cn += (asg[i] >= 0 && (asg[i] >> 24) == tid) ? 1 : 0;
            ebase[tid] = cn > 0 ? (int)atomicAdd(&cnt[tid], (unsigned)cn) : 0;
        }
        __syncthreads();
        if (tid < n) {
            const int v = asg[tid];
            if (v >= 0) {
                const int e = v >> 24;
                int rk = 0;
                for (int i = 0; i < tid; ++i) rk += (asg[i] >= 0 && (asg[i] >> 24) == e) ? 1 : 0;
                list[(size_t)e * TP + ebase[e] + rk] = (u32)(v & 0xffffff);
            }
        }
        __syncthreads();
    }
}

template <int STAGE>
DI void phase_moe(const Params& p, int layer, unsigned char* lds) {
    const int tid = tid_opaque(), lane = tid & 63, wid = tid >> 6, c = lane & 15, g = lane >> 4, wm = wid >> 2, wn = wid & 3;
    int* tl = (int*)(lds + 2 * (128 + 256) * 144);
    int* pre = tl + 256;
    const unsigned* cnt = (const unsigned*)(p.ws + WS_CTL) + CW_CNT + layer * 32;
    if (tid < 32) pre[64 + tid] = (int)cnt[tid];
    __syncthreads();
    if (tid == 0) { int s = 0; for (int e = 0; e < 32; ++e) { pre[e] = s; s += (pre[64 + e] + 255) >> 8; } pre[32] = s; }
    __syncthreads();
    constexpr int FT = STAGE == 0 ? 4 : 8;
    const int ntiles = pre[32] * FT;
    const u32* list = (const u32*)(p.ws + WS_LIST);
    const float* cw = (const float*)(p.ws + WS_CW);
    const u16* HN = (const u16*)(p.ws + WS_HN);
    u16* ACT = (u16*)(p.ws + WS_P0 + P0_ACT);
    u16* Y = (u16*)(p.ws + WS_P0 + P0_Y);
    for (int t = blockIdx.x; t < ntiles; t += gridDim.x) {
        const int rtile = t / FT, ft = t - rtile * FT;
        int e = 0;
        for (int i = 1; i < 32; ++i) if (pre[i] <= rtile) e = i;
        const int rt = rtile - pre[e], ne = pre[64 + e];
        if (tid < 256) { const int gi = rt * 256 + tid; tl[tid] = gi < ne ? (int)list[(size_t)e * TP + gi] : -1; }
        __syncthreads();
        GemmAcc<4> acc;
        if (STAGE == 0) {
            const u16* W = (const u16*)(p.ws + WS_P0 + P0_WGU) + (size_t)e * 512 * 1024;
            const int f0 = ft * 64;
            auto pf = [=](int lr) -> u32 { const int x = lr & 63, w = lr >> 6; return (u32)((x < 32 ? f0 + w * 32 + x : 256 + f0 + w * 32 + (x - 32)) * 1024); };
            auto qf = [=](int n) -> u32 { const int a = tl[n]; return (u32)((a < 0 ? (tl[0] >> 1) : (a >> 1)) * 1024); };
            gemm_tile<4>(W, HN, 16, pf, qf, acc, lds);
#pragma unroll
            for (int ni = 0; ni < 4; ++ni) {
                const int a = tl[wn * 64 + 16 * ni + c];
                if (a < 0) continue;
                const float cwa = cw[a];
#pragma unroll
                for (int mi = 0; mi < 2; ++mi) {
                    const f32x4 gt = acc.a[mi][ni], up = acc.a[mi + 2][ni];
                    u32x2 w;
                    w.x = pk2(silu(gt[0]) * up[0] * cwa, silu(gt[1]) * up[1] * cwa);
                    w.y = pk2(silu(gt[2]) * up[2] * cwa, silu(gt[3]) * up[3] * cwa);
                    *(u32x2*)(ACT + (size_t)a * 256 + f0 + wm * 32 + 16 * mi + 4 * g) = w;
                }
            }
        } else {
            const u16* W = (const u16*)(p.ws + WS_P0 + P0_WDN) + (size_t)e * 1024 * 256;
            auto qf = [=](int n) -> u32 { const int a = tl[n]; return (u32)((a < 0 ? tl[0] : a) * 256); };
            gemm_tile<4>(W, ACT, 4, LinRow{(u32)(ft * 128) * 256u, 256u}, qf, acc, lds);
#pragma unroll
            for (int ni = 0; ni < 4; ++ni) {
                const int a = tl[wn * 64 + 16 * ni + c];
                if (a < 0) continue;
#pragma unroll
                for (int mi = 0; mi < 4; ++mi) {
                    const f32x4 v = acc.a[mi][ni];
                    u32x2 w; w.x = pk2(v[0], v[1]); w.y = pk2(v[2], v[3]);
                    *(u32x2*)(Y + (size_t)a * 1024 + ft * 128 + wm * 64 + 16 * mi + 4 * g) = w;
                }
            }
        }
        __syncthreads();
    }
}

DI void phase_post1(const Params& p, unsigned char* lds) {
    const int lane = tid_opaque() & 63, wid = tid_opaque() >> 6;
    const float* KRAW = (const float*)(p.ws + WS_P0 + P0_KRAW);
    const float* KIRAW = (const float*)((unsigned char*)p.out + DO_KIRAW);
    u16* KN = (u16*)((unsigned char*)p.out + DO_KN);
    _Float16* KI = (_Float16*)((unsigned char*)p.out + DO_KI);
    for (int row = blockIdx.x * 8 + wid; row < TP; row += gridDim.x * 8) {
        const f32x4 k = *(const f32x4*)(KRAW + (size_t)row * 256 + 4 * lane);
        float ss = k[0] * k[0] + k[1] * k[1] + k[2] * k[2] + k[3] * k[3];
#pragma unroll
        for (int o = 16; o >= 1; o >>= 1) ss += __shfl_xor(ss, o);
        const float rstd = rsqrtf(ss * (1.f / 128.f) + RMS_EPS);
        const int d = (4 * lane) & 127;
        const f32x4 kg = *(const f32x4*)(p.dsa_k_norm + d), qg = *(const f32x4*)(p.dsa_q_norm + d);
        u32x2 w; w.x = pk2(k[0] * rstd * kg[0] * qg[0], k[1] * rstd * kg[1] * qg[1]); w.y = pk2(k[2] * rstd * kg[2] * qg[2], k[3] * rstd * kg[3] * qg[3]);
        *(u32x2*)(KN + (size_t)row * 256 + 4 * lane) = w;
        const float x = KIRAW[(size_t)row * 64 + lane];
        const float mu = wave_sum(x) * (1.f / 64.f);
        const float xc = x - mu;
        const float var = wave_sum(xc * xc) * (1.f / 64.f);
        KI[(size_t)row * 64 + lane] = (_Float16)(xc * rsqrtf(var + RMS_EPS) * p.dsa_ln_g[lane] + p.dsa_ln_b[lane]);
    }
}

constexpr int IX_HIST = 0;
constexpr int IX_SEL = 65536;
constexpr int IX_CV = IX_SEL + 16384;
constexpr int IX_CI = IX_CV + 16384;
constexpr int IX_CNT = IX_CI + 8192;
constexpr int IX_QI = IX_CNT + 512;
DI int score_bin(float s) { return (int)fminf(fmaxf((s + 8.f) * 64.f, 0.f), 1023.f); }
template <int PASS>
DI void index_pass(const _Float16* __restrict__ KIb, int ktiles, int wid, int lane, const float (&w8)[8], unsigned char* lds) {
    const int q = lane & 31, hh = lane >> 5;
    u32* hist = (u32*)(lds + IX_HIST);
    u16* sell = (u16*)(lds + IX_SEL);
    float* cv = (float*)(lds + IX_CV);
    u16* ci = (u16*)(lds + IX_CI);
    int* cn = (int*)(lds + IX_CNT);
    const int tbq = (PASS == 1) ? cn[64 + q] : 0;
    for (int kt = 1 + wid; kt < ktiles; kt += 8) {
        f16x8 a[4];
#pragma unroll
        for (int s = 0; s < 4; ++s) a[s] = *(const f16x8*)(KIb + (size_t)(32 * kt + q) * 64 + 16 * s + 8 * hh);
        float sc[16];
#pragma unroll
        for (int r = 0; r < 16; ++r) sc[r] = 0.f;
#pragma unroll
        for (int hd = 0; hd < 8; ++hd) {
            f32x16 d;
#pragma unroll
            for (int r = 0; r < 16; ++r) d[r] = 0.f;
#pragma unroll
            for (int s = 0; s < 4; ++s) d = __builtin_amdgcn_mfma_f32_32x32x16_f16(a[s], *(const f16x8*)(lds + IX_QI + q * 1040 + hd * 128 + s * 32 + hh * 16), d, 0, 0, 0);
#pragma unroll
            for (int r = 0; r < 16; ++r) sc[r] += w8[hd] * fmaxf(d[r], 0.f);
            if (hd & 1) __builtin_amdgcn_sched_barrier(0);
        }
#pragma unroll
        for (int r = 0; r < 16; ++r) {
            const int kr = (r & 3) + 8 * (r >> 2) + 4 * hh;
            const int key = 32 * kt + kr;
            if (key < 48) continue;
            const int bin = score_bin(sc[r]);
            if (PASS == 0) atomicAdd(&hist[q * 512 + (bin >> 1)], 1u << (16 * (bin & 1)));
            else {
                if (bin > tbq) { const int pos = atomicAdd(&cn[q], 1); if (pos < 256) sell[q * 256 + pos] = (u16)key; }
                else if (bin == tbq) { const int pos = atomicAdd(&cn[32 + q], 1); if (pos < 128) { cv[q * 128 + pos] = sc[r]; ci[q * 128 + pos] = (u16)key; } }
            }
        }
    }
}
DI void index_unit(const Params& p, int b, int ch, int half, unsigned char* lds) {
    const int tid = tid_opaque(), lane = tid & 63, wid = tid >> 6;
    u16* SEL = (u16*)((unsigned char*)p.out + DO_SEL);
    const int qrow0 = b * LP + 64 * ch + 32 * half;
    const int nkeys = 64 * (ch + 1) - 48;
    if (nkeys <= 256) {
        for (int i = tid; i < 32 * 256; i += NTHREADS) { const int qq = i >> 8, s = i & 255; SEL[(size_t)(qrow0 + qq) * 256 + s] = (u16)(s < nkeys ? 48 + s : 48); }
        return;
    }
    u32* hist = (u32*)(lds + IX_HIST);
    int* cn = (int*)(lds + IX_CNT);
    for (int i = tid; i < 32 * 512; i += NTHREADS) hist[i] = 0u;
    if (tid < 128) cn[tid] = 0;
    { u16* sell0 = (u16*)(lds + IX_SEL); for (int i = tid; i < 32 * 256; i += NTHREADS) sell0[i] = 48; }
    const _Float16* QI = (const _Float16*)(p.ws + WS_P0 + P0_QI);
    const float* WI = (const float*)((unsigned char*)p.out + DO_WI);
    const _Float16* KIb = (const _Float16*)((unsigned char*)p.out + DO_KI) + (size_t)b * LP * 64;
    const int q = lane & 31;
    float w8[8];
#pragma unroll
    for (int hd = 0; hd < 8; ++hd) w8[hd] = WI[(size_t)(qrow0 + q) * 8 + hd];
#pragma unroll
    for (int i = 0; i < 4; ++i) { const int id = tid + NTHREADS * i, rr = id >> 6, cc = id & 63; *(u32x4*)(lds + IX_QI + rr * 1040 + cc * 16) = *(const u32x4*)(QI + (size_t)(qrow0 + rr) * 512 + cc * 8); }
    const int ktiles = 2 * (ch + 1);
    __syncthreads();
    index_pass<0>(KIb, ktiles, wid, lane, w8, lds);
    __syncthreads();
    for (int qi = 0; qi < 4; ++qi) {
        const int qq = 4 * wid + qi;
        u32 hw[8];
        int cl = 0;
#pragma unroll
        for (int i = 0; i < 8; ++i) { hw[i] = hist[qq * 512 + 8 * lane + i]; cl += (int)(hw[i] & 0xffffu) + (int)(hw[i] >> 16); }
        int suf = cl;
#pragma unroll
        for (int o = 1; o < 64; o <<= 1) { const int t = __shfl_down(suf, o); if (lane + o < 64) suf += t; }
        const int above = suf - cl;
        if (above < 256 && above + cl >= 256) {
            int acc = above, tb = 16 * lane, na = above;
#pragma unroll
            for (int i = 15; i >= 0; --i) {
                const int cb = (int)((hw[i >> 1] >> (16 * (i & 1))) & 0xffffu);
                if (acc < 256 && acc + cb >= 256) { tb = 16 * lane + i; na = acc; }
                acc += cb;
            }
            cn[64 + qq] = tb; cn[96 + qq] = na;
        }
    }
    __syncthreads();
    index_pass<1>(KIb, ktiles, wid, lane, w8, lds);
    __syncthreads();
    {
        u16* sell = (u16*)(lds + IX_SEL);
        const float* cv = (const float*)(lds + IX_CV);
        const u16* ci = (const u16*)(lds + IX_CI);
        for (int qi = 0; qi < 4; ++qi) {
            const int qq = 4 * wid + qi;
            const int na = cn[96 + qq], need = 256 - na;
            int nc = cn[32 + qq]; nc = nc < 128 ? nc : 128;
#pragma unroll
            for (int half2 = 0; half2 < 2; ++half2) {
                const int i = lane + 64 * half2;
                if (i < nc) {
                    const float vi = cv[qq * 128 + i]; const int ki = ci[qq * 128 + i];
                    int rank = 0;
                    for (int j = 0; j < nc; ++j) { const float vj = cv[qq * 128 + j]; const int kj = ci[qq * 128 + j]; rank += (vj > vi || (vj == vi && kj < ki)) ? 1 : 0; }
                    if (rank < need) sell[qq * 256 + na + rank] = (u16)ki;
                }
            }
        }
    }
    __syncthreads();
    {
        const u32x4* src = (const u32x4*)(lds + IX_SEL);
        u32x4* dst = (u32x4*)(SEL + (size_t)qrow0 * 256);
        for (int i = tid; i < 1024; i += NTHREADS) dst[i] = src[i];
    }
    __syncthreads();
}
DI void phase_index(const Params& p, unsigned char* lds) {
    const int G = gridDim.x;
    for (int r = 0;; ++r) {
        const int u = (r & 1) ? r * G + (G - 1 - (int)blockIdx.x) : r * G + (int)blockIdx.x;
        if (r * G >= 516) break;
        if (u < 516) index_unit(p, (u >> 1) & 1, 128 - (u >> 2), u & 1, lds);
    }
}

DI int t5_bucket(int rel) {
    const int n = rel < 0 ? -rel : rel;
    const int base = rel > 0 ? 16 : 0;
    const int lg = 8 + (n >= 12) + (n >= 16) + (n >= 23) + (n >= 32) + (n >= 46) + (n >= 64) + (n >= 91);
    return base + (n < 8 ? n : lg);
}
constexpr int AT_ITEMS = 513;
constexpr int AT_WAVE_LDS = 9216;
DI void attn_query(const Params& p, int b, int n, int qi, unsigned char* wl) {
    const int lane = tid_opaque() & 63, c = lane & 15, g = lane >> 4;
    u32* widx = (u32*)wl;
    float* Lg = (float*)(wl + 1024);
    float* Pl = (float*)(wl + 5120);
    const u16* SEL = (const u16*)((unsigned char*)p.out + DO_SEL);
    const u16* QRAW = (const u16*)(p.ws + WS_P0 + P0_QRAW);
    const u16* KN = (const u16*)((unsigned char*)p.out + DO_KN);
    const u16* VN = (const u16*)(p.ws + WS_P0 + P0_VN);
    u16* OA = (u16*)((unsigned char*)p.out + DO_OG);
    const int pq = 48 + qi, row = b * LP + pq;
    const int chq = pq >> 6, nkeys = 64 * (chq + 1) - 48, nsel = nkeys < 256 ? nkeys : 256, ntile = nsel >> 4;
    {
        const u32x2 w = *(const u32x2*)(SEL + (size_t)row * 256 + 4 * lane);
        u32x4 o;
        const int k0 = w.x & 0xffff, k1 = w.x >> 16, k2 = w.y & 0xffff, k3 = w.y >> 16;
        o.x = k0 | (t5_bucket(k0 - pq) << 16); o.y = k1 | (t5_bucket(k1 - pq) << 16); o.z = k2 | (t5_bucket(k2 - pq) << 16); o.w = k3 | (t5_bucket(k3 - pq) << 16);
        *(u32x4*)(widx + 4 * lane) = o;
    }
    const size_t kb = (size_t)b * LP;
    bf16x8 qf[4];
    float ssq = 0.f;
#pragma unroll
    for (int s = 0; s < 4; ++s) {
        if (c < 4) {
            const u32x4 w = *(const u32x4*)(QRAW + (size_t)row * 1024 + (4 * n + c) * 128 + 32 * s + 8 * g);
            qf[s] = __builtin_bit_cast(bf16x8, w);
            ssq += bflo(w.x) * bflo(w.x) + bfhi(w.x) * bfhi(w.x) + bflo(w.y) * bflo(w.y) + bfhi(w.y) * bfhi(w.y)
                 + bflo(w.z) * bflo(w.z) + bfhi(w.z) * bfhi(w.z) + bflo(w.w) * bflo(w.w) + bfhi(w.w) * bfhi(w.w);
        } else qf[s] = (bf16x8){0, 0, 0, 0, 0, 0, 0, 0};
    }
    ssq += __shfl_xor(ssq, 16); ssq += __shfl_xor(ssq, 32);
    const float qscale = rsqrtf(ssq * (1.f / 128.f) + RMS_EPS) * 0.08838834764831845f;
    bf16x8 bb;
    {
        const float iq = 1.f / qscale;
        const float* rb = p.rel_bias + (8 * g) * 8 + 4 * n + (c & 3);
        u32x4 w;
        w.x = pk2(rb[0] * iq, rb[8] * iq); w.y = pk2(rb[16] * iq, rb[24] * iq); w.z = pk2(rb[32] * iq, rb[40] * iq); w.w = pk2(rb[48] * iq, rb[56] * iq);
        if (c >= 4) w = (u32x4){0u, 0u, 0u, 0u};
        bb = __builtin_bit_cast(bf16x8, w);
    }
    float mx = -3.0e38f;
#define ATT_LOADK(dst, oh, bt) do { _Pragma("unroll") for (int t = 0; t < 4; ++t) { const u32 e_ = widx[16 * (4 * (bt) + t) + c]; const int kid_ = e_ & 0xffff, bk_ = e_ >> 16; \
        const u16* kp_ = KN + (kb + kid_) * 256 + n * 128 + 8 * g; \
        _Pragma("unroll") for (int s_ = 0; s_ < 4; ++s_) dst[t][s_] = *(const bf16x8*)(kp_ + 32 * s_); \
        const u32 hv_ = ((bk_ >> 3) == g) ? (0x3f80u << (16 * (bk_ & 1))) : 0u; const int wq_ = (bk_ & 7) >> 1; \
        u32x4 ow_; ow_.x = wq_ == 0 ? hv_ : 0u; ow_.y = wq_ == 1 ? hv_ : 0u; ow_.z = wq_ == 2 ? hv_ : 0u; ow_.w = wq_ == 3 ? hv_ : 0u; oh[t] = __builtin_bit_cast(bf16x8, ow_); } } while (0)
#define ATT_QK(src, oh, bt) do { _Pragma("unroll") for (int t = 0; t < 4; ++t) { f32x4 a4 = (f32x4){0.f, 0.f, 0.f, 0.f}; \
        _Pragma("unroll") for (int s_ = 0; s_ < 4; ++s_) a4 = mfma16(src[t][s_], qf[s_], a4); \
        a4 = mfma16(oh[t], bb, a4); \
        const bool val_ = (4 * (bt) + t) < ntile; \
        _Pragma("unroll") for (int r = 0; r < 4; ++r) { a4[r] = val_ ? a4[r] * qscale : -3.0e38f; mx = fmaxf(mx, a4[r]); } \
        lq[t] = a4; } \
        if (c < 4) { _Pragma("unroll") for (int t = 0; t < 4; ++t) *(f32x4*)(Lg + c * 256 + 16 * (4 * (bt) + t) + 4 * g) = lq[t]; } } while (0)
    {
        bf16x8 ka[4][4], kc[4][4], oa[4], oc[4];
        f32x4 lq[4];
        ATT_LOADK(ka, oa, 0);
        ATT_LOADK(kc, oc, 1);
        ATT_QK(ka, oa, 0);
        ATT_LOADK(ka, oa, 2);
        ATT_QK(kc, oc, 1);
        ATT_LOADK(kc, oc, 3);
        ATT_QK(ka, oa, 2);
        ATT_QK(kc, oc, 3);
    }
#undef ATT_LOADK
#undef ATT_QK
    mx = fmaxf(mx, __shfl_xor(mx, 16)); mx = fmaxf(mx, __shfl_xor(mx, 32));
    float inv[4];
    {
        f32x4 e[4];
        float sm[4];
#pragma unroll
        for (int hd = 0; hd < 4; ++hd) {
            const float m = __shfl(mx, hd);
            const f32x4 l4 = *(const f32x4*)(Lg + hd * 256 + 4 * lane);
            e[hd] = (f32x4){__expf(l4[0] - m), __expf(l4[1] - m), __expf(l4[2] - m), __expf(l4[3] - m)};
            if (4 * lane >= nsel) e[hd] = (f32x4){0.f, 0.f, 0.f, 0.f};
            sm[hd] = wave_sum(e[hd][0] + e[hd][1] + e[hd][2] + e[hd][3]);
            inv[hd] = 1.f / sm[hd];
        }
#pragma unroll
        for (int i = 0; i < 4; ++i) *(f32x4*)(Pl + (4 * lane + i) * 4) = (f32x4){e[0][i], e[1][i], e[2][i], e[3][i]};
    }
    float o[4][8];
#pragma unroll
    for (int hd = 0; hd < 4; ++hd)
#pragma unroll
        for (int d = 0; d < 8; ++d) o[hd][d] = 0.f;
    const u16* vb = VN + kb * 256 + n * 128 + 8 * c;
#define ATT_LOADV(dst, s0) do { _Pragma("unroll") for (int i = 0; i < 8; ++i) { const int kid_ = widx[(s0) + 4 * i + g] & 0xffff; dst[i] = *(const u32x4*)(vb + (size_t)kid_ * 256); } } while (0)
#define ATT_PV(src, s0) do { _Pragma("unroll") for (int i = 0; i < 8; ++i) { const f32x4 p4 = *(const f32x4*)(Pl + ((s0) + 4 * i + g) * 4); \
        const float v0 = bflo(src[i].x), v1 = bfhi(src[i].x), v2 = bflo(src[i].y), v3 = bfhi(src[i].y), v4 = bflo(src[i].z), v5 = bfhi(src[i].z), v6 = bflo(src[i].w), v7 = bfhi(src[i].w); \
        _Pragma("unroll") for (int hd = 0; hd < 4; ++hd) { o[hd][0] += p4[hd] * v0; o[hd][1] += p4[hd] * v1; o[hd][2] += p4[hd] * v2; o[hd][3] += p4[hd] * v3; \
            o[hd][4] += p4[hd] * v4; o[hd][5] += p4[hd] * v5; o[hd][6] += p4[hd] * v6; o[hd][7] += p4[hd] * v7; } } } while (0)
    {
        u32x4 va[8], vc[8];
        ATT_LOADV(va, 0);
#pragma unroll 1
        for (int s0 = 0; s0 < 256; s0 += 64) {
            ATT_LOADV(vc, s0 + 32);
            ATT_PV(va, s0);
            if (s0 + 64 < 256) ATT_LOADV(va, s0 + 64);
            ATT_PV(vc, s0 + 32);
        }
    }
#undef ATT_LOADV
#undef ATT_PV
#pragma unroll
    for (int hd = 0; hd < 4; ++hd) {
#pragma unroll
        for (int d = 0; d < 8; ++d) { o[hd][d] += __shfl_xor(o[hd][d], 16); o[hd][d] += __shfl_xor(o[hd][d], 32); }
        if (g == 0) {
            u32x4 w;
            w.x = pk2(o[hd][0] * inv[hd], o[hd][1] * inv[hd]); w.y = pk2(o[hd][2] * inv[hd], o[hd][3] * inv[hd]);
            w.z = pk2(o[hd][4] * inv[hd], o[hd][5] * inv[hd]); w.w = pk2(o[hd][6] * inv[hd], o[hd][7] * inv[hd]);
            *(u32x4*)(OA + (size_t)row * 1024 + (4 * n + hd) * 128 + 8 * c) = w;
        }
    }
}
DI void phase_attn(const Params& p, unsigned xcc, unsigned char* lds) {
    const int tid = tid_opaque(), lane = tid & 63, wid = tid >> 6;
    unsigned char* wl = lds + wid * AT_WAVE_LDS;
    volatile int* item_s = (volatile int*)(lds + 8 * AT_WAVE_LDS);
    u16* OA = (u16*)((unsigned char*)p.out + DO_OG);
    for (int i = blockIdx.x * NTHREADS + tid; i < 96 * 128; i += gridDim.x * NTHREADS) {
        const int r = i >> 7, b = r / 48, pp = r - 48 * b;
        *(u32x4*)(OA + ((size_t)b * LP + pp) * 1024 + (i & 127) * 8) = (u32x4){0u, 0u, 0u, 0u};
    }
    unsigned* qctr = (unsigned*)(p.ws + WS_CTL) + CW_AQ;
    const int my = (int)(xcc & 3u);
    for (;;) {
        if (tid == 0) {
            int it = -1;
            for (int t = 0; t < 4 && it < 0; ++t) {
                const int cb = (my + t) & 3;
                const unsigned j = atomicAdd(&qctr[cb * 64], 1u);
                if (j < (unsigned)AT_ITEMS) it = cb * AT_ITEMS + (int)j;
            }
            *item_s = it;
        }
        __syncthreads();
        const int it = *item_s;
        __syncthreads();
        if (it < 0) break;
        const int cb = it / AT_ITEMS, j = it - cb * AT_ITEMS;
        attn_query(p, cb >> 1, cb & 1, 16 * j + wid, wl);
        attn_query(p, cb >> 1, cb & 1, 16 * j + 8 + wid, wl);
    }
}

DI void phase_final(const Params& p) {
    const float* H = (const float*)(p.ws + WS_H);
    const u16* Y = (const u16*)(p.ws + WS_P0 + P0_Y);
    for (size_t i = (size_t)blockIdx.x * NTHREADS + tid_opaque(); i < (size_t)2 * SEQ * 256; i += (size_t)gridDim.x * NTHREADS) {
        const size_t orow = i >> 8; const int col = (int)(i & 255) * 4;
        const int b = (int)(orow >> 13), s = (int)(orow & 8191);
        const size_t row = (size_t)b * LP + 64 + s;
        f32x4 v = *(const f32x4*)(H + row * DM + col);
        const u32x2 y0 = *(const u32x2*)(Y + (2 * row) * DM + col), y1 = *(const u32x2*)(Y + (2 * row + 1) * DM + col);
        v[0] += bflo(y0.x) + bflo(y1.x); v[1] += bfhi(y0.x) + bfhi(y1.x); v[2] += bflo(y0.y) + bflo(y1.y); v[3] += bfhi(y0.y) + bfhi(y1.y);
        *(f32x4*)(p.out + orow * DM + col) = v;
    }
}

__global__ void __launch_bounds__(NTHREADS, 2) mega(Params p) {
    extern __shared__ __attribute__((aligned(16))) unsigned char lds[];
    if (threadIdx.x < 4) ((volatile LAS unsigned*)(lds + LDS_BAR))[threadIdx.x] = 0u;
    __syncthreads();
    XcdBarrier bar = xcd_barrier_post((unsigned*)(p.ws + WS_CTL) + CW_BAR, (volatile LAS unsigned*)(lds + LDS_BAR));
    phase_prep(p, lds);                                                   xcd_barrier(bar);
    phase_gemm_in0(p, lds);                                               xcd_barrier(bar);
    phase_gdn_prep(p, lds);                                             xcd_barrier(bar);
    phase_gdn_scan(p, lds);                                               xcd_barrier(bar);
    phase_gdn_out(p, lds);                                              xcd_barrier(bar);
    phase_gemm_out(p, (const u16*)(p.ws + WS_W_OUT0), (const u16*)((unsigned char*)p.out + DO_OG), lds);   xcd_barrier(bar);
    phase_norm<false, true>(p, p.norm_ffn, 0, lds);
    conv_moe_weights(p, 0, lds);                                          xcd_barrier(bar);
    phase_moe<0>(p, 0, lds);                                              xcd_barrier(bar);
    phase_moe<1>(p, 0, lds);                                              xcd_barrier(bar);
    phase_norm<true, false>(p, p.norm_mix + DM, 0, lds);
    conv_moe_weights(p, 1, lds);                                          xcd_barrier(bar);
    phase_gemm_in1(p, lds);                                               xcd_barrier(bar);
    phase_post1(p, lds);                                                  xcd_barrier(bar);
    phase_index(p, lds);                                                  xcd_barrier(bar);
    phase_attn(p, bar.x, lds);                                                   xcd_barrier(bar);
    phase_gemm_out(p, (const u16*)(p.ws + WS_W_OUT1), (const u16*)((unsigned char*)p.out + DO_OG), lds);   xcd_barrier(bar);
    phase_norm<false, true>(p, p.norm_ffn + DM, 1, lds);                  xcd_barrier(bar);
    phase_moe<0>(p, 1, lds);                                              xcd_barrier(bar);
    phase_moe<1>(p, 1, lds);                                              xcd_barrier(bar);
    phase_final(p);
}

extern "C" void kernel_launch(void* const* d_in, const int* in_sizes, int n_in, void* d_out, int out_size, void* d_ws, size_t ws_size, hipStream_t stream) {
    static int grid = 0;
    if (grid == 0) {
        if (n_in != 23 || out_size != 2 * SEQ * DM || ws_size < WS_END) { fprintf(stderr, "kernel_launch: unexpected sizes (n_in %d out %d ws %zu need %zu)\n", n_in, out_size, ws_size, (size_t)WS_END); grid = -1; return; }
        int dev = 0, cus = 0;
        if (hipGetDevice(&dev) != hipSuccess || hipDeviceGetAttribute(&cus, hipDeviceAttributeMultiprocessorCount, dev) != hipSuccess) { grid = -1; return; }
        if (hipFuncSetAttribute((const void*)mega, hipFuncAttributeMaxDynamicSharedMemorySize, LDS_BYTES) != hipSuccess) { fprintf(stderr, "kernel_launch: hipFuncSetAttribute failed\n"); grid = -1; return; }
        grid = cus > 256 ? 256 : cus;
        if (grid < 16) { grid = -1; return; }
    }
    if (grid < 0) return;
    (void)hipMemsetAsync((unsigned char*)d_ws + WS_CTL, 0, CTL_BYTES, stream);
    Params p{};
    const float** f = (const float**)&p;
    for (int i = 0; i < 23; ++i) f[i] = (const float*)d_in[i];
    p.out = (float*)d_out; p.ws = (unsigned char*)d_ws;
    hipLaunchKernelGGL(mega, dim3(grid), dim3(NTHREADS), LDS_BYTES, stream, p);
}
```

```cpp
#include <hip/hip_runtime.h>
#include <stdint.h>
#include <stdio.h>

#define DI __device__ __forceinline__
#define LAS __attribute__((address_space(3)))
typedef unsigned short u16;
typedef unsigned int u32;
typedef short bf16x8 __attribute__((ext_vector_type(8)));
typedef _Float16 f16x8 __attribute__((ext_vector_type(8)));
typedef float f32x4 __attribute__((ext_vector_type(4)));
typedef float f32x16 __attribute__((ext_vector_type(16)));
typedef u32 u32x4 __attribute__((ext_vector_type(4)));
typedef u32 u32x2 __attribute__((ext_vector_type(2)));
typedef short s16x4 __attribute__((ext_vector_type(4)));

constexpr int DM = 1024, SEQ = 8192, LP = 8256, TP = 16512, TPA = 16640, NCH = 129;
constexpr int NTHREADS = 512;
constexpr int LDS_BYTES = 155648;
constexpr int LDS_BAR = LDS_BYTES - 16;
constexpr float RMS_EPS = 1e-6f;

constexpr size_t WS_CTL = 0, CTL_BYTES = 1u << 20;
constexpr size_t WS_W_IN0 = CTL_BYTES;
constexpr size_t WS_W_OUT0 = WS_W_IN0 + (size_t)4224 * 1024 * 2;
constexpr size_t WS_W_IN1 = WS_W_OUT0 + (size_t)1024 * 1024 * 2;
constexpr size_t WS_W_OUT1 = WS_W_IN1 + (size_t)2176 * 1024 * 2;
constexpr size_t WS_BA = WS_W_OUT1 + (size_t)1024 * 1024 * 2;
constexpr size_t WS_LIST = WS_BA + (size_t)TPA * 16 * 4;
constexpr size_t WS_CW = WS_LIST + (size_t)32 * TP * 4;
constexpr size_t WS_H = WS_CW + (size_t)2 * TP * 4;
constexpr size_t WS_NS = WS_H + (size_t)TPA * 1024 * 4;
constexpr size_t WS_HN = WS_NS;
constexpr size_t WS_P0 = WS_NS + (size_t)16 * 129 * 128 * 128 * 2;
constexpr size_t WS_HALO = WS_P0 + (size_t)TPA * 4096 * 2;
constexpr size_t WS_END = WS_HALO + (size_t)2 * 129 * 3 * 3072 * 2;
constexpr size_t P0_WGU = 0;
constexpr size_t P0_WDN = P0_WGU + (size_t)32 * 512 * 1024 * 2;
constexpr size_t P0_ACT = P0_WDN + (size_t)32 * 1024 * 256 * 2;
constexpr size_t P0_Y = P0_ACT + (size_t)2 * TP * 256 * 2;
constexpr size_t P0_QRAW = P0_ACT;
constexpr size_t P0_KRAW = P0_QRAW + (size_t)TP * 1024 * 2;
constexpr size_t P0_VN = P0_KRAW + (size_t)TP * 256 * 4;
constexpr size_t P0_QI = P0_VN + (size_t)TP * 256 * 2;
static_assert(P0_Y + (size_t)2 * TP * 1024 * 2 <= (size_t)TPA * 4096 * 2, "P0 map");
static_assert(P0_QI + (size_t)TP * 512 * 2 <= (size_t)TPA * 4096 * 2, "P0 map 2");
constexpr size_t DO_M = 0;
constexpr size_t DO_OG = 0;
constexpr size_t DO_SEL = (size_t)TPA * 1024 * 2;
constexpr size_t DO_KN = DO_SEL + (size_t)TP * 256 * 2;
constexpr size_t DO_KI = DO_KN + (size_t)TP * 256 * 2;
constexpr size_t DO_WI = DO_KI + (size_t)TP * 64 * 2;
constexpr size_t DO_KIRAW = DO_WI + (size_t)TP * 8 * 4;
static_assert(DO_KIRAW + (size_t)TP * 64 * 4 <= (size_t)2 * SEQ * 1024 * 4, "d_out map");
constexpr int CW_BAR = 0;
constexpr int CW_CNT = 4096;
constexpr int CW_AQ = 4352;

struct Params {
    const float *x, *meta, *norm_mix, *norm_ffn, *rel_bias, *gdn_w_in, *gdn_conv, *gdn_a_log, *gdn_dt_bias, *gdn_o_norm, *gdn_w_out,
        *dsa_w_in, *dsa_q_norm, *dsa_k_norm, *dsa_ln_g, *dsa_ln_b, *dsa_w_out, *moe_w_group, *moe_b_group, *moe_w_expert, *moe_b_expert,
        *moe_w_gu, *moe_w_down;
    float* out;
    unsigned char* ws;
};

DI u16 f2bf(float f) { return __builtin_bit_cast(u16, (__bf16)f); }
DI float bf2f(u16 h) { return __uint_as_float(((u32)h) << 16); }
DI u32 pk2(float a, float b) { return (u32)f2bf(a) | ((u32)f2bf(b) << 16); }
DI float bflo(u32 w) { return __uint_as_float(w << 16); }
DI float bfhi(u32 w) { return __uint_as_float(w & 0xffff0000u); }
typedef float f32x2 __attribute__((ext_vector_type(2)));
DI u32 pk4_fp8(float a, float b, float c, float d) { int w = 0; w = __builtin_amdgcn_cvt_pk_fp8_f32(a, b, w, false); w = __builtin_amdgcn_cvt_pk_fp8_f32(c, d, w, true); return (u32)w; }
DI u32x2 fp8x4_to_bf16x4(u32 w) {
    const f32x2 lo = __builtin_amdgcn_cvt_pk_f32_fp8((int)w, false), hi = __builtin_amdgcn_cvt_pk_f32_fp8((int)w, true);
    u32x2 r; r.x = pk2(lo[0], lo[1]); r.y = pk2(hi[0], hi[1]); return r;
}
DI bf16x8 fp8x8_to_bf16x8(u32 w0, u32 w1) { const u32x2 a = fp8x4_to_bf16x4(w0), b = fp8x4_to_bf16x4(w1); return __builtin_bit_cast(bf16x8, (u32x4){a.x, a.y, b.x, b.y}); }
DI float wave_sum(float v) {
#pragma unroll
    for (int o = 32; o >= 1; o >>= 1) v += __shfl_xor(v, o);
    return v;
}
DI int tid_opaque() { int t = threadIdx.x; asm volatile("" : "+v"(t)); return t; }
DI float silu(float x) { return x / (1.f + __expf(-x)); }
DI f32x4 mfma16(bf16x8 a, bf16x8 b, f32x4 c) { return __builtin_amdgcn_mfma_f32_16x16x32_bf16(a, b, c, 0, 0, 0); }
DI bf16x8 ldsfrag(const unsigned char* base, int row, int strideB, int kel) { return *(const bf16x8*)(base + row * strideB + kel * 2); }

#define XB_TMO      128
#define XB_XCNT(j)  (256  + 64 * (j))
#define XB_XSUB(j)  (1280 + 64 * (j))
#define XB_XGEN(j)  (2304 + 64 * (j))
#define XB_TOP      3328
#define XB_TOPGEN   3392
#define XCD_BAR_WORDS 3456
#define XB_SPIN_CAP (1u << 21)
DI unsigned xb_ld(unsigned* p) { return __hip_atomic_load(p, __ATOMIC_RELAXED, __HIP_MEMORY_SCOPE_AGENT); }
DI unsigned xb_add(unsigned* p, unsigned v) { return __hip_atomic_fetch_add(p, v, __ATOMIC_RELAXED, __HIP_MEMORY_SCOPE_AGENT); }
DI unsigned xb_xcc_id() { return (unsigned)__builtin_amdgcn_s_getreg((3 << 11) | 20) & 0xFu; }
#define XB_SPIN(cond, bar) do { unsigned _sp = 0; while (cond) { __builtin_amdgcn_s_sleep(1); \
    if ((++_sp & 255u) == 0u) { if (xb_ld(&(bar)[XB_TMO])) break; if (_sp > XB_SPIN_CAP) { atomicAdd(&(bar)[XB_TMO], 1u); break; } } } } while (0)
struct XcdBarrier { unsigned* bar; unsigned x; volatile LAS unsigned* st; };
DI XcdBarrier xcd_barrier_post(unsigned* bar, volatile LAS unsigned* st) {
    XcdBarrier b; b.bar = bar; b.x = xb_xcc_id(); b.st = st;
    if (threadIdx.x == 0) (void)xb_add(&bar[XB_XCNT(b.x)], 1u);
    return b;
}
DI void xcd_barrier_complete(unsigned* bar, unsigned x, unsigned& nloc, unsigned& nx) {
    const unsigned G = gridDim.x * gridDim.y * gridDim.z;
    unsigned sum, cnt, mine, sp = 0u;
    for (;;) {
        sum = 0u; cnt = 0u; mine = 0u;
#pragma unroll
        for (unsigned j = 0; j < 16; ++j) { const unsigned c = xb_ld(&bar[XB_XCNT(j)]); sum += c; cnt += (c > 0u) ? 1u : 0u; mine = (j == x) ? c : mine; }
        if (sum == G) break;
        __builtin_amdgcn_s_sleep(1);
        if ((++sp & 255u) == 0u) { if (xb_ld(&bar[XB_TMO])) break; if (sp > XB_SPIN_CAP) { atomicAdd(&bar[XB_TMO], 1u); break; } }
    }
    nloc = mine > 0u ? mine : 1u; nx = cnt > 0u ? cnt : 1u;
}
DI void xcd_barrier(const XcdBarrier& b) {
    asm volatile("s_waitcnt vmcnt(0)" ::: "memory");
    __syncthreads();
    if (threadIdx.x == 0) {
        unsigned* bar = b.bar;
        __builtin_amdgcn_s_waitcnt(0);
        unsigned nloc = b.st[0], nx = b.st[1];
        if (nloc == 0u) { xcd_barrier_complete(bar, b.x, nloc, nx); b.st[0] = nloc; b.st[1] = nx; }
        const unsigned old = xb_add(&bar[XB_XSUB(b.x)], 1u);
        const unsigned gen = old / nloc;
        if (old + 1u == (gen + 1u) * nloc) {
            __builtin_amdgcn_fence(__ATOMIC_RELEASE, "agent");
            asm volatile("s_waitcnt vmcnt(0)" ::: "memory");
            const unsigned og = xb_add(&bar[XB_TOP], 1u);
            const unsigned tg = og / nx;
            if (og + 1u == (tg + 1u) * nx) xb_add(&bar[XB_TOPGEN], 1u);
            else XB_SPIN(xb_ld(&bar[XB_TOPGEN]) == tg, bar);
            __builtin_amdgcn_fence(__ATOMIC_ACQUIRE, "agent");
            xb_add(&bar[XB_XGEN(b.x)], 1u);
            asm volatile("s_waitcnt vmcnt(0)" ::: "memory");
        } else {
            XB_SPIN(xb_ld(&bar[XB_XGEN(b.x)]) == gen, bar);
            __builtin_amdgcn_fence(__ATOMIC_ACQUIRE, "agent");
            asm volatile("s_waitcnt vmcnt(0)" ::: "memory");
        }
    }
    __syncthreads();
}

struct ConvJob { const float* src; u16* dst; int K, N, kt, nt; };
DI void convT_load(const ConvJob& j, float (&r)[16], int tid) {
    const int l32 = tid & 31, kb = tid >> 5;
#pragma unroll
    for (int kk = 0; kk < 4; ++kk)
#pragma unroll
        for (int q = 0; q < 4; ++q) {
            const int k = j.kt * 64 + kb + 16 * kk, n = j.nt * 128 + l32 + 32 * q;
            r[4 * kk + q] = (n < j.N) ? j.src[(size_t)k * j.N + n] : 0.f;
        }
}
DI void convT_store(const ConvJob& j, const float (&r)[16], int tid, unsigned char* lds) {
    const int l32 = tid & 31, kb = tid >> 5;
    u16* img = (u16*)lds;
#pragma unroll
    for (int kk = 0; kk < 4; ++kk)
#pragma unroll
        for (int q = 0; q < 4; ++q) img[(l32 + 32 * q) * 68 + kb + 16 * kk] = f2bf(r[4 * kk + q]);
    __syncthreads();
#pragma unroll
    for (int i = 0; i < 2; ++i) {
        const int id = tid + NTHREADS * i, n = id >> 3, ck = id & 7;
        const u32x2 a = *(const u32x2*)(lds + n * 136 + ck * 16), b2 = *(const u32x2*)(lds + n * 136 + ck * 16 + 8);
        *(u32x4*)(j.dst + (size_t)(j.nt * 128 + n) * j.K + j.kt * 64 + ck * 8) = (u32x4){a.x, a.y, b2.x, b2.y};
    }
    __syncthreads();
}
template <class DEC> DI void convT_run(DEC dec, int nunits, unsigned char* lds) {
    const int tid = tid_opaque();
    int u = blockIdx.x;
    if (u >= nunits) return;
    ConvJob cur = dec(u), nxt = cur;
    float r[16];
    convT_load(cur, r, tid);
    for (;;) {
        const int un = u + (int)gridDim.x;
        const bool more = un < nunits;
        float rn[16];
        u16* img = (u16*)lds;
        {
            const int l32 = tid & 31, kb = tid >> 5;
#pragma unroll
            for (int kk = 0; kk < 4; ++kk)
#pragma unroll
                for (int q = 0; q < 4; ++q) img[(l32 + 32 * q) * 68 + kb + 16 * kk] = f2bf(r[4 * kk + q]);
        }
        if (more) { nxt = dec(un); convT_load(nxt, rn, tid); }
        __syncthreads();
#pragma unroll
        for (int i = 0; i < 2; ++i) {
            const int id = tid + NTHREADS * i, n = id >> 3, ck = id & 7;
            const u32x2 a = *(const u32x2*)(lds + n * 136 + ck * 16), b2 = *(const u32x2*)(lds + n * 136 + ck * 16 + 8);
            *(u32x4*)(cur.dst + (size_t)(cur.nt * 128 + n) * cur.K + cur.kt * 64 + ck * 8) = (u32x4){a.x, a.y, b2.x, b2.y};
        }
        __syncthreads();
        if (!more) break;
        u = un; cur = nxt;
#pragma unroll
        for (int i = 0; i < 16; ++i) r[i] = rn[i];
    }
}

template <int NI> struct GemmAcc { f32x4 a[4][NI]; };
template <int NI, class PF, class QF>
DI void gemm_tile(const u16* __restrict__ Pb, const u16* __restrict__ Qb, int KT, PF pf, QF qf, GemmAcc<NI>& acc, unsigned char* lds) {
    constexpr int TN = 64 * NI, QC = TN * 8 / NTHREADS, BUF = (128 + TN) * 144;
    const int tid = tid_opaque(), lane = tid & 63, wid = tid >> 6, c = lane & 15, g = lane >> 4, wm = wid >> 2, wn = wid & 3;
    u32 poff[2], qoff[QC];
#pragma unroll
    for (int i = 0; i < 2; ++i) { const int id = tid + NTHREADS * i; poff[i] = pf(id >> 3) + (id & 7) * 8; }
#pragma unroll
    for (int i = 0; i < QC; ++i) { const int id = tid + NTHREADS * i; qoff[i] = qf(id >> 3) + (id & 7) * 8; }
    u32x4 pr[2], qr[QC];
#pragma unroll
    for (int mi = 0; mi < 4; ++mi)
#pragma unroll
        for (int ni = 0; ni < NI; ++ni) acc.a[mi][ni] = (f32x4){0.f, 0.f, 0.f, 0.f};
#pragma unroll
    for (int i = 0; i < 2; ++i) pr[i] = *(const u32x4*)(Pb + poff[i]);
#pragma unroll
    for (int i = 0; i < QC; ++i) qr[i] = *(const u32x4*)(Qb + qoff[i]);
#pragma unroll
    for (int i = 0; i < 2; ++i) { const int id = tid + NTHREADS * i; *(u32x4*)(lds + (id >> 3) * 144 + (id & 7) * 16) = pr[i]; }
#pragma unroll
    for (int i = 0; i < QC; ++i) { const int id = tid + NTHREADS * i; *(u32x4*)(lds + 128 * 144 + (id >> 3) * 144 + (id & 7) * 16) = qr[i]; }
    __syncthreads();
    for (int kt = 0; kt < KT; ++kt) {
        const unsigned char* cur = lds + (kt & 1) * BUF;
        unsigned char* nxt = lds + ((kt + 1) & 1) * BUF;
        if (kt + 1 < KT) {
#pragma unroll
            for (int i = 0; i < 2; ++i) pr[i] = *(const u32x4*)(Pb + poff[i] + (kt + 1) * 64);
#pragma unroll
            for (int i = 0; i < QC; ++i) qr[i] = *(const u32x4*)(Qb + qoff[i] + (kt + 1) * 64);
        }
#pragma unroll
        for (int ks = 0; ks < 2; ++ks) {
            bf16x8 af[4], bfr[NI];
#pragma unroll
            for (int mi = 0; mi < 4; ++mi) af[mi] = ldsfrag(cur, wm * 64 + 16 * mi + c, 144, 32 * ks + 8 * g);
#pragma unroll
            for (int ni = 0; ni < NI; ++ni) bfr[ni] = ldsfrag(cur + 128 * 144, wn * 16 * NI + 16 * ni + c, 144, 32 * ks + 8 * g);
#pragma unroll
            for (int mi = 0; mi < 4; ++mi)
#pragma unroll
                for (int ni = 0; ni < NI; ++ni) acc.a[mi][ni] = mfma16(af[mi], bfr[ni], acc.a[mi][ni]);
        }
        if (kt + 1 < KT) {
#pragma unroll
            for (int i = 0; i < 2; ++i) { const int id = tid + NTHREADS * i; *(u32x4*)(nxt + (id >> 3) * 144 + (id & 7) * 16) = pr[i]; }
#pragma unroll
            for (int i = 0; i < QC; ++i) { const int id = tid + NTHREADS * i; *(u32x4*)(nxt + 128 * 144 + (id >> 3) * 144 + (id & 7) * 16) = qr[i]; }
        }
        __syncthreads();
    }
}
struct LinRow { u32 base, ld; DI u32 operator()(int r) const { return base + (u32)r * ld; } };

namespace pg {
constexpr int BM = 256, BK = 64, HALF = 128, HTB = HALF * BK * 2;
DI int lds_byte(int r, int c) { const int st = (r >> 4) * 2 + (c >> 5), rr = r & 15, cc = c & 31, ob = rr * 64 + cc * 2; return st * 1024 + (ob ^ (((ob >> 9) & 1) << 5)); }
DI void stage_rc(int b, int& R, int& C) { const int st = b / 1024, sb = b % 1024, swz = sb ^ (((sb >> 9) & 1) << 5); R = (st >> 1) * 16 + swz / 64; C = (st & 1) * 32 + (swz % 64) / 2; }
DI int perm32(int rho) { const int n = rho >> 4, i = rho & 15; return 8 * (i >> 2) + 4 * n + (i & 3); }
struct Unit { int pm, pn, e, n; };
typedef f32x4 Acc[2][2][4][2];
template <class Sched, class Epi>
DI void gemm(LAS unsigned char* lds, const int K, const Sched& S, const Epi& E) {
    const int tid = tid_opaque(), wid = __builtin_amdgcn_readfirstlane(tid >> 6), lane = tid & 63, wr = wid >> 2, wc = wid & 3, fr = lane & 15, fq = lane >> 4;
    const int nt = K / BK;
    int Rs[2], Cs[2];
    unsigned voffB[2];
#pragma unroll
    for (int i = 0; i < 2; ++i) { stage_rc(tid * 16 + i * 8192, Rs[i], Cs[i]); const int Rb = Epi::PERM ? ((Rs[i] & ~31) + perm32(Rs[i] & 31)) : Rs[i]; voffB[i] = (unsigned)(Rb * K + Cs[i]) * 2u; }
    const size_t kstep = (size_t)(BK * 2);
    const size_t bh1 = S.bh1();
    const unsigned ldsw = (unsigned)wid * 1024u;
    const int aoff = lds_byte(wr * 64 + fr, fq * 8), boff = lds_byte(wc * 32 + fr, fq * 8);
    const char* Ab = S.abase();
#define PG_SA(b, h) (((b) * 2 + (h)) * HTB)
#define PG_SB(b, h) ((4 + (b) * 2 + (h)) * HTB)
#define PG_STAGE(bufoff, gbase, voff) do { _Pragma("unroll") for (int _i = 0; _i < 2; ++_i) \
        __builtin_amdgcn_global_load_lds((const unsigned*)((const char*)(gbase) + (voff)[_i]), (LAS unsigned*)(lds + (bufoff) + ldsw + _i * 8192), 16, 0, 0); } while (0)
#define PG_LDA(dst, b, h) do { _Pragma("unroll") for (int m = 0; m < 4; ++m) _Pragma("unroll") for (int k = 0; k < 2; ++k) dst[m][k] = *(const LAS bf16x8*)(lds + PG_SA(b, h) + aoff + m * 2048 + k * 1024); } while (0)
#define PG_LDB(dst, b, h) do { _Pragma("unroll") for (int n = 0; n < 2; ++n) _Pragma("unroll") for (int k = 0; k < 2; ++k) dst[n][k] = *(const LAS bf16x8*)(lds + PG_SB(b, h) + boff + n * 2048 + k * 1024); } while (0)
#define PG_MMA(ai, bj, At, Bt) do { __builtin_amdgcn_s_setprio(1); _Pragma("unroll") for (int m = 0; m < 4; ++m) _Pragma("unroll") for (int n = 0; n < 2; ++n) _Pragma("unroll") for (int k = 0; k < 2; ++k) \
        acc[ai][bj][m][n] = __builtin_amdgcn_mfma_f32_16x16x32_bf16(Bt[n][k], At[m][k], acc[ai][bj][m][n], 0, 0, 0); __builtin_amdgcn_s_setprio(0); } while (0)
#define PG_WAIT_V(n) asm volatile("s_waitcnt vmcnt(" #n ")" ::: "memory")
#define PG_WAIT_L(n) asm volatile("s_waitcnt lgkmcnt(" #n ")" ::: "memory")
#define PG_BAR __builtin_amdgcn_s_barrier()
#define PG_SCHED __builtin_amdgcn_sched_barrier(0)
#define PG_AOFF(dst, u) do { _Pragma("unroll") for (int h_ = 0; h_ < 2; ++h_) _Pragma("unroll") for (int i_ = 0; i_ < 2; ++i_) dst[h_][i_] = (unsigned)(S.arow(u, h_ * HALF + Rs[i_]) * K + Cs[i_]) * 2u; } while (0)
    Unit cur, nxt; int ui = 0;
    if (!S.next(0, cur)) return;
    Acc acc;
#pragma unroll
    for (int a = 0; a < 2; ++a)
#pragma unroll
        for (int b = 0; b < 2; ++b)
#pragma unroll
            for (int m = 0; m < 4; ++m)
#pragma unroll
                for (int n = 0; n < 2; ++n) acc[a][b][m][n] = (f32x4){0.f, 0.f, 0.f, 0.f};
    bf16x8 At[4][2], B0[2][2], B1[2][2];
    unsigned aoC[2][2], aoN[2][2];
    PG_AOFF(aoC, cur);
    const char* cB = S.bbase(cur);
    PG_STAGE(PG_SB(0, 0), cB, voffB); PG_STAGE(PG_SA(0, 0), Ab, aoC[0]); PG_STAGE(PG_SB(0, 1), cB + bh1, voffB); PG_STAGE(PG_SA(0, 1), Ab, aoC[1]);
    if (wr == 1) PG_BAR;
    PG_WAIT_V(4); PG_BAR;
    PG_STAGE(PG_SB(1, 0), cB + kstep, voffB); PG_STAGE(PG_SA(1, 0), Ab + kstep, aoC[0]); PG_STAGE(PG_SB(1, 1), cB + bh1 + kstep, voffB);
    PG_WAIT_V(6); PG_BAR;
    for (;;) {
        const bool has_next = S.next(ui + 1, nxt);
        const char* nB = has_next ? S.bbase(nxt) : cB;
        if (has_next) PG_AOFF(aoN, nxt);
        else {
#pragma unroll
            for (int h_ = 0; h_ < 2; ++h_)
#pragma unroll
                for (int i_ = 0; i_ < 2; ++i_) aoN[h_][i_] = aoC[h_][i_];
        }
#pragma unroll 1
        for (int t = 0; t < nt; t += 2) {
            const bool last = (t == nt - 2);
            const char* a1 = Ab + (size_t)(t + 1) * kstep;
            const char* a2 = last ? Ab : Ab + (size_t)(t + 2) * kstep; const char* b2 = last ? nB : cB + (size_t)(t + 2) * kstep;
            const char* a3 = a2 + kstep; const char* b3 = b2 + kstep;
            unsigned o2[2][2];
#pragma unroll
            for (int h_ = 0; h_ < 2; ++h_)
#pragma unroll
                for (int i_ = 0; i_ < 2; ++i_) o2[h_][i_] = last ? aoN[h_][i_] : aoC[h_][i_];
            PG_LDB(B0, 0, 0); PG_SCHED; PG_LDA(At, 0, 0); PG_STAGE(PG_SA(1, 1), a1, aoC[1]);
            PG_WAIT_L(8); PG_BAR; PG_WAIT_L(0); PG_MMA(0, 0, At, B0); PG_BAR; PG_SCHED;
            PG_LDB(B1, 0, 1); PG_STAGE(PG_SB(0, 0), b2, voffB);
            PG_BAR; PG_WAIT_L(0); PG_MMA(0, 1, At, B1); PG_BAR;
            PG_LDA(At, 0, 1); PG_STAGE(PG_SA(0, 0), a2, o2[0]);
            PG_BAR; PG_WAIT_L(0); PG_MMA(1, 0, At, B0); PG_BAR; PG_SCHED;
            PG_STAGE(PG_SB(0, 1), b2 + bh1, voffB);
            PG_WAIT_V(6); PG_BAR; PG_MMA(1, 1, At, B1); PG_BAR;
            PG_LDB(B0, 1, 0); PG_SCHED; PG_LDA(At, 1, 0); PG_STAGE(PG_SA(0, 1), a2, o2[1]);
            PG_WAIT_L(8); PG_BAR; PG_WAIT_L(0); PG_MMA(0, 0, At, B0); PG_BAR; PG_SCHED;
            PG_LDB(B1, 1, 1); PG_STAGE(PG_SB(1, 0), b3, voffB);
            PG_BAR; PG_WAIT_L(0); PG_MMA(0, 1, At, B1); PG_BAR;
            PG_LDA(At, 1, 1); PG_STAGE(PG_SA(1, 0), a3, o2[0]);
            PG_BAR; PG_WAIT_L(0); PG_MMA(1, 0, At, B0); PG_BAR; PG_SCHED;
            PG_STAGE(PG_SB(1, 1), b3 + bh1, voffB);
            PG_WAIT_V(6); PG_BAR; PG_MMA(1, 1, At, B1); PG_BAR;
        }
        E(acc, cur, wr, wc, fr, fq);
        if (!has_next) break;
#pragma unroll
        for (int a = 0; a < 2; ++a)
#pragma unroll
            for (int b = 0; b < 2; ++b)
#pragma unroll
                for (int m = 0; m < 4; ++m)
#pragma unroll
                    for (int n = 0; n < 2; ++n) acc[a][b][m][n] = (f32x4){0.f, 0.f, 0.f, 0.f};
        cur = nxt; cB = nB; ++ui;
#pragma unroll
        for (int h_ = 0; h_ < 2; ++h_)
#pragma unroll
            for (int i_ = 0; i_ < 2; ++i_) aoC[h_][i_] = aoN[h_][i_];
    }
    PG_WAIT_V(0);
    if (wr == 0) PG_BAR;
    PG_BAR;
#undef PG_SA
#undef PG_SB
#undef PG_STAGE
#undef PG_LDA
#undef PG_LDB
#undef PG_MMA
#undef PG_WAIT_V
#undef PG_WAIT_L
#undef PG_BAR
#undef PG_SCHED
#undef PG_AOFF
}
}

DI void conv_small_weights(const Params& p, unsigned char* lds) {
    const int n0 = 16 * 33, n1 = 16 * 8, n2 = 16 * 17, n3 = 16 * 8;
    auto dec = [=](int u) -> ConvJob {
        if (u < n0) return ConvJob{p.gdn_w_in, (u16*)(p.ws + WS_W_IN0), 1024, 4112, u & 15, u >> 4};
        if (u < n0 + n1) { const int v = u - n0; return ConvJob{p.gdn_w_out, (u16*)(p.ws + WS_W_OUT0), 1024, 1024, v & 15, v >> 4}; }
        if (u < n0 + n1 + n2) { const int v = u - n0 - n1; return ConvJob{p.dsa_w_in, (u16*)(p.ws + WS_W_IN1), 1024, 2120, v & 15, v >> 4}; }
        const int v = u - n0 - n1 - n2; return ConvJob{p.dsa_w_out, (u16*)(p.ws + WS_W_OUT1), 1024, 1024, v & 15, v >> 4};
    };
    convT_run(dec, n0 + n1 + n2 + n3, lds);
}
DI void conv_moe_weights(const Params& p, int layer, unsigned char* lds) {
    const int ngu = 32 * 64, ndn = 32 * 32;
    auto dec = [=](int u) -> ConvJob {
        if (u < ngu) { const int e = u >> 6, v = u & 63;
            return ConvJob{p.moe_w_gu + ((size_t)layer * 32 + e) * 1024 * 512, (u16*)(p.ws + WS_P0 + P0_WGU) + (size_t)e * 512 * 1024, 1024, 512, v & 15, v >> 4}; }
        const int w = u - ngu, e = w >> 5, v = w & 31;
        return ConvJob{p.moe_w_down + ((size_t)layer * 32 + e) * 256 * 1024, (u16*)(p.ws + WS_P0 + P0_WDN) + (size_t)e * 1024 * 256, 256, 1024, v & 3, v >> 2};
    };
    convT_run(dec, ngu + ndn, lds);
}
DI void phase_prep(const Params& p, unsigned char* lds) {
    conv_small_weights(p, lds);
    const int lane = tid_opaque() & 63, wid = tid_opaque() >> 6;
    float* H = (float*)(p.ws + WS_H);
    u16* HN = (u16*)(p.ws + WS_HN);
    for (int row = blockIdx.x * 8 + wid; row < TPA; row += gridDim.x * 8) {
        const int b = row / LP, pp = row - b * LP;
        const bool real = row < TP && pp >= 48;
        const float* src = real ? (pp < 64 ? p.meta + (size_t)(pp - 48) * DM : p.x + ((size_t)b * SEQ + (pp - 64)) * DM) : nullptr;
        f32x4 v[4];
        float ss = 0.f;
#pragma unroll
        for (int i = 0; i < 4; ++i) {
            v[i] = real ? *(const f32x4*)(src + 4 * lane + 256 * i) : (f32x4){0.f, 0.f, 0.f, 0.f};
            ss += v[i][0] * v[i][0] + v[i][1] * v[i][1] + v[i][2] * v[i][2] + v[i][3] * v[i][3];
        }
        ss = wave_sum(ss);
        const float rstd = rsqrtf(ss * (1.f / DM) + RMS_EPS);
#pragma unroll
        for (int i = 0; i < 4; ++i) {
            const int col = 4 * lane + 256 * i;
            *(f32x4*)(H + (size_t)row * DM + col) = v[i];
            const f32x4 gn = *(const f32x4*)(p.norm_mix + col);
            u32x2 w; w.x = pk2(v[i][0] * rstd * gn[0], v[i][1] * rstd * gn[1]); w.y = pk2(v[i][2] * rstd * gn[2], v[i][3] * rstd * gn[3]);
            *(u32x2*)(HN + (size_t)row * DM + col) = w;
        }
    }
}

DI int frame_row(int pm, int r) { return (pm >> 5) * LP + 64 + (pm & 31) * 256 + r; }
struct DenseSched {
    const char* A; const char* Bt; int K, npn, total;
    DI bool next(int i, pg::Unit& u) const { const int L = i * (int)gridDim.x + (int)blockIdx.x; if (L >= total) return false; u.pn = L % npn; u.pm = L / npn; u.e = 0; u.n = 256; return true; }
    DI int arow(const pg::Unit& u, int r) const { return frame_row(u.pm, r); }
    DI const char* abase() const { return A; }
    DI const char* bbase(const pg::Unit& u) const { return Bt + (size_t)u.pn * 256 * K * 2; }
    DI size_t bh1() const { return (size_t)128 * K * 2; }
};
struct EpiIn0 {
    static constexpr bool PERM = true;
    u16* P0; u16* HALO;
    DI void store(int row, int col, u32x4 w) const {
        *(u32x4*)(P0 + (size_t)row * 4096 + col) = w;
        if (col < 3072) { const int bb = row / LP, pp = row - bb * LP;
            if ((pp & 63) >= 61 && (pp >> 6) < 128) *(u32x4*)(HALO + ((size_t)(bb * 129 + (pp >> 6) + 1) * 3 + ((pp & 63) - 61)) * 3072 + col) = w; }
    }
    DI void operator()(const pg::Acc& acc, const pg::Unit& u, int wr, int wc, int fr, int fq) const {
#pragma unroll
        for (int ai = 0; ai < 2; ++ai)
#pragma unroll
            for (int m = 0; m < 4; ++m) {
                const int row = frame_row(u.pm, 128 * ai + 64 * wr + 16 * m + fr);
#pragma unroll
                for (int bj = 0; bj < 2; ++bj) {
                    const f32x4 v0 = acc[ai][bj][m][0], v1 = acc[ai][bj][m][1];
                    u32x4 w; w.x = pk2(v0[0], v0[1]); w.y = pk2(v0[2], v0[3]); w.z = pk2(v1[0], v1[1]); w.w = pk2(v1[2], v1[3]);
                    store(row, 256 * u.pn + 128 * bj + 32 * wc + 8 * fq, w);
                }
            }
    }
};
DI void phase_gemm_in0(const Params& p, unsigned char* lds) {
    const u16* W = (const u16*)(p.ws + WS_W_IN0);
    const u16* X = (const u16*)(p.ws + WS_HN);
    u16* P0 = (u16*)(p.ws + WS_P0);
    float* BA = (float*)(p.ws + WS_BA);
    u16* HALO = (u16*)(p.ws + WS_HALO);
    {
        DenseSched S{(const char*)X, (const char*)W, 1024, 16, 64 * 16};
        EpiIn0 E{P0, HALO};
        pg::gemm((LAS unsigned char*)lds, 1024, S, E);
    }
    __syncthreads();
    const int lane = tid_opaque() & 63, wid = tid_opaque() >> 6, c = lane & 15, g = lane >> 4, wm = wid >> 2, wn = wid & 3;
    for (int t = blockIdx.x; t < 64 + 130; t += gridDim.x) {
        const bool lead = t < 64;
        const int mt = lead ? (t & 31) : 32;
        const int row0 = lead ? (t >> 5) * LP : (t - 64) * 128;
        GemmAcc<2> acc;
        gemm_tile<2>(W, X, 16, LinRow{(u32)(mt * 128) * 1024u, 1024u}, LinRow{(u32)row0 * 1024u, 1024u}, acc, lds);
#pragma unroll
        for (int mi = 0; mi < 4; ++mi) {
            const int f = mt * 128 + wm * 64 + 16 * mi + 4 * g;
#pragma unroll
            for (int ni = 0; ni < 2; ++ni) {
                const int tok = row0 + wn * 32 + 16 * ni + c;
                const f32x4 v = acc.a[mi][ni];
                if (lead) { if (tok - row0 < 64) { u32x2 w; w.x = pk2(v[0], v[1]); w.y = pk2(v[2], v[3]); *(u32x2*)(P0 + (size_t)tok * 4096 + f) = w;
                        if (f < 3072 && tok - row0 >= 61) *(u32x2*)(HALO + ((size_t)((t >> 5) * 129 + 1) * 3 + (tok - row0 - 61)) * 3072 + f) = w; } }
                else if (f < 4112) *(f32x4*)(BA + (size_t)tok * 16 + (f - 4096)) = v;
            }
        }
    }
}
struct EpiOut {
    static constexpr bool PERM = false;
    float* H;
    DI void operator()(const pg::Acc& acc, const pg::Unit& u, int wr, int wc, int fr, int fq) const {
#pragma unroll
        for (int ai = 0; ai < 2; ++ai)
#pragma unroll
            for (int m = 0; m < 4; ++m) {
                float* hp = H + (size_t)frame_row(u.pm, 128 * ai + 64 * wr + 16 * m + fr) * DM + 256 * u.pn + 32 * wc + 4 * fq;
#pragma unroll
                for (int bj = 0; bj < 2; ++bj)
#pragma unroll
                    for (int n = 0; n < 2; ++n) { f32x4* q = (f32x4*)(hp + 128 * bj + 16 * n); *q = *q + acc[ai][bj][m][n]; }
            }
    }
};
DI void phase_gemm_out(const Params& p, const u16* W, const u16* X, unsigned char* lds) {
    float* H = (float*)(p.ws + WS_H);
    {
        DenseSched S{(const char*)X, (const char*)W, 1024, 4, 64 * 4};
        EpiOut E{H};
        pg::gemm((LAS unsigned char*)lds, 1024, S, E);
    }
    __syncthreads();
    const int lane = tid_opaque() & 63, wid = tid_opaque() >> 6, c = lane & 15, g = lane >> 4, wm = wid >> 2, wn = wid & 3;
    for (int t = (int)gridDim.x - 1 - (int)blockIdx.x; t < 16; t += gridDim.x) {
        const int mt = t & 7, row0 = (t >> 3) * LP;
        GemmAcc<2> acc;
        gemm_tile<2>(W, X, 16, LinRow{(u32)(mt * 128) * 1024u, 1024u}, LinRow{(u32)row0 * 1024u, 1024u}, acc, lds);
#pragma unroll
        for (int mi = 0; mi < 4; ++mi) {
            const int f = mt * 128 + wm * 64 + 16 * mi + 4 * g;
#pragma unroll
            for (int ni = 0; ni < 2; ++ni) {
                const int tok = row0 + wn * 32 + 16 * ni + c;
                if (tok - row0 < 64) { f32x4* hp = (f32x4*)(H + (size_t)tok * DM + f); *hp = *hp + acc.a[mi][ni]; }
            }
        }
    }
}
struct EpiIn1 {
    static constexpr bool PERM = true;
    u16* QRAW; float* KRAW; unsigned char* VN; _Float16* QI;
    DI void operator()(const pg::Acc& acc, const pg::Unit& u, int wr, int wc, int fr, int fq) const {
#pragma unroll
        for (int ai = 0; ai < 2; ++ai)
#pragma unroll
            for (int m = 0; m < 4; ++m) {
                const size_t row = (size_t)frame_row(u.pm, 128 * ai + 64 * wr + 16 * m + fr);
#pragma unroll
                for (int bj = 0; bj < 2; ++bj) {
                    const f32x4 v0 = acc[ai][bj][m][0], v1 = acc[ai][bj][m][1];
                    const int cl = 128 * bj + 32 * wc + 8 * fq;
                    if (u.pn < 4) { u32x4 w; w.x = pk2(v0[0], v0[1]); w.y = pk2(v0[2], v0[3]); w.z = pk2(v1[0], v1[1]); w.w = pk2(v1[2], v1[3]); *(u32x4*)(QRAW + row * 1024 + 256 * u.pn + cl) = w; }
                    else if (u.pn == 4) { *(f32x4*)(KRAW + row * 256 + cl) = v0; *(f32x4*)(KRAW + row * 256 + cl + 4) = v1; }
                    else if (u.pn == 5) { u32x2 w; w.x = pk4_fp8(v0[0], v0[1], v0[2], v0[3]); w.y = pk4_fp8(v1[0], v1[1], v1[2], v1[3]); *(u32x2*)(VN + row * 256 + cl) = w; }
                    else { f16x8 h8; h8[0] = (_Float16)v0[0]; h8[1] = (_Float16)v0[1]; h8[2] = (_Float16)v0[2]; h8[3] = (_Float16)v0[3]; h8[4] = (_Float16)v1[0]; h8[5] = (_Float16)v1[1]; h8[6] = (_Float16)v1[2]; h8[7] = (_Float16)v1[3];
                        *(f16x8*)(QI + row * 512 + 256 * (u.pn - 6) + cl) = h8; }
                }
            }
    }
};
DI void phase_gemm_in1(const Params& p, unsigned char* lds) {
    const u16* W = (const u16*)(p.ws + WS_W_IN1);
    const u16* X = (const u16*)(p.ws + WS_HN);
    u16* QRAW = (u16*)(p.ws + WS_P0 + P0_QRAW);
    float* KRAW = (float*)(p.ws + WS_P0 + P0_KRAW);
    unsigned char* VN = p.ws + WS_P0 + P0_VN;
    _Float16* QI = (_Float16*)(p.ws + WS_P0 + P0_QI);
    float* KIRAW = (float*)((unsigned char*)p.out + DO_KIRAW);
    float* WI = (float*)((unsigned char*)p.out + DO_WI);
    {
        DenseSched S{(const char*)X, (const char*)W, 1024, 8, 64 * 8};
        EpiIn1 E{QRAW, KRAW, VN, QI};
        pg::gemm((LAS unsigned char*)lds, 1024, S, E);
    }
    __syncthreads();
    const int lane = tid_opaque() & 63, wid = tid_opaque() >> 6, c = lane & 15, g = lane >> 4, wm = wid >> 2, wn = wid & 3;
    for (int t = blockIdx.x; t < 32 + 130; t += gridDim.x) {
        const bool lead = t < 32;
        const int mt = lead ? (t & 15) : 16;
        const int row0 = lead ? (t >> 4) * LP : (t - 32) * 128;
        GemmAcc<2> acc;
        gemm_tile<2>(W, X, 16, LinRow{(u32)(mt * 128) * 1024u, 1024u}, LinRow{(u32)row0 * 1024u, 1024u}, acc, lds);
#pragma unroll
        for (int mi = 0; mi < 4; ++mi) {
            const int f = mt * 128 + wm * 64 + 16 * mi + 4 * g;
#pragma unroll
            for (int ni = 0; ni < 2; ++ni) {
                const int tok = row0 + wn * 32 + 16 * ni + c;
                if (tok >= TP || (lead && tok - row0 >= 64)) continue;
                const f32x4 v = acc.a[mi][ni];
                if (f < 1024) { u32x2 w; w.x = pk2(v[0], v[1]); w.y = pk2(v[2], v[3]); *(u32x2*)(QRAW + (size_t)tok * 1024 + f) = w; }
                else if (f < 1280) *(f32x4*)(KRAW + (size_t)tok * 256 + (f - 1024)) = v;
                else if (f < 1536) *(u32*)(VN + (size_t)tok * 256 + (f - 1280)) = pk4_fp8(v[0], v[1], v[2], v[3]);
                else if (f < 2048) {
                    _Float16* q = QI + (size_t)tok * 512 + (f - 1536);
                    q[0] = (_Float16)v[0]; q[1] = (_Float16)v[1]; q[2] = (_Float16)v[2]; q[3] = (_Float16)v[3];
                }
                else if (f < 2112) *(f32x4*)(KIRAW + (size_t)tok * 64 + (f - 2048)) = v;
                else if (f < 2120) *(f32x4*)(WI + (size_t)tok * 8 + (f - 2112)) = v * 0.04419417382415922f;
            }
        }
    }
}

constexpr int G_KT = 0, G_QT = 17408, G_KRT = 34816, G_VRT = 53248, G_LF = 71680, G_TF = 88320, G_TMP = 104960, G_TTW = 109184, G_TTU = 118400,
              G_QKT = 127616, G_SC = 136832;
constexpr int G_WT = G_LF, G_UT = G_LF + 18432;
constexpr int G_ST = G_KRT;
static_assert(G_UT + 18432 <= G_TTW, "WT/UT alias");
DI void gdn_prep_unit(const Params& p, int bh, int ch, unsigned char* lds) {
    const int tid = tid_opaque(), lane = tid & 63, wid = tid >> 6, c = lane & 15, g = lane >> 4;
    const int b = bh >> 3, h = bh & 7;
    const size_t row0 = (size_t)b * LP + (size_t)ch * 64;
    u16* P0 = (u16*)(p.ws + WS_P0);
    const u16* HALO = (const u16*)(p.ws + WS_HALO);
    float* SC = (float*)(lds + G_SC);
    float bb = 0.f, aa = 0.f;
    if (wid == 7) { const float* BA = (const float*)(p.ws + WS_BA); bb = BA[(row0 + lane) * 16 + h]; aa = BA[(row0 + lane) * 16 + 8 + h]; }
    {
        const int cp = tid & 63, part = tid >> 6;
        u32 raw[3][11];
        f32x4 wlo[3], whi[3];
#pragma unroll
        for (int X = 0; X < 3; ++X) {
            const int col = X * 1024 + h * 128 + 2 * cp;
#pragma unroll
            for (int i = 0; i < 11; ++i) {
                const int rr = 8 * part - 3 + i;
                raw[X][i] = rr < 0 ? (ch == 0 ? 0u : *(const u32*)(HALO + ((size_t)(b * 129 + ch) * 3 + (rr + 3)) * 3072 + col)) : *(const u32*)(P0 + (row0 + rr) * 4096 + col);
            }
#pragma unroll
            for (int j = 0; j < 4; ++j) { const float* wp = p.gdn_conv + j * 3072 + col; wlo[X][j] = wp[0]; whi[X][j] = wp[1]; }
        }
        if (wid == 7) {
            const float beta = 1.f / (1.f + __expf(-bb));
            const float xs = aa + p.gdn_dt_bias[h];
            const float sp = xs > 20.f ? xs : log1pf(__expf(xs));
            const float gg = -__expf(p.gdn_a_log[h]) * sp;
            float gc = gg;
#pragma unroll
            for (int o = 1; o < 64; o <<= 1) { const float t = __shfl_up(gc, o); if (lane >= o) gc += t; }
            const float glast = __shfl(gc, 63);
            SC[lane] = gc; SC[64 + lane] = beta; SC[128 + lane] = __expf(gc); SC[192 + lane] = __expf(glast - gc);
            if (lane == 0) SC[384] = __expf(glast);
        }
#pragma unroll
        for (int X = 0; X < 3; ++X) {
            u32 o[8];
#pragma unroll
            for (int i = 0; i < 8; ++i) {
                const float a0 = wlo[X][0] * bflo(raw[X][i]) + wlo[X][1] * bflo(raw[X][i + 1]) + wlo[X][2] * bflo(raw[X][i + 2]) + wlo[X][3] * bflo(raw[X][i + 3]);
                const float a1 = whi[X][0] * bfhi(raw[X][i]) + whi[X][1] * bfhi(raw[X][i + 1]) + whi[X][2] * bfhi(raw[X][i + 2]) + whi[X][3] * bfhi(raw[X][i + 3]);
                o[i] = pk2(silu(a0), silu(a1));
            }
            if (X < 2) {
                u16* T = (u16*)(lds + (X == 0 ? G_QT : G_KT));
#pragma unroll
                for (int i = 0; i < 8; ++i) *(u32*)(T + (8 * part + i) * 136 + 2 * cp) = o[i];
            }
            if (X >= 1) {
                u16* T = (u16*)(lds + (X == 1 ? G_KRT : G_VRT));
                u32x4 lo, hi;
                lo.x = (o[0] & 0xffffu) | (o[1] << 16); lo.y = (o[2] & 0xffffu) | (o[3] << 16); lo.z = (o[4] & 0xffffu) | (o[5] << 16); lo.w = (o[6] & 0xffffu) | (o[7] << 16);
                hi.x = (o[0] >> 16) | (o[1] & 0xffff0000u); hi.y = (o[2] >> 16) | (o[3] & 0xffff0000u); hi.z = (o[4] >> 16) | (o[5] & 0xffff0000u); hi.w = (o[6] >> 16) | (o[7] & 0xffff0000u);
                *(u32x4*)(T + (2 * cp) * 72 + 8 * part) = lo; *(u32x4*)(T + (2 * cp + 1) * 72 + 8 * part) = hi;
            }
        }
    }
    { float* TF = (float*)(lds + G_TF); for (int i = tid; i < 64 * 65; i += NTHREADS) TF[i] = 0.f; }
    __syncthreads();
    {
        const int rt = wid & 3;
        const unsigned char* Arow = lds + (wid < 4 ? G_KT : G_QT);
        f32x4 acc[4], qq = (f32x4){0.f, 0.f, 0.f, 0.f};
#pragma unroll
        for (int ni = 0; ni < 4; ++ni) acc[ni] = (f32x4){0.f, 0.f, 0.f, 0.f};
#pragma unroll
        for (int ks = 0; ks < 4; ++ks) {
            const bf16x8 a = ldsfrag(Arow, 16 * rt + c, 272, 32 * ks + 8 * g);
#pragma unroll
            for (int ni = 0; ni < 4; ++ni) acc[ni] = mfma16(a, ldsfrag(lds + G_KT, 16 * ni + c, 272, 32 * ks + 8 * g), acc[ni]);
            if (wid >= 4) qq = mfma16(a, a, qq);
        }
        {
            const f32x4 kd_ = rt == 0 ? acc[0] : (rt == 1 ? acc[1] : (rt == 2 ? acc[2] : acc[3]));
            const f32x4 d = (wid < 4) ? kd_ : qq;
            if (g == (c >> 2)) {
                const int r = c & 3;
                const float dv = r == 0 ? d[0] : (r == 1 ? d[1] : (r == 2 ? d[2] : d[3]));
                SC[(wid < 4 ? 256 : 320) + 16 * rt + c] = rsqrtf(dv + 1e-6f);
            }
        }
        __syncthreads();
        float* LF = (float*)(lds + G_LF);
        u16* QKT = (u16*)(lds + G_QKT);
#pragma unroll
        for (int ni = 0; ni < 4; ++ni) {
            const int j = 16 * ni + c;
            const float gcj = SC[j], rkj = SC[256 + j];
#pragma unroll
            for (int r = 0; r < 4; ++r) {
                const int i = 16 * rt + 4 * g + r;
                const float gci = SC[i];
                if (wid < 4) {
                    const float v = (i > j) ? SC[64 + i] * SC[256 + i] * rkj * acc[ni][r] * __expf(gci - gcj) : 0.f;
                    LF[i * 65 + j] = v;
                } else {
                    const float v = (i >= j) ? SC[320 + i] * 0.08838834764831845f * rkj * acc[ni][r] * __expf(gci - gcj) : 0.f;
                    QKT[i * 72 + j] = f2bf(v);
                }
            }
        }
    }
    __syncthreads();
    {
        const float* LF = (const float*)(lds + G_LF);
        float* TF = (float*)(lds + G_TF);
        float* TMP = (float*)(lds + G_TMP);
        if (wid == 0) {
            const int b4 = lane >> 4, j = lane & 15;
            float t[16];
#pragma unroll
            for (int i = 0; i < 16; ++i) {
                float s = (i == j) ? 1.f : 0.f;
#pragma unroll
                for (int m = 0; m < i; ++m) s -= LF[(16 * b4 + i) * 65 + 16 * b4 + m] * t[m];
                t[i] = s;
            }
#pragma unroll
            for (int i = 0; i < 16; ++i) TF[(16 * b4 + i) * 65 + 16 * b4 + j] = t[i];
        }
        __syncthreads();
        {
            const int pp = tid >> 8, i = (tid >> 4) & 15, j = tid & 15;
            float s = 0.f;
#pragma unroll
            for (int m = 0; m < 16; ++m) s += LF[(16 * (2 * pp + 1) + i) * 65 + 32 * pp + m] * TF[(32 * pp + m) * 65 + 32 * pp + j];
            TMP[pp * 256 + i * 16 + j] = s;
            __syncthreads();
            float x = 0.f;
#pragma unroll
            for (int m = 0; m < 16; ++m) x -= TF[(16 * (2 * pp + 1) + i) * 65 + 16 * (2 * pp + 1) + m] * TMP[pp * 256 + m * 16 + j];
            TF[(16 * (2 * pp + 1) + i) * 65 + 32 * pp + j] = x;
        }
        __syncthreads();
        {
            const int i = tid >> 4, j0 = tid & 15;
            float s0 = 0.f, s1 = 0.f;
            for (int m = 0; m < 32; ++m) { const float l = LF[(32 + i) * 65 + m]; s0 += l * TF[m * 65 + j0]; s1 += l * TF[m * 65 + j0 + 16]; }
            __syncthreads();
            TMP[i * 33 + j0] = s0; TMP[i * 33 + j0 + 16] = s1;
            __syncthreads();
            float x0 = 0.f, x1 = 0.f;
            for (int m = 0; m < 32; ++m) { const float tt = TF[(32 + i) * 65 + 32 + m]; x0 -= tt * TMP[m * 33 + j0]; x1 -= tt * TMP[m * 33 + j0 + 16]; }
            TF[(32 + i) * 65 + j0] = x0; TF[(32 + i) * 65 + j0 + 16] = x1;
        }
        __syncthreads();
        u16* TTW = (u16*)(lds + G_TTW);
        u16* TTU = (u16*)(lds + G_TTU);
#pragma unroll
        for (int i = 0; i < 8; ++i) {
            const int e = tid + NTHREADS * i, t = e >> 6, s = e & 63;
            const float tv = (s <= t) ? TF[t * 65 + s] : 0.f;
            const float bs = SC[64 + s];
            TTW[t * 72 + s] = f2bf(tv * bs * SC[256 + s] * SC[128 + s]);
            TTU[t * 72 + s] = f2bf(tv * bs);
        }
    }
    __syncthreads();
    {
        const int tt = wid & 3, isu = wid >> 2;
        f32x4 acc[8];
#pragma unroll
        for (int ni = 0; ni < 8; ++ni) acc[ni] = (f32x4){0.f, 0.f, 0.f, 0.f};
        const unsigned char* A = lds + (isu ? G_TTU : G_TTW);
        const unsigned char* Bt = lds + (isu ? G_VRT : G_KRT);
#pragma unroll
        for (int ks = 0; ks < 2; ++ks) {
            const bf16x8 a = ldsfrag(A, 16 * tt + c, 144, 32 * ks + 8 * g);
#pragma unroll
            for (int ni = 0; ni < 8; ++ni) acc[ni] = mfma16(a, ldsfrag(Bt, 16 * ni + c, 144, 32 * ks + 8 * g), acc[ni]);
        }
        __syncthreads();
        u16* WU = (u16*)(lds + (isu ? G_UT : G_WT));
        const int t0 = 16 * tt + 4 * g;
#pragma unroll
        for (int ni = 0; ni < 8; ++ni) {
            u32x2 w; w.x = pk2(acc[ni][0], acc[ni][1]); w.y = pk2(acc[ni][2], acc[ni][3]);
            *(u32x2*)(WU + (16 * ni + c) * 72 + t0) = w;
        }
    }
    __syncthreads();
    {
        f32x4 acc[4];
#pragma unroll
        for (int ni = 0; ni < 4; ++ni) acc[ni] = (f32x4){0.f, 0.f, 0.f, 0.f};
#pragma unroll
        for (int ks = 0; ks < 2; ++ks) {
            const bf16x8 a = ldsfrag(lds + G_WT, 16 * wid + c, 144, 32 * ks + 8 * g);
#pragma unroll
            for (int ni = 0; ni < 4; ++ni) acc[ni] = mfma16(a, ldsfrag(lds + G_QKT, 16 * ni + c, 144, 32 * ks + 8 * g), acc[ni]);
        }
        u16* QT = (u16*)(lds + G_QT);
#pragma unroll
        for (int ni = 0; ni < 4; ++ni) {
            const int t = 16 * ni + c, j0 = 16 * wid + 4 * g;
            const float qs = SC[320 + t] * 0.08838834764831845f * SC[128 + t];
            u32x2* qp = (u32x2*)(QT + t * 136 + j0);
            const u32x2 q = *qp;
            u32x2 w;
            w.x = pk2(bflo(q.x) * qs - acc[ni][0], bfhi(q.x) * qs - acc[ni][1]);
            w.y = pk2(bflo(q.y) * qs - acc[ni][2], bfhi(q.y) * qs - acc[ni][3]);
            *qp = w;
        }
    }
    {
        const int tt = wid & 3, dvh = wid >> 2;
        f32x4 acc[4];
#pragma unroll
        for (int ni = 0; ni < 4; ++ni) acc[ni] = (f32x4){0.f, 0.f, 0.f, 0.f};
#pragma unroll
        for (int ks = 0; ks < 2; ++ks) {
            const bf16x8 a = ldsfrag(lds + G_QKT, 16 * tt + c, 144, 32 * ks + 8 * g);
#pragma unroll
            for (int ni = 0; ni < 4; ++ni) acc[ni] = mfma16(a, ldsfrag(lds + G_UT, 16 * (4 * dvh + ni) + c, 144, 32 * ks + 8 * g), acc[ni]);
        }
        u16* KT = (u16*)(lds + G_KT);
#pragma unroll
        for (int ni = 0; ni < 4; ++ni)
#pragma unroll
            for (int r = 0; r < 4; ++r) KT[(16 * tt + 4 * g + r) * 136 + 16 * (4 * dvh + ni) + c] = f2bf(acc[ni][r]);
    }
    __syncthreads();
    {
#pragma unroll
        for (int i = 0; i < 2; ++i) {
            const int id = tid + NTHREADS * i, t = id >> 4, ck = id & 15;
            *(u32x4*)(P0 + (row0 + t) * 4096 + h * 128 + 8 * ck) = *(const u32x4*)(lds + G_QT + t * 272 + ck * 16);
            *(u32x4*)(P0 + (row0 + t) * 4096 + 1024 + h * 128 + 8 * ck) = *(const u32x4*)(lds + G_KT + t * 272 + ck * 16);
        }
        const int dim = tid >> 2, s0 = (tid & 3) * 16;
        float sc[16];
#pragma unroll
        for (int i = 0; i < 16; ++i) sc[i] = SC[256 + s0 + i] * SC[192 + s0 + i];
#pragma unroll
        for (int X = 0; X < 2; ++X) {
            u32x4* tp = (u32x4*)(lds + (X ? G_UT : G_WT) + dim * 144 + s0 * 2);
#pragma unroll
            for (int hf = 0; hf < 2; ++hf) {
                u32x4 w = tp[hf];
                w.x = pk2(bflo(w.x) * sc[8 * hf + 0], bfhi(w.x) * sc[8 * hf + 1]); w.y = pk2(bflo(w.y) * sc[8 * hf + 2], bfhi(w.y) * sc[8 * hf + 3]);
                w.z = pk2(bflo(w.z) * sc[8 * hf + 4], bfhi(w.z) * sc[8 * hf + 5]); w.w = pk2(bflo(w.w) * sc[8 * hf + 6], bfhi(w.w) * sc[8 * hf + 7]);
                tp[hf] = w;
            }
        }
    }
    __syncthreads();
    {
        {
            f32x4 acc[8];
#pragma unroll
            for (int ni = 0; ni < 8; ++ni) acc[ni] = (f32x4){0.f, 0.f, 0.f, 0.f};
#pragma unroll
            for (int ks = 0; ks < 2; ++ks) {
                const bf16x8 a = ldsfrag(lds + G_WT, 16 * wid + c, 144, 32 * ks + 8 * g);
#pragma unroll
                for (int ni = 0; ni < 8; ++ni) acc[ni] = mfma16(a, ldsfrag(lds + G_KRT, 16 * ni + c, 144, 32 * ks + 8 * g), acc[ni]);
            }
            if (ch > 0) {
                u16* Mg = (u16*)((unsigned char*)p.out + DO_M) + ((size_t)bh * 128 + (ch - 1)) * 16384;
                const float cd = SC[384];
                const int gp = ((g & 1) << 1) | (g >> 1);
#pragma unroll
                for (int ni = 0; ni < 8; ++ni) {
                    const int i = 16 * ni + c, j0 = 16 * wid + 4 * g;
                    float v[4];
#pragma unroll
                    for (int r = 0; r < 4; ++r) v[r] = ((i == j0 + r) ? cd : 0.f) - acc[ni][r];
                    u32x2 w; w.x = pk2(v[0], v[1]); w.y = pk2(v[2], v[3]);
                    *(u32x2*)(Mg + (size_t)i * 128 + 16 * wid + 4 * gp) = w;
                }
            }
        }
        {
            f32x4 acc[8];
#pragma unroll
            for (int ni = 0; ni < 8; ++ni) acc[ni] = (f32x4){0.f, 0.f, 0.f, 0.f};
#pragma unroll
            for (int ks = 0; ks < 2; ++ks) {
                const bf16x8 a = ldsfrag(lds + G_KRT, 16 * wid + c, 144, 32 * ks + 8 * g);
#pragma unroll
                for (int ni = 0; ni < 8; ++ni) acc[ni] = mfma16(a, ldsfrag(lds + G_UT, 16 * ni + c, 144, 32 * ks + 8 * g), acc[ni]);
            }
            u16* NT = (u16*)(p.ws + WS_NS) + ((size_t)bh * NCH + ch) * 16384;
#pragma unroll
            for (int ni = 0; ni < 8; ++ni) {
                u32x2 w; w.x = pk2(acc[ni][0], acc[ni][1]); w.y = pk2(acc[ni][2], acc[ni][3]);
                *(u32x2*)(NT + ((size_t)(4 * wid + g) * 128 + 16 * ni + c) * 4) = w;
            }
        }
    }
    __syncthreads();
}
constexpr int GO_QE = 0, GO_O0 = 17408, GO_ST = 34816, GO_SC = 69632;
DI void gdn_out_unit(const Params& p, int bh, int ch, unsigned char* lds) {
    const int tid = tid_opaque(), lane = tid & 63, wid = tid >> 6, c = lane & 15, g = lane >> 4;
    const int b = bh >> 3, h = bh & 7;
    const size_t row0 = (size_t)b * LP + (size_t)ch * 64;
    const u16* P0 = (const u16*)(p.ws + WS_P0);
    float* SC = (float*)(lds + GO_SC);
#pragma unroll
    for (int i = 0; i < 2; ++i) {
        const int id = tid + NTHREADS * i, t = id >> 4, ck = id & 15;
        *(u32x4*)(lds + GO_QE + t * 272 + ck * 16) = *(const u32x4*)(P0 + (row0 + t) * 4096 + h * 128 + 8 * ck);
        *(u32x4*)(lds + GO_O0 + t * 272 + ck * 16) = *(const u32x4*)(P0 + (row0 + t) * 4096 + 1024 + h * 128 + 8 * ck);
    }
    if (ch > 0) {
        const u16* ST = (const u16*)(p.ws + WS_NS) + ((size_t)bh * NCH + (ch - 1)) * 16384;
#pragma unroll
        for (int i = 0; i < 4; ++i) { const int id = tid + NTHREADS * i, i4 = id >> 6, dvp = id & 63;
            const u32x4 w = *(const u32x4*)(ST + (size_t)id * 8);
            *(u32x2*)(lds + GO_ST + (2 * dvp) * 272 + i4 * 8) = (u32x2){w.x, w.y};
            *(u32x2*)(lds + GO_ST + (2 * dvp + 1) * 272 + i4 * 8) = (u32x2){w.z, w.w}; }
    }
    __syncthreads();
    const int tt = wid & 3, dvh = wid >> 2;
    f32x4 acc[4];
    const u16* O0 = (const u16*)(lds + GO_O0);
#pragma unroll
    for (int ni = 0; ni < 4; ++ni)
#pragma unroll
        for (int r = 0; r < 4; ++r) acc[ni][r] = bf2f(O0[(16 * tt + 4 * g + r) * 136 + 16 * (4 * dvh + ni) + c]);
    if (ch > 0) {
#pragma unroll
        for (int ks = 0; ks < 4; ++ks) {
            const bf16x8 a = ldsfrag(lds + GO_QE, 16 * tt + c, 272, 32 * ks + 8 * g);
#pragma unroll
            for (int ni = 0; ni < 4; ++ni) acc[ni] = mfma16(a, ldsfrag(lds + GO_ST, 16 * (4 * dvh + ni) + c, 272, 32 * ks + 8 * g), acc[ni]);
        }
    }
    float ss[4];
#pragma unroll
    for (int r = 0; r < 4; ++r) {
        float s = 0.f;
#pragma unroll
        for (int ni = 0; ni < 4; ++ni) s += acc[ni][r] * acc[ni][r];
        s += __shfl_xor(s, 1); s += __shfl_xor(s, 2); s += __shfl_xor(s, 4); s += __shfl_xor(s, 8);
        ss[r] = s;
    }
    if (c == 0) {
#pragma unroll
        for (int r = 0; r < 4; ++r) SC[dvh * 64 + 16 * tt + 4 * g + r] = ss[r];
    }
    __syncthreads();
    u16* OG = (u16*)((unsigned char*)p.out + DO_OG);
#pragma unroll
    for (int r = 0; r < 4; ++r) {
        const int t = 16 * tt + 4 * g + r;
        const float rstd = rsqrtf((SC[t] + SC[64 + t]) * (1.f / 128.f) + RMS_EPS);
#pragma unroll
        for (int ni = 0; ni < 4; ++ni) {
            const int dv = 16 * (4 * dvh + ni) + c;
            const float z = bf2f(P0[(row0 + t) * 4096 + 3072 + h * 128 + dv]);
            OG[(row0 + t) * 1024 + h * 128 + dv] = f2bf(acc[ni][r] * rstd * p.gdn_o_norm[dv] * silu(z));
        }
    }
    __syncthreads();
}
DI void phase_gdn_prep(const Params& p, unsigned char* lds) {
    for (int u = blockIdx.x; u < 16 * 128; u += gridDim.x) gdn_prep_unit(p, u >> 7, u & 127, lds);
}
DI void phase_gdn_out(const Params& p, unsigned char* lds) {
    for (int u = blockIdx.x; u < 16 * NCH; u += gridDim.x) gdn_out_unit(p, u / NCH, u % NCH, lds);
}

DI void scan_loadM(u32x4 (&r)[8], const u16* Mg, int j, int t4) {
    if (j <= 127) {
        const u16* src = Mg + (size_t)(j - 1) * 16384;
#pragma unroll
        for (int i = 0; i < 8; ++i) { const int id = t4 + 256 * i; r[i] = *(const u32x4*)(src + (size_t)(id >> 4) * 128 + (id & 15) * 8); }
    }
}
DI void scan_storeM(const u32x4 (&r)[8], unsigned char* slot, int t4) {
#pragma unroll
    for (int i = 0; i < 8; ++i) { const int id = t4 + 256 * i; *(u32x4*)(slot + (id >> 4) * 272 + (id & 15) * 16) = r[i]; }
}
DI void scan_loadNq(u32x4 (&r)[8], const u16* NSb, int j, int lane) {
    if (j <= 127) {
        const u16* s0 = NSb + (size_t)j * 16384;
#pragma unroll
        for (int k = 0; k < 8; ++k) { const int id = lane + 64 * k; r[k] = *(const u32x4*)(s0 + (id >> 4) * 512 + (id & 15) * 8); }
    }
}
#define SCAN_BAR() do { asm volatile("s_waitcnt lgkmcnt(0)" ::: "memory"); __builtin_amdgcn_s_barrier(); asm volatile("" ::: "memory"); } while (0)
DI void scan_loadM2(u32x4 (&r)[16], const u16* Mg, int j, int t2) {
    if (j <= 127) {
        const u16* src = Mg + (size_t)(j - 1) * 16384;
#pragma unroll
        for (int i = 0; i < 16; ++i) { const int id = t2 + 128 * i; r[i] = *(const u32x4*)(src + (size_t)(id >> 4) * 128 + (id & 15) * 8); }
    }
}
DI void scan_storeM2(const u32x4 (&r)[16], unsigned char* slot, int t2) {
#pragma unroll
    for (int i = 0; i < 16; ++i) { const int id = t2 + 128 * i; *(u32x4*)(slot + (id >> 4) * 272 + (id & 15) * 16) = r[i]; }
}
DI void phase_gdn_scan(const Params& p, unsigned char* lds) {
    if (blockIdx.x >= 64) { if (blockIdx.x < 80) gdn_prep_unit(p, blockIdx.x - 64, 128, lds); return; }
    const int bh = blockIdx.x & 15, dvq = blockIdx.x >> 4;
    const int tid = tid_opaque(), lane = tid & 63, wid = __builtin_amdgcn_readfirstlane(tid >> 6), col = lane & 31, hh = lane >> 5;
    const u16* Mg = (const u16*)((unsigned char*)p.out + DO_M) + (size_t)bh * 128 * 16384;
    u16* NSb = (u16*)(p.ws + WS_NS) + (size_t)bh * NCH * 16384 + (size_t)(32 * dvq) * 4;
    unsigned char* slot0 = lds, *slot1 = lds + 34816;
    unsigned char* nb0 = lds + 69632, *nb1 = nb0 + 8192, *sb0 = nb1 + 8192, *sb1 = sb0 + 8192, *fb0 = sb1 + 8192, *fb1 = fb0 + 8192;
    if (wid >= 6) {
        const int t2 = tid - 384;
        u32x4 r0[16], r1[16], r2[16];
        scan_loadM2(r0, Mg, 1, t2); scan_storeM2(r0, slot1, t2); scan_loadM2(r0, Mg, 2, t2); scan_loadM2(r1, Mg, 3, t2); scan_loadM2(r2, Mg, 4, t2);
        SCAN_BAR();
#define SCAN_LD(cc, R) do { if ((cc) <= 127) { if ((cc) + 1 <= 127) scan_storeM2(R, ((cc) + 1) & 1 ? slot1 : slot0, t2); scan_loadM2(R, Mg, (cc) + 4, t2); SCAN_BAR(); } } while (0)
#pragma unroll 1
        for (int c0 = 1; c0 <= 127; c0 += 3) { SCAN_LD(c0, r0); SCAN_LD(c0 + 1, r1); SCAN_LD(c0 + 2, r2); }
#undef SCAN_LD
    } else if (wid == 4) {
        u32x4 r0[8], r1[8], r2[8];
#define SCAN_STN(R, buf) do { _Pragma("unroll") for (int k = 0; k < 8; ++k) *(u32x4*)((buf) + (lane + 64 * k) * 16) = R[k]; } while (0)
        scan_loadNq(r0, NSb, 1, lane); SCAN_STN(r0, nb1); scan_loadNq(r0, NSb, 2, lane); scan_loadNq(r1, NSb, 3, lane); scan_loadNq(r2, NSb, 4, lane);
        SCAN_BAR();
#define SCAN_LN(cc, R) do { if ((cc) <= 127) { if ((cc) + 1 <= 127) SCAN_STN(R, ((cc) + 1) & 1 ? nb1 : nb0); scan_loadNq(R, NSb, (cc) + 4, lane); SCAN_BAR(); } } while (0)
#pragma unroll 1
        for (int c0 = 1; c0 <= 127; c0 += 3) { SCAN_LN(c0, r0); SCAN_LN(c0 + 1, r1); SCAN_LN(c0 + 2, r2); }
#undef SCAN_LN
#undef SCAN_STN
    } else if (wid == 5) {
        SCAN_BAR();
#pragma unroll 1
        for (int cc = 1; cc <= 128; ++cc) {
            if (cc >= 2) {
                const unsigned char* sb = ((cc - 1) & 1) ? sb1 : sb0;
                u16* dst = NSb + (size_t)(cc - 1) * 16384;
#pragma unroll
                for (int k = 0; k < 8; ++k) { const int id = lane + 64 * k; *(u32x4*)(dst + (id >> 4) * 512 + (id & 15) * 8) = *(const u32x4*)(sb + id * 16); }
            }
            if (cc <= 127) SCAN_BAR();
        }
    } else {
        const int ob = wid;
        f32x16 acc;
#pragma unroll
        for (int q = 0; q < 4; ++q) {
            const u32x2 w = *(const u32x2*)(NSb + ((8 * ob + 2 * q + hh) * 128 + col) * 4);
            acc[4 * q + 0] = bflo(w.x); acc[4 * q + 1] = bfhi(w.x); acc[4 * q + 2] = bflo(w.y); acc[4 * q + 3] = bfhi(w.y);
        }
#define SCAN_PUBF(buf) do { _Pragma("unroll") for (int s_ = 0; s_ < 2; ++s_) { bf16x8 f_; _Pragma("unroll") for (int j = 0; j < 8; ++j) f_[j] = (short)f2bf(acc[8 * s_ + j]); \
            *(bf16x8*)((buf) + ((2 * ob + s_) * 64 + lane) * 16) = f_; } } while (0)
        SCAN_PUBF(fb1);
        SCAN_BAR();
        const int apo = (32 * ob + col) * 272 + hh * 16;
#pragma unroll 1
        for (int cc = 1; cc <= 127; ++cc) {
            const unsigned char* cur = (cc & 1) ? slot1 : slot0;
            const unsigned char* nbuf = (cc & 1) ? nb1 : nb0;
            unsigned char* sbuf = (cc & 1) ? sb1 : sb0;
            const unsigned char* fin = (cc & 1) ? fb1 : fb0;
            unsigned char* fout = (cc & 1) ? fb0 : fb1;
            bf16x8 fa[8], fbq[8];
#pragma unroll
            for (int ks = 0; ks < 8; ++ks) { fbq[ks] = *(const bf16x8*)(fin + (ks * 64 + lane) * 16); fa[ks] = *(const bf16x8*)(cur + apo + ks * 32); }
            f32x16 nw;
#pragma unroll
            for (int q = 0; q < 4; ++q) {
                const u32x2 w = *(const u32x2*)(nbuf + ((8 * ob + 2 * q + hh) * 32 + col) * 8);
                nw[4 * q + 0] = bflo(w.x); nw[4 * q + 1] = bfhi(w.x); nw[4 * q + 2] = bflo(w.y); nw[4 * q + 3] = bfhi(w.y);
            }
#pragma unroll
            for (int ks = 0; ks < 8; ++ks) nw = __builtin_amdgcn_mfma_f32_32x32x16_bf16(fa[ks], fbq[ks], nw, 0, 0, 0);
            acc = nw;
#pragma unroll
            for (int q = 0; q < 4; ++q) {
                u32x2 w; w.x = pk2(acc[4 * q], acc[4 * q + 1]); w.y = pk2(acc[4 * q + 2], acc[4 * q + 3]);
                *(u32x2*)(sbuf + ((8 * ob + 2 * q + hh) * 32 + col) * 8) = w;
            }
            SCAN_PUBF(fout);
            SCAN_BAR();
        }
#undef SCAN_PUBF
    }
}
#undef SCAN_BAR

template <bool ADDY, bool ROUTE>
DI void phase_norm(const Params& p, const float* gain, int layer, unsigned char* lds) {
    const int tid = tid_opaque(), lane = tid & 63, wid = tid >> 6;
    float* H = (float*)(p.ws + WS_H);
    u16* HN = (u16*)(p.ws + WS_HN);
    const u16* Y = (const u16*)(p.ws + WS_P0 + P0_Y);
    float* xs = (float*)lds;
    float* part = (float*)(lds + 32768);
    float* logit = (float*)(lds + 32768 + 9216);
    int* asg = (int*)(lds + 32768 + 9216 + 1152);
    int iter = 0;
    const float* wg = p.moe_w_group + (size_t)layer * 1024 * 4;
    const float* we = p.moe_w_expert + (size_t)layer * 1024 * 32;
    float wr[128];
    if (ROUTE) {
        const float* wp = lane < 4 ? wg + lane : we + ((lane < 36 ? lane : 35) - 4);
        const int wst = lane < 4 ? 4 : 32;
#pragma unroll
        for (int k = 0; k < 128; ++k) wr[k] = wp[(size_t)(128 * wid + k) * wst];
    }
    for (int base = blockIdx.x * 8; base < TP; base += gridDim.x * 8) {
        const int row = base + wid;
        {
            f32x4 v[4];
            float ss = 0.f;
#pragma unroll
            for (int i = 0; i < 4; ++i) {
                const int col = 4 * lane + 256 * i;
                v[i] = *(const f32x4*)(H + (size_t)row * DM + col);
                if (ADDY) {
                    const u32x2 y0 = *(const u32x2*)(Y + (size_t)(2 * row) * DM + col), y1 = *(const u32x2*)(Y + (size_t)(2 * row + 1) * DM + col);
                    const int pp = row % LP;
                    if (pp >= 48) {
                        v[i][0] += bflo(y0.x) + bflo(y1.x); v[i][1] += bfhi(y0.x) + bfhi(y1.x); v[i][2] += bflo(y0.y) + bflo(y1.y); v[i][3] += bfhi(y0.y) + bfhi(y1.y);
                        *(f32x4*)(H + (size_t)row * DM + col) = v[i];
                    }
                }
                ss += v[i][0] * v[i][0] + v[i][1] * v[i][1] + v[i][2] * v[i][2] + v[i][3] * v[i][3];
            }
            ss = wave_sum(ss);
            const float rstd = rsqrtf(ss * (1.f / DM) + RMS_EPS);
#pragma unroll
            for (int i = 0; i < 4; ++i) {
                const int col = 4 * lane + 256 * i;
                const f32x4 gn = *(const f32x4*)(gain + col);
                const f32x4 o = (f32x4){v[i][0] * rstd * gn[0], v[i][1] * rstd * gn[1], v[i][2] * rstd * gn[2], v[i][3] * rstd * gn[3]};
                u32x2 w; w.x = pk2(o[0], o[1]); w.y = pk2(o[2], o[3]);
                *(u32x2*)(HN + (size_t)row * DM + col) = w;
                if (ROUTE) *(f32x4*)(xs + wid * 1024 + col) = o;
            }
        }
        if (ROUTE) {
            __syncthreads();
            {
                float a8[8];
#pragma unroll
                for (int r = 0; r < 8; ++r) a8[r] = 0.f;
                if (lane < 36) {
#pragma unroll
                    for (int k4 = 0; k4 < 32; ++k4) {
#pragma unroll
                        for (int r = 0; r < 8; ++r) {
                            const f32x4 x4 = *(const f32x4*)(xs + r * 1024 + 128 * wid + 4 * k4);
                            a8[r] += x4[0] * wr[4 * k4] + x4[1] * wr[4 * k4 + 1] + x4[2] * wr[4 * k4 + 2] + x4[3] * wr[4 * k4 + 3];
                        }
                    }
#pragma unroll
                    for (int r = 0; r < 8; ++r) part[(wid * 8 + r) * 36 + lane] = a8[r];
                }
            }
            __syncthreads();
            if (tid < 288) {
                const int r = tid / 36, n = tid - r * 36;
                float s = 0.f;
#pragma unroll
                for (int w = 0; w < 8; ++w) s += part[(w * 8 + r) * 36 + n];
                s += (n < 4) ? p.moe_b_group[layer * 4 + n] : p.moe_b_expert[layer * 32 + n - 4];
                logit[r * 36 + n] = s;
            }
            __syncthreads();
            if (tid < 8) {
                const int rr = base + tid, pp = rr % LP;
                if (pp >= 48) {
                    const float* lg = logit + tid * 36;
                    int gs = 0; float gm = lg[0];
#pragma unroll
                    for (int i = 1; i < 4; ++i) if (lg[i] > gm) { gm = lg[i]; gs = i; }
                    float gsum = 0.f;
#pragma unroll
                    for (int i = 0; i < 4; ++i) gsum += __expf(lg[i] - gm);
                    const float gw = 1.f / gsum;
                    const float* el = lg + 4 + 8 * gs;
                    int i0 = 0; float m0 = el[0];
#pragma unroll
                    for (int i = 1; i < 8; ++i) if (el[i] > m0) { m0 = el[i]; i0 = i; }
                    int i1 = -1; float m1 = -3.0e38f;
#pragma unroll
                    for (int i = 0; i < 8; ++i) if (i != i0 && el[i] > m1) { m1 = el[i]; i1 = i; }
                    const float e1 = __expf(m1 - m0);
                    const float c0 = gw / (1.f + e1), c1 = gw * e1 / (1.f + e1);
                    float* cw = (float*)(p.ws + WS_CW);
                    cw[2 * rr] = c0; cw[2 * rr + 1] = c1;
                    const int slot = 16 * iter + 2 * tid;
                    asg[slot] = ((8 * gs + i0) << 24) | (2 * rr); asg[slot + 1] = ((8 * gs + i1) << 24) | (2 * rr + 1);
                } else {
                    const int slot = 16 * iter + 2 * tid;
                    asg[slot] = -1; asg[slot + 1] = -1;
                }
            }
            __syncthreads();
        }
        ++iter;
    }
    if (ROUTE) {
        const int n = 16 * iter;
        unsigned* cnt = (unsigned*)(p.ws + WS_CTL) + CW_CNT + layer * 32;
        u32* list = (u32*)(p.ws + WS_LIST);
        int* ebase = asg + 256;
        if (tid < 32) {
            int cn = 0;
            for (int i = 0; i < n; ++i) cn += (asg[i] >= 0 && (asg[i] >> 24) == tid) ? 1 : 0;
            ebase[tid] = cn > 0 ? (int)atomicAdd(&cnt[tid], (unsigned)cn) : 0;
        }
        __syncthreads();
        if (tid < n) {
            const int v = asg[tid];
            if (v >= 0) {
                const int e = v >> 24;
                int rk = 0;
                for (int i = 0; i < tid; ++i) rk += (asg[i] >= 0 && (asg[i] >> 24) == e) ? 1 : 0;
                list[(size_t)e * TP + ebase[e] + rk] = (u32)(v & 0xffffff);
            }
        }
        __syncthreads();
    }
}

struct MoeSched {
    const char* A; const char* Bt; const u32* list; const int* pre;
    int K, ncol, rshift, total; size_t estride, cstride, h1;
    DI bool next(int i, pg::Unit& u) const {
        const int L = i * (int)gridDim.x + (int)blockIdx.x; if (L >= total) return false;
        const int rtile = L / ncol; u.pn = L - rtile * ncol;
        int e = 0;
        for (int j = 1; j < 32; ++j) if (pre[j] <= rtile) e = j;
        u.e = e; u.pm = rtile - pre[e]; u.n = pre[64 + e];
        return true;
    }
    DI int asg(const pg::Unit& u, int r) const { const int gi = u.pm * 256 + r; return (int)list[(size_t)u.e * TP + (gi < u.n ? gi : 0)]; }
    DI int arow(const pg::Unit& u, int r) const { return asg(u, r) >> rshift; }
    DI const char* abase() const { return A; }
    DI const char* bbase(const pg::Unit& u) const { return Bt + (size_t)u.e * estride + (size_t)u.pn * cstride; }
    DI size_t bh1() const { return h1; }
};
struct EpiGateUp {
    static constexpr bool PERM = true;
    const MoeSched* S; const float* cw; u16* ACT;
    DI void operator()(const pg::Acc& acc, const pg::Unit& u, int wr, int wc, int fr, int fq) const {
#pragma unroll
        for (int ai = 0; ai < 2; ++ai)
#pragma unroll
            for (int m = 0; m < 4; ++m) {
                const int r = 128 * ai + 64 * wr + 16 * m + fr;
                if (u.pm * 256 + r >= u.n) continue;
                const int a = S->asg(u, r);
                const float cwa = cw[a];
                const f32x4 g0 = acc[ai][0][m][0], g1 = acc[ai][0][m][1], u0 = acc[ai][1][m][0], u1 = acc[ai][1][m][1];
                u32x4 w;
                w.x = pk2(silu(g0[0]) * u0[0] * cwa, silu(g0[1]) * u0[1] * cwa); w.y = pk2(silu(g0[2]) * u0[2] * cwa, silu(g0[3]) * u0[3] * cwa);
                w.z = pk2(silu(g1[0]) * u1[0] * cwa, silu(g1[1]) * u1[1] * cwa); w.w = pk2(silu(g1[2]) * u1[2] * cwa, silu(g1[3]) * u1[3] * cwa);
                *(u32x4*)(ACT + (size_t)a * 256 + 128 * u.pn + 32 * wc + 8 * fq) = w;
            }
    }
};
struct EpiDown {
    static constexpr bool PERM = true;
    const MoeSched* S; u16* Y;
    DI void operator()(const pg::Acc& acc, const pg::Unit& u, int wr, int wc, int fr, int fq) const {
#pragma unroll
        for (int ai = 0; ai < 2; ++ai)
#pragma unroll
            for (int m = 0; m < 4; ++m) {
                const int r = 128 * ai + 64 * wr + 16 * m + fr;
                if (u.pm * 256 + r >= u.n) continue;
                const int a = S->asg(u, r);
#pragma unroll
                for (int bj = 0; bj < 2; ++bj) {
                    const f32x4 v0 = acc[ai][bj][m][0], v1 = acc[ai][bj][m][1];
                    u32x4 w; w.x = pk2(v0[0], v0[1]); w.y = pk2(v0[2], v0[3]); w.z = pk2(v1[0], v1[1]); w.w = pk2(v1[2], v1[3]);
                    *(u32x4*)(Y + (size_t)a * 1024 + 256 * u.pn + 128 * bj + 32 * wc + 8 * fq) = w;
                }
            }
    }
};
template <int STAGE>
DI void phase_moe(const Params& p, int layer, unsigned char* lds) {
    const int tid = tid_opaque(), lane = tid & 63, wid = tid >> 6, c = lane & 15, g = lane >> 4, wm = wid >> 2, wn = wid & 3;
    int* pre = (int*)(lds + 131072);
    int* tl = pre + 192;
    const unsigned* cnt = (const unsigned*)(p.ws + WS_CTL) + CW_CNT + layer * 32;
    if (tid < 32) pre[64 + tid] = (int)cnt[tid];
    __syncthreads();
    if (tid == 0) {
        int s = 0, s2 = 0;
        for (int e = 0; e < 32; ++e) { const int n = pre[64 + e]; pre[e] = s; s += n >> 8; pre[128 + e] = s2; s2 += ((n & 255) + 127) >> 7; }
        pre[32] = s; pre[160] = s2;
    }
    __syncthreads();
    const u32* list = (const u32*)(p.ws + WS_LIST);
    const float* cw = (const float*)(p.ws + WS_CW);
    const u16* HN = (const u16*)(p.ws + WS_HN);
    u16* ACT = (u16*)(p.ws + WS_P0 + P0_ACT);
    u16* Y = (u16*)(p.ws + WS_P0 + P0_Y);
    if (STAGE == 0) {
        MoeSched S{(const char*)HN, (const char*)(p.ws + WS_P0 + P0_WGU), list, pre, 1024, 2, 1, pre[32] * 2,
                   (size_t)512 * 1024 * 2, (size_t)128 * 1024 * 2, (size_t)256 * 1024 * 2};
        EpiGateUp E{&S, cw, ACT};
        pg::gemm((LAS unsigned char*)lds, 1024, S, E);
    } else {
        MoeSched S{(const char*)ACT, (const char*)(p.ws + WS_P0 + P0_WDN), list, pre, 256, 4, 0, pre[32] * 4,
                   (size_t)1024 * 256 * 2, (size_t)256 * 256 * 2, (size_t)128 * 256 * 2};
        EpiDown E{&S, Y};
        pg::gemm((LAS unsigned char*)lds, 256, S, E);
    }
    __syncthreads();
    constexpr int FT = STAGE == 0 ? 4 : 8;
    const int nleft = pre[160] * FT;
    for (int t = (int)gridDim.x - 1 - (int)blockIdx.x; t < nleft; t += gridDim.x) {
        const int rtile = t / FT, ft = t - rtile * FT;
        int e = 0;
        for (int i = 1; i < 32; ++i) if (pre[128 + i] <= rtile) e = i;
        const int ne = pre[64 + e], r0 = (ne & ~255) + (rtile - pre[128 + e]) * 128;
        if (tid < 128) { const int gi = r0 + tid; tl[tid] = gi < ne ? (int)list[(size_t)e * TP + gi] : -1; }
        __syncthreads();
        GemmAcc<2> acc;
        if (STAGE == 0) {
            const u16* W = (const u16*)(p.ws + WS_P0 + P0_WGU) + (size_t)e * 512 * 1024;
            const int f0 = ft * 64;
            auto pf = [=](int lr) -> u32 { const int x = lr & 63, w = lr >> 6; return (u32)((x < 32 ? f0 + w * 32 + x : 256 + f0 + w * 32 + (x - 32)) * 1024); };
            auto qf = [=](int n) -> u32 { const int a = tl[n]; return (u32)((a < 0 ? (tl[0] >> 1) : (a >> 1)) * 1024); };
            gemm_tile<2>(W, HN, 16, pf, qf, acc, lds);
#pragma unroll
            for (int ni = 0; ni < 2; ++ni) {
                const int a = tl[wn * 32 + 16 * ni + c];
                if (a < 0) continue;
                const float cwa = cw[a];
#pragma unroll
                for (int mi = 0; mi < 2; ++mi) {
                    const f32x4 gt = acc.a[mi][ni], up = acc.a[mi + 2][ni];
                    u32x2 w;
                    w.x = pk2(silu(gt[0]) * up[0] * cwa, silu(gt[1]) * up[1] * cwa);
                    w.y = pk2(silu(gt[2]) * up[2] * cwa, silu(gt[3]) * up[3] * cwa);
                    *(u32x2*)(ACT + (size_t)a * 256 + f0 + wm * 32 + 16 * mi + 4 * g) = w;
                }
            }
        } else {
            const u16* W = (const u16*)(p.ws + WS_P0 + P0_WDN) + (size_t)e * 1024 * 256;
            auto qf = [=](int n) -> u32 { const int a = tl[n]; return (u32)((a < 0 ? tl[0] : a) * 256); };
            gemm_tile<2>(W, ACT, 4, LinRow{(u32)(ft * 128) * 256u, 256u}, qf, acc, lds);
#pragma unroll
            for (int ni = 0; ni < 2; ++ni) {
                const int a = tl[wn * 32 + 16 * ni + c];
                if (a < 0) continue;
#pragma unroll
                for (int mi = 0; mi < 4; ++mi) {
                    const f32x4 v = acc.a[mi][ni];
                    u32x2 w; w.x = pk2(v[0], v[1]); w.y = pk2(v[2], v[3]);
                    *(u32x2*)(Y + (size_t)a * 1024 + ft * 128 + wm * 64 + 16 * mi + 4 * g) = w;
                }
            }
        }
        __syncthreads();
    }
}

DI void phase_post1(const Params& p, unsigned char* lds) {
    const int lane = tid_opaque() & 63, wid = tid_opaque() >> 6;
    const float* KRAW = (const float*)(p.ws + WS_P0 + P0_KRAW);
    const float* KIRAW = (const float*)((unsigned char*)p.out + DO_KIRAW);
    unsigned char* KN = (unsigned char*)p.out + DO_KN;
    _Float16* KI = (_Float16*)((unsigned char*)p.out + DO_KI);
    for (int row = blockIdx.x * 8 + wid; row < TP; row += gridDim.x * 8) {
        const f32x4 k = *(const f32x4*)(KRAW + (size_t)row * 256 + 4 * lane);
        float ss = k[0] * k[0] + k[1] * k[1] + k[2] * k[2] + k[3] * k[3];
#pragma unroll
        for (int o = 16; o >= 1; o >>= 1) ss += __shfl_xor(ss, o);
        const float rstd = rsqrtf(ss * (1.f / 128.f) + RMS_EPS);
        const int d = (4 * lane) & 127;
        const f32x4 kg = *(const f32x4*)(p.dsa_k_norm + d), qg = *(const f32x4*)(p.dsa_q_norm + d);
        *(u32*)(KN + (size_t)row * 256 + 4 * lane) = pk4_fp8(k[0] * rstd * kg[0] * qg[0], k[1] * rstd * kg[1] * qg[1], k[2] * rstd * kg[2] * qg[2], k[3] * rstd * kg[3] * qg[3]);
        const float x = KIRAW[(size_t)row * 64 + lane];
        const float mu = wave_sum(x) * (1.f / 64.f);
        const float xc = x - mu;
        const float var = wave_sum(xc * xc) * (1.f / 64.f);
        KI[(size_t)row * 64 + lane] = (_Float16)(xc * rsqrtf(var + RMS_EPS) * p.dsa_ln_g[lane] + p.dsa_ln_b[lane]);
    }
}

constexpr int IX_HIST = 0;
constexpr int IX_SEL = 65536;
constexpr int IX_CV = IX_SEL + 16384;
constexpr int IX_CI = IX_CV + 16384;
constexpr int IX_CNT = IX_CI + 8192;
constexpr int IX_QI = IX_CNT + 512;
constexpr int IX_QROW = 1296;
template <int PASS>
DI void index_pass(const _Float16* __restrict__ KIb, int ktiles, int wid, int lane, const float (&wh)[8], float sQ, unsigned char* lds) {
    const int q = lane & 31, hh = lane >> 5;
    u32* hist = (u32*)(lds + IX_HIST);
    u16* sell = (u16*)(lds + IX_SEL);
    float* cv = (float*)(lds + IX_CV);
    u16* ci = (u16*)(lds + IX_CI);
    int* cn = (int*)(lds + IX_CNT);
    const int tbq = (PASS == 1) ? cn[64 + q] : 0;
    const unsigned char* qb = lds + IX_QI + q * IX_QROW + hh * 16;
    for (int kt = 1 + wid; kt < ktiles; kt += 8) {
        f16x8 a[4];
#pragma unroll
        for (int s = 0; s < 4; ++s) a[s] = *(const f16x8*)(KIb + (size_t)(32 * kt + q) * 64 + 16 * s + 8 * hh);
        float sc[16];
        {
            f32x16 d;
#pragma unroll
            for (int r = 0; r < 16; ++r) d[r] = 0.f;
#pragma unroll
            for (int hd = 8; hd < 10; ++hd)
#pragma unroll
                for (int s = 0; s < 4; ++s) d = __builtin_amdgcn_mfma_f32_32x32x16_f16(a[s], *(const f16x8*)(qb + hd * 128 + s * 32), d, 0, 0, 0);
#pragma unroll
            for (int r = 0; r < 16; ++r) sc[r] = d[r];
        }
#pragma unroll
        for (int hd = 0; hd < 8; ++hd) {
            f32x16 d;
#pragma unroll
            for (int r = 0; r < 16; ++r) d[r] = 0.f;
#pragma unroll
            for (int s = 0; s < 4; ++s) d = __builtin_amdgcn_mfma_f32_32x32x16_f16(a[s], *(const f16x8*)(qb + hd * 128 + s * 32), d, 0, 0, 0);
#pragma unroll
            for (int r = 0; r < 16; ++r) sc[r] = fmaf(fabsf(d[r]), wh[hd], sc[r]);
            if (hd & 1) __builtin_amdgcn_sched_barrier(0);
        }
        const int kbase = 32 * kt + 4 * hh;
        if (PASS == 0) {
#pragma unroll
            for (int r = 0; r < 16; ++r) {
                const int key = kbase + (r & 3) + 8 * (r >> 2);
                const int bin = (int)fminf(fmaxf(fmaf(sc[r], sQ, 512.f), 0.f), 1023.f);
                if (key >= 48) atomicAdd(&hist[q * 512 + (bin >> 1)], 1u << (16 * (bin & 1)));
            }
        } else {
            u32 selm = 0u, candm = 0u;
#pragma unroll
            for (int r = 0; r < 16; ++r) {
                const int key = kbase + (r & 3) + 8 * (r >> 2);
                const int bin = (int)fminf(fmaxf(fmaf(sc[r], sQ, 512.f), 0.f), 1023.f);
                selm |= (key >= 48 && bin > tbq) ? (1u << r) : 0u;
                candm |= (key >= 48 && bin == tbq) ? (1u << r) : 0u;
            }
            if (selm) {
                int pos = atomicAdd(&cn[q], (int)__builtin_popcount(selm));
                while (selm) {
                    const int r = __builtin_ctz(selm); selm &= selm - 1u;
                    if (pos < 256) sell[q * 256 + pos] = (u16)(kbase + (r & 3) + 8 * (r >> 2));
                    ++pos;
                }
            }
            if (candm) {
                int pos = atomicAdd(&cn[32 + q], (int)__builtin_popcount(candm));
#pragma unroll
                for (int r = 0; r < 16; ++r) if (candm & (1u << r)) { if (pos < 128) { cv[q * 128 + pos] = sc[r]; ci[q * 128 + pos] = (u16)(kbase + (r & 3) + 8 * (r >> 2)); } ++pos; }
            }
        }
    }
}
DI void index_unit(const Params& p, int b, int ch, int half, unsigned char* lds) {
    const int tid = tid_opaque(), lane = tid & 63, wid = tid >> 6;
    u16* SEL = (u16*)((unsigned char*)p.out + DO_SEL);
    const int qrow0 = b * LP + 64 * ch + 32 * half;
    const int nkeys = 64 * (ch + 1) - 48;
    if (nkeys <= 256) {
        for (int i = tid; i < 32 * 256; i += NTHREADS) { const int qq = i >> 8, s = i & 255; SEL[(size_t)(qrow0 + qq) * 256 + s] = (u16)(s < nkeys ? 48 + s : 48); }
        return;
    }
    u32* hist = (u32*)(lds + IX_HIST);
    int* cn = (int*)(lds + IX_CNT);
    for (int i = tid; i < 32 * 512; i += NTHREADS) hist[i] = 0u;
    if (tid < 128) cn[tid] = 0;
    { u16* sell0 = (u16*)(lds + IX_SEL); for (int i = tid; i < 32 * 256; i += NTHREADS) sell0[i] = 48; }
    const _Float16* QI = (const _Float16*)(p.ws + WS_P0 + P0_QI);
    const float* WI = (const float*)((unsigned char*)p.out + DO_WI);
    const _Float16* KIb = (const _Float16*)((unsigned char*)p.out + DO_KI) + (size_t)b * LP * 64;
    const int q = lane & 31;
    float wh[8], sQ;
    {
        float n2 = 0.f;
#pragma unroll
        for (int hd = 0; hd < 8; ++hd) { const float w = WI[(size_t)(qrow0 + q) * 8 + hd]; wh[hd] = 0.5f * w; n2 += w * w; }
        sQ = 512.f / (28.f * sqrtf(n2) + 1e-20f);
    }
#pragma unroll
    for (int i = 0; i < 4; ++i) { const int id = tid + NTHREADS * i, rr = id >> 6, cc = id & 63; *(u32x4*)(lds + IX_QI + rr * IX_QROW + cc * 16) = *(const u32x4*)(QI + (size_t)(qrow0 + rr) * 512 + cc * 8); }
    const int ktiles = 2 * (ch + 1);
    __syncthreads();
    {
        const int qq = tid >> 4, dg = tid & 15;
        float c4[4] = {0.f, 0.f, 0.f, 0.f};
#pragma unroll
        for (int hd = 0; hd < 8; ++hd) {
            const float w = 0.5f * WI[(size_t)(qrow0 + qq) * 8 + hd];
            const _Float16* qp = (const _Float16*)(lds + IX_QI + qq * IX_QROW + hd * 128 + dg * 8);
#pragma unroll
            for (int k = 0; k < 4; ++k) c4[k] += w * (float)qp[k];
        }
        _Float16* ph = (_Float16*)(lds + IX_QI + qq * IX_QROW + 8 * 128 + dg * 8);
        _Float16* pl = (_Float16*)(lds + IX_QI + qq * IX_QROW + 9 * 128 + dg * 8);
#pragma unroll
        for (int k = 0; k < 4; ++k) { const _Float16 hi = (_Float16)c4[k]; ph[k] = hi; pl[k] = (_Float16)(c4[k] - (float)hi); }
    }
    __syncthreads();
    index_pass<0>(KIb, ktiles, wid, lane, wh, sQ, lds);
    __syncthreads();
    for (int qi = 0; qi < 4; ++qi) {
        const int qq = 4 * wid + qi;
        u32 hw[8];
        int cl = 0;
#pragma unroll
        for (int i = 0; i < 8; ++i) { hw[i] = hist[qq * 512 + 8 * lane + i]; cl += (int)(hw[i] & 0xffffu) + (int)(hw[i] >> 16); }
        int suf = cl;
#pragma unroll
        for (int o = 1; o < 64; o <<= 1) { const int t = __shfl_down(suf, o); if (lane + o < 64) suf += t; }
        const int above = suf - cl;
        if (above < 256 && above + cl >= 256) {
            int acc = above, tb = 16 * lane, na = above;
#pragma unroll
            for (int i = 15; i >= 0; --i) {
                const int cb = (int)((hw[i >> 1] >> (16 * (i & 1))) & 0xffffu);
                if (acc < 256 && acc + cb >= 256) { tb = 16 * lane + i; na = acc; }
                acc += cb;
            }
            cn[64 + qq] = tb; cn[96 + qq] = na;
        }
    }
    __syncthreads();
    index_pass<1>(KIb, ktiles, wid, lane, wh, sQ, lds);
    __syncthreads();
    {
        u16* sell = (u16*)(lds + IX_SEL);
        const float* cv = (const float*)(lds + IX_CV);
        const u16* ci = (const u16*)(lds + IX_CI);
        for (int qi = 0; qi < 4; ++qi) {
            const int qq = 4 * wid + qi;
            const int na = cn[96 + qq], need = 256 - na;
            int nc = cn[32 + qq]; nc = nc < 128 ? nc : 128;
#pragma unroll
            for (int half2 = 0; half2 < 2; ++half2) {
                const int i = lane + 64 * half2;
                if (i < nc) {
                    const float vi = cv[qq * 128 + i]; const int ki = ci[qq * 128 + i];
                    int rank = 0;
                    for (int j = 0; j < nc; ++j) { const float vj = cv[qq * 128 + j]; const int kj = ci[qq * 128 + j]; rank += (vj > vi || (vj == vi && kj < ki)) ? 1 : 0; }
                    if (rank < need) sell[qq * 256 + na + rank] = (u16)ki;
                }
            }
        }
    }
    __syncthreads();
    {
        const u32x4* src = (const u32x4*)(lds + IX_SEL);
        u32x4* dst = (u32x4*)(SEL + (size_t)qrow0 * 256);
        for (int i = tid; i < 1024; i += NTHREADS) dst[i] = src[i];
    }
    __syncthreads();
}
DI void phase_index(const Params& p, unsigned char* lds) {
    const int G = gridDim.x;
    for (int r = 0;; ++r) {
        const int u = (r & 1) ? r * G + (G - 1 - (int)blockIdx.x) : r * G + (int)blockIdx.x;
        if (r * G >= 516) break;
        if (u < 516) index_unit(p, (u >> 1) & 1, 128 - (u >> 2), u & 1, lds);
    }
}

DI int t5_bucket(int rel) {
    const int n = rel < 0 ? -rel : rel;
    const int base = rel > 0 ? 16 : 0;
    const int lg = 8 + (n >= 12) + (n >= 16) + (n >= 23) + (n >= 32) + (n >= 46) + (n >= 64) + (n >= 91);
    return base + (n < 8 ? n : lg);
}
constexpr int AT_ITEMS = 513;
constexpr int AT_WAVE_LDS = 11264;
DI int at_swz(int r) { return ((r >> 1) & 1) | (((r >> 3) & 1) << 1); }
DI void attn_query(const Params& p, int b, int n, int qi, unsigned char* wl) {
    const int lane = tid_opaque() & 63, c = lane & 15, g = lane >> 4;
    u32* widx = (u32*)wl;
    u16* Pb = (u16*)(wl + 1024);
    unsigned char* ring = wl + 3072;
    float* Lg = (float*)(ring + 4096);
    const u16* SEL = (const u16*)((unsigned char*)p.out + DO_SEL);
    const u16* QRAW = (const u16*)(p.ws + WS_P0 + P0_QRAW);
    const unsigned char* KN = (const unsigned char*)p.out + DO_KN;
    const unsigned char* VN = p.ws + WS_P0 + P0_VN;
    u16* OA = (u16*)((unsigned char*)p.out + DO_OG);
    const int pq = 48 + qi, row = b * LP + pq;
    const int chq = pq >> 6, nkeys = 64 * (chq + 1) - 48, nsel = nkeys < 256 ? nkeys : 256, ntile = nsel >> 4;
    {
        const u32x2 w = *(const u32x2*)(SEL + (size_t)row * 256 + 4 * lane);
        u32x4 o;
        const int k0 = w.x & 0xffff, k1 = w.x >> 16, k2 = w.y & 0xffff, k3 = w.y >> 16;
        o.x = k0 | (t5_bucket(k0 - pq) << 16); o.y = k1 | (t5_bucket(k1 - pq) << 16); o.z = k2 | (t5_bucket(k2 - pq) << 16); o.w = k3 | (t5_bucket(k3 - pq) << 16);
        *(u32x4*)(widx + 4 * lane) = o;
    }
    const size_t kb = (size_t)b * LP;
    bf16x8 qf[4];
    float ssq = 0.f;
#pragma unroll
    for (int s = 0; s < 4; ++s) {
        if (c < 4) {
            const u32x4 w = *(const u32x4*)(QRAW + (size_t)row * 1024 + (4 * n + c) * 128 + 64 * (s >> 1) + 16 * g + 8 * (s & 1));
            qf[s] = __builtin_bit_cast(bf16x8, w);
            ssq += bflo(w.x) * bflo(w.x) + bfhi(w.x) * bfhi(w.x) + bflo(w.y) * bflo(w.y) + bfhi(w.y) * bfhi(w.y)
                 + bflo(w.z) * bflo(w.z) + bfhi(w.z) * bfhi(w.z) + bflo(w.w) * bflo(w.w) + bfhi(w.w) * bfhi(w.w);
        } else qf[s] = (bf16x8){0, 0, 0, 0, 0, 0, 0, 0};
    }
    ssq += __shfl_xor(ssq, 16); ssq += __shfl_xor(ssq, 32);
    const float qscale = rsqrtf(ssq * (1.f / 128.f) + RMS_EPS) * 0.08838834764831845f;
    bf16x8 bb;
    {
        const float iq = 1.f / qscale;
        const float* rb = p.rel_bias + (8 * g) * 8 + 4 * n + (c & 3);
        u32x4 w;
        w.x = pk2(rb[0] * iq, rb[8] * iq); w.y = pk2(rb[16] * iq, rb[24] * iq); w.z = pk2(rb[32] * iq, rb[40] * iq); w.w = pk2(rb[48] * iq, rb[56] * iq);
        if (c >= 4) w = (u32x4){0u, 0u, 0u, 0u};
        bb = __builtin_bit_cast(bf16x8, w);
    }
    float mx = -3.0e38f;
#define ATT_LOADK(dst, oh, bt) do { _Pragma("unroll") for (int t = 0; t < 4; ++t) { const u32 e_ = widx[16 * (4 * (bt) + t) + c]; const int kid_ = e_ & 0xffff, bk_ = e_ >> 16; \
        const unsigned char* kp_ = KN + (kb + kid_) * 256 + n * 128 + 16 * g; \
        dst[t][0] = *(const u32x4*)(kp_); dst[t][1] = *(const u32x4*)(kp_ + 64); \
        const u32 hv_ = ((bk_ >> 3) == g) ? (0x3f80u << (16 * (bk_ & 1))) : 0u; const int wq_ = (bk_ & 7) >> 1; \
        u32x4 ow_; ow_.x = wq_ == 0 ? hv_ : 0u; ow_.y = wq_ == 1 ? hv_ : 0u; ow_.z = wq_ == 2 ? hv_ : 0u; ow_.w = wq_ == 3 ? hv_ : 0u; oh[t] = __builtin_bit_cast(bf16x8, ow_); } } while (0)
#define ATT_QK(src, oh, bt) do { _Pragma("unroll") for (int t = 0; t < 4; ++t) { f32x4 a4 = (f32x4){0.f, 0.f, 0.f, 0.f}; \
        a4 = mfma16(fp8x8_to_bf16x8(src[t][0].x, src[t][0].y), qf[0], a4); a4 = mfma16(fp8x8_to_bf16x8(src[t][0].z, src[t][0].w), qf[1], a4); \
        a4 = mfma16(fp8x8_to_bf16x8(src[t][1].x, src[t][1].y), qf[2], a4); a4 = mfma16(fp8x8_to_bf16x8(src[t][1].z, src[t][1].w), qf[3], a4); \
        a4 = mfma16(oh[t], bb, a4); \
        const bool val_ = (4 * (bt) + t) < ntile; \
        _Pragma("unroll") for (int r = 0; r < 4; ++r) { a4[r] = val_ ? a4[r] * qscale : -3.0e38f; mx = fmaxf(mx, a4[r]); } \
        lq[t] = a4; } \
        if (c < 4) { _Pragma("unroll") for (int t = 0; t < 4; ++t) *(f32x4*)(Lg + c * 256 + 16 * (4 * (bt) + t) + 4 * g) = lq[t]; } } while (0)
    {
        u32x4 ka[4][2], kc[4][2]; bf16x8 oa[4], oc[4];
        f32x4 lq[4];
        ATT_LOADK(ka, oa, 0);
        ATT_LOADK(kc, oc, 1);
        ATT_QK(ka, oa, 0);
        ATT_LOADK(ka, oa, 2);
        ATT_QK(kc, oc, 1);
        ATT_LOADK(kc, oc, 3);
        ATT_QK(ka, oa, 2);
        ATT_QK(kc, oc, 3);
    }
#undef ATT_LOADK
#undef ATT_QK
    const int kr = lane >> 2, c4 = lane & 3;
    const unsigned char* vbase = VN + kb * 256 + n * 128 + 16 * c4;
#define ATT_LDV(dst, st) do { _Pragma("unroll") for (int j = 0; j < 2; ++j) { const int kid_ = widx[32 * ((st) & 7) + 16 * j + kr] & 0xffff; \
        dst[j] = *(const u32x4*)(vbase + (size_t)kid_ * 256 + 64 * ((st) >> 3)); } } while (0)
#define ATT_STV(src, st) do { unsigned char* sl_ = ring + ((st) & 1) * 4096; _Pragma("unroll") for (int j = 0; j < 2; ++j) { const int r_ = 16 * j + kr; \
        unsigned char* d_ = sl_ + r_ * 128 + ((c4 ^ at_swz(r_)) * 32); \
        *(bf16x8*)(d_) = fp8x8_to_bf16x8(src[j].x, src[j].y); *(bf16x8*)(d_ + 16) = fp8x8_to_bf16x8(src[j].z, src[j].w); } } while (0)
    u32x4 v0[2], v1[2], v2[2], v3[2];
    ATT_LDV(v0, 0); ATT_LDV(v1, 1); ATT_LDV(v2, 2);
    mx = fmaxf(mx, __shfl_xor(mx, 16)); mx = fmaxf(mx, __shfl_xor(mx, 32));
    float inv[4];
    {
#pragma unroll
        for (int hd = 0; hd < 4; ++hd) {
            const float m = __shfl(mx, hd);
            const f32x4 l4 = *(const f32x4*)(Lg + hd * 256 + 4 * lane);
            f32x4 e = (f32x4){__expf(l4[0] - m), __expf(l4[1] - m), __expf(l4[2] - m), __expf(l4[3] - m)};
            if (4 * lane >= nsel) e = (f32x4){0.f, 0.f, 0.f, 0.f};
            inv[hd] = 1.f / wave_sum(e[0] + e[1] + e[2] + e[3]);
            u32x2 w; w.x = pk2(e[0], e[1]); w.y = pk2(e[2], e[3]);
            *(u32x2*)(Pb + hd * 256 + 4 * lane) = w;
        }
    }
    f32x4 acc[2][4];
#pragma unroll
    for (int hf = 0; hf < 2; ++hf)
#pragma unroll
        for (int t = 0; t < 4; ++t) acc[hf][t] = (f32x4){0.f, 0.f, 0.f, 0.f};
#define ATT_PVC(st) do { const unsigned char* sl_ = ring + ((st) & 1) * 4096; \
        bf16x8 pa_ = (bf16x8){0, 0, 0, 0, 0, 0, 0, 0}; if (c < 4) pa_ = *(const bf16x8*)(Pb + c * 256 + 32 * ((st) & 7) + 8 * g); \
        _Pragma("unroll") for (int t = 0; t < 4; ++t) { \
            const int r0_ = 8 * g + (c >> 2), r1_ = r0_ + 4; \
            const s16x4 lo_ = __builtin_amdgcn_ds_read_tr16_b64_v4i16((LAS s16x4*)(sl_ + r0_ * 128 + ((t ^ at_swz(r0_)) * 32) + (c & 3) * 8)); \
            const s16x4 hi_ = __builtin_amdgcn_ds_read_tr16_b64_v4i16((LAS s16x4*)(sl_ + r1_ * 128 + ((t ^ at_swz(r1_)) * 32) + (c & 3) * 8)); \
            const bf16x8 vb_ = (bf16x8){lo_[0], lo_[1], lo_[2], lo_[3], hi_[0], hi_[1], hi_[2], hi_[3]}; \
            acc[(st) >> 3][t] = mfma16(pa_, vb_, acc[(st) >> 3][t]); } } while (0)
    ATT_STV(v0, 0);
#define ATT_STEP(st, vcur, vnext) do { if ((st) + 3 < 16) ATT_LDV(vcur, (st) + 3 + 1 - 1); } while (0)
#pragma unroll
    for (int s4 = 0; s4 < 16; s4 += 4) {
        if (s4 + 3 < 16) ATT_LDV(v3, s4 + 3);
        ATT_STV(v1, s4 + 1); ATT_PVC(s4);
        if (s4 + 4 < 16) ATT_LDV(v0, s4 + 4);
        ATT_STV(v2, s4 + 2); ATT_PVC(s4 + 1);
        if (s4 + 5 < 16) ATT_LDV(v1, s4 + 5);
        ATT_STV(v3, s4 + 3); ATT_PVC(s4 + 2);
        if (s4 + 6 < 16) ATT_LDV(v2, s4 + 6);
        if (s4 + 4 < 16) ATT_STV(v0, s4 + 4);
        ATT_PVC(s4 + 3);
    }
#undef ATT_STEP
#undef ATT_LDV
#undef ATT_STV
#undef ATT_PVC
    if (g == 0) {
#pragma unroll
        for (int r = 0; r < 4; ++r)
#pragma unroll
            for (int hf = 0; hf < 2; ++hf)
#pragma unroll
                for (int t = 0; t < 4; ++t) OA[(size_t)row * 1024 + (4 * n + r) * 128 + 64 * hf + 16 * t + c] = f2bf(acc[hf][t][r] * inv[r]);
    }
}
DI void phase_attn(const Params& p, unsigned xcc, unsigned char* lds) {
    const int tid = tid_opaque(), lane = tid & 63, wid = tid >> 6;
    unsigned char* wl = lds + wid * AT_WAVE_LDS;
    volatile int* item_s = (volatile int*)(lds + 8 * AT_WAVE_LDS);
    u16* OA = (u16*)((unsigned char*)p.out + DO_OG);
    for (int i = blockIdx.x * NTHREADS + tid; i < 96 * 128; i += gridDim.x * NTHREADS) {
        const int r = i >> 7, b = r / 48, pp = r - 48 * b;
        *(u32x4*)(OA + ((size_t)b * LP + pp) * 1024 + (i & 127) * 8) = (u32x4){0u, 0u, 0u, 0u};
    }
    unsigned* qctr = (unsigned*)(p.ws + WS_CTL) + CW_AQ;
    const int my = (int)(xcc & 3u);
    for (;;) {
        if (tid == 0) {
            int it = -1;
            for (int t = 0; t < 4 && it < 0; ++t) {
                const int cb = (my + t) & 3;
                const unsigned j = atomicAdd(&qctr[cb * 64], 1u);
                if (j < (unsigned)AT_ITEMS) it = cb * AT_ITEMS + (int)j;
            }
            *item_s = it;
        }
        __syncthreads();
        const int it = *item_s;
        __syncthreads();
        if (it < 0) break;
        const int cb = it / AT_ITEMS, j = it - cb * AT_ITEMS;
        attn_query(p, cb >> 1, cb & 1, 16 * j + wid, wl);
        attn_query(p, cb >> 1, cb & 1, 16 * j + 8 + wid, wl);
    }
}

DI void phase_final(const Params& p) {
    const float* H = (const float*)(p.ws + WS_H);
    const u16* Y = (const u16*)(p.ws + WS_P0 + P0_Y);
    for (size_t i = (size_t)blockIdx.x * NTHREADS + tid_opaque(); i < (size_t)2 * SEQ * 256; i += (size_t)gridDim.x * NTHREADS) {
        const size_t orow = i >> 8; const int col = (int)(i & 255) * 4;
        const int b = (int)(orow >> 13), s = (int)(orow & 8191);
        const size_t row = (size_t)b * LP + 64 + s;
        f32x4 v = *(const f32x4*)(H + row * DM + col);
        const u32x2 y0 = *(const u32x2*)(Y + (2 * row) * DM + col), y1 = *(const u32x2*)(Y + (2 * row + 1) * DM + col);
        v[0] += bflo(y0.x) + bflo(y1.x); v[1] += bfhi(y0.x) + bfhi(y1.x); v[2] += bflo(y0.y) + bflo(y1.y); v[3] += bfhi(y0.y) + bfhi(y1.y);
        *(f32x4*)(p.out + orow * DM + col) = v;
    }
}

__global__ void __launch_bounds__(NTHREADS, 2) mega(Params p) {
    extern __shared__ __attribute__((aligned(16))) unsigned char lds[];
    if (threadIdx.x < 4) ((volatile LAS unsigned*)(lds + LDS_BAR))[threadIdx.x] = 0u;
    __syncthreads();
    XcdBarrier bar = xcd_barrier_post((unsigned*)(p.ws + WS_CTL) + CW_BAR, (volatile LAS unsigned*)(lds + LDS_BAR));
    phase_prep(p, lds);                                                   xcd_barrier(bar);
    phase_gemm_in0(p, lds);                                               xcd_barrier(bar);
    phase_gdn_prep(p, lds);                                             xcd_barrier(bar);
    phase_gdn_scan(p, lds);                                               xcd_barrier(bar);
    phase_gdn_out(p, lds);                                              xcd_barrier(bar);
    phase_gemm_out(p, (const u16*)(p.ws + WS_W_OUT0), (const u16*)((unsigned char*)p.out + DO_OG), lds);   xcd_barrier(bar);
    phase_norm<false, true>(p, p.norm_ffn, 0, lds);
    conv_moe_weights(p, 0, lds);                                          xcd_barrier(bar);
    phase_moe<0>(p, 0, lds);                                              xcd_barrier(bar);
    phase_moe<1>(p, 0, lds);                                              xcd_barrier(bar);
    phase_norm<true, false>(p, p.norm_mix + DM, 0, lds);
    conv_moe_weights(p, 1, lds);                                          xcd_barrier(bar);
    phase_gemm_in1(p, lds);                                               xcd_barrier(bar);
    phase_post1(p, lds);                                                  xcd_barrier(bar);
    phase_index(p, lds);                                                  xcd_barrier(bar);
    phase_attn(p, bar.x, lds);                                                   xcd_barrier(bar);
    phase_gemm_out(p, (const u16*)(p.ws + WS_W_OUT1), (const u16*)((unsigned char*)p.out + DO_OG), lds);   xcd_barrier(bar);
    phase_norm<false, true>(p, p.norm_ffn + DM, 1, lds);                  xcd_barrier(bar);
    phase_moe<0>(p, 1, lds);                                              xcd_barrier(bar);
    phase_moe<1>(p, 1, lds);                                              xcd_barrier(bar);
    phase_final(p);
}

extern "C" void kernel_launch(void* const* d_in, const int* in_sizes, int n_in, void* d_out, int out_size, void* d_ws, size_t ws_size, hipStream_t stream) {
    static int grid = 0;
    if (grid == 0) {
        if (n_in != 23 || out_size != 2 * SEQ * DM || ws_size < WS_END) { fprintf(stderr, "kernel_launch: unexpected sizes (n_in %d out %d ws %zu need %zu)\n", n_in, out_size, ws_size, (size_t)WS_END); grid = -1; return; }
        int dev = 0, cus = 0;
        if (hipGetDevice(&dev) != hipSuccess || hipDeviceGetAttribute(&cus, hipDeviceAttributeMultiprocessorCount, dev) != hipSuccess) { grid = -1; return; }
        if (hipFuncSetAttribute((const void*)mega, hipFuncAttributeMaxDynamicSharedMemorySize, LDS_BYTES) != hipSuccess) { fprintf(stderr, "kernel_launch: hipFuncSetAttribute failed\n"); grid = -1; return; }
        grid = cus > 256 ? 256 : cus;
        if (grid < 16) { grid = -1; return; }
    }
    if (grid < 0) return;
    (void)hipMemsetAsync((unsigned char*)d_ws + WS_CTL, 0, CTL_BYTES, stream);
    Params p{};
    const float** f = (const float**)&p;
    for (int i = 0; i < 23; ++i) f[i] = (const float*)d_in[i];
    p.out = (float*)d_out; p.ws = (unsigned char*)d_ws;
    hipLaunchKernelGGL(mega, dim3(grid), dim3(NTHREADS), LDS_BYTES, stream, p);
}
```

```cpp
#include <hip/hip_runtime.h>
#include <stdint.h>
#include <stdio.h>

#define DI __device__ __forceinline__
#define LAS __attribute__((address_space(3)))
typedef unsigned short u16;
typedef unsigned int u32;
typedef short bf16x8 __attribute__((ext_vector_type(8)));
typedef _Float16 f16x8 __attribute__((ext_vector_type(8)));
typedef float f32x4 __attribute__((ext_vector_type(4)));
typedef float f32x16 __attribute__((ext_vector_type(16)));
typedef u32 u32x4 __attribute__((ext_vector_type(4)));
typedef u32 u32x2 __attribute__((ext_vector_type(2)));
typedef short s16x4 __attribute__((ext_vector_type(4)));

constexpr int DM = 1024, SEQ = 8192, LP = 8256, TP = 16512, TPA = 16640, NCH = 129;
constexpr int NTHREADS = 512;
constexpr int LDS_BYTES = 155648;
constexpr int LDS_BAR = LDS_BYTES - 16;
constexpr float RMS_EPS = 1e-6f;

constexpr size_t WS_CTL = 0, CTL_BYTES = 1u << 20;
constexpr size_t WS_W_IN0 = CTL_BYTES;
constexpr size_t WS_W_OUT0 = WS_W_IN0 + (size_t)4224 * 1024 * 2;
constexpr size_t WS_W_IN1 = WS_W_OUT0 + (size_t)1024 * 1024 * 2;
constexpr size_t WS_W_OUT1 = WS_W_IN1 + (size_t)2176 * 1024 * 2;
constexpr size_t WS_BA = WS_W_OUT1 + (size_t)1024 * 1024 * 2;
constexpr size_t WS_LIST = WS_BA + (size_t)TPA * 16 * 4;
constexpr size_t WS_CW = WS_LIST + (size_t)32 * TP * 4;
constexpr size_t WS_H = WS_CW + (size_t)2 * TP * 4;
constexpr size_t WS_NS = WS_H + (size_t)TPA * 1024 * 4;
constexpr size_t WS_HN = WS_NS;
constexpr size_t WS_P0 = WS_NS + (size_t)16 * 129 * 128 * 128 * 2;
constexpr size_t WS_HALO = WS_P0 + (size_t)TPA * 4096 * 2;
constexpr size_t WS_END = WS_HALO + (size_t)2 * 129 * 3 * 3072 * 2;
constexpr size_t P0_WGU = 0;
constexpr size_t P0_WDN = P0_WGU + (size_t)32 * 512 * 1024 * 2;
constexpr size_t P0_ACT = P0_WDN + (size_t)32 * 1024 * 256 * 2;
constexpr size_t P0_Y = P0_ACT + (size_t)2 * TP * 256 * 2;
constexpr size_t P0_QRAW = P0_ACT;
constexpr size_t P0_KRAW = P0_QRAW + (size_t)TP * 1024 * 2;
constexpr size_t P0_VN = P0_KRAW + (size_t)TP * 256 * 4;
constexpr size_t P0_QI = P0_VN + (size_t)TP * 256 * 2;
static_assert(P0_Y + (size_t)2 * TP * 1024 * 2 <= (size_t)TPA * 4096 * 2, "P0 map");
static_assert(P0_QI + (size_t)TP * 512 * 2 <= (size_t)TPA * 4096 * 2, "P0 map 2");
constexpr size_t DO_M = 0;
constexpr size_t DO_OG = 0;
constexpr size_t DO_SEL = (size_t)TPA * 1024 * 2;
constexpr size_t DO_KN = DO_SEL + (size_t)TP * 256 * 2;
constexpr size_t DO_KI = DO_KN + (size_t)TP * 256 * 2;
constexpr size_t DO_WI = DO_KI + (size_t)TP * 64 * 2;
constexpr size_t DO_KIRAW = DO_WI + (size_t)TP * 8 * 4;
static_assert(DO_KIRAW + (size_t)TP * 64 * 4 <= (size_t)2 * SEQ * 1024 * 4, "d_out map");
constexpr int CW_BAR = 0;
constexpr int CW_CNT = 4096;
constexpr int CW_AQ = 4352;

struct Params {
    const float *x, *meta, *norm_mix, *norm_ffn, *rel_bias, *gdn_w_in, *gdn_conv, *gdn_a_log, *gdn_dt_bias, *gdn_o_norm, *gdn_w_out,
        *dsa_w_in, *dsa_q_norm, *dsa_k_norm, *dsa_ln_g, *dsa_ln_b, *dsa_w_out, *moe_w_group, *moe_b_group, *moe_w_expert, *moe_b_expert,
        *moe_w_gu, *moe_w_down;
    float* out;
    unsigned char* ws;
};

DI u16 f2bf(float f) { return __builtin_bit_cast(u16, (__bf16)f); }
DI float bf2f(u16 h) { return __uint_as_float(((u32)h) << 16); }
DI u32 pk2(float a, float b) { return (u32)f2bf(a) | ((u32)f2bf(b) << 16); }
DI float bflo(u32 w) { return __uint_as_float(w << 16); }
DI float bfhi(u32 w) { return __uint_as_float(w & 0xffff0000u); }
typedef float f32x2 __attribute__((ext_vector_type(2)));
DI u32 pk4_fp8(float a, float b, float c, float d) { int w = 0; w = __builtin_amdgcn_cvt_pk_fp8_f32(a, b, w, false); w = __builtin_amdgcn_cvt_pk_fp8_f32(c, d, w, true); return (u32)w; }
DI u32x2 fp8x4_to_bf16x4(u32 w) {
    const f32x2 lo = __builtin_amdgcn_cvt_pk_f32_fp8((int)w, false), hi = __builtin_amdgcn_cvt_pk_f32_fp8((int)w, true);
    u32x2 r; r.x = pk2(lo[0], lo[1]); r.y = pk2(hi[0], hi[1]); return r;
}
DI bf16x8 fp8x8_to_bf16x8(u32 w0, u32 w1) { const u32x2 a = fp8x4_to_bf16x4(w0), b = fp8x4_to_bf16x4(w1); return __builtin_bit_cast(bf16x8, (u32x4){a.x, a.y, b.x, b.y}); }
DI float wave_sum(float v) {
#pragma unroll
    for (int o = 32; o >= 1; o >>= 1) v += __shfl_xor(v, o);
    return v;
}
DI int tid_opaque() { int t = threadIdx.x; asm volatile("" : "+v"(t)); return t; }
#define LDS_BARRIER() do { asm volatile("s_waitcnt lgkmcnt(0)" ::: "memory"); __builtin_amdgcn_s_barrier(); asm volatile("" ::: "memory"); } while (0)
DI float silu(float x) { return x / (1.f + __expf(-x)); }
DI f32x4 mfma16(bf16x8 a, bf16x8 b, f32x4 c) { return __builtin_amdgcn_mfma_f32_16x16x32_bf16(a, b, c, 0, 0, 0); }
DI bf16x8 ldsfrag(const unsigned char* base, int row, int strideB, int kel) { return *(const bf16x8*)(base + row * strideB + kel * 2); }

#define XB_TMO      128
#define XB_XCNT(j)  (256  + 64 * (j))
#define XB_XSUB(j)  (1280 + 64 * (j))
#define XB_XGEN(j)  (2304 + 64 * (j))
#define XB_TOP      3328
#define XB_TOPGEN   3392
#define XCD_BAR_WORDS 3456
#define XB_SPIN_CAP (1u << 21)
DI unsigned xb_ld(unsigned* p) { return __hip_atomic_load(p, __ATOMIC_RELAXED, __HIP_MEMORY_SCOPE_AGENT); }
DI unsigned xb_add(unsigned* p, unsigned v) { return __hip_atomic_fetch_add(p, v, __ATOMIC_RELAXED, __HIP_MEMORY_SCOPE_AGENT); }
DI unsigned xb_xcc_id() { return (unsigned)__builtin_amdgcn_s_getreg((3 << 11) | 20) & 0xFu; }
#define XB_SPIN(cond, bar) do { unsigned _sp = 0; while (cond) { __builtin_amdgcn_s_sleep(1); \
    if ((++_sp & 255u) == 0u) { if (xb_ld(&(bar)[XB_TMO])) break; if (_sp > XB_SPIN_CAP) { atomicAdd(&(bar)[XB_TMO], 1u); break; } } } } while (0)
struct XcdBarrier { unsigned* bar; unsigned x; volatile LAS unsigned* st; };
DI XcdBarrier xcd_barrier_post(unsigned* bar, volatile LAS unsigned* st) {
    XcdBarrier b; b.bar = bar; b.x = xb_xcc_id(); b.st = st;
    if (threadIdx.x == 0) (void)xb_add(&bar[XB_XCNT(b.x)], 1u);
    return b;
}
DI void xcd_barrier_complete(unsigned* bar, unsigned x, unsigned& nloc, unsigned& nx) {
    const unsigned G = gridDim.x * gridDim.y * gridDim.z;
    unsigned sum, cnt, mine, sp = 0u;
    for (;;) {
        sum = 0u; cnt = 0u; mine = 0u;
#pragma unroll
        for (unsigned j = 0; j < 16; ++j) { const unsigned c = xb_ld(&bar[XB_XCNT(j)]); sum += c; cnt += (c > 0u) ? 1u : 0u; }
        mine = xb_ld(&bar[XB_XCNT(x)]);
        if (sum == G) break;
        __builtin_amdgcn_s_sleep(1);
        if ((++sp & 255u) == 0u) { if (xb_ld(&bar[XB_TMO])) break; if (sp > XB_SPIN_CAP) { atomicAdd(&bar[XB_TMO], 1u); break; } }
    }
    nloc = mine > 0u ? mine : 1u; nx = cnt > 0u ? cnt : 1u;
}
DI void xcd_barrier(const XcdBarrier& b) {
    asm volatile("s_waitcnt vmcnt(0)" ::: "memory");
    __syncthreads();
    if (threadIdx.x == 0) {
        unsigned* bar = b.bar;
        __builtin_amdgcn_s_waitcnt(0);
        unsigned nloc = b.st[0], nx = b.st[1];
        if (nloc == 0u) { xcd_barrier_complete(bar, b.x, nloc, nx); b.st[0] = nloc; b.st[1] = nx; }
        const unsigned old = xb_add(&bar[XB_XSUB(b.x)], 1u);
        const unsigned gen = old / nloc;
        if (old + 1u == (gen + 1u) * nloc) {
            __builtin_amdgcn_fence(__ATOMIC_RELEASE, "agent");
            asm volatile("s_waitcnt vmcnt(0)" ::: "memory");
            const unsigned og = xb_add(&bar[XB_TOP], 1u);
            const unsigned tg = og / nx;
            if (og + 1u == (tg + 1u) * nx) xb_add(&bar[XB_TOPGEN], 1u);
            else XB_SPIN(xb_ld(&bar[XB_TOPGEN]) == tg, bar);
            __builtin_amdgcn_fence(__ATOMIC_ACQUIRE, "agent");
            xb_add(&bar[XB_XGEN(b.x)], 1u);
            asm volatile("s_waitcnt vmcnt(0)" ::: "memory");
        } else {
            XB_SPIN(xb_ld(&bar[XB_XGEN(b.x)]) == gen, bar);
            __builtin_amdgcn_fence(__ATOMIC_ACQUIRE, "agent");
            asm volatile("s_waitcnt vmcnt(0)" ::: "memory");
        }
    }
    __syncthreads();
}

struct ConvJob { const float* src; u16* dst; int K, N, kt, nt; };
DI void convT_load(const ConvJob& j, float (&r)[16], int tid) {
    const int l32 = tid & 31, kb = tid >> 5;
#pragma unroll
    for (int kk = 0; kk < 4; ++kk)
#pragma unroll
        for (int q = 0; q < 4; ++q) {
            const int k = j.kt * 64 + kb + 16 * kk, n = j.nt * 128 + l32 + 32 * q;
            r[4 * kk + q] = (n < j.N) ? j.src[(size_t)k * j.N + n] : 0.f;
        }
}
DI void convT_store(const ConvJob& j, const float (&r)[16], int tid, unsigned char* lds) {
    const int l32 = tid & 31, kb = tid >> 5;
    u16* img = (u16*)lds;
#pragma unroll
    for (int kk = 0; kk < 4; ++kk)
#pragma unroll
        for (int q = 0; q < 4; ++q) img[(l32 + 32 * q) * 68 + kb + 16 * kk] = f2bf(r[4 * kk + q]);
    __syncthreads();
#pragma unroll
    for (int i = 0; i < 2; ++i) {
        const int id = tid + NTHREADS * i, n = id >> 3, ck = id & 7;
        const u32x2 a = *(const u32x2*)(lds + n * 136 + ck * 16), b2 = *(const u32x2*)(lds + n * 136 + ck * 16 + 8);
        *(u32x4*)(j.dst + (size_t)(j.nt * 128 + n) * j.K + j.kt * 64 + ck * 8) = (u32x4){a.x, a.y, b2.x, b2.y};
    }
    __syncthreads();
}
template <class DEC> DI void convT_run(DEC dec, int nunits, unsigned char* lds) {
    const int tid = tid_opaque();
    int u = blockIdx.x;
    if (u >= nunits) return;
    ConvJob cur = dec(u), nxt = cur;
    float r[16];
    convT_load(cur, r, tid);
    for (;;) {
        const int un = u + (int)gridDim.x;
        const bool more = un < nunits;
        float rn[16];
        u16* img = (u16*)lds;
        {
            const int l32 = tid & 31, kb = tid >> 5;
#pragma unroll
            for (int kk = 0; kk < 4; ++kk)
#pragma unroll
                for (int q = 0; q < 4; ++q) img[(l32 + 32 * q) * 68 + kb + 16 * kk] = f2bf(r[4 * kk + q]);
        }
        if (more) { nxt = dec(un); convT_load(nxt, rn, tid); }
        __syncthreads();
#pragma unroll
        for (int i = 0; i < 2; ++i) {
            const int id = tid + NTHREADS * i, n = id >> 3, ck = id & 7;
            const u32x2 a = *(const u32x2*)(lds + n * 136 + ck * 16), b2 = *(const u32x2*)(lds + n * 136 + ck * 16 + 8);
            *(u32x4*)(cur.dst + (size_t)(cur.nt * 128 + n) * cur.K + cur.kt * 64 + ck * 8) = (u32x4){a.x, a.y, b2.x, b2.y};
        }
        __syncthreads();
        if (!more) break;
        u = un; cur = nxt;
#pragma unroll
        for (int i = 0; i < 16; ++i) r[i] = rn[i];
    }
}

template <int NI> struct GemmAcc { f32x4 a[4][NI]; };
template <int NI, class PF, class QF>
DI void gemm_tile(const u16* __restrict__ Pb, const u16* __restrict__ Qb, int KT, PF pf, QF qf, GemmAcc<NI>& acc, unsigned char* lds) {
    constexpr int TN = 64 * NI, QC = TN * 8 / NTHREADS, BUF = (128 + TN) * 144;
    const int tid = tid_opaque(), lane = tid & 63, wid = tid >> 6, c = lane & 15, g = lane >> 4, wm = wid >> 2, wn = wid & 3;
    u32 poff[2], qoff[QC];
#pragma unroll
    for (int i = 0; i < 2; ++i) { const int id = tid + NTHREADS * i; poff[i] = pf(id >> 3) + (id & 7) * 8; }
#pragma unroll
    for (int i = 0; i < QC; ++i) { const int id = tid + NTHREADS * i; qoff[i] = qf(id >> 3) + (id & 7) * 8; }
#pragma unroll
    for (int mi = 0; mi < 4; ++mi)
#pragma unroll
        for (int ni = 0; ni < NI; ++ni) acc.a[mi][ni] = (f32x4){0.f, 0.f, 0.f, 0.f};
    u32x4 p0[2], p1[2], p2[2], p3[2], q0[QC], q1[QC], q2[QC], q3[QC];
#define GT_LOAD(P, Q, kt) do { if ((kt) < KT) { _Pragma("unroll") for (int i = 0; i < 2; ++i) P[i] = *(const u32x4*)(Pb + poff[i] + (kt) * 64); \
        _Pragma("unroll") for (int i = 0; i < QC; ++i) Q[i] = *(const u32x4*)(Qb + qoff[i] + (kt) * 64); } } while (0)
#define GT_STORE(P, Q, buf) do { _Pragma("unroll") for (int i = 0; i < 2; ++i) { const int id = tid + NTHREADS * i; *(u32x4*)((buf) + (id >> 3) * 144 + (id & 7) * 16) = P[i]; } \
        _Pragma("unroll") for (int i = 0; i < QC; ++i) { const int id = tid + NTHREADS * i; *(u32x4*)((buf) + 128 * 144 + (id >> 3) * 144 + (id & 7) * 16) = Q[i]; } } while (0)
#define GT_STEP(kt, PN, QN, PC, QC_) do { if ((kt) < KT) { const unsigned char* cur = lds + ((kt) & 1) * BUF; \
        _Pragma("unroll") for (int ks = 0; ks < 2; ++ks) { bf16x8 af[4], bfr[NI]; \
            _Pragma("unroll") for (int mi = 0; mi < 4; ++mi) af[mi] = ldsfrag(cur, wm * 64 + 16 * mi + c, 144, 32 * ks + 8 * g); \
            _Pragma("unroll") for (int ni = 0; ni < NI; ++ni) bfr[ni] = ldsfrag(cur + 128 * 144, wn * 16 * NI + 16 * ni + c, 144, 32 * ks + 8 * g); \
            _Pragma("unroll") for (int mi = 0; mi < 4; ++mi) _Pragma("unroll") for (int ni = 0; ni < NI; ++ni) acc.a[mi][ni] = mfma16(af[mi], bfr[ni], acc.a[mi][ni]); } \
        if ((kt) + 1 < KT) GT_STORE(PN, QN, lds + (((kt) + 1) & 1) * BUF); \
        GT_LOAD(PC, QC_, (kt) + 4); \
        __syncthreads(); } } while (0)
    GT_LOAD(p0, q0, 0); GT_LOAD(p1, q1, 1); GT_LOAD(p2, q2, 2); GT_LOAD(p3, q3, 3);
    GT_STORE(p0, q0, lds);
    __syncthreads();
    for (int k0 = 0; k0 < KT; k0 += 4) {
        GT_STEP(k0, p1, q1, p0, q0);
        GT_STEP(k0 + 1, p2, q2, p1, q1);
        GT_STEP(k0 + 2, p3, q3, p2, q2);
        GT_STEP(k0 + 3, p0, q0, p3, q3);
    }
#undef GT_LOAD
#undef GT_STORE
#undef GT_STEP
}
struct LinRow { u32 base, ld; DI u32 operator()(int r) const { return base + (u32)r * ld; } };

namespace pg {
constexpr int BM = 256, BK = 64, HALF = 128, HTB = HALF * BK * 2;
DI int lds_byte(int r, int c) { const int st = (r >> 4) * 2 + (c >> 5), rr = r & 15, cc = c & 31, ob = rr * 64 + cc * 2; return st * 1024 + (ob ^ (((ob >> 9) & 1) << 5)); }
DI void stage_rc(int b, int& R, int& C) { const int st = b / 1024, sb = b % 1024, swz = sb ^ (((sb >> 9) & 1) << 5); R = (st >> 1) * 16 + swz / 64; C = (st & 1) * 32 + (swz % 64) / 2; }
DI int perm32(int rho) { const int n = rho >> 4, i = rho & 15; return 8 * (i >> 2) + 4 * n + (i & 3); }
struct Unit { int pm, pn, e, n; };
typedef f32x4 Acc[2][2][4][2];
template <class Sched, class Epi>
DI void gemm(LAS unsigned char* lds, const int K, const Sched& S, const Epi& E) {
    const int tid = tid_opaque(), wid = __builtin_amdgcn_readfirstlane(tid >> 6), lane = tid & 63, wr = wid >> 2, wc = wid & 3, fr = lane & 15, fq = lane >> 4;
    const int nt = K / BK;
    int Rs[2], Cs[2];
    unsigned voffB[2];
#pragma unroll
    for (int i = 0; i < 2; ++i) { stage_rc(tid * 16 + i * 8192, Rs[i], Cs[i]); const int Rb = Epi::PERM ? ((Rs[i] & ~31) + perm32(Rs[i] & 31)) : Rs[i]; voffB[i] = (unsigned)(Rb * K + Cs[i]) * 2u; }
    const size_t kstep = (size_t)(BK * 2);
    const size_t bh1 = S.bh1();
    const unsigned ldsw = (unsigned)wid * 1024u;
    const int aoff = lds_byte(wr * 64 + fr, fq * 8), boff = lds_byte(wc * 32 + fr, fq * 8);
    const char* Ab = S.abase();
#define PG_SA(b, h) (((b) * 2 + (h)) * HTB)
#define PG_SB(b, h) ((4 + (b) * 2 + (h)) * HTB)
#define PG_STAGE(bufoff, gbase, voff) do { _Pragma("unroll") for (int _i = 0; _i < 2; ++_i) \
        __builtin_amdgcn_global_load_lds((const unsigned*)((const char*)(gbase) + (voff)[_i]), (LAS unsigned*)(lds + (bufoff) + ldsw + _i * 8192), 16, 0, 0); } while (0)
#define PG_LDA(dst, b, h) do { _Pragma("unroll") for (int m = 0; m < 4; ++m) _Pragma("unroll") for (int k = 0; k < 2; ++k) dst[m][k] = *(const LAS bf16x8*)(lds + PG_SA(b, h) + aoff + m * 2048 + k * 1024); } while (0)
#define PG_LDB(dst, b, h) do { _Pragma("unroll") for (int n = 0; n < 2; ++n) _Pragma("unroll") for (int k = 0; k < 2; ++k) dst[n][k] = *(const LAS bf16x8*)(lds + PG_SB(b, h) + boff + n * 2048 + k * 1024); } while (0)
#define PG_MMA(ai, bj, At, Bt) do { __builtin_amdgcn_s_setprio(1); _Pragma("unroll") for (int m = 0; m < 4; ++m) _Pragma("unroll") for (int n = 0; n < 2; ++n) _Pragma("unroll") for (int k = 0; k < 2; ++k) \
        acc[ai][bj][m][n] = __builtin_amdgcn_mfma_f32_16x16x32_bf16(Bt[n][k], At[m][k], acc[ai][bj][m][n], 0, 0, 0); __builtin_amdgcn_s_setprio(0); } while (0)
#define PG_WAIT_V(n) asm volatile("s_waitcnt vmcnt(" #n ")" ::: "memory")
#define PG_WAIT_L(n) asm volatile("s_waitcnt lgkmcnt(" #n ")" ::: "memory")
#define PG_BAR __builtin_amdgcn_s_barrier()
#define PG_SCHED __builtin_amdgcn_sched_barrier(0)
#define PG_AOFF(dst, u) do { _Pragma("unroll") for (int h_ = 0; h_ < 2; ++h_) _Pragma("unroll") for (int i_ = 0; i_ < 2; ++i_) dst[h_][i_] = (unsigned)(S.arow(u, h_ * HALF + Rs[i_]) * S.lda() + Cs[i_]) * 2u; } while (0)
    Unit cur, nxt; int ui = 0;
    if (!S.next(0, cur)) return;
    Acc acc;
#pragma unroll
    for (int a = 0; a < 2; ++a)
#pragma unroll
        for (int b = 0; b < 2; ++b)
#pragma unroll
            for (int m = 0; m < 4; ++m)
#pragma unroll
                for (int n = 0; n < 2; ++n) acc[a][b][m][n] = (f32x4){0.f, 0.f, 0.f, 0.f};
    bf16x8 At[4][2], B0[2][2], B1[2][2];
    unsigned aoC[2][2], aoN[2][2];
    PG_AOFF(aoC, cur);
    const char* cB = S.bbase(cur);
    PG_STAGE(PG_SB(0, 0), cB, voffB); PG_STAGE(PG_SA(0, 0), Ab, aoC[0]); PG_STAGE(PG_SB(0, 1), cB + bh1, voffB); PG_STAGE(PG_SA(0, 1), Ab, aoC[1]);
    if (wr == 1) PG_BAR;
    PG_WAIT_V(4); PG_BAR;
    PG_STAGE(PG_SB(1, 0), cB + kstep, voffB); PG_STAGE(PG_SA(1, 0), Ab + kstep, aoC[0]); PG_STAGE(PG_SB(1, 1), cB + bh1 + kstep, voffB);
    PG_WAIT_V(6); PG_BAR;
    for (;;) {
        const bool has_next = S.next(ui + 1, nxt);
        const char* nB = has_next ? S.bbase(nxt) : cB;
        if (has_next) PG_AOFF(aoN, nxt);
        else {
#pragma unroll
            for (int h_ = 0; h_ < 2; ++h_)
#pragma unroll
                for (int i_ = 0; i_ < 2; ++i_) aoN[h_][i_] = aoC[h_][i_];
        }
#pragma unroll 1
        for (int t = 0; t < nt; t += 2) {
            const bool last = (t == nt - 2);
            const char* a1 = Ab + (size_t)(t + 1) * kstep;
            const char* a2 = last ? Ab : Ab + (size_t)(t + 2) * kstep; const char* b2 = last ? nB : cB + (size_t)(t + 2) * kstep;
            const char* a3 = a2 + kstep; const char* b3 = b2 + kstep;
            unsigned o2[2][2];
#pragma unroll
            for (int h_ = 0; h_ < 2; ++h_)
#pragma unroll
                for (int i_ = 0; i_ < 2; ++i_) o2[h_][i_] = last ? aoN[h_][i_] : aoC[h_][i_];
            PG_LDB(B0, 0, 0); PG_SCHED; PG_LDA(At, 0, 0); PG_STAGE(PG_SA(1, 1), a1, aoC[1]);
            PG_WAIT_L(8); PG_BAR; PG_WAIT_L(0); PG_MMA(0, 0, At, B0); PG_BAR; PG_SCHED;
            PG_LDB(B1, 0, 1); PG_STAGE(PG_SB(0, 0), b2, voffB);
            PG_BAR; PG_WAIT_L(0); PG_MMA(0, 1, At, B1); PG_BAR;
            PG_LDA(At, 0, 1); PG_STAGE(PG_SA(0, 0), a2, o2[0]);
            PG_BAR; PG_WAIT_L(0); PG_MMA(1, 0, At, B0); PG_BAR; PG_SCHED;
            PG_STAGE(PG_SB(0, 1), b2 + bh1, voffB);
            PG_WAIT_V(6); PG_BAR; PG_MMA(1, 1, At, B1); PG_BAR;
            PG_LDB(B0, 1, 0); PG_SCHED; PG_LDA(At, 1, 0); PG_STAGE(PG_SA(0, 1), a2, o2[1]);
            PG_WAIT_L(8); PG_BAR; PG_WAIT_L(0); PG_MMA(0, 0, At, B0); PG_BAR; PG_SCHED;
            PG_LDB(B1, 1, 1); PG_STAGE(PG_SB(1, 0), b3, voffB);
            PG_BAR; PG_WAIT_L(0); PG_MMA(0, 1, At, B1); PG_BAR;
            PG_LDA(At, 1, 1); PG_STAGE(PG_SA(1, 0), a3, o2[0]);
            PG_BAR; PG_WAIT_L(0); PG_MMA(1, 0, At, B0); PG_BAR; PG_SCHED;
            PG_STAGE(PG_SB(1, 1), b3 + bh1, voffB);
            PG_WAIT_V(6); PG_BAR; PG_MMA(1, 1, At, B1); PG_BAR;
        }
        E(acc, cur, wr, wc, fr, fq);
        if (!has_next) break;
#pragma unroll
        for (int a = 0; a < 2; ++a)
#pragma unroll
            for (int b = 0; b < 2; ++b)
#pragma unroll
                for (int m = 0; m < 4; ++m)
#pragma unroll
                    for (int n = 0; n < 2; ++n) acc[a][b][m][n] = (f32x4){0.f, 0.f, 0.f, 0.f};
        cur = nxt; cB = nB; ++ui;
#pragma unroll
        for (int h_ = 0; h_ < 2; ++h_)
#pragma unroll
            for (int i_ = 0; i_ < 2; ++i_) aoC[h_][i_] = aoN[h_][i_];
    }
    PG_WAIT_V(0);
    if (wr == 0) PG_BAR;
    PG_BAR;
#undef PG_SA
#undef PG_SB
#undef PG_STAGE
#undef PG_LDA
#undef PG_LDB
#undef PG_MMA
#undef PG_WAIT_V
#undef PG_WAIT_L
#undef PG_BAR
#undef PG_SCHED
#undef PG_AOFF
}
}

DI void conv_small_weights(const Params& p, unsigned char* lds) {
    const int n0 = 16 * 33, n1 = 16 * 8, n2 = 16 * 17, n3 = 16 * 8;
    auto dec = [=](int u) -> ConvJob {
        if (u < n0) return ConvJob{p.gdn_w_in, (u16*)(p.ws + WS_W_IN0), 1024, 4112, u & 15, u >> 4};
        if (u < n0 + n1) { const int v = u - n0; return ConvJob{p.gdn_w_out, (u16*)(p.ws + WS_W_OUT0), 1024, 1024, v & 15, v >> 4}; }
        if (u < n0 + n1 + n2) { const int v = u - n0 - n1; return ConvJob{p.dsa_w_in, (u16*)(p.ws + WS_W_IN1), 1024, 2120, v & 15, v >> 4}; }
        const int v = u - n0 - n1 - n2; return ConvJob{p.dsa_w_out, (u16*)(p.ws + WS_W_OUT1), 1024, 1024, v & 15, v >> 4};
    };
    convT_run(dec, n0 + n1 + n2 + n3, lds);
}
DI void conv_moe_weights(const Params& p, int layer, unsigned char* lds) {
    const int ngu = 32 * 64, ndn = 32 * 32;
    auto dec = [=](int u) -> ConvJob {
        if (u < ngu) { const int e = u >> 6, v = u & 63;
            return ConvJob{p.moe_w_gu + ((size_t)layer * 32 + e) * 1024 * 512, (u16*)(p.ws + WS_P0 + P0_WGU) + (size_t)e * 512 * 1024, 1024, 512, v & 15, v >> 4}; }
        const int w = u - ngu, e = w >> 5, v = w & 31;
        return ConvJob{p.moe_w_down + ((size_t)layer * 32 + e) * 256 * 1024, (u16*)(p.ws + WS_P0 + P0_WDN) + (size_t)e * 1024 * 256, 256, 1024, v & 3, v >> 2};
    };
    convT_run(dec, ngu + ndn, lds);
}
DI void phase_prep(const Params& p, unsigned char* lds) {
    conv_small_weights(p, lds);
    const int lane = tid_opaque() & 63, wid = tid_opaque() >> 6;
    float* H = (float*)(p.ws + WS_H);
    u16* HN = (u16*)(p.ws + WS_HN);
    for (int row = blockIdx.x * 8 + wid; row < TPA; row += gridDim.x * 8) {
        const int b = row / LP, pp = row - b * LP;
        const bool real = row < TP && pp >= 48;
        const float* src = real ? (pp < 64 ? p.meta + (size_t)(pp - 48) * DM : p.x + ((size_t)b * SEQ + (pp - 64)) * DM) : nullptr;
        f32x4 v[4];
        float ss = 0.f;
#pragma unroll
        for (int i = 0; i < 4; ++i) {
            v[i] = real ? *(const f32x4*)(src + 4 * lane + 256 * i) : (f32x4){0.f, 0.f, 0.f, 0.f};
            ss += v[i][0] * v[i][0] + v[i][1] * v[i][1] + v[i][2] * v[i][2] + v[i][3] * v[i][3];
        }
        ss = wave_sum(ss);
        const float rstd = rsqrtf(ss * (1.f / DM) + RMS_EPS);
#pragma unroll
        for (int i = 0; i < 4; ++i) {
            const int col = 4 * lane + 256 * i;
            *(f32x4*)(H + (size_t)row * DM + col) = v[i];
            const f32x4 gn = *(const f32x4*)(p.norm_mix + col);
            u32x2 w; w.x = pk2(v[i][0] * rstd * gn[0], v[i][1] * rstd * gn[1]); w.y = pk2(v[i][2] * rstd * gn[2], v[i][3] * rstd * gn[3]);
            *(u32x2*)(HN + (size_t)row * DM + col) = w;
        }
    }
}

DI int frame_row(int pm, int r) { return (pm >> 5) * LP + 64 + (pm & 31) * 256 + r; }
struct DenseSched {
    const char* A; const char* Bt; int K, npn, total, ldA;
    DI bool next(int i, pg::Unit& u) const { const int L = i * (int)gridDim.x + (int)blockIdx.x; if (L >= total) return false; u.pn = L % npn; u.pm = L / npn; u.e = 0; u.n = 256; return true; }
    DI int arow(const pg::Unit& u, int r) const { return frame_row(u.pm, r); }
    DI const char* abase() const { return A; }
    DI int lda() const { return ldA; }
    DI const char* bbase(const pg::Unit& u) const { return Bt + (size_t)u.pn * 256 * K * 2; }
    DI size_t bh1() const { return (size_t)128 * K * 2; }
};
struct EpiIn0 {
    static constexpr bool PERM = true;
    u16* P0; u16* HALO;
    DI void store(int row, int col, u32x4 w) const {
        *(u32x4*)(P0 + (size_t)row * 4096 + col) = w;
        if (col < 3072) { const int bb = row / LP, pp = row - bb * LP;
            if ((pp & 63) >= 61 && (pp >> 6) < 128) *(u32x4*)(HALO + ((size_t)(bb * 129 + (pp >> 6) + 1) * 3 + ((pp & 63) - 61)) * 3072 + col) = w; }
    }
    DI void operator()(const pg::Acc& acc, const pg::Unit& u, int wr, int wc, int fr, int fq) const {
#pragma unroll
        for (int ai = 0; ai < 2; ++ai)
#pragma unroll
            for (int m = 0; m < 4; ++m) {
                const int row = frame_row(u.pm, 128 * ai + 64 * wr + 16 * m + fr);
#pragma unroll
                for (int bj = 0; bj < 2; ++bj) {
                    const f32x4 v0 = acc[ai][bj][m][0], v1 = acc[ai][bj][m][1];
                    u32x4 w; w.x = pk2(v0[0], v0[1]); w.y = pk2(v0[2], v0[3]); w.z = pk2(v1[0], v1[1]); w.w = pk2(v1[2], v1[3]);
                    store(row, 256 * u.pn + 128 * bj + 32 * wc + 8 * fq, w);
                }
            }
    }
};
DI void phase_gemm_in0(const Params& p, unsigned char* lds) {
    const u16* W = (const u16*)(p.ws + WS_W_IN0);
    const u16* X = (const u16*)(p.ws + WS_HN);
    u16* P0 = (u16*)(p.ws + WS_P0);
    float* BA = (float*)(p.ws + WS_BA);
    u16* HALO = (u16*)(p.ws + WS_HALO);
    {
        DenseSched S{(const char*)X, (const char*)W, 1024, 16, 64 * 16, 1024};
        EpiIn0 E{P0, HALO};
        pg::gemm((LAS unsigned char*)lds, 1024, S, E);
    }
    __syncthreads();
    const int lane = tid_opaque() & 63, wid = tid_opaque() >> 6, c = lane & 15, g = lane >> 4, wm = wid >> 2, wn = wid & 3;
    for (int t = blockIdx.x; t < 64 + 130; t += gridDim.x) {
        const bool lead = t < 64;
        const int mt = lead ? (t & 31) : 32;
        const int row0 = lead ? (t >> 5) * LP : (t - 64) * 128;
        GemmAcc<2> acc;
        gemm_tile<2>(W, X, 16, LinRow{(u32)(mt * 128) * 1024u, 1024u}, LinRow{(u32)row0 * 1024u, 1024u}, acc, lds);
#pragma unroll
        for (int mi = 0; mi < 4; ++mi) {
            const int f = mt * 128 + wm * 64 + 16 * mi + 4 * g;
#pragma unroll
            for (int ni = 0; ni < 2; ++ni) {
                const int tok = row0 + wn * 32 + 16 * ni + c;
                const f32x4 v = acc.a[mi][ni];
                if (lead) { if (tok - row0 < 64) { u32x2 w; w.x = pk2(v[0], v[1]); w.y = pk2(v[2], v[3]); *(u32x2*)(P0 + (size_t)tok * 4096 + f) = w;
                        if (f < 3072 && tok - row0 >= 61) *(u32x2*)(HALO + ((size_t)((t >> 5) * 129 + 1) * 3 + (tok - row0 - 61)) * 3072 + f) = w; } }
                else if (f < 4112) *(f32x4*)(BA + (size_t)tok * 16 + (f - 4096)) = v;
            }
        }
    }
}
struct EpiOut {
    static constexpr bool PERM = false;
    float* H;
    DI void operator()(const pg::Acc& acc, const pg::Unit& u, int wr, int wc, int fr, int fq) const {
#pragma unroll
        for (int ai = 0; ai < 2; ++ai)
#pragma unroll
            for (int m = 0; m < 4; ++m) {
                float* hp = H + (size_t)frame_row(u.pm, 128 * ai + 64 * wr + 16 * m + fr) * DM + 256 * u.pn + 32 * wc + 4 * fq;
#pragma unroll
                for (int bj = 0; bj < 2; ++bj)
#pragma unroll
                    for (int n = 0; n < 2; ++n) { f32x4* q = (f32x4*)(hp + 128 * bj + 16 * n); *q = *q + acc[ai][bj][m][n]; }
            }
    }
};
DI void phase_gemm_out(const Params& p, const u16* W, const u16* X, const int ldx, unsigned char* lds) {
    float* H = (float*)(p.ws + WS_H);
    {
        DenseSched S{(const char*)X, (const char*)W, 1024, 4, 64 * 4, ldx};
        EpiOut E{H};
        pg::gemm((LAS unsigned char*)lds, 1024, S, E);
    }
    __syncthreads();
    const int lane = tid_opaque() & 63, wid = tid_opaque() >> 6, c = lane & 15, g = lane >> 4, wm = wid >> 2, wn = wid & 3;
    for (int t = (int)gridDim.x - 1 - (int)blockIdx.x; t < 16; t += gridDim.x) {
        const int mt = t & 7, row0 = (t >> 3) * LP;
        GemmAcc<2> acc;
        gemm_tile<2>(W, X, 16, LinRow{(u32)(mt * 128) * 1024u, 1024u}, LinRow{(u32)row0 * (u32)ldx, (u32)ldx}, acc, lds);
#pragma unroll
        for (int mi = 0; mi < 4; ++mi) {
            const int f = mt * 128 + wm * 64 + 16 * mi + 4 * g;
#pragma unroll
            for (int ni = 0; ni < 2; ++ni) {
                const int tok = row0 + wn * 32 + 16 * ni + c;
                if (tok - row0 < 64) { f32x4* hp = (f32x4*)(H + (size_t)tok * DM + f); *hp = *hp + acc.a[mi][ni]; }
            }
        }
    }
}
struct EpiIn1 {
    static constexpr bool PERM = true;
    u16* QRAW; float* KRAW; unsigned char* VN; _Float16* QI;
    DI void operator()(const pg::Acc& acc, const pg::Unit& u, int wr, int wc, int fr, int fq) const {
#pragma unroll
        for (int ai = 0; ai < 2; ++ai)
#pragma unroll
            for (int m = 0; m < 4; ++m) {
                const size_t row = (size_t)frame_row(u.pm, 128 * ai + 64 * wr + 16 * m + fr);
#pragma unroll
                for (int bj = 0; bj < 2; ++bj) {
                    const f32x4 v0 = acc[ai][bj][m][0], v1 = acc[ai][bj][m][1];
                    const int cl = 128 * bj + 32 * wc + 8 * fq;
                    if (u.pn < 4) { u32x4 w; w.x = pk2(v0[0], v0[1]); w.y = pk2(v0[2], v0[3]); w.z = pk2(v1[0], v1[1]); w.w = pk2(v1[2], v1[3]); *(u32x4*)(QRAW + row * 1024 + 256 * u.pn + cl) = w; }
                    else if (u.pn == 4) { *(f32x4*)(KRAW + row * 256 + cl) = v0; *(f32x4*)(KRAW + row * 256 + cl + 4) = v1; }
                    else if (u.pn == 5) { u32x2 w; w.x = pk4_fp8(v0[0], v0[1], v0[2], v0[3]); w.y = pk4_fp8(v1[0], v1[1], v1[2], v1[3]); *(u32x2*)(VN + row * 256 + cl) = w; }
                    else { f16x8 h8; h8[0] = (_Float16)v0[0]; h8[1] = (_Float16)v0[1]; h8[2] = (_Float16)v0[2]; h8[3] = (_Float16)v0[3]; h8[4] = (_Float16)v1[0]; h8[5] = (_Float16)v1[1]; h8[6] = (_Float16)v1[2]; h8[7] = (_Float16)v1[3];
                        *(f16x8*)(QI + row * 512 + 256 * (u.pn - 6) + cl) = h8; }
                }
            }
    }
};
DI void phase_gemm_in1(const Params& p, unsigned char* lds) {
    const u16* W = (const u16*)(p.ws + WS_W_IN1);
    const u16* X = (const u16*)(p.ws + WS_HN);
    u16* QRAW = (u16*)(p.ws + WS_P0 + P0_QRAW);
    float* KRAW = (float*)(p.ws + WS_P0 + P0_KRAW);
    unsigned char* VN = p.ws + WS_P0 + P0_VN;
    _Float16* QI = (_Float16*)(p.ws + WS_P0 + P0_QI);
    float* KIRAW = (float*)((unsigned char*)p.out + DO_KIRAW);
    float* WI = (float*)((unsigned char*)p.out + DO_WI);
    {
        DenseSched S{(const char*)X, (const char*)W, 1024, 8, 64 * 8, 1024};
        EpiIn1 E{QRAW, KRAW, VN, QI};
        pg::gemm((LAS unsigned char*)lds, 1024, S, E);
    }
    __syncthreads();
    const int lane = tid_opaque() & 63, wid = tid_opaque() >> 6, c = lane & 15, g = lane >> 4, wm = wid >> 2, wn = wid & 3;
    for (int t = blockIdx.x; t < 32 + 130; t += gridDim.x) {
        const bool lead = t < 32;
        const int mt = lead ? (t & 15) : 16;
        const int row0 = lead ? (t >> 4) * LP : (t - 32) * 128;
        GemmAcc<2> acc;
        gemm_tile<2>(W, X, 16, LinRow{(u32)(mt * 128) * 1024u, 1024u}, LinRow{(u32)row0 * 1024u, 1024u}, acc, lds);
#pragma unroll
        for (int mi = 0; mi < 4; ++mi) {
            const int f = mt * 128 + wm * 64 + 16 * mi + 4 * g;
#pragma unroll
            for (int ni = 0; ni < 2; ++ni) {
                const int tok = row0 + wn * 32 + 16 * ni + c;
                if (tok >= TP || (lead && tok - row0 >= 64)) continue;
                const f32x4 v = acc.a[mi][ni];
                if (f < 1024) { u32x2 w; w.x = pk2(v[0], v[1]); w.y = pk2(v[2], v[3]); *(u32x2*)(QRAW + (size_t)tok * 1024 + f) = w; }
                else if (f < 1280) *(f32x4*)(KRAW + (size_t)tok * 256 + (f - 1024)) = v;
                else if (f < 1536) *(u32*)(VN + (size_t)tok * 256 + (f - 1280)) = pk4_fp8(v[0], v[1], v[2], v[3]);
                else if (f < 2048) {
                    _Float16* q = QI + (size_t)tok * 512 + (f - 1536);
                    q[0] = (_Float16)v[0]; q[1] = (_Float16)v[1]; q[2] = (_Float16)v[2]; q[3] = (_Float16)v[3];
                }
                else if (f < 2112) *(f32x4*)(KIRAW + (size_t)tok * 64 + (f - 2048)) = v;
                else if (f < 2120) *(f32x4*)(WI + (size_t)tok * 8 + (f - 2112)) = v * 0.04419417382415922f;
            }
        }
    }
}

constexpr int G_KT = 0, G_QT = 17408, G_KRT = 34816, G_VRT = 53248, G_LF = 71680, G_TF = 88320, G_TMP = 104960, G_TTW = 109184, G_TTU = 118400,
              G_QKT = 127616, G_SC = 136832;
constexpr int G_WT = G_LF, G_UT = G_LF + 18432;
constexpr int G_ST = G_KRT;
static_assert(G_UT + 18432 <= G_TTW, "WT/UT alias");
DI void gdn_prep_unit(const Params& p, int bh, int ch, unsigned char* lds) {
    const int tid = tid_opaque(), lane = tid & 63, wid = tid >> 6, c = lane & 15, g = lane >> 4;
    const int b = bh >> 3, h = bh & 7;
    const size_t row0 = (size_t)b * LP + (size_t)ch * 64;
    u16* P0 = (u16*)(p.ws + WS_P0);
    const u16* HALO = (const u16*)(p.ws + WS_HALO);
    float* SC = (float*)(lds + G_SC);
    float bb = 0.f, aa = 0.f;
    if (wid == 7) { const float* BA = (const float*)(p.ws + WS_BA); bb = BA[(row0 + lane) * 16 + h]; aa = BA[(row0 + lane) * 16 + 8 + h]; }
    {
        const int cp = tid & 63, part = tid >> 6;
        u32 raw[3][11];
#pragma unroll
        for (int X = 0; X < 3; ++X) {
            const int col = X * 1024 + h * 128 + 2 * cp;
#pragma unroll
            for (int i = 0; i < 11; ++i) {
                const int rr = 8 * part - 3 + i;
                raw[X][i] = rr < 0 ? (ch == 0 ? 0u : *(const u32*)(HALO + ((size_t)(b * 129 + ch) * 3 + (rr + 3)) * 3072 + col)) : *(const u32*)(P0 + (row0 + rr) * 4096 + col);
            }
        }
        if (wid == 7) {
            const float beta = 1.f / (1.f + __expf(-bb));
            const float xs = aa + p.gdn_dt_bias[h];
            const float sp = xs > 20.f ? xs : log1pf(__expf(xs));
            const float gg = -__expf(p.gdn_a_log[h]) * sp;
            float gc = gg;
#pragma unroll
            for (int o = 1; o < 64; o <<= 1) { const float t = __shfl_up(gc, o); if (lane >= o) gc += t; }
            const float glast = __shfl(gc, 63);
            SC[lane] = gc; SC[64 + lane] = beta; SC[128 + lane] = __expf(gc); SC[192 + lane] = __expf(glast - gc);
            if (lane == 0) SC[384] = __expf(glast);
        }
#pragma unroll
        for (int X = 0; X < 3; ++X) {
            u32 o[8];
            f32x2 wv[4];
#pragma unroll
            for (int j = 0; j < 4; ++j) wv[j] = *(const f32x2*)(p.gdn_conv + j * 3072 + X * 1024 + h * 128 + 2 * cp);
#pragma unroll
            for (int i = 0; i < 8; ++i) {
                const float a0 = wv[0][0] * bflo(raw[X][i]) + wv[1][0] * bflo(raw[X][i + 1]) + wv[2][0] * bflo(raw[X][i + 2]) + wv[3][0] * bflo(raw[X][i + 3]);
                const float a1 = wv[0][1] * bfhi(raw[X][i]) + wv[1][1] * bfhi(raw[X][i + 1]) + wv[2][1] * bfhi(raw[X][i + 2]) + wv[3][1] * bfhi(raw[X][i + 3]);
                o[i] = pk2(silu(a0), silu(a1));
            }
            if (X < 2) {
                u16* T = (u16*)(lds + (X == 0 ? G_QT : G_KT));
#pragma unroll
                for (int i = 0; i < 8; ++i) *(u32*)(T + (8 * part + i) * 136 + 2 * cp) = o[i];
            }
            if (X >= 1) {
                u16* T = (u16*)(lds + (X == 1 ? G_KRT : G_VRT));
                u32x4 lo, hi;
                lo.x = (o[0] & 0xffffu) | (o[1] << 16); lo.y = (o[2] & 0xffffu) | (o[3] << 16); lo.z = (o[4] & 0xffffu) | (o[5] << 16); lo.w = (o[6] & 0xffffu) | (o[7] << 16);
                hi.x = (o[0] >> 16) | (o[1] & 0xffff0000u); hi.y = (o[2] >> 16) | (o[3] & 0xffff0000u); hi.z = (o[4] >> 16) | (o[5] & 0xffff0000u); hi.w = (o[6] >> 16) | (o[7] & 0xffff0000u);
                *(u32x4*)(T + (2 * cp) * 72 + 8 * part) = lo; *(u32x4*)(T + (2 * cp + 1) * 72 + 8 * part) = hi;
            }
        }
    }
    { float* TF = (float*)(lds + G_TF); for (int i = tid; i < 64 * 65; i += NTHREADS) TF[i] = 0.f; }
    __syncthreads();
    {
        const int rt = wid & 3;
        const unsigned char* Arow = lds + (wid < 4 ? G_KT : G_QT);
        f32x4 acc[4], qq = (f32x4){0.f, 0.f, 0.f, 0.f};
#pragma unroll
        for (int ni = 0; ni < 4; ++ni) acc[ni] = (f32x4){0.f, 0.f, 0.f, 0.f};
#pragma unroll
        for (int ks = 0; ks < 4; ++ks) {
            const bf16x8 a = ldsfrag(Arow, 16 * rt + c, 272, 32 * ks + 8 * g);
#pragma unroll
            for (int ni = 0; ni < 4; ++ni) acc[ni] = mfma16(a, ldsfrag(lds + G_KT, 16 * ni + c, 272, 32 * ks + 8 * g), acc[ni]);
            if (wid >= 4) qq = mfma16(a, a, qq);
        }
        {
            const f32x4 kd_ = rt == 0 ? acc[0] : (rt == 1 ? acc[1] : (rt == 2 ? acc[2] : acc[3]));
            const f32x4 d = (wid < 4) ? kd_ : qq;
            if (g == (c >> 2)) {
                const int r = c & 3;
                const float dv = r == 0 ? d[0] : (r == 1 ? d[1] : (r == 2 ? d[2] : d[3]));
                SC[(wid < 4 ? 256 : 320) + 16 * rt + c] = rsqrtf(dv + 1e-6f);
            }
        }
        __syncthreads();
        float* LF = (float*)(lds + G_LF);
        u16* QKT = (u16*)(lds + G_QKT);
#pragma unroll
        for (int ni = 0; ni < 4; ++ni) {
            const int j = 16 * ni + c;
            const float gcj = SC[j], rkj = SC[256 + j];
#pragma unroll
            for (int r = 0; r < 4; ++r) {
                const int i = 16 * rt + 4 * g + r;
                const float gci = SC[i];
                if (wid < 4) {
                    const float v = (i > j) ? SC[64 + i] * SC[256 + i] * rkj * acc[ni][r] * __expf(gci - gcj) : 0.f;
                    LF[i * 65 + j] = v;
                } else {
                    const float v = (i >= j) ? SC[320 + i] * 0.08838834764831845f * rkj * acc[ni][r] * __expf(gci - gcj) : 0.f;
                    QKT[i * 72 + j] = f2bf(v);
                }
            }
        }
    }
    __syncthreads();
    {
        const float* LF = (const float*)(lds + G_LF);
        float* TF = (float*)(lds + G_TF);
        float* TMP = (float*)(lds + G_TMP);
        if (wid == 0) {
            const int b4 = lane >> 4, j = lane & 15;
            float t[16];
#pragma unroll
            for (int i = 0; i < 16; ++i) {
                float s = (i == j) ? 1.f : 0.f;
#pragma unroll
                for (int m = 0; m < i; ++m) s -= LF[(16 * b4 + i) * 65 + 16 * b4 + m] * t[m];
                t[i] = s;
            }
#pragma unroll
            for (int i = 0; i < 16; ++i) TF[(16 * b4 + i) * 65 + 16 * b4 + j] = t[i];
        }
        __syncthreads();
        {
            const int pp = tid >> 8, i = (tid >> 4) & 15, j = tid & 15;
            float s = 0.f;
#pragma unroll
            for (int m = 0; m < 16; ++m) s += LF[(16 * (2 * pp + 1) + i) * 65 + 32 * pp + m] * TF[(32 * pp + m) * 65 + 32 * pp + j];
            TMP[pp * 256 + i * 16 + j] = s;
            __syncthreads();
            float x = 0.f;
#pragma unroll
            for (int m = 0; m < 16; ++m) x -= TF[(16 * (2 * pp + 1) + i) * 65 + 16 * (2 * pp + 1) + m] * TMP[pp * 256 + m * 16 + j];
            TF[(16 * (2 * pp + 1) + i) * 65 + 32 * pp + j] = x;
        }
        __syncthreads();
        {
            const int i = tid >> 4, j0 = tid & 15;
            float s0 = 0.f, s1 = 0.f;
#pragma unroll
            for (int m = 0; m < 32; ++m) { const float l = LF[(32 + i) * 65 + m]; s0 += l * TF[m * 65 + j0]; s1 += l * TF[m * 65 + j0 + 16]; }
            __syncthreads();
            TMP[i * 33 + j0] = s0; TMP[i * 33 + j0 + 16] = s1;
            __syncthreads();
            float x0 = 0.f, x1 = 0.f;
#pragma unroll
            for (int m = 0; m < 32; ++m) { const float tt = TF[(32 + i) * 65 + 32 + m]; x0 -= tt * TMP[m * 33 + j0]; x1 -= tt * TMP[m * 33 + j0 + 16]; }
            TF[(32 + i) * 65 + j0] = x0; TF[(32 + i) * 65 + j0 + 16] = x1;
        }
        __syncthreads();
        u16* TTW = (u16*)(lds + G_TTW);
        u16* TTU = (u16*)(lds + G_TTU);
#pragma unroll
        for (int i = 0; i < 8; ++i) {
            const int e = tid + NTHREADS * i, t = e >> 6, s = e & 63;
            const float tv = (s <= t) ? TF[t * 65 + s] : 0.f;
            const float bs = SC[64 + s];
            TTW[t * 72 + s] = f2bf(tv * bs * SC[256 + s] * SC[128 + s]);
            TTU[t * 72 + s] = f2bf(tv * bs);
        }
    }
    __syncthreads();
    {
        const int tt = wid & 3, isu = wid >> 2;
        f32x4 acc[8];
#pragma unroll
        for (int ni = 0; ni < 8; ++ni) acc[ni] = (f32x4){0.f, 0.f, 0.f, 0.f};
        const unsigned char* A = lds + (isu ? G_TTU : G_TTW);
        const unsigned char* Bt = lds + (isu ? G_VRT : G_KRT);
#pragma unroll
        for (int ks = 0; ks < 2; ++ks) {
            const bf16x8 a = ldsfrag(A, 16 * tt + c, 144, 32 * ks + 8 * g);
#pragma unroll
            for (int ni = 0; ni < 8; ++ni) acc[ni] = mfma16(a, ldsfrag(Bt, 16 * ni + c, 144, 32 * ks + 8 * g), acc[ni]);
        }
        __syncthreads();
        u16* WU = (u16*)(lds + (isu ? G_UT : G_WT));
        const int t0 = 16 * tt + 4 * g;
#pragma unroll
        for (int ni = 0; ni < 8; ++ni) {
            u32x2 w; w.x = pk2(acc[ni][0], acc[ni][1]); w.y = pk2(acc[ni][2], acc[ni][3]);
            *(u32x2*)(WU + (16 * ni + c) * 72 + t0) = w;
        }
    }
    __syncthreads();
    {
        f32x4 acc[4];
#pragma unroll
        for (int ni = 0; ni < 4; ++ni) acc[ni] = (f32x4){0.f, 0.f, 0.f, 0.f};
#pragma unroll
        for (int ks = 0; ks < 2; ++ks) {
            const bf16x8 a = ldsfrag(lds + G_WT, 16 * wid + c, 144, 32 * ks + 8 * g);
#pragma unroll
            for (int ni = 0; ni < 4; ++ni) acc[ni] = mfma16(a, ldsfrag(lds + G_QKT, 16 * ni + c, 144, 32 * ks + 8 * g), acc[ni]);
        }
        u16* QT = (u16*)(lds + G_QT);
#pragma unroll
        for (int ni = 0; ni < 4; ++ni) {
            const int t = 16 * ni + c, j0 = 16 * wid + 4 * g;
            const float qs = SC[320 + t] * 0.08838834764831845f * SC[128 + t];
            u32x2* qp = (u32x2*)(QT + t * 136 + j0);
            const u32x2 q = *qp;
            u32x2 w;
            w.x = pk2(bflo(q.x) * qs - acc[ni][0], bfhi(q.x) * qs - acc[ni][1]);
            w.y = pk2(bflo(q.y) * qs - acc[ni][2], bfhi(q.y) * qs - acc[ni][3]);
            *qp = w;
        }
    }
    {
        const int tt = wid & 3, dvh = wid >> 2;
        f32x4 acc[4];
#pragma unroll
        for (int ni = 0; ni < 4; ++ni) acc[ni] = (f32x4){0.f, 0.f, 0.f, 0.f};
#pragma unroll
        for (int ks = 0; ks < 2; ++ks) {
            const bf16x8 a = ldsfrag(lds + G_QKT, 16 * tt + c, 144, 32 * ks + 8 * g);
#pragma unroll
            for (int ni = 0; ni < 4; ++ni) acc[ni] = mfma16(a, ldsfrag(lds + G_UT, 16 * (4 * dvh + ni) + c, 144, 32 * ks + 8 * g), acc[ni]);
        }
        u16* KT = (u16*)(lds + G_KT);
#pragma unroll
        for (int ni = 0; ni < 4; ++ni)
#pragma unroll
            for (int r = 0; r < 4; ++r) KT[(16 * tt + 4 * g + r) * 136 + 16 * (4 * dvh + ni) + c] = f2bf(acc[ni][r]);
    }
    __syncthreads();
    {
#pragma unroll
        for (int i = 0; i < 2; ++i) {
            const int id = tid + NTHREADS * i, t = id >> 4, ck = id & 15;
            *(u32x4*)(P0 + (row0 + t) * 4096 + h * 128 + 8 * ck) = *(const u32x4*)(lds + G_QT + t * 272 + ck * 16);
            *(u32x4*)(P0 + (row0 + t) * 4096 + 1024 + h * 128 + 8 * ck) = *(const u32x4*)(lds + G_KT + t * 272 + ck * 16);
        }
        const int dim = tid >> 2, s0 = (tid & 3) * 16;
        float sc[16];
#pragma unroll
        for (int i = 0; i < 16; ++i) sc[i] = SC[256 + s0 + i] * SC[192 + s0 + i];
#pragma unroll
        for (int X = 0; X < 2; ++X) {
            u32x4* tp = (u32x4*)(lds + (X ? G_UT : G_WT) + dim * 144 + s0 * 2);
#pragma unroll
            for (int hf = 0; hf < 2; ++hf) {
                u32x4 w = tp[hf];
                w.x = pk2(bflo(w.x) * sc[8 * hf + 0], bfhi(w.x) * sc[8 * hf + 1]); w.y = pk2(bflo(w.y) * sc[8 * hf + 2], bfhi(w.y) * sc[8 * hf + 3]);
                w.z = pk2(bflo(w.z) * sc[8 * hf + 4], bfhi(w.z) * sc[8 * hf + 5]); w.w = pk2(bflo(w.w) * sc[8 * hf + 6], bfhi(w.w) * sc[8 * hf + 7]);
                tp[hf] = w;
            }
        }
    }
    LDS_BARRIER();
    {
        {
            f32x4 acc[8];
#pragma unroll
            for (int ni = 0; ni < 8; ++ni) acc[ni] = (f32x4){0.f, 0.f, 0.f, 0.f};
#pragma unroll
            for (int ks = 0; ks < 2; ++ks) {
                const bf16x8 a = ldsfrag(lds + G_WT, 16 * wid + c, 144, 32 * ks + 8 * g);
#pragma unroll
                for (int ni = 0; ni < 8; ++ni) acc[ni] = mfma16(a, ldsfrag(lds + G_KRT, 16 * ni + c, 144, 32 * ks + 8 * g), acc[ni]);
            }
            if (ch > 0) {
                u16* Mg = (u16*)((unsigned char*)p.out + DO_M) + ((size_t)bh * 128 + (ch - 1)) * 16384;
                const float cd = SC[384];
                const int gp = ((g & 1) << 1) | (g >> 1);
#pragma unroll
                for (int ni = 0; ni < 8; ++ni) {
                    const int i = 16 * ni + c, j0 = 16 * wid + 4 * g;
                    float v[4];
#pragma unroll
                    for (int r = 0; r < 4; ++r) v[r] = ((i == j0 + r) ? cd : 0.f) - acc[ni][r];
                    u32x2 w; w.x = pk2(v[0], v[1]); w.y = pk2(v[2], v[3]);
                    *(u32x2*)(Mg + (size_t)i * 128 + 16 * wid + 4 * gp) = w;
                }
            }
        }
        {
            f32x4 acc[8];
#pragma unroll
            for (int ni = 0; ni < 8; ++ni) acc[ni] = (f32x4){0.f, 0.f, 0.f, 0.f};
#pragma unroll
            for (int ks = 0; ks < 2; ++ks) {
                const bf16x8 a = ldsfrag(lds + G_KRT, 16 * wid + c, 144, 32 * ks + 8 * g);
#pragma unroll
                for (int ni = 0; ni < 8; ++ni) acc[ni] = mfma16(a, ldsfrag(lds + G_UT, 16 * ni + c, 144, 32 * ks + 8 * g), acc[ni]);
            }
            u16* NT = (u16*)(p.ws + WS_NS) + ((size_t)bh * NCH + ch) * 16384;
#pragma unroll
            for (int ni = 0; ni < 8; ++ni) {
                u32x2 w; w.x = pk2(acc[ni][0], acc[ni][1]); w.y = pk2(acc[ni][2], acc[ni][3]);
                *(u32x2*)(NT + ((size_t)(4 * wid + g) * 128 + 16 * ni + c) * 4) = w;
            }
        }
    }
    LDS_BARRIER();
}
constexpr int GO_QE = 0, GO_O0 = 17408, GO_ST = 34816, GO_SC = 69632;
DI void gdn_out_unit(const Params& p, int bh, int ch, unsigned char* lds) {
    const int tid = tid_opaque(), lane = tid & 63, wid = tid >> 6, c = lane & 15, g = lane >> 4;
    const int b = bh >> 3, h = bh & 7;
    const size_t row0 = (size_t)b * LP + (size_t)ch * 64;
    const u16* P0 = (const u16*)(p.ws + WS_P0);
    float* SC = (float*)(lds + GO_SC);
#pragma unroll
    for (int i = 0; i < 2; ++i) {
        const int id = tid + NTHREADS * i, t = id >> 4, ck = id & 15;
        *(u32x4*)(lds + GO_QE + t * 272 + ck * 16) = *(const u32x4*)(P0 + (row0 + t) * 4096 + h * 128 + 8 * ck);
        *(u32x4*)(lds + GO_O0 + t * 272 + ck * 16) = *(const u32x4*)(P0 + (row0 + t) * 4096 + 1024 + h * 128 + 8 * ck);
    }
    if (ch > 0) {
        const u16* ST = (const u16*)(p.ws + WS_NS) + ((size_t)bh * NCH + (ch - 1)) * 16384;
#pragma unroll
        for (int i = 0; i < 4; ++i) { const int id = tid + NTHREADS * i, i4 = id >> 6, dvp = id & 63;
            const u32x4 w = *(const u32x4*)(ST + (size_t)id * 8);
            *(u32x2*)(lds + GO_ST + (2 * dvp) * 272 + i4 * 8) = (u32x2){w.x, w.y};
            *(u32x2*)(lds + GO_ST + (2 * dvp + 1) * 272 + i4 * 8) = (u32x2){w.z, w.w}; }
    }
    __syncthreads();
    const int tt = wid & 3, dvh = wid >> 2;
    f32x4 acc[4];
    const u16* O0 = (const u16*)(lds + GO_O0);
#pragma unroll
    for (int ni = 0; ni < 4; ++ni)
#pragma unroll
        for (int r = 0; r < 4; ++r) acc[ni][r] = bf2f(O0[(16 * tt + 4 * g + r) * 136 + 16 * (4 * dvh + ni) + c]);
    if (ch > 0) {
#pragma unroll
        for (int ks = 0; ks < 4; ++ks) {
            const bf16x8 a = ldsfrag(lds + GO_QE, 16 * tt + c, 272, 32 * ks + 8 * g);
#pragma unroll
            for (int ni = 0; ni < 4; ++ni) acc[ni] = mfma16(a, ldsfrag(lds + GO_ST, 16 * (4 * dvh + ni) + c, 272, 32 * ks + 8 * g), acc[ni]);
        }
    }
    float ss[4];
#pragma unroll
    for (int r = 0; r < 4; ++r) {
        float s = 0.f;
#pragma unroll
        for (int ni = 0; ni < 4; ++ni) s += acc[ni][r] * acc[ni][r];
        s += __shfl_xor(s, 1); s += __shfl_xor(s, 2); s += __shfl_xor(s, 4); s += __shfl_xor(s, 8);
        ss[r] = s;
    }
    if (c == 0) {
#pragma unroll
        for (int r = 0; r < 4; ++r) SC[dvh * 64 + 16 * tt + 4 * g + r] = ss[r];
    }
    __syncthreads();
    u16* OG = (u16*)(p.ws + WS_P0) + 2048;
#pragma unroll
    for (int r = 0; r < 4; ++r) {
        const int t = 16 * tt + 4 * g + r;
        const float rstd = rsqrtf((SC[t] + SC[64 + t]) * (1.f / 128.f) + RMS_EPS);
#pragma unroll
        for (int ni = 0; ni < 4; ++ni) {
            const int dv = 16 * (4 * dvh + ni) + c;
            const float z = bf2f(P0[(row0 + t) * 4096 + 3072 + h * 128 + dv]);
            OG[(row0 + t) * 4096 + h * 128 + dv] = f2bf(acc[ni][r] * rstd * p.gdn_o_norm[dv] * silu(z));
        }
    }
    LDS_BARRIER();
}
DI void phase_gdn_prep(const Params& p, unsigned char* lds) {
    for (int u = blockIdx.x; u < 16 * 128; u += gridDim.x) gdn_prep_unit(p, u >> 7, u & 127, lds);
}
DI void phase_gdn_out(const Params& p, unsigned char* lds) {
    for (int u = blockIdx.x; u < 16 * NCH; u += gridDim.x) gdn_out_unit(p, u / NCH, u % NCH, lds);
}

DI void scan_loadM(u32x4 (&r)[8], const u16* Mg, int j, int t4) {
    if (j <= 127) {
        const u16* src = Mg + (size_t)(j - 1) * 16384;
#pragma unroll
        for (int i = 0; i < 8; ++i) { const int id = t4 + 256 * i; r[i] = *(const u32x4*)(src + (size_t)(id >> 4) * 128 + (id & 15) * 8); }
    }
}
DI void scan_storeM(const u32x4 (&r)[8], unsigned char* slot, int t4) {
#pragma unroll
    for (int i = 0; i < 8; ++i) { const int id = t4 + 256 * i; *(u32x4*)(slot + (id >> 4) * 272 + (id & 15) * 16) = r[i]; }
}
DI void scan_loadNq(u32x4 (&r)[8], const u16* NSb, int j, int lane) {
    if (j <= 127) {
        const u16* s0 = NSb + (size_t)j * 16384;
#pragma unroll
        for (int k = 0; k < 8; ++k) { const int id = lane + 64 * k; r[k] = *(const u32x4*)(s0 + (id >> 4) * 512 + (id & 15) * 8); }
    }
}
#define SCAN_BAR() do { asm volatile("s_waitcnt lgkmcnt(0)" ::: "memory"); __builtin_amdgcn_s_barrier(); asm volatile("" ::: "memory"); } while (0)
DI void scan_loadM2(u32x4 (&r)[16], const u16* Mg, int j, int t2) {
    if (j <= 127) {
        const u16* src = Mg + (size_t)(j - 1) * 16384;
#pragma unroll
        for (int i = 0; i < 16; ++i) { const int id = t2 + 128 * i; r[i] = *(const u32x4*)(src + (size_t)(id >> 4) * 128 + (id & 15) * 8); }
    }
}
DI void scan_storeM2(const u32x4 (&r)[16], unsigned char* slot, int t2) {
#pragma unroll
    for (int i = 0; i < 16; ++i) { const int id = t2 + 128 * i; *(u32x4*)(slot + (id >> 4) * 272 + (id & 15) * 16) = r[i]; }
}
DI void phase_gdn_scan(const Params& p, unsigned char* lds, const int C0, const int C1) {
    int bh = blockIdx.x & 15, dvq = blockIdx.x >> 4;
    asm volatile("" : "+s"(bh), "+s"(dvq));
    const int tid = tid_opaque(), lane = tid & 63, wid = __builtin_amdgcn_readfirstlane(tid >> 6), col = lane & 31, hh = lane >> 5;
    const u16* Mg = (const u16*)((unsigned char*)p.out + DO_M) + (size_t)bh * 128 * 16384;
    u16* NSb = (u16*)(p.ws + WS_NS) + (size_t)bh * NCH * 16384 + (size_t)(32 * dvq) * 4;
    unsigned char* slot0 = lds, *slot1 = lds + 34816;
    unsigned char* nb0 = lds + 69632, *nb1 = nb0 + 8192, *sb0 = nb1 + 8192, *sb1 = sb0 + 8192, *fb0 = sb1 + 8192, *fb1 = fb0 + 8192;
    if (wid >= 6) {
        const int t2 = tid - 384;
        u32x4 r0[16], r1[16], r2[16];
        scan_loadM2(r0, Mg, C0, t2); scan_storeM2(r0, (C0 & 1) ? slot1 : slot0, t2); scan_loadM2(r0, Mg, C0 + 1, t2); scan_loadM2(r1, Mg, C0 + 2, t2); scan_loadM2(r2, Mg, C0 + 3, t2);
        SCAN_BAR();
#define SCAN_LD(cc, R) do { if ((cc) <= C1) { if ((cc) + 1 <= C1) scan_storeM2(R, ((cc) + 1) & 1 ? slot1 : slot0, t2); scan_loadM2(R, Mg, (cc) + 4, t2); SCAN_BAR(); } } while (0)
#pragma unroll 1
        for (int c0 = C0; c0 <= C1; c0 += 3) { SCAN_LD(c0, r0); SCAN_LD(c0 + 1, r1); SCAN_LD(c0 + 2, r2); }
#undef SCAN_LD
    } else if (wid == 4) {
        u32x4 r0[8], r1[8], r2[8];
#define SCAN_STN(R, buf) do { _Pragma("unroll") for (int k = 0; k < 8; ++k) *(u32x4*)((buf) + (lane + 64 * k) * 16) = R[k]; } while (0)
        scan_loadNq(r0, NSb, C0, lane); SCAN_STN(r0, (C0 & 1) ? nb1 : nb0); scan_loadNq(r0, NSb, C0 + 1, lane); scan_loadNq(r1, NSb, C0 + 2, lane); scan_loadNq(r2, NSb, C0 + 3, lane);
        SCAN_BAR();
#define SCAN_LN(cc, R) do { if ((cc) <= C1) { if ((cc) + 1 <= C1) SCAN_STN(R, ((cc) + 1) & 1 ? nb1 : nb0); scan_loadNq(R, NSb, (cc) + 4, lane); SCAN_BAR(); } } while (0)
#pragma unroll 1
        for (int c0 = C0; c0 <= C1; c0 += 3) { SCAN_LN(c0, r0); SCAN_LN(c0 + 1, r1); SCAN_LN(c0 + 2, r2); }
#undef SCAN_LN
#undef SCAN_STN
    } else if (wid == 5) {
        SCAN_BAR();
#pragma unroll 1
        for (int cc = C0; cc <= C1 + 1; ++cc) {
            if (cc >= C0 + 1) {
                const unsigned char* sb = ((cc - 1) & 1) ? sb1 : sb0;
                u16* dst = NSb + (size_t)(cc - 1) * 16384;
#pragma unroll
                for (int k = 0; k < 8; ++k) { const int id = lane + 64 * k; *(u32x4*)(dst + (id >> 4) * 512 + (id & 15) * 8) = *(const u32x4*)(sb + id * 16); }
            }
            if (cc <= C1) SCAN_BAR();
        }
    } else {
        const int ob = wid;
        f32x16 acc;
#pragma unroll
        for (int q = 0; q < 4; ++q) {
            const u32x2 w = *(const u32x2*)(NSb + (size_t)(C0 - 1) * 16384 + ((8 * ob + 2 * q + hh) * 128 + col) * 4);
            acc[4 * q + 0] = bflo(w.x); acc[4 * q + 1] = bfhi(w.x); acc[4 * q + 2] = bflo(w.y); acc[4 * q + 3] = bfhi(w.y);
        }
#define SCAN_PUBF(buf) do { _Pragma("unroll") for (int s_ = 0; s_ < 2; ++s_) { bf16x8 f_; _Pragma("unroll") for (int j = 0; j < 8; ++j) f_[j] = (short)f2bf(acc[8 * s_ + j]); \
            *(bf16x8*)((buf) + ((2 * ob + s_) * 64 + lane) * 16) = f_; } } while (0)
        SCAN_PUBF((C0 & 1) ? fb1 : fb0);
        SCAN_BAR();
        const int apo = (32 * ob + col) * 272 + hh * 16;
#pragma unroll 1
        for (int cc = C0; cc <= C1; ++cc) {
            const unsigned char* cur = (cc & 1) ? slot1 : slot0;
            const unsigned char* nbuf = (cc & 1) ? nb1 : nb0;
            unsigned char* sbuf = (cc & 1) ? sb1 : sb0;
            const unsigned char* fin = (cc & 1) ? fb1 : fb0;
            unsigned char* fout = (cc & 1) ? fb0 : fb1;
            bf16x8 fa[8], fbq[8];
#pragma unroll
            for (int ks = 0; ks < 8; ++ks) { fbq[ks] = *(const bf16x8*)(fin + (ks * 64 + lane) * 16); fa[ks] = *(const bf16x8*)(cur + apo + ks * 32); }
            f32x16 nw;
#pragma unroll
            for (int q = 0; q < 4; ++q) {
                const u32x2 w = *(const u32x2*)(nbuf + ((8 * ob + 2 * q + hh) * 32 + col) * 8);
                nw[4 * q + 0] = bflo(w.x); nw[4 * q + 1] = bfhi(w.x); nw[4 * q + 2] = bflo(w.y); nw[4 * q + 3] = bfhi(w.y);
            }
#pragma unroll
            for (int ks = 0; ks < 8; ++ks) nw = __builtin_amdgcn_mfma_f32_32x32x16_bf16(fa[ks], fbq[ks], nw, 0, 0, 0);
            acc = nw;
#pragma unroll
            for (int q = 0; q < 4; ++q) {
                u32x2 w; w.x = pk2(acc[4 * q], acc[4 * q + 1]); w.y = pk2(acc[4 * q + 2], acc[4 * q + 3]);
                *(u32x2*)(sbuf + ((8 * ob + 2 * q + hh) * 32 + col) * 8) = w;
            }
            SCAN_PUBF(fout);
            SCAN_BAR();
        }
#undef SCAN_PUBF
    }
}
#undef SCAN_BAR

template <bool ADDY, bool ROUTE>
DI void phase_norm(const Params& p, const float* gain, int layer, unsigned char* lds) {
    const int tid = tid_opaque(), lane = tid & 63, wid = tid >> 6;
    float* H = (float*)(p.ws + WS_H);
    u16* HN = (u16*)(p.ws + WS_HN);
    const u16* Y = (const u16*)(p.ws + WS_P0 + P0_Y);
    float* xs = (float*)lds;
    float* part = (float*)(lds + 32768);
    float* logit = (float*)(lds + 32768 + 9216);
    int* asg = (int*)(lds + 32768 + 9216 + 1152);
    int iter = 0;
    const float* wg = p.moe_w_group + (size_t)layer * 1024 * 4;
    const float* we = p.moe_w_expert + (size_t)layer * 1024 * 32;
    float wr[128];
    if (ROUTE) {
        const float* wp = lane < 4 ? wg + lane : we + ((lane < 36 ? lane : 35) - 4);
        const int wst = lane < 4 ? 4 : 32;
#pragma unroll
        for (int k = 0; k < 128; ++k) wr[k] = wp[(size_t)(128 * wid + k) * wst];
    }
    for (int base = blockIdx.x * 8; base < TP; base += gridDim.x * 8) {
        const int row = base + wid;
        {
            f32x4 v[4];
            float ss = 0.f;
#pragma unroll
            for (int i = 0; i < 4; ++i) {
                const int col = 4 * lane + 256 * i;
                v[i] = *(const f32x4*)(H + (size_t)row * DM + col);
                if (ADDY) {
                    const u32x2 y0 = *(const u32x2*)(Y + (size_t)(2 * row) * DM + col), y1 = *(const u32x2*)(Y + (size_t)(2 * row + 1) * DM + col);
                    const int pp = row % LP;
                    if (pp >= 48) {
                        v[i][0] += bflo(y0.x) + bflo(y1.x); v[i][1] += bfhi(y0.x) + bfhi(y1.x); v[i][2] += bflo(y0.y) + bflo(y1.y); v[i][3] += bfhi(y0.y) + bfhi(y1.y);
                        *(f32x4*)(H + (size_t)row * DM + col) = v[i];
                    }
                }
                ss += v[i][0] * v[i][0] + v[i][1] * v[i][1] + v[i][2] * v[i][2] + v[i][3] * v[i][3];
            }
            ss = wave_sum(ss);
            const float rstd = rsqrtf(ss * (1.f / DM) + RMS_EPS);
#pragma unroll
            for (int i = 0; i < 4; ++i) {
                const int col = 4 * lane + 256 * i;
                const f32x4 gn = *(const f32x4*)(gain + col);
                const f32x4 o = (f32x4){v[i][0] * rstd * gn[0], v[i][1] * rstd * gn[1], v[i][2] * rstd * gn[2], v[i][3] * rstd * gn[3]};
                u32x2 w; w.x = pk2(o[0], o[1]); w.y = pk2(o[2], o[3]);
                *(u32x2*)(HN + (size_t)row * DM + col) = w;
                if (ROUTE) *(f32x4*)(xs + wid * 1024 + col) = o;
            }
        }
        if (ROUTE) {
            __syncthreads();
            {
                float a8[8];
#pragma unroll
                for (int r = 0; r < 8; ++r) a8[r] = 0.f;
                if (lane < 36) {
#pragma unroll
                    for (int k4 = 0; k4 < 32; ++k4) {
#pragma unroll
                        for (int r = 0; r < 8; ++r) {
                            const f32x4 x4 = *(const f32x4*)(xs + r * 1024 + 128 * wid + 4 * k4);
                            a8[r] += x4[0] * wr[4 * k4] + x4[1] * wr[4 * k4 + 1] + x4[2] * wr[4 * k4 + 2] + x4[3] * wr[4 * k4 + 3];
                        }
                    }
#pragma unroll
                    for (int r = 0; r < 8; ++r) part[(wid * 8 + r) * 36 + lane] = a8[r];
                }
            }
            __syncthreads();
            if (tid < 288) {
                const int r = tid / 36, n = tid - r * 36;
                float s = 0.f;
#pragma unroll
                for (int w = 0; w < 8; ++w) s += part[(w * 8 + r) * 36 + n];
                s += (n < 4) ? p.moe_b_group[layer * 4 + n] : p.moe_b_expert[layer * 32 + n - 4];
                logit[r * 36 + n] = s;
            }
            __syncthreads();
            if (tid < 8) {
                const int rr = base + tid, pp = rr % LP;
                if (pp >= 48) {
                    const float* lg = logit + tid * 36;
                    int gs = 0; float gm = lg[0];
#pragma unroll
                    for (int i = 1; i < 4; ++i) if (lg[i] > gm) { gm = lg[i]; gs = i; }
                    float gsum = 0.f;
#pragma unroll
                    for (int i = 0; i < 4; ++i) gsum += __expf(lg[i] - gm);
                    const float gw = 1.f / gsum;
                    const float* el = lg + 4 + 8 * gs;
                    int i0 = 0; float m0 = el[0];
#pragma unroll
                    for (int i = 1; i < 8; ++i) if (el[i] > m0) { m0 = el[i]; i0 = i; }
                    int i1 = -1; float m1 = -3.0e38f;
#pragma unroll
                    for (int i = 0; i < 8; ++i) if (i != i0 && el[i] > m1) { m1 = el[i]; i1 = i; }
                    const float e1 = __expf(m1 - m0);
                    const float c0 = gw / (1.f + e1), c1 = gw * e1 / (1.f + e1);
                    float* cw = (float*)(p.ws + WS_CW);
                    cw[2 * rr] = c0; cw[2 * rr + 1] = c1;
                    const int slot = 16 * iter + 2 * tid;
                    asg[slot] = ((8 * gs + i0) << 24) | (2 * rr); asg[slot + 1] = ((8 * gs + i1) << 24) | (2 * rr + 1);
                } else {
                    const int slot = 16 * iter + 2 * tid;
                    asg[slot] = -1; asg[slot + 1] = -1;
                }
            }
            __syncthreads();
        }
        ++iter;
    }
    if (ROUTE) {
        const int n = 16 * iter;
        unsigned* cnt = (unsigned*)(p.ws + WS_CTL) + CW_CNT + layer * 32;
        u32* list = (u32*)(p.ws + WS_LIST);
        int* ebase = asg + 256;
        if (tid < 32) {
            int cn = 0;
            for (int i = 0; i < n; ++i) cn += (asg[i] >= 0 && (asg[i] >> 24) == tid) ? 1 : 0;
            ebase[tid] = cn > 0 ? (int)atomicAdd(&cnt[tid], (unsigned)cn) : 0;
        }
        __syncthreads();
        if (tid < n) {
            const int v = asg[tid];
            if (v >= 0) {
                const int e = v >> 24;
                int rk = 0;
                for (int i = 0; i < tid; ++i) rk += (asg[i] >= 0 && (asg[i] >> 24) == e) ? 1 : 0;
                list[(size_t)e * TP + ebase[e] + rk] = (u32)(v & 0xffffff);
            }
        }
        __syncthreads();
    }
}

struct MoeSched {
    const char* A; const char* Bt; const u32* list; const int* pre;
    int K, ncol, rshift, total; size_t estride, cstride, h1;
    DI bool next(int i, pg::Unit& u) const {
        const int L = i * (int)gridDim.x + (int)blockIdx.x; if (L >= total) return false;
        const int rtile = L / ncol; u.pn = L - rtile * ncol;
        int e = 0;
        for (int j = 1; j < 32; ++j) if (pre[j] <= rtile) e = j;
        u.e = e; u.pm = rtile - pre[e]; u.n = pre[64 + e];
        return true;
    }
    DI int asg(const pg::Unit& u, int r) const { const int gi = u.pm * 256 + r; return (int)list[(size_t)u.e * TP + (gi < u.n ? gi : 0)]; }
    DI int arow(const pg::Unit& u, int r) const { return asg(u, r) >> rshift; }
    DI const char* abase() const { return A; }
    DI int lda() const { return K; }
    DI const char* bbase(const pg::Unit& u) const { return Bt + (size_t)u.e * estride + (size_t)u.pn * cstride; }
    DI size_t bh1() const { return h1; }
};
struct EpiGateUp {
    static constexpr bool PERM = true;
    const MoeSched* S; const float* cw; u16* ACT;
    DI void operator()(const pg::Acc& acc, const pg::Unit& u, int wr, int wc, int fr, int fq) const {
#pragma unroll
        for (int ai = 0; ai < 2; ++ai)
#pragma unroll
            for (int m = 0; m < 4; ++m) {
                const int r = 128 * ai + 64 * wr + 16 * m + fr;
                if (u.pm * 256 + r >= u.n) continue;
                const int a = S->asg(u, r);
                const float cwa = cw[a];
                const f32x4 g0 = acc[ai][0][m][0], g1 = acc[ai][0][m][1], u0 = acc[ai][1][m][0], u1 = acc[ai][1][m][1];
                u32x4 w;
                w.x = pk2(silu(g0[0]) * u0[0] * cwa, silu(g0[1]) * u0[1] * cwa); w.y = pk2(silu(g0[2]) * u0[2] * cwa, silu(g0[3]) * u0[3] * cwa);
                w.z = pk2(silu(g1[0]) * u1[0] * cwa, silu(g1[1]) * u1[1] * cwa); w.w = pk2(silu(g1[2]) * u1[2] * cwa, silu(g1[3]) * u1[3] * cwa);
                *(u32x4*)(ACT + (size_t)a * 256 + 128 * u.pn + 32 * wc + 8 * fq) = w;
            }
    }
};
struct EpiDown {
    static constexpr bool PERM = true;
    const MoeSched* S; u16* Y;
    DI void operator()(const pg::Acc& acc, const pg::Unit& u, int wr, int wc, int fr, int fq) const {
#pragma unroll
        for (int ai = 0; ai < 2; ++ai)
#pragma unroll
            for (int m = 0; m < 4; ++m) {
                const int r = 128 * ai + 64 * wr + 16 * m + fr;
                if (u.pm * 256 + r >= u.n) continue;
                const int a = S->asg(u, r);
#pragma unroll
                for (int bj = 0; bj < 2; ++bj) {
                    const f32x4 v0 = acc[ai][bj][m][0], v1 = acc[ai][bj][m][1];
                    u32x4 w; w.x = pk2(v0[0], v0[1]); w.y = pk2(v0[2], v0[3]); w.z = pk2(v1[0], v1[1]); w.w = pk2(v1[2], v1[3]);
                    *(u32x4*)(Y + (size_t)a * 1024 + 256 * u.pn + 128 * bj + 32 * wc + 8 * fq) = w;
                }
            }
    }
};
template <int STAGE>
DI void phase_moe(const Params& p, int layer, unsigned char* lds) {
    const int tid = tid_opaque(), lane = tid & 63, wid = tid >> 6, c = lane & 15, g = lane >> 4, wm = wid >> 2, wn = wid & 3;
    int* pre = (int*)(lds + 131072);
    int* tl = pre + 192;
    const unsigned* cnt = (const unsigned*)(p.ws + WS_CTL) + CW_CNT + layer * 32;
    if (tid < 32) pre[64 + tid] = (int)cnt[tid];
    __syncthreads();
    if (tid == 0) {
        int s = 0, s2 = 0;
        for (int e = 0; e < 32; ++e) { const int n = pre[64 + e]; pre[e] = s; s += n >> 8; pre[128 + e] = s2; s2 += ((n & 255) + 127) >> 7; }
        pre[32] = s; pre[160] = s2;
    }
    __syncthreads();
    const u32* list = (const u32*)(p.ws + WS_LIST);
    const float* cw = (const float*)(p.ws + WS_CW);
    const u16* HN = (const u16*)(p.ws + WS_HN);
    u16* ACT = (u16*)(p.ws + WS_P0 + P0_ACT);
    u16* Y = (u16*)(p.ws + WS_P0 + P0_Y);
    if (STAGE == 0) {
        MoeSched S{(const char*)HN, (const char*)(p.ws + WS_P0 + P0_WGU), list, pre, 1024, 2, 1, pre[32] * 2,
                   (size_t)512 * 1024 * 2, (size_t)128 * 1024 * 2, (size_t)256 * 1024 * 2};
        EpiGateUp E{&S, cw, ACT};
        pg::gemm((LAS unsigned char*)lds, 1024, S, E);
    } else {
        MoeSched S{(const char*)ACT, (const char*)(p.ws + WS_P0 + P0_WDN), list, pre, 256, 4, 0, pre[32] * 4,
                   (size_t)1024 * 256 * 2, (size_t)256 * 256 * 2, (size_t)128 * 256 * 2};
        EpiDown E{&S, Y};
        pg::gemm((LAS unsigned char*)lds, 256, S, E);
    }
    __syncthreads();
    constexpr int FT = STAGE == 0 ? 4 : 8;
    const int nleft = pre[160] * FT;
    for (int t = (int)gridDim.x - 1 - (int)blockIdx.x; t < nleft; t += gridDim.x) {
        const int rtile = t / FT, ft = t - rtile * FT;
        int e = 0;
        for (int i = 1; i < 32; ++i) if (pre[128 + i] <= rtile) e = i;
        const int ne = pre[64 + e], r0 = (ne & ~255) + (rtile - pre[128 + e]) * 128;
        if (tid < 128) { const int gi = r0 + tid; tl[tid] = gi < ne ? (int)list[(size_t)e * TP + gi] : -1; }
        __syncthreads();
        GemmAcc<2> acc;
        if (STAGE == 0) {
            const u16* W = (const u16*)(p.ws + WS_P0 + P0_WGU) + (size_t)e * 512 * 1024;
            const int f0 = ft * 64;
            auto pf = [=](int lr) -> u32 { const int x = lr & 63, w = lr >> 6; return (u32)((x < 32 ? f0 + w * 32 + x : 256 + f0 + w * 32 + (x - 32)) * 1024); };
            auto qf = [=](int n) -> u32 { const int a = tl[n]; return (u32)((a < 0 ? (tl[0] >> 1) : (a >> 1)) * 1024); };
            gemm_tile<2>(W, HN, 16, pf, qf, acc, lds);
#pragma unroll
            for (int ni = 0; ni < 2; ++ni) {
                const int a = tl[wn * 32 + 16 * ni + c];
                if (a < 0) continue;
                const float cwa = cw[a];
#pragma unroll
                for (int mi = 0; mi < 2; ++mi) {
                    const f32x4 gt = acc.a[mi][ni], up = acc.a[mi + 2][ni];
                    u32x2 w;
                    w.x = pk2(silu(gt[0]) * up[0] * cwa, silu(gt[1]) * up[1] * cwa);
                    w.y = pk2(silu(gt[2]) * up[2] * cwa, silu(gt[3]) * up[3] * cwa);
                    *(u32x2*)(ACT + (size_t)a * 256 + f0 + wm * 32 + 16 * mi + 4 * g) = w;
                }
            }
        } else {
            const u16* W = (const u16*)(p.ws + WS_P0 + P0_WDN) + (size_t)e * 1024 * 256;
            auto qf = [=](int n) -> u32 { const int a = tl[n]; return (u32)((a < 0 ? tl[0] : a) * 256); };
            gemm_tile<2>(W, ACT, 4, LinRow{(u32)(ft * 128) * 256u, 256u}, qf, acc, lds);
#pragma unroll
            for (int ni = 0; ni < 2; ++ni) {
                const int a = tl[wn * 32 + 16 * ni + c];
                if (a < 0) continue;
#pragma unroll
                for (int mi = 0; mi < 4; ++mi) {
                    const f32x4 v = acc.a[mi][ni];
                    u32x2 w; w.x = pk2(v[0], v[1]); w.y = pk2(v[2], v[3]);
                    *(u32x2*)(Y + (size_t)a * 1024 + ft * 128 + wm * 64 + 16 * mi + 4 * g) = w;
                }
            }
        }
        __syncthreads();
    }
}

DI void phase_post1(const Params& p, unsigned char* lds) {
    const int lane = tid_opaque() & 63, wid = tid_opaque() >> 6;
    const float* KRAW = (const float*)(p.ws + WS_P0 + P0_KRAW);
    const float* KIRAW = (const float*)((unsigned char*)p.out + DO_KIRAW);
    unsigned char* KN = (unsigned char*)p.out + DO_KN;
    _Float16* KI = (_Float16*)((unsigned char*)p.out + DO_KI);
    for (int row = blockIdx.x * 8 + wid; row < TP; row += gridDim.x * 8) {
        const f32x4 k = *(const f32x4*)(KRAW + (size_t)row * 256 + 4 * lane);
        float ss = k[0] * k[0] + k[1] * k[1] + k[2] * k[2] + k[3] * k[3];
#pragma unroll
        for (int o = 16; o >= 1; o >>= 1) ss += __shfl_xor(ss, o);
        const float rstd = rsqrtf(ss * (1.f / 128.f) + RMS_EPS);
        const int d = (4 * lane) & 127;
        const f32x4 kg = *(const f32x4*)(p.dsa_k_norm + d), qg = *(const f32x4*)(p.dsa_q_norm + d);
        *(u32*)(KN + (size_t)row * 256 + 4 * lane) = pk4_fp8(k[0] * rstd * kg[0] * qg[0], k[1] * rstd * kg[1] * qg[1], k[2] * rstd * kg[2] * qg[2], k[3] * rstd * kg[3] * qg[3]);
        const float x = KIRAW[(size_t)row * 64 + lane];
        const float mu = wave_sum(x) * (1.f / 64.f);
        const float xc = x - mu;
        const float var = wave_sum(xc * xc) * (1.f / 64.f);
        KI[(size_t)row * 64 + lane] = (_Float16)(xc * rsqrtf(var + RMS_EPS) * p.dsa_ln_g[lane] + p.dsa_ln_b[lane]);
    }
}

constexpr int IX_HIST = 0;
constexpr int IX_SEL = 65536;
constexpr int IX_CV = IX_SEL + 16384;
constexpr int IX_CI = IX_CV + 16384;
constexpr int IX_CNT = IX_CI + 8192;
constexpr int IX_QI = IX_CNT + 512;
constexpr int IX_QROW = 1296;
template <int PASS>
DI void index_pass(const _Float16* __restrict__ KIb, int ktiles, int wid, int lane, const float (&wh)[8], float sQ, unsigned char* lds) {
    const int q = lane & 31, hh = lane >> 5;
    u32* hist = (u32*)(lds + IX_HIST);
    u16* sell = (u16*)(lds + IX_SEL);
    float* cv = (float*)(lds + IX_CV);
    u16* ci = (u16*)(lds + IX_CI);
    int* cn = (int*)(lds + IX_CNT);
    const int tbq = (PASS == 1) ? cn[64 + q] : 0;
    const unsigned char* qb = lds + IX_QI + q * IX_QROW + hh * 16;
    for (int kt = 1 + wid; kt < ktiles; kt += 8) {
        f16x8 a[4];
#pragma unroll
        for (int s = 0; s < 4; ++s) a[s] = *(const f16x8*)(KIb + (size_t)(32 * kt + q) * 64 + 16 * s + 8 * hh);
        float sc[16];
        {
            f32x16 d;
#pragma unroll
            for (int r = 0; r < 16; ++r) d[r] = 0.f;
#pragma unroll
            for (int hd = 8; hd < 10; ++hd)
#pragma unroll
                for (int s = 0; s < 4; ++s) d = __builtin_amdgcn_mfma_f32_32x32x16_f16(a[s], *(const f16x8*)(qb + hd * 128 + s * 32), d, 0, 0, 0);
#pragma unroll
            for (int r = 0; r < 16; ++r) sc[r] = d[r];
        }
#pragma unroll
        for (int hd = 0; hd < 8; ++hd) {
            f32x16 d;
#pragma unroll
            for (int r = 0; r < 16; ++r) d[r] = 0.f;
#pragma unroll
            for (int s = 0; s < 4; ++s) d = __builtin_amdgcn_mfma_f32_32x32x16_f16(a[s], *(const f16x8*)(qb + hd * 128 + s * 32), d, 0, 0, 0);
#pragma unroll
            for (int r = 0; r < 16; ++r) sc[r] = fmaf(fabsf(d[r]), wh[hd], sc[r]);
            if (hd & 1) __builtin_amdgcn_sched_barrier(0);
        }
        const int kbase = 32 * kt + 4 * hh;
        if (PASS == 0) {
#pragma unroll
            for (int r = 0; r < 16; ++r) {
                const int key = kbase + (r & 3) + 8 * (r >> 2);
                const int bin = (int)fminf(fmaxf(fmaf(sc[r], sQ, 512.f), 0.f), 1023.f);
                if (key >= 48) atomicAdd(&hist[q * 512 + (bin >> 1)], 1u << (16 * (bin & 1)));
            }
        } else {
            u32 selm = 0u, candm = 0u;
#pragma unroll
            for (int r = 0; r < 16; ++r) {
                const int key = kbase + (r & 3) + 8 * (r >> 2);
                const int bin = (int)fminf(fmaxf(fmaf(sc[r], sQ, 512.f), 0.f), 1023.f);
                selm |= (key >= 48 && bin > tbq) ? (1u << r) : 0u;
                candm |= (key >= 48 && bin == tbq) ? (1u << r) : 0u;
            }
            if (selm) {
                int pos = atomicAdd(&cn[q], (int)__builtin_popcount(selm));
                while (selm) {
                    const int r = __builtin_ctz(selm); selm &= selm - 1u;
                    if (pos < 256) sell[q * 256 + pos] = (u16)(kbase + (r & 3) + 8 * (r >> 2));
                    ++pos;
                }
            }
            if (candm) {
                int pos = atomicAdd(&cn[32 + q], (int)__builtin_popcount(candm));
#pragma unroll
                for (int r = 0; r < 16; ++r) if (candm & (1u << r)) { if (pos < 128) { cv[q * 128 + pos] = sc[r]; ci[q * 128 + pos] = (u16)(kbase + (r & 3) + 8 * (r >> 2)); } ++pos; }
            }
        }
    }
}
DI void index_unit(const Params& p, int b, int ch, int half, unsigned char* lds) {
    const int tid = tid_opaque(), lane = tid & 63, wid = tid >> 6;
    u16* SEL = (u16*)((unsigned char*)p.out + DO_SEL);
    const int qrow0 = b * LP + 64 * ch + 32 * half;
    const int nkeys = 64 * (ch + 1) - 48;
    if (nkeys <= 256) {
        for (int i = tid; i < 32 * 256; i += NTHREADS) { const int qq = i >> 8, s = i & 255; SEL[(size_t)(qrow0 + qq) * 256 + s] = (u16)(s < nkeys ? 48 + s : 48); }
        return;
    }
    u32* hist = (u32*)(lds + IX_HIST);
    int* cn = (int*)(lds + IX_CNT);
    for (int i = tid; i < 32 * 512; i += NTHREADS) hist[i] = 0u;
    if (tid < 128) cn[tid] = 0;
    { u16* sell0 = (u16*)(lds + IX_SEL); for (int i = tid; i < 32 * 256; i += NTHREADS) sell0[i] = 48; }
    const _Float16* QI = (const _Float16*)(p.ws + WS_P0 + P0_QI);
    const float* WI = (const float*)((unsigned char*)p.out + DO_WI);
    const _Float16* KIb = (const _Float16*)((unsigned char*)p.out + DO_KI) + (size_t)b * LP * 64;
    const int q = lane & 31;
    float wh[8], sQ;
    {
        float n2 = 0.f;
#pragma unroll
        for (int hd = 0; hd < 8; ++hd) { const float w = WI[(size_t)(qrow0 + q) * 8 + hd]; wh[hd] = 0.5f * w; n2 += w * w; }
        sQ = 512.f / (28.f * sqrtf(n2) + 1e-20f);
    }
#pragma unroll
    for (int i = 0; i < 4; ++i) { const int id = tid + NTHREADS * i, rr = id >> 6, cc = id & 63; *(u32x4*)(lds + IX_QI + rr * IX_QROW + cc * 16) = *(const u32x4*)(QI + (size_t)(qrow0 + rr) * 512 + cc * 8); }
    const int ktiles = 2 * (ch + 1);
    __syncthreads();
    {
        const int qq = tid >> 4, dg = tid & 15;
        float c4[4] = {0.f, 0.f, 0.f, 0.f};
#pragma unroll
        for (int hd = 0; hd < 8; ++hd) {
            const float w = 0.5f * WI[(size_t)(qrow0 + qq) * 8 + hd];
            const _Float16* qp = (const _Float16*)(lds + IX_QI + qq * IX_QROW + hd * 128 + dg * 8);
#pragma unroll
            for (int k = 0; k < 4; ++k) c4[k] += w * (float)qp[k];
        }
        _Float16* ph = (_Float16*)(lds + IX_QI + qq * IX_QROW + 8 * 128 + dg * 8);
        _Float16* pl = (_Float16*)(lds + IX_QI + qq * IX_QROW + 9 * 128 + dg * 8);
#pragma unroll
        for (int k = 0; k < 4; ++k) { const _Float16 hi = (_Float16)c4[k]; ph[k] = hi; pl[k] = (_Float16)(c4[k] - (float)hi); }
    }
    __syncthreads();
    index_pass<0>(KIb, ktiles, wid, lane, wh, sQ, lds);
    __syncthreads();
    for (int qi = 0; qi < 4; ++qi) {
        const int qq = 4 * wid + qi;
        u32 hw[8];
        int cl = 0;
#pragma unroll
        for (int i = 0; i < 8; ++i) { hw[i] = hist[qq * 512 + 8 * lane + i]; cl += (int)(hw[i] & 0xffffu) + (int)(hw[i] >> 16); }
        int suf = cl;
#pragma unroll
        for (int o = 1; o < 64; o <<= 1) { const int t = __shfl_down(suf, o); if (lane + o < 64) suf += t; }
        const int above = suf - cl;
        if (above < 256 && above + cl >= 256) {
            int acc = above, tb = 16 * lane, na = above;
#pragma unroll
            for (int i = 15; i >= 0; --i) {
                const int cb = (int)((hw[i >> 1] >> (16 * (i & 1))) & 0xffffu);
                if (acc < 256 && acc + cb >= 256) { tb = 16 * lane + i; na = acc; }
                acc += cb;
            }
            cn[64 + qq] = tb; cn[96 + qq] = na;
        }
    }
    __syncthreads();
    index_pass<1>(KIb, ktiles, wid, lane, wh, sQ, lds);
    __syncthreads();
    {
        u16* sell = (u16*)(lds + IX_SEL);
        const float* cv = (const float*)(lds + IX_CV);
        const u16* ci = (const u16*)(lds + IX_CI);
        for (int qi = 0; qi < 4; ++qi) {
            const int qq = 4 * wid + qi;
            const int na = cn[96 + qq], need = 256 - na;
            int nc = cn[32 + qq]; nc = nc < 128 ? nc : 128;
#pragma unroll
            for (int half2 = 0; half2 < 2; ++half2) {
                const int i = lane + 64 * half2;
                if (i < nc) {
                    const float vi = cv[qq * 128 + i]; const int ki = ci[qq * 128 + i];
                    int rank = 0;
                    for (int j = 0; j < nc; ++j) { const float vj = cv[qq * 128 + j]; const int kj = ci[qq * 128 + j]; rank += (vj > vi || (vj == vi && kj < ki)) ? 1 : 0; }
                    if (rank < need) sell[qq * 256 + na + rank] = (u16)ki;
                }
            }
        }
    }
    __syncthreads();
    {
        const u32x4* src = (const u32x4*)(lds + IX_SEL);
        u32x4* dst = (u32x4*)(SEL + (size_t)qrow0 * 256);
        for (int i = tid; i < 1024; i += NTHREADS) dst[i] = src[i];
    }
    __syncthreads();
}
DI void phase_index(const Params& p, unsigned char* lds) {
    const int G = gridDim.x;
    for (int r = 0;; ++r) {
        const int u = (r & 1) ? r * G + (G - 1 - (int)blockIdx.x) : r * G + (int)blockIdx.x;
        if (r * G >= 516) break;
        if (u < 516) index_unit(p, (u >> 1) & 1, 128 - (u >> 2), u & 1, lds);
    }
}

DI int t5_bucket(int rel) {
    const int n = rel < 0 ? -rel : rel;
    const int base = rel > 0 ? 16 : 0;
    const int lg = 8 + (n >= 12) + (n >= 16) + (n >= 23) + (n >= 32) + (n >= 46) + (n >= 64) + (n >= 91);
    return base + (n < 8 ? n : lg);
}
constexpr int AT_ITEMS = 513;
constexpr int AT_WAVE_LDS = 11264;
DI int at_swz(int r) { return ((r >> 1) & 1) | (((r >> 3) & 1) << 1); }
DI void attn_query(const Params& p, int b, int n, int qi, unsigned char* wl) {
    const int lane = tid_opaque() & 63, c = lane & 15, g = lane >> 4;
    u32* widx = (u32*)wl;
    u16* Pb = (u16*)(wl + 1024);
    unsigned char* ring = wl + 3072;
    float* Lg = (float*)ring;
    const u16* SEL = (const u16*)((unsigned char*)p.out + DO_SEL);
    const u16* QRAW = (const u16*)(p.ws + WS_P0 + P0_QRAW);
    const unsigned char* KN = (const unsigned char*)p.out + DO_KN;
    const unsigned char* VN = p.ws + WS_P0 + P0_VN;
    u16* OA = (u16*)((unsigned char*)p.out + DO_OG);
    const int pq = 48 + qi, row = b * LP + pq;
    const int chq = pq >> 6, nkeys = 64 * (chq + 1) - 48, nsel = nkeys < 256 ? nkeys : 256, ntile = nsel >> 4;
    {
        const u32x2 w = *(const u32x2*)(SEL + (size_t)row * 256 + 4 * lane);
        u32x4 o;
        const int k0 = w.x & 0xffff, k1 = w.x >> 16, k2 = w.y & 0xffff, k3 = w.y >> 16;
        o.x = k0 | (t5_bucket(k0 - pq) << 16); o.y = k1 | (t5_bucket(k1 - pq) << 16); o.z = k2 | (t5_bucket(k2 - pq) << 16); o.w = k3 | (t5_bucket(k3 - pq) << 16);
        *(u32x4*)(widx + 4 * lane) = o;
    }
    const size_t kb = (size_t)b * LP;
    u32x4 qraw[4];
#pragma unroll
    for (int s = 0; s < 4; ++s)
        qraw[s] = (c < 4) ? *(const u32x4*)(QRAW + (size_t)row * 1024 + (4 * n + c) * 128 + 64 * (s >> 1) + 16 * g + 8 * (s & 1))
                          : (u32x4){0u, 0u, 0u, 0u};
    float rbv[8];
    {
        const float* rb = p.rel_bias + (8 * g) * 8 + 4 * n + (c & 3);
#pragma unroll
        for (int j = 0; j < 8; ++j) rbv[j] = rb[8 * j];
    }
#define ATT_LOADK(dst, oh, bt) do { _Pragma("unroll") for (int t = 0; t < 4; ++t) { const u32 e_ = widx[16 * (4 * (bt) + t) + c]; const int kid_ = e_ & 0xffff, bk_ = e_ >> 16; \
        const unsigned char* kp_ = KN + (kb + kid_) * 256 + n * 128 + 16 * g; \
        dst[t][0] = *(const u32x4*)(kp_); dst[t][1] = *(const u32x4*)(kp_ + 64); \
        const u32 hv_ = ((bk_ >> 3) == g) ? (0x3f80u << (16 * (bk_ & 1))) : 0u; const int wq_ = (bk_ & 7) >> 1; \
        u32x4 ow_; ow_.x = wq_ == 0 ? hv_ : 0u; ow_.y = wq_ == 1 ? hv_ : 0u; ow_.z = wq_ == 2 ? hv_ : 0u; ow_.w = wq_ == 3 ? hv_ : 0u; oh[t] = __builtin_bit_cast(bf16x8, ow_); } } while (0)
#define ATT_QK(src, oh, bt) do { _Pragma("unroll") for (int t = 0; t < 4; ++t) { f32x4 a4 = (f32x4){0.f, 0.f, 0.f, 0.f}; \
        a4 = mfma16(fp8x8_to_bf16x8(src[t][0].x, src[t][0].y), qf[0], a4); a4 = mfma16(fp8x8_to_bf16x8(src[t][0].z, src[t][0].w), qf[1], a4); \
        a4 = mfma16(fp8x8_to_bf16x8(src[t][1].x, src[t][1].y), qf[2], a4); a4 = mfma16(fp8x8_to_bf16x8(src[t][1].z, src[t][1].w), qf[3], a4); \
        a4 = mfma16(oh[t], bb, a4); \
        const bool val_ = (4 * (bt) + t) < ntile; \
        _Pragma("unroll") for (int r = 0; r < 4; ++r) { a4[r] = val_ ? a4[r] * qscale : -3.0e38f; mx = fmaxf(mx, a4[r]); } \
        lq[t] = a4; } \
        if (c < 4) { _Pragma("unroll") for (int t = 0; t < 4; ++t) *(f32x4*)(Lg + c * 256 + 16 * (4 * (bt) + t) + 4 * g) = lq[t]; } } while (0)
    u32x4 ka[4][2], kc[4][2]; bf16x8 oa[4], oc[4];
    ATT_LOADK(ka, oa, 0);
    ATT_LOADK(kc, oc, 1);
    bf16x8 qf[4];
    float ssq = 0.f;
#pragma unroll
    for (int s = 0; s < 4; ++s) {
        const u32x4 w = qraw[s];
        qf[s] = __builtin_bit_cast(bf16x8, w);
        ssq += bflo(w.x) * bflo(w.x) + bfhi(w.x) * bfhi(w.x) + bflo(w.y) * bflo(w.y) + bfhi(w.y) * bfhi(w.y)
             + bflo(w.z) * bflo(w.z) + bfhi(w.z) * bfhi(w.z) + bflo(w.w) * bflo(w.w) + bfhi(w.w) * bfhi(w.w);
    }
    ssq += __shfl_xor(ssq, 16); ssq += __shfl_xor(ssq, 32);
    const float qscale = rsqrtf(ssq * (1.f / 128.f) + RMS_EPS) * 0.08838834764831845f;
    bf16x8 bb;
    {
        const float iq = 1.f / qscale;
        u32x4 w;
        w.x = pk2(rbv[0] * iq, rbv[1] * iq); w.y = pk2(rbv[2] * iq, rbv[3] * iq); w.z = pk2(rbv[4] * iq, rbv[5] * iq); w.w = pk2(rbv[6] * iq, rbv[7] * iq);
        if (c >= 4) w = (u32x4){0u, 0u, 0u, 0u};
        bb = __builtin_bit_cast(bf16x8, w);
    }
    float mx = -3.0e38f;
    {
        f32x4 lq[4];
        ATT_QK(ka, oa, 0);
        ATT_LOADK(ka, oa, 2);
        ATT_QK(kc, oc, 1);
        ATT_LOADK(kc, oc, 3);
        ATT_QK(ka, oa, 2);
        ATT_QK(kc, oc, 3);
    }
#undef ATT_LOADK
#undef ATT_QK
    const int kr = lane >> 3, c8 = lane & 7;
    const unsigned char* vbase = VN + kb * 256 + n * 128 + 16 * c8;
#define ATT_SWZ2(r) (((r) & 3) | ((((r) >> 3) & 1) << 2))
#define ATT_LDV(dst, st) do { _Pragma("unroll") for (int j = 0; j < 4; ++j) { const int kid_ = widx[32 * (st) + 8 * j + kr] & 0xffff; \
        dst[j] = *(const u32x4*)(vbase + (size_t)kid_ * 256); } } while (0)
#define ATT_STV(src) do { _Pragma("unroll") for (int j = 0; j < 4; ++j) { const int r_ = 8 * j + kr; \
        unsigned char* d_ = ring + r_ * 256 + ((c8 ^ ATT_SWZ2(r_)) * 32); \
        *(bf16x8*)(d_) = fp8x8_to_bf16x8(src[j].x, src[j].y); *(bf16x8*)(d_ + 16) = fp8x8_to_bf16x8(src[j].z, src[j].w); } } while (0)
    u32x4 v0[4], v1[4], v2[4], v3[4];
    ATT_LDV(v0, 0); ATT_LDV(v1, 1); ATT_LDV(v2, 2); ATT_LDV(v3, 3);
    mx = fmaxf(mx, __shfl_xor(mx, 16)); mx = fmaxf(mx, __shfl_xor(mx, 32));
    float inv[4];
    {
#pragma unroll
        for (int hd = 0; hd < 4; ++hd) {
            const float m = __shfl(mx, hd);
            const f32x4 l4 = *(const f32x4*)(Lg + hd * 256 + 4 * lane);
            f32x4 e = (f32x4){__expf(l4[0] - m), __expf(l4[1] - m), __expf(l4[2] - m), __expf(l4[3] - m)};
            if (4 * lane >= nsel) e = (f32x4){0.f, 0.f, 0.f, 0.f};
            inv[hd] = 1.f / wave_sum(e[0] + e[1] + e[2] + e[3]);
            u32x2 w; w.x = pk2(e[0], e[1]); w.y = pk2(e[2], e[3]);
            *(u32x2*)(Pb + hd * 256 + 4 * lane) = w;
        }
    }
    f32x4 acc[8];
#pragma unroll
    for (int t = 0; t < 8; ++t) acc[t] = (f32x4){0.f, 0.f, 0.f, 0.f};
#define ATT_PVC(st) do { \
        bf16x8 pa_ = (bf16x8){0, 0, 0, 0, 0, 0, 0, 0}; if (c < 4) pa_ = *(const bf16x8*)(Pb + c * 256 + 32 * (st) + 8 * g); \
        const int r0_ = 8 * g + (c >> 2), r1_ = r0_ + 4; \
        _Pragma("unroll") for (int t = 0; t < 8; ++t) { \
            const s16x4 lo_ = __builtin_amdgcn_ds_read_tr16_b64_v4i16((LAS s16x4*)(ring + r0_ * 256 + ((t ^ ATT_SWZ2(r0_)) * 32) + (c & 3) * 8)); \
            const s16x4 hi_ = __builtin_amdgcn_ds_read_tr16_b64_v4i16((LAS s16x4*)(ring + r1_ * 256 + ((t ^ ATT_SWZ2(r1_)) * 32) + (c & 3) * 8)); \
            const bf16x8 vb_ = (bf16x8){lo_[0], lo_[1], lo_[2], lo_[3], hi_[0], hi_[1], hi_[2], hi_[3]}; \
            acc[t] = mfma16(pa_, vb_, acc[t]); } } while (0)
#define ATT_ST(st, vcur) do { ATT_STV(vcur); ATT_PVC(st); if ((st) + 4 < 8) ATT_LDV(vcur, (st) + 4); } while (0)
    ATT_ST(0, v0); ATT_ST(1, v1); ATT_ST(2, v2); ATT_ST(3, v3); ATT_ST(4, v0); ATT_ST(5, v1); ATT_ST(6, v2); ATT_ST(7, v3);
#undef ATT_ST
#undef ATT_LDV
#undef ATT_STV
#undef ATT_PVC
#undef ATT_SWZ2
    if (g == 0) {
#pragma unroll
        for (int r = 0; r < 4; ++r)
#pragma unroll
            for (int t = 0; t < 8; ++t) OA[(size_t)row * 1024 + (4 * n + r) * 128 + 16 * t + c] = f2bf(acc[t][r] * inv[r]);
    }
}
DI void phase_attn(const Params& p, unsigned xcc, unsigned char* lds) {
    const int tid = tid_opaque(), lane = tid & 63, wid = tid >> 6;
    unsigned char* wl = lds + wid * AT_WAVE_LDS;
    u16* OA = (u16*)((unsigned char*)p.out + DO_OG);
    for (int i = blockIdx.x * NTHREADS + tid; i < 96 * 128; i += gridDim.x * NTHREADS) {
        const int r = i >> 7, b = r / 48, pp = r - 48 * b;
        *(u32x4*)(OA + ((size_t)b * LP + pp) * 1024 + (i & 127) * 8) = (u32x4){0u, 0u, 0u, 0u};
    }
    unsigned* qctr = (unsigned*)(p.ws + WS_CTL) + CW_AQ;
    const int my = (int)(xcc & 3u);
    constexpr int NIT = 8208 / 2;
    int cbq = my;
    unsigned jn = 0;
    if (lane == 0) jn = atomicAdd(&qctr[cbq * 64], 1u);
    for (;;) {
        int j = (int)__builtin_amdgcn_readfirstlane(jn), cb = cbq;
        while (j >= NIT) {
            if (((cbq + 1) & 3) == my) { j = -1; break; }
            cbq = (cbq + 1) & 3; cb = cbq;
            unsigned t = 0; if (lane == 0) t = atomicAdd(&qctr[cbq * 64], 1u);
            j = (int)__builtin_amdgcn_readfirstlane(t);
        }
        if (j < 0) break;
        if (lane == 0) jn = atomicAdd(&qctr[cbq * 64], 1u);
        attn_query(p, cb >> 1, cb & 1, 2 * j, wl);
        attn_query(p, cb >> 1, cb & 1, 2 * j + 1, wl);
    }
}

DI void phase_final(const Params& p) {
    const float* H = (const float*)(p.ws + WS_H);
    const u16* Y = (const u16*)(p.ws + WS_P0 + P0_Y);
    for (size_t i = (size_t)blockIdx.x * NTHREADS + tid_opaque(); i < (size_t)2 * SEQ * 256; i += (size_t)gridDim.x * NTHREADS) {
        const size_t orow = i >> 8; const int col = (int)(i & 255) * 4;
        const int b = (int)(orow >> 13), s = (int)(orow & 8191);
        const size_t row = (size_t)b * LP + 64 + s;
        f32x4 v = *(const f32x4*)(H + row * DM + col);
        const u32x2 y0 = *(const u32x2*)(Y + (2 * row) * DM + col), y1 = *(const u32x2*)(Y + (2 * row + 1) * DM + col);
        v[0] += bflo(y0.x) + bflo(y1.x); v[1] += bfhi(y0.x) + bfhi(y1.x); v[2] += bflo(y0.y) + bflo(y1.y); v[3] += bfhi(y0.y) + bfhi(y1.y);
        *(f32x4*)(p.out + orow * DM + col) = v;
    }
}

__global__ void __launch_bounds__(NTHREADS, 2) mega(Params p) {
    extern __shared__ __attribute__((aligned(16))) unsigned char lds[];
    if (threadIdx.x < 4) ((volatile LAS unsigned*)(lds + LDS_BAR))[threadIdx.x] = 0u;
    __syncthreads();
    XcdBarrier bar = xcd_barrier_post((unsigned*)(p.ws + WS_CTL) + CW_BAR, (volatile LAS unsigned*)(lds + LDS_BAR));
    phase_prep(p, lds);                                                   xcd_barrier(bar);
    phase_gemm_in0(p, lds);                                               xcd_barrier(bar);
    phase_gdn_prep(p, lds);                                             xcd_barrier(bar);
    { int c0 = 1, c1 = 66; asm volatile("" : "+s"(c0), "+s"(c1));
      if (blockIdx.x < 64) phase_gdn_scan(p, lds, c0, c1); else if (blockIdx.x < 80) gdn_prep_unit(p, blockIdx.x - 64, 128, lds); }
    xcd_barrier(bar);
    { int c0 = 67, c1 = 127; asm volatile("" : "+s"(c0), "+s"(c1));
      if (blockIdx.x < 64) phase_gdn_scan(p, lds, c0, c1); else { for (int u = blockIdx.x - 64; u < 16 * 68; u += gridDim.x - 64) gdn_out_unit(p, u / 68, u % 68, lds); } }
    xcd_barrier(bar);
    for (int u = blockIdx.x; u < 16 * 61; u += gridDim.x) gdn_out_unit(p, u / 61, 68 + u % 61, lds);
    xcd_barrier(bar);
    phase_gemm_out(p, (const u16*)(p.ws + WS_W_OUT0), (const u16*)(p.ws + WS_P0) + 2048, 4096, lds);   xcd_barrier(bar);
    phase_norm<false, true>(p, p.norm_ffn, 0, lds);
    conv_moe_weights(p, 0, lds);                                          xcd_barrier(bar);
    phase_moe<0>(p, 0, lds);                                              xcd_barrier(bar);
    phase_moe<1>(p, 0, lds);                                              xcd_barrier(bar);
    phase_norm<true, false>(p, p.norm_mix + DM, 0, lds);
    conv_moe_weights(p, 1, lds);                                          xcd_barrier(bar);
    phase_gemm_in1(p, lds);                                               xcd_barrier(bar);
    phase_post1(p, lds);                                                  xcd_barrier(bar);
    phase_index(p, lds);                                                  xcd_barrier(bar);
    phase_attn(p, bar.x, lds);                                                   xcd_barrier(bar);
    phase_gemm_out(p, (const u16*)(p.ws + WS_W_OUT1), (const u16*)((unsigned char*)p.out + DO_OG), 1024, lds);   xcd_barrier(bar);
    phase_norm<false, true>(p, p.norm_ffn + DM, 1, lds);                  xcd_barrier(bar);
    phase_moe<0>(p, 1, lds);                                              xcd_barrier(bar);
    phase_moe<1>(p, 1, lds);                                              xcd_barrier(bar);
    phase_final(p);
}

extern "C" void kernel_launch(void* const* d_in, const int* in_sizes, int n_in, void* d_out, int out_size, void* d_ws, size_t ws_size, hipStream_t stream) {
    static int grid = 0;
    if (grid == 0) {
        if (n_in != 23 || out_size != 2 * SEQ * DM || ws_size < WS_END) { fprintf(stderr, "kernel_launch: unexpected sizes (n_in %d out %d ws %zu need %zu)\n", n_in, out_size, ws_size, (size_t)WS_END); grid = -1; return; }
        int dev = 0, cus = 0;
        if (hipGetDevice(&dev) != hipSuccess || hipDeviceGetAttribute(&cus, hipDeviceAttributeMultiprocessorCount, dev) != hipSuccess) { grid = -1; return; }
        if (hipFuncSetAttribute((const void*)mega, hipFuncAttributeMaxDynamicSharedMemorySize, LDS_BYTES) != hipSuccess) { fprintf(stderr, "kernel_launch: hipFuncSetAttribute failed\n"); grid = -1; return; }
        grid = cus > 256 ? 256 : cus;
        if (grid < 16) { grid = -1; return; }
    }
    if (grid < 0) return;
    (void)hipMemsetAsync((unsigned char*)d_ws + WS_CTL, 0, CTL_BYTES, stream);
    Params p{};
    const float** f = (const float**)&p;
    for (int i = 0; i < 23; ++i) f[i] = (const float*)d_in[i];
    p.out = (float*)d_out; p.ws = (unsigned char*)d_ws;
    hipLaunchKernelGGL(mega, dim3(grid), dim3(NTHREADS), LDS_BYTES, stream, p);
}
```

```cpp
#include <hip/hip_runtime.h>
#include <stdint.h>
#include <stdio.h>

#define DI __device__ __forceinline__
#define LAS __attribute__((address_space(3)))
typedef unsigned short u16;
typedef unsigned int u32;
typedef short bf16x8 __attribute__((ext_vector_type(8)));
typedef _Float16 f16x8 __attribute__((ext_vector_type(8)));
typedef float f32x4 __attribute__((ext_vector_type(4)));
typedef float f32x16 __attribute__((ext_vector_type(16)));
typedef u32 u32x4 __attribute__((ext_vector_type(4)));
typedef u32 u32x2 __attribute__((ext_vector_type(2)));
typedef short s16x4 __attribute__((ext_vector_type(4)));

constexpr int DM = 1024, SEQ = 8192, LP = 8256, TP = 16512, TPA = 16640, NCH = 129;
constexpr int NTHREADS = 512;
constexpr int LDS_BYTES = 155648;
constexpr int LDS_BAR = LDS_BYTES - 16;
constexpr float RMS_EPS = 1e-6f;

constexpr size_t WS_CTL = 0, CTL_BYTES = 1u << 20;
constexpr size_t WS_W_IN0 = CTL_BYTES;
constexpr size_t WS_W_OUT0 = WS_W_IN0 + (size_t)4224 * 1024 * 2;
constexpr size_t WS_W_IN1 = WS_W_OUT0 + (size_t)1024 * 1024 * 2;
constexpr size_t WS_W_OUT1 = WS_W_IN1 + (size_t)2176 * 1024 * 2;
constexpr size_t WS_BA = WS_W_OUT1 + (size_t)1024 * 1024 * 2;
constexpr size_t WS_LIST = WS_BA + (size_t)TPA * 16 * 4;
constexpr size_t WS_CW = WS_LIST + (size_t)32 * TP * 4;
constexpr size_t WS_H = WS_CW + (size_t)2 * TP * 4;
constexpr size_t WS_NS = WS_H + (size_t)TPA * 1024 * 4;
constexpr size_t WS_HN = WS_NS;
constexpr size_t WS_P0 = WS_NS + (size_t)16 * 129 * 128 * 128 * 2;
constexpr size_t WS_HALO = WS_P0 + (size_t)TPA * 4096 * 2;
constexpr size_t WS_END = WS_HALO + (size_t)2 * 129 * 3 * 3072 * 2;
constexpr size_t P0_WGU = 0;
constexpr size_t P0_WDN = P0_WGU + (size_t)32 * 512 * 1024 * 2;
constexpr size_t P0_ACT = P0_WDN + (size_t)32 * 1024 * 256 * 2;
constexpr size_t P0_Y = P0_ACT + (size_t)2 * TP * 256 * 2;
constexpr size_t P0_QRAW = P0_ACT;
constexpr size_t P0_KRAW = P0_QRAW + (size_t)TP * 1024 * 2;
constexpr size_t P0_VN = P0_KRAW + (size_t)TP * 256 * 4;
constexpr size_t P0_QI = P0_VN + (size_t)TP * 256 * 2;
static_assert(P0_Y + (size_t)2 * TP * 1024 * 2 <= (size_t)TPA * 4096 * 2, "P0 map");
static_assert(P0_QI + (size_t)TP * 512 * 2 <= (size_t)TPA * 4096 * 2, "P0 map 2");
constexpr size_t DO_M = 0;
constexpr size_t DO_OG = 0;
constexpr size_t DO_SEL = (size_t)TPA * 1024 * 2;
constexpr size_t DO_KN = DO_SEL + (size_t)TP * 256 * 2;
constexpr size_t DO_KI = DO_KN + (size_t)TP * 256 * 2;
constexpr size_t DO_WI = DO_KI + (size_t)TP * 64 * 2;
constexpr size_t DO_KIRAW = DO_WI + (size_t)TP * 8 * 4;
static_assert(DO_KIRAW + (size_t)TP * 64 * 4 <= (size_t)2 * SEQ * 1024 * 4, "d_out map");
constexpr int CW_BAR = 0;
constexpr int CW_CNT = 4096;
constexpr int CW_AQ = 4352;

struct Params {
    const float *x, *meta, *norm_mix, *norm_ffn, *rel_bias, *gdn_w_in, *gdn_conv, *gdn_a_log, *gdn_dt_bias, *gdn_o_norm, *gdn_w_out,
        *dsa_w_in, *dsa_q_norm, *dsa_k_norm, *dsa_ln_g, *dsa_ln_b, *dsa_w_out, *moe_w_group, *moe_b_group, *moe_w_expert, *moe_b_expert,
        *moe_w_gu, *moe_w_down;
    float* out;
    unsigned char* ws;
};

DI u16 f2bf(float f) { return __builtin_bit_cast(u16, (__bf16)f); }
DI float bf2f(u16 h) { return __uint_as_float(((u32)h) << 16); }
DI u32 pk2(float a, float b) { return (u32)f2bf(a) | ((u32)f2bf(b) << 16); }
DI float bflo(u32 w) { return __uint_as_float(w << 16); }
DI float bfhi(u32 w) { return __uint_as_float(w & 0xffff0000u); }
typedef float f32x2 __attribute__((ext_vector_type(2)));
DI u32 pk4_fp8(float a, float b, float c, float d) { int w = 0; w = __builtin_amdgcn_cvt_pk_fp8_f32(a, b, w, false); w = __builtin_amdgcn_cvt_pk_fp8_f32(c, d, w, true); return (u32)w; }
DI u32x2 fp8x4_to_bf16x4(u32 w) {
    const f32x2 lo = __builtin_amdgcn_cvt_pk_f32_fp8((int)w, false), hi = __builtin_amdgcn_cvt_pk_f32_fp8((int)w, true);
    u32x2 r; r.x = pk2(lo[0], lo[1]); r.y = pk2(hi[0], hi[1]); return r;
}
DI bf16x8 fp8x8_to_bf16x8(u32 w0, u32 w1) { const u32x2 a = fp8x4_to_bf16x4(w0), b = fp8x4_to_bf16x4(w1); return __builtin_bit_cast(bf16x8, (u32x4){a.x, a.y, b.x, b.y}); }
DI float wave_sum(float v) {
#pragma unroll
    for (int o = 32; o >= 1; o >>= 1) v += __shfl_xor(v, o);
    return v;
}
DI int tid_opaque() { int t = threadIdx.x; asm volatile("" : "+v"(t)); return t; }
#define LDS_BARRIER() do { asm volatile("s_waitcnt lgkmcnt(0)" ::: "memory"); __builtin_amdgcn_s_barrier(); asm volatile("" ::: "memory"); } while (0)
DI float silu(float x) { return x / (1.f + __expf(-x)); }
DI f32x4 mfma16(bf16x8 a, bf16x8 b, f32x4 c) { return __builtin_amdgcn_mfma_f32_16x16x32_bf16(a, b, c, 0, 0, 0); }
DI bf16x8 ldsfrag(const unsigned char* base, int row, int strideB, int kel) { return *(const bf16x8*)(base + row * strideB + kel * 2); }

#define XB_TMO      128
#define XB_XCNT(j)  (256  + 64 * (j))
#define XB_XSUB(j)  (1280 + 64 * (j))
#define XB_XGEN(j)  (2304 + 64 * (j))
#define XB_TOP      3328
#define XB_TOPGEN   3392
#define XCD_BAR_WORDS 3456
#define XB_SPIN_CAP (1u << 21)
DI unsigned xb_ld(unsigned* p) { return __hip_atomic_load(p, __ATOMIC_RELAXED, __HIP_MEMORY_SCOPE_AGENT); }
DI unsigned xb_add(unsigned* p, unsigned v) { return __hip_atomic_fetch_add(p, v, __ATOMIC_RELAXED, __HIP_MEMORY_SCOPE_AGENT); }
DI unsigned xb_xcc_id() { return (unsigned)__builtin_amdgcn_s_getreg((3 << 11) | 20) & 0xFu; }
#define XB_SPIN(cond, bar) do { unsigned _sp = 0; while (cond) { __builtin_amdgcn_s_sleep(1); \
    if ((++_sp & 255u) == 0u) { if (xb_ld(&(bar)[XB_TMO])) break; if (_sp > XB_SPIN_CAP) { atomicAdd(&(bar)[XB_TMO], 1u); break; } } } } while (0)
struct XcdBarrier { unsigned* bar; unsigned x; volatile LAS unsigned* st; };
DI XcdBarrier xcd_barrier_post(unsigned* bar, volatile LAS unsigned* st) {
    XcdBarrier b; b.bar = bar; b.x = xb_xcc_id(); b.st = st;
    if (threadIdx.x == 0) (void)xb_add(&bar[XB_XCNT(b.x)], 1u);
    return b;
}
DI void xcd_barrier_complete(unsigned* bar, unsigned x, unsigned& nloc, unsigned& nx) {
    const unsigned G = gridDim.x * gridDim.y * gridDim.z;
    unsigned sum, cnt, mine, sp = 0u;
    for (;;) {
        sum = 0u; cnt = 0u; mine = 0u;
#pragma unroll
        for (unsigned j = 0; j < 16; ++j) { const unsigned c = xb_ld(&bar[XB_XCNT(j)]); sum += c; cnt += (c > 0u) ? 1u : 0u; }
        mine = xb_ld(&bar[XB_XCNT(x)]);
        if (sum == G) break;
        __builtin_amdgcn_s_sleep(1);
        if ((++sp & 255u) == 0u) { if (xb_ld(&bar[XB_TMO])) break; if (sp > XB_SPIN_CAP) { atomicAdd(&bar[XB_TMO], 1u); break; } }
    }
    nloc = mine > 0u ? mine : 1u; nx = cnt > 0u ? cnt : 1u;
}
DI void xcd_barrier(const XcdBarrier& b) {
    asm volatile("s_waitcnt vmcnt(0)" ::: "memory");
    __syncthreads();
    if (threadIdx.x == 0) {
        unsigned* bar = b.bar;
        __builtin_amdgcn_s_waitcnt(0);
        unsigned nloc = b.st[0], nx = b.st[1];
        if (nloc == 0u) { xcd_barrier_complete(bar, b.x, nloc, nx); b.st[0] = nloc; b.st[1] = nx; }
        const unsigned old = xb_add(&bar[XB_XSUB(b.x)], 1u);
        const unsigned gen = old / nloc;
        if (old + 1u == (gen + 1u) * nloc) {
            __builtin_amdgcn_fence(__ATOMIC_RELEASE, "agent");
            asm volatile("s_waitcnt vmcnt(0)" ::: "memory");
            const unsigned og = xb_add(&bar[XB_TOP], 1u);
            const unsigned tg = og / nx;
            if (og + 1u == (tg + 1u) * nx) xb_add(&bar[XB_TOPGEN], 1u);
            else XB_SPIN(xb_ld(&bar[XB_TOPGEN]) == tg, bar);
            __builtin_amdgcn_fence(__ATOMIC_ACQUIRE, "agent");
            xb_add(&bar[XB_XGEN(b.x)], 1u);
            asm volatile("s_waitcnt vmcnt(0)" ::: "memory");
        } else {
            XB_SPIN(xb_ld(&bar[XB_XGEN(b.x)]) == gen, bar);
            __builtin_amdgcn_fence(__ATOMIC_ACQUIRE, "agent");
            asm volatile("s_waitcnt vmcnt(0)" ::: "memory");
        }
    }
    __syncthreads();
}

struct ConvJob { const float* src; u16* dst; int K, N, kt, nt; };
DI void convT_load(const ConvJob& j, float (&r)[16], int tid) {
    const int l32 = tid & 31, kb = tid >> 5;
#pragma unroll
    for (int kk = 0; kk < 4; ++kk)
#pragma unroll
        for (int q = 0; q < 4; ++q) {
            const int k = j.kt * 64 + kb + 16 * kk, n = j.nt * 128 + l32 + 32 * q;
            r[4 * kk + q] = (n < j.N) ? j.src[(size_t)k * j.N + n] : 0.f;
        }
}
DI void convT_store(const ConvJob& j, const float (&r)[16], int tid, unsigned char* lds) {
    const int l32 = tid & 31, kb = tid >> 5;
    u16* img = (u16*)lds;
#pragma unroll
    for (int kk = 0; kk < 4; ++kk)
#pragma unroll
        for (int q = 0; q < 4; ++q) img[(l32 + 32 * q) * 68 + kb + 16 * kk] = f2bf(r[4 * kk + q]);
    __syncthreads();
#pragma unroll
    for (int i = 0; i < 2; ++i) {
        const int id = tid + NTHREADS * i, n = id >> 3, ck = id & 7;
        const u32x2 a = *(const u32x2*)(lds + n * 136 + ck * 16), b2 = *(const u32x2*)(lds + n * 136 + ck * 16 + 8);
        *(u32x4*)(j.dst + (size_t)(j.nt * 128 + n) * j.K + j.kt * 64 + ck * 8) = (u32x4){a.x, a.y, b2.x, b2.y};
    }
    __syncthreads();
}
template <class DEC> DI void convT_run(DEC dec, int nunits, unsigned char* lds) {
    const int tid = tid_opaque();
    int u = blockIdx.x;
    if (u >= nunits) return;
    ConvJob cur = dec(u), nxt = cur;
    float r[16];
    convT_load(cur, r, tid);
    for (;;) {
        const int un = u + (int)gridDim.x;
        const bool more = un < nunits;
        float rn[16];
        u16* img = (u16*)lds;
        {
            const int l32 = tid & 31, kb = tid >> 5;
#pragma unroll
            for (int kk = 0; kk < 4; ++kk)
#pragma unroll
                for (int q = 0; q < 4; ++q) img[(l32 + 32 * q) * 68 + kb + 16 * kk] = f2bf(r[4 * kk + q]);
        }
        if (more) { nxt = dec(un); convT_load(nxt, rn, tid); }
        __syncthreads();
#pragma unroll
        for (int i = 0; i < 2; ++i) {
            const int id = tid + NTHREADS * i, n = id >> 3, ck = id & 7;
            const u32x2 a = *(const u32x2*)(lds + n * 136 + ck * 16), b2 = *(const u32x2*)(lds + n * 136 + ck * 16 + 8);
            *(u32x4*)(cur.dst + (size_t)(cur.nt * 128 + n) * cur.K + cur.kt * 64 + ck * 8) = (u32x4){a.x, a.y, b2.x, b2.y};
        }
        __syncthreads();
        if (!more) break;
        u = un; cur = nxt;
#pragma unroll
        for (int i = 0; i < 16; ++i) r[i] = rn[i];
    }
}

template <int NI> struct GemmAcc { f32x4 a[4][NI]; };
template <int NI, class PF, class QF>
DI void gemm_tile(const u16* __restrict__ Pb, const u16* __restrict__ Qb, int KT, PF pf, QF qf, GemmAcc<NI>& acc, unsigned char* lds) {
    constexpr int TN = 64 * NI, QC = TN * 8 / NTHREADS, BUF = (128 + TN) * 144;
    const int tid = tid_opaque(), lane = tid & 63, wid = tid >> 6, c = lane & 15, g = lane >> 4, wm = wid >> 2, wn = wid & 3;
    u32 poff[2], qoff[QC];
#pragma unroll
    for (int i = 0; i < 2; ++i) { const int id = tid + NTHREADS * i; poff[i] = pf(id >> 3) + (id & 7) * 8; }
#pragma unroll
    for (int i = 0; i < QC; ++i) { const int id = tid + NTHREADS * i; qoff[i] = qf(id >> 3) + (id & 7) * 8; }
#pragma unroll
    for (int mi = 0; mi < 4; ++mi)
#pragma unroll
        for (int ni = 0; ni < NI; ++ni) acc.a[mi][ni] = (f32x4){0.f, 0.f, 0.f, 0.f};
    u32x4 p0[2], p1[2], p2[2], p3[2], q0[QC], q1[QC], q2[QC], q3[QC];
#define GT_LOAD(P, Q, kt) do { if ((kt) < KT) { _Pragma("unroll") for (int i = 0; i < 2; ++i) P[i] = *(const u32x4*)(Pb + poff[i] + (kt) * 64); \
        _Pragma("unroll") for (int i = 0; i < QC; ++i) Q[i] = *(const u32x4*)(Qb + qoff[i] + (kt) * 64); } } while (0)
#define GT_STORE(P, Q, buf) do { _Pragma("unroll") for (int i = 0; i < 2; ++i) { const int id = tid + NTHREADS * i; *(u32x4*)((buf) + (id >> 3) * 144 + (id & 7) * 16) = P[i]; } \
        _Pragma("unroll") for (int i = 0; i < QC; ++i) { const int id = tid + NTHREADS * i; *(u32x4*)((buf) + 128 * 144 + (id >> 3) * 144 + (id & 7) * 16) = Q[i]; } } while (0)
#define GT_STEP(kt, PN, QN, PC, QC_) do { if ((kt) < KT) { const unsigned char* cur = lds + ((kt) & 1) * BUF; \
        _Pragma("unroll") for (int ks = 0; ks < 2; ++ks) { bf16x8 af[4], bfr[NI]; \
            _Pragma("unroll") for (int mi = 0; mi < 4; ++mi) af[mi] = ldsfrag(cur, wm * 64 + 16 * mi + c, 144, 32 * ks + 8 * g); \
            _Pragma("unroll") for (int ni = 0; ni < NI; ++ni) bfr[ni] = ldsfrag(cur + 128 * 144, wn * 16 * NI + 16 * ni + c, 144, 32 * ks + 8 * g); \
            _Pragma("unroll") for (int mi = 0; mi < 4; ++mi) _Pragma("unroll") for (int ni = 0; ni < NI; ++ni) acc.a[mi][ni] = mfma16(af[mi], bfr[ni], acc.a[mi][ni]); } \
        if ((kt) + 1 < KT) GT_STORE(PN, QN, lds + (((kt) + 1) & 1) * BUF); \
        GT_LOAD(PC, QC_, (kt) + 4); \
        __syncthreads(); } } while (0)
    GT_LOAD(p0, q0, 0); GT_LOAD(p1, q1, 1); GT_LOAD(p2, q2, 2); GT_LOAD(p3, q3, 3);
    GT_STORE(p0, q0, lds);
    __syncthreads();
    for (int k0 = 0; k0 < KT; k0 += 4) {
        GT_STEP(k0, p1, q1, p0, q0);
        GT_STEP(k0 + 1, p2, q2, p1, q1);
        GT_STEP(k0 + 2, p3, q3, p2, q2);
        GT_STEP(k0 + 3, p0, q0, p3, q3);
    }
#undef GT_LOAD
#undef GT_STORE
#undef GT_STEP
}
struct LinRow { u32 base, ld; DI u32 operator()(int r) const { return base + (u32)r * ld; } };

namespace pg {
constexpr int BM = 256, BK = 64, HALF = 128, HTB = HALF * BK * 2;
DI int lds_byte(int r, int c) { const int st = (r >> 4) * 2 + (c >> 5), rr = r & 15, cc = c & 31, ob = rr * 64 + cc * 2; return st * 1024 + (ob ^ (((ob >> 9) & 1) << 5)); }
DI void stage_rc(int b, int& R, int& C) { const int st = b / 1024, sb = b % 1024, swz = sb ^ (((sb >> 9) & 1) << 5); R = (st >> 1) * 16 + swz / 64; C = (st & 1) * 32 + (swz % 64) / 2; }
DI int perm32(int rho) { const int n = rho >> 4, i = rho & 15; return 8 * (i >> 2) + 4 * n + (i & 3); }
struct Unit { int pm, pn, e, n; };
typedef f32x4 Acc[2][2][4][2];
template <class Sched, class Epi>
DI void gemm(LAS unsigned char* lds, const int K, const Sched& S, const Epi& E) {
    const int tid = tid_opaque(), wid = __builtin_amdgcn_readfirstlane(tid >> 6), lane = tid & 63, wr = wid >> 2, wc = wid & 3, fr = lane & 15, fq = lane >> 4;
    const int nt = K / BK;
    int Rs[2], Cs[2];
    unsigned voffB[2];
#pragma unroll
    for (int i = 0; i < 2; ++i) { stage_rc(tid * 16 + i * 8192, Rs[i], Cs[i]); const int Rb = Epi::PERM ? ((Rs[i] & ~31) + perm32(Rs[i] & 31)) : Rs[i]; voffB[i] = (unsigned)(Rb * K + Cs[i]) * 2u; }
    const size_t kstep = (size_t)(BK * 2);
    const size_t bh1 = S.bh1();
    const unsigned ldsw = (unsigned)wid * 1024u;
    const int aoff = lds_byte(wr * 64 + fr, fq * 8), boff = lds_byte(wc * 32 + fr, fq * 8);
    const char* Ab = S.abase();
#define PG_SA(b, h) (((b) * 2 + (h)) * HTB)
#define PG_SB(b, h) ((4 + (b) * 2 + (h)) * HTB)
#define PG_STAGE(bufoff, gbase, voff) do { _Pragma("unroll") for (int _i = 0; _i < 2; ++_i) \
        __builtin_amdgcn_global_load_lds((const unsigned*)((const char*)(gbase) + (voff)[_i]), (LAS unsigned*)(lds + (bufoff) + ldsw + _i * 8192), 16, 0, 0); } while (0)
#define PG_LDA(dst, b, h) do { _Pragma("unroll") for (int m = 0; m < 4; ++m) _Pragma("unroll") for (int k = 0; k < 2; ++k) dst[m][k] = *(const LAS bf16x8*)(lds + PG_SA(b, h) + aoff + m * 2048 + k * 1024); } while (0)
#define PG_LDB(dst, b, h) do { _Pragma("unroll") for (int n = 0; n < 2; ++n) _Pragma("unroll") for (int k = 0; k < 2; ++k) dst[n][k] = *(const LAS bf16x8*)(lds + PG_SB(b, h) + boff + n * 2048 + k * 1024); } while (0)
#define PG_MMA(ai, bj, At, Bt) do { __builtin_amdgcn_s_setprio(1); _Pragma("unroll") for (int m = 0; m < 4; ++m) _Pragma("unroll") for (int n = 0; n < 2; ++n) _Pragma("unroll") for (int k = 0; k < 2; ++k) \
        acc[ai][bj][m][n] = __builtin_amdgcn_mfma_f32_16x16x32_bf16(Bt[n][k], At[m][k], acc[ai][bj][m][n], 0, 0, 0); __builtin_amdgcn_s_setprio(0); } while (0)
#define PG_WAIT_V(n) asm volatile("s_waitcnt vmcnt(" #n ")" ::: "memory")
#define PG_WAIT_L(n) asm volatile("s_waitcnt lgkmcnt(" #n ")" ::: "memory")
#define PG_BAR __builtin_amdgcn_s_barrier()
#define PG_SCHED __builtin_amdgcn_sched_barrier(0)
#define PG_AOFF(dst, u) do { _Pragma("unroll") for (int h_ = 0; h_ < 2; ++h_) _Pragma("unroll") for (int i_ = 0; i_ < 2; ++i_) dst[h_][i_] = (unsigned)(S.arow(u, h_ * HALF + Rs[i_]) * S.lda() + Cs[i_]) * 2u; } while (0)
    Unit cur, nxt; int ui = 0;
    if (!S.next(0, cur)) return;
    Acc acc;
#pragma unroll
    for (int a = 0; a < 2; ++a)
#pragma unroll
        for (int b = 0; b < 2; ++b)
#pragma unroll
            for (int m = 0; m < 4; ++m)
#pragma unroll
                for (int n = 0; n < 2; ++n) acc[a][b][m][n] = (f32x4){0.f, 0.f, 0.f, 0.f};
    bf16x8 At[4][2], B0[2][2], B1[2][2];
    unsigned aoC[2][2], aoN[2][2];
    PG_AOFF(aoC, cur);
    const char* cB = S.bbase(cur);
    PG_STAGE(PG_SB(0, 0), cB, voffB); PG_STAGE(PG_SA(0, 0), Ab, aoC[0]); PG_STAGE(PG_SB(0, 1), cB + bh1, voffB); PG_STAGE(PG_SA(0, 1), Ab, aoC[1]);
    if (wr == 1) PG_BAR;
    PG_WAIT_V(4); PG_BAR;
    PG_STAGE(PG_SB(1, 0), cB + kstep, voffB); PG_STAGE(PG_SA(1, 0), Ab + kstep, aoC[0]); PG_STAGE(PG_SB(1, 1), cB + bh1 + kstep, voffB);
    PG_WAIT_V(6); PG_BAR;
    for (;;) {
        const bool has_next = S.next(ui + 1, nxt);
        const char* nB = has_next ? S.bbase(nxt) : cB;
        if (has_next) PG_AOFF(aoN, nxt);
        else {
#pragma unroll
            for (int h_ = 0; h_ < 2; ++h_)
#pragma unroll
                for (int i_ = 0; i_ < 2; ++i_) aoN[h_][i_] = aoC[h_][i_];
        }
#pragma unroll 1
        for (int t = 0; t < nt; t += 2) {
            const bool last = (t == nt - 2);
            const char* a1 = Ab + (size_t)(t + 1) * kstep;
            const char* a2 = last ? Ab : Ab + (size_t)(t + 2) * kstep; const char* b2 = last ? nB : cB + (size_t)(t + 2) * kstep;
            const char* a3 = a2 + kstep; const char* b3 = b2 + kstep;
            unsigned o2[2][2];
#pragma unroll
            for (int h_ = 0; h_ < 2; ++h_)
#pragma unroll
                for (int i_ = 0; i_ < 2; ++i_) o2[h_][i_] = last ? aoN[h_][i_] : aoC[h_][i_];
            PG_LDB(B0, 0, 0); PG_SCHED; PG_LDA(At, 0, 0); PG_STAGE(PG_SA(1, 1), a1, aoC[1]);
            PG_WAIT_L(8); PG_BAR; PG_WAIT_L(0); PG_MMA(0, 0, At, B0); PG_BAR; PG_SCHED;
            PG_LDB(B1, 0, 1); PG_STAGE(PG_SB(0, 0), b2, voffB);
            PG_BAR; PG_WAIT_L(0); PG_MMA(0, 1, At, B1); PG_BAR;
            PG_LDA(At, 0, 1); PG_STAGE(PG_SA(0, 0), a2, o2[0]);
            PG_BAR; PG_WAIT_L(0); PG_MMA(1, 0, At, B0); PG_BAR; PG_SCHED;
            PG_STAGE(PG_SB(0, 1), b2 + bh1, voffB);
            PG_WAIT_V(6); PG_BAR; PG_MMA(1, 1, At, B1); PG_BAR;
            PG_LDB(B0, 1, 0); PG_SCHED; PG_LDA(At, 1, 0); PG_STAGE(PG_SA(0, 1), a2, o2[1]);
            PG_WAIT_L(8); PG_BAR; PG_WAIT_L(0); PG_MMA(0, 0, At, B0); PG_BAR; PG_SCHED;
            PG_LDB(B1, 1, 1); PG_STAGE(PG_SB(1, 0), b3, voffB);
            PG_BAR; PG_WAIT_L(0); PG_MMA(0, 1, At, B1); PG_BAR;
            PG_LDA(At, 1, 1); PG_STAGE(PG_SA(1, 0), a3, o2[0]);
            PG_BAR; PG_WAIT_L(0); PG_MMA(1, 0, At, B0); PG_BAR; PG_SCHED;
            PG_STAGE(PG_SB(1, 1), b3 + bh1, voffB);
            PG_WAIT_V(6); PG_BAR; PG_MMA(1, 1, At, B1); PG_BAR;
        }
        E(acc, cur, wr, wc, fr, fq);
        if (!has_next) break;
#pragma unroll
        for (int a = 0; a < 2; ++a)
#pragma unroll
            for (int b = 0; b < 2; ++b)
#pragma unroll
                for (int m = 0; m < 4; ++m)
#pragma unroll
                    for (int n = 0; n < 2; ++n) acc[a][b][m][n] = (f32x4){0.f, 0.f, 0.f, 0.f};
        cur = nxt; cB = nB; ++ui;
#pragma unroll
        for (int h_ = 0; h_ < 2; ++h_)
#pragma unroll
            for (int i_ = 0; i_ < 2; ++i_) aoC[h_][i_] = aoN[h_][i_];
    }
    PG_WAIT_V(0);
    if (wr == 0) PG_BAR;
    PG_BAR;
#undef PG_SA
#undef PG_SB
#undef PG_STAGE
#undef PG_LDA
#undef PG_LDB
#undef PG_MMA
#undef PG_WAIT_V
#undef PG_WAIT_L
#undef PG_BAR
#undef PG_SCHED
#undef PG_AOFF
}
}

DI void conv_small_weights(const Params& p, unsigned char* lds) {
    const int n0 = 16 * 33, n1 = 16 * 8, n2 = 16 * 17, n3 = 16 * 8;
    auto dec = [=](int u) -> ConvJob {
        if (u < n0) return ConvJob{p.gdn_w_in, (u16*)(p.ws + WS_W_IN0), 1024, 4112, u & 15, u >> 4};
        if (u < n0 + n1) { const int v = u - n0; return ConvJob{p.gdn_w_out, (u16*)(p.ws + WS_W_OUT0), 1024, 1024, v & 15, v >> 4}; }
        if (u < n0 + n1 + n2) { const int v = u - n0 - n1; return ConvJob{p.dsa_w_in, (u16*)(p.ws + WS_W_IN1), 1024, 2120, v & 15, v >> 4}; }
        const int v = u - n0 - n1 - n2; return ConvJob{p.dsa_w_out, (u16*)(p.ws + WS_W_OUT1), 1024, 1024, v & 15, v >> 4};
    };
    convT_run(dec, n0 + n1 + n2 + n3, lds);
}
DI void conv_moe_weights(const Params& p, int layer, unsigned char* lds) {
    const int ngu = 32 * 64, ndn = 32 * 32;
    auto dec = [=](int u) -> ConvJob {
        if (u < ngu) { const int e = u >> 6, v = u & 63;
            return ConvJob{p.moe_w_gu + ((size_t)layer * 32 + e) * 1024 * 512, (u16*)(p.ws + WS_P0 + P0_WGU) + (size_t)e * 512 * 1024, 1024, 512, v & 15, v >> 4}; }
        const int w = u - ngu, e = w >> 5, v = w & 31;
        return ConvJob{p.moe_w_down + ((size_t)layer * 32 + e) * 256 * 1024, (u16*)(p.ws + WS_P0 + P0_WDN) + (size_t)e * 1024 * 256, 256, 1024, v & 3, v >> 2};
    };
    convT_run(dec, ngu + ndn, lds);
}
DI void phase_prep(const Params& p, unsigned char* lds) {
    conv_small_weights(p, lds);
    const int lane = tid_opaque() & 63, wid = tid_opaque() >> 6;
    float* H = (float*)(p.ws + WS_H);
    u16* HN = (u16*)(p.ws + WS_HN);
    for (int row = blockIdx.x * 8 + wid; row < TPA; row += gridDim.x * 8) {
        const int b = row / LP, pp = row - b * LP;
        const bool real = row < TP && pp >= 48;
        const float* src = real ? (pp < 64 ? p.meta + (size_t)(pp - 48) * DM : p.x + ((size_t)b * SEQ + (pp - 64)) * DM) : nullptr;
        f32x4 v[4];
        float ss = 0.f;
#pragma unroll
        for (int i = 0; i < 4; ++i) {
            v[i] = real ? *(const f32x4*)(src + 4 * lane + 256 * i) : (f32x4){0.f, 0.f, 0.f, 0.f};
            ss += v[i][0] * v[i][0] + v[i][1] * v[i][1] + v[i][2] * v[i][2] + v[i][3] * v[i][3];
        }
        ss = wave_sum(ss);
        const float rstd = rsqrtf(ss * (1.f / DM) + RMS_EPS);
#pragma unroll
        for (int i = 0; i < 4; ++i) {
            const int col = 4 * lane + 256 * i;
            *(f32x4*)(H + (size_t)row * DM + col) = v[i];
            const f32x4 gn = *(const f32x4*)(p.norm_mix + col);
            u32x2 w; w.x = pk2(v[i][0] * rstd * gn[0], v[i][1] * rstd * gn[1]); w.y = pk2(v[i][2] * rstd * gn[2], v[i][3] * rstd * gn[3]);
            *(u32x2*)(HN + (size_t)row * DM + col) = w;
        }
    }
}

DI int frame_row(int pm, int r) { return (pm >> 5) * LP + 64 + (pm & 31) * 256 + r; }
struct DenseSched {
    const char* A; const char* Bt; int K, npn, total, ldA;
    DI bool next(int i, pg::Unit& u) const { const int L = i * (int)gridDim.x + (int)blockIdx.x; if (L >= total) return false; u.pn = L % npn; u.pm = L / npn; u.e = 0; u.n = 256; return true; }
    DI int arow(const pg::Unit& u, int r) const { return frame_row(u.pm, r); }
    DI const char* abase() const { return A; }
    DI int lda() const { return ldA; }
    DI const char* bbase(const pg::Unit& u) const { return Bt + (size_t)u.pn * 256 * K * 2; }
    DI size_t bh1() const { return (size_t)128 * K * 2; }
};
struct EpiIn0 {
    static constexpr bool PERM = true;
    u16* P0; u16* HALO;
    DI void store(int row, int col, u32x4 w) const {
        *(u32x4*)(P0 + (size_t)row * 4096 + col) = w;
        if (col < 3072) { const int bb = row / LP, pp = row - bb * LP;
            if ((pp & 63) >= 61 && (pp >> 6) < 128) *(u32x4*)(HALO + ((size_t)(bb * 129 + (pp >> 6) + 1) * 3 + ((pp & 63) - 61)) * 3072 + col) = w; }
    }
    DI void operator()(const pg::Acc& acc, const pg::Unit& u, int wr, int wc, int fr, int fq) const {
#pragma unroll
        for (int ai = 0; ai < 2; ++ai)
#pragma unroll
            for (int m = 0; m < 4; ++m) {
                const int row = frame_row(u.pm, 128 * ai + 64 * wr + 16 * m + fr);
#pragma unroll
                for (int bj = 0; bj < 2; ++bj) {
                    const f32x4 v0 = acc[ai][bj][m][0], v1 = acc[ai][bj][m][1];
                    u32x4 w; w.x = pk2(v0[0], v0[1]); w.y = pk2(v0[2], v0[3]); w.z = pk2(v1[0], v1[1]); w.w = pk2(v1[2], v1[3]);
                    store(row, 256 * u.pn + 128 * bj + 32 * wc + 8 * fq, w);
                }
            }
    }
};
DI void phase_gemm_in0(const Params& p, unsigned char* lds) {
    const u16* W = (const u16*)(p.ws + WS_W_IN0);
    const u16* X = (const u16*)(p.ws + WS_HN);
    u16* P0 = (u16*)(p.ws + WS_P0);
    float* BA = (float*)(p.ws + WS_BA);
    u16* HALO = (u16*)(p.ws + WS_HALO);
    {
        DenseSched S{(const char*)X, (const char*)W, 1024, 16, 64 * 16, 1024};
        EpiIn0 E{P0, HALO};
        pg::gemm((LAS unsigned char*)lds, 1024, S, E);
    }
    __syncthreads();
    const int lane = tid_opaque() & 63, wid = tid_opaque() >> 6, c = lane & 15, g = lane >> 4, wm = wid >> 2, wn = wid & 3;
    for (int t = blockIdx.x; t < 64 + 130; t += gridDim.x) {
        const bool lead = t < 64;
        const int mt = lead ? (t & 31) : 32;
        const int row0 = lead ? (t >> 5) * LP : (t - 64) * 128;
        GemmAcc<2> acc;
        gemm_tile<2>(W, X, 16, LinRow{(u32)(mt * 128) * 1024u, 1024u}, LinRow{(u32)row0 * 1024u, 1024u}, acc, lds);
#pragma unroll
        for (int mi = 0; mi < 4; ++mi) {
            const int f = mt * 128 + wm * 64 + 16 * mi + 4 * g;
#pragma unroll
            for (int ni = 0; ni < 2; ++ni) {
                const int tok = row0 + wn * 32 + 16 * ni + c;
                const f32x4 v = acc.a[mi][ni];
                if (lead) { if (tok - row0 < 64) { u32x2 w; w.x = pk2(v[0], v[1]); w.y = pk2(v[2], v[3]); *(u32x2*)(P0 + (size_t)tok * 4096 + f) = w;
                        if (f < 3072 && tok - row0 >= 61) *(u32x2*)(HALO + ((size_t)((t >> 5) * 129 + 1) * 3 + (tok - row0 - 61)) * 3072 + f) = w; } }
                else if (f < 4112) *(f32x4*)(BA + (size_t)tok * 16 + (f - 4096)) = v;
            }
        }
    }
}
struct EpiOut {
    static constexpr bool PERM = false;
    float* H;
    DI void operator()(const pg::Acc& acc, const pg::Unit& u, int wr, int wc, int fr, int fq) const {
#pragma unroll
        for (int ai = 0; ai < 2; ++ai)
#pragma unroll
            for (int m = 0; m < 4; ++m) {
                float* hp = H + (size_t)frame_row(u.pm, 128 * ai + 64 * wr + 16 * m + fr) * DM + 256 * u.pn + 32 * wc + 4 * fq;
#pragma unroll
                for (int bj = 0; bj < 2; ++bj)
#pragma unroll
                    for (int n = 0; n < 2; ++n) { f32x4* q = (f32x4*)(hp + 128 * bj + 16 * n); *q = *q + acc[ai][bj][m][n]; }
            }
    }
};
DI void phase_gemm_out(const Params& p, const u16* W, const u16* X, const int ldx, unsigned char* lds) {
    float* H = (float*)(p.ws + WS_H);
    {
        DenseSched S{(const char*)X, (const char*)W, 1024, 4, 64 * 4, ldx};
        EpiOut E{H};
        pg::gemm((LAS unsigned char*)lds, 1024, S, E);
    }
    __syncthreads();
    const int lane = tid_opaque() & 63, wid = tid_opaque() >> 6, c = lane & 15, g = lane >> 4, wm = wid >> 2, wn = wid & 3;
    for (int t = (int)gridDim.x - 1 - (int)blockIdx.x; t < 16; t += gridDim.x) {
        const int mt = t & 7, row0 = (t >> 3) * LP;
        GemmAcc<2> acc;
        gemm_tile<2>(W, X, 16, LinRow{(u32)(mt * 128) * 1024u, 1024u}, LinRow{(u32)row0 * (u32)ldx, (u32)ldx}, acc, lds);
#pragma unroll
        for (int mi = 0; mi < 4; ++mi) {
            const int f = mt * 128 + wm * 64 + 16 * mi + 4 * g;
#pragma unroll
            for (int ni = 0; ni < 2; ++ni) {
                const int tok = row0 + wn * 32 + 16 * ni + c;
                if (tok - row0 < 64) { f32x4* hp = (f32x4*)(H + (size_t)tok * DM + f); *hp = *hp + acc.a[mi][ni]; }
            }
        }
    }
}
struct EpiIn1 {
    static constexpr bool PERM = true;
    u16* QRAW; float* KRAW; unsigned char* VN; _Float16* QI;
    DI void operator()(const pg::Acc& acc, const pg::Unit& u, int wr, int wc, int fr, int fq) const {
#pragma unroll
        for (int ai = 0; ai < 2; ++ai)
#pragma unroll
            for (int m = 0; m < 4; ++m) {
                const size_t row = (size_t)frame_row(u.pm, 128 * ai + 64 * wr + 16 * m + fr);
#pragma unroll
                for (int bj = 0; bj < 2; ++bj) {
                    const f32x4 v0 = acc[ai][bj][m][0], v1 = acc[ai][bj][m][1];
                    const int cl = 128 * bj + 32 * wc + 8 * fq;
                    if (u.pn < 4) { u32x4 w; w.x = pk2(v0[0], v0[1]); w.y = pk2(v0[2], v0[3]); w.z = pk2(v1[0], v1[1]); w.w = pk2(v1[2], v1[3]); *(u32x4*)(QRAW + row * 1024 + 256 * u.pn + cl) = w; }
                    else if (u.pn == 4) { *(f32x4*)(KRAW + row * 256 + cl) = v0; *(f32x4*)(KRAW + row * 256 + cl + 4) = v1; }
                    else if (u.pn == 5) { u32x2 w; w.x = pk4_fp8(v0[0], v0[1], v0[2], v0[3]); w.y = pk4_fp8(v1[0], v1[1], v1[2], v1[3]); *(u32x2*)(VN + row * 256 + cl) = w; }
                    else { f16x8 h8; h8[0] = (_Float16)v0[0]; h8[1] = (_Float16)v0[1]; h8[2] = (_Float16)v0[2]; h8[3] = (_Float16)v0[3]; h8[4] = (_Float16)v1[0]; h8[5] = (_Float16)v1[1]; h8[6] = (_Float16)v1[2]; h8[7] = (_Float16)v1[3];
                        *(f16x8*)(QI + row * 512 + 256 * (u.pn - 6) + cl) = h8; }
                }
            }
    }
};
DI void phase_gemm_in1(const Params& p, unsigned char* lds) {
    const u16* W = (const u16*)(p.ws + WS_W_IN1);
    const u16* X = (const u16*)(p.ws + WS_HN);
    u16* QRAW = (u16*)(p.ws + WS_P0 + P0_QRAW);
    float* KRAW = (float*)(p.ws + WS_P0 + P0_KRAW);
    unsigned char* VN = p.ws + WS_P0 + P0_VN;
    _Float16* QI = (_Float16*)(p.ws + WS_P0 + P0_QI);
    float* KIRAW = (float*)((unsigned char*)p.out + DO_KIRAW);
    float* WI = (float*)((unsigned char*)p.out + DO_WI);
    {
        DenseSched S{(const char*)X, (const char*)W, 1024, 8, 64 * 8, 1024};
        EpiIn1 E{QRAW, KRAW, VN, QI};
        pg::gemm((LAS unsigned char*)lds, 1024, S, E);
    }
    __syncthreads();
    const int lane = tid_opaque() & 63, wid = tid_opaque() >> 6, c = lane & 15, g = lane >> 4, wm = wid >> 2, wn = wid & 3;
    for (int t = blockIdx.x; t < 32 + 130; t += gridDim.x) {
        const bool lead = t < 32;
        const int mt = lead ? (t & 15) : 16;
        const int row0 = lead ? (t >> 4) * LP : (t - 32) * 128;
        GemmAcc<2> acc;
        gemm_tile<2>(W, X, 16, LinRow{(u32)(mt * 128) * 1024u, 1024u}, LinRow{(u32)row0 * 1024u, 1024u}, acc, lds);
#pragma unroll
        for (int mi = 0; mi < 4; ++mi) {
            const int f = mt * 128 + wm * 64 + 16 * mi + 4 * g;
#pragma unroll
            for (int ni = 0; ni < 2; ++ni) {
                const int tok = row0 + wn * 32 + 16 * ni + c;
                if (tok >= TP || (lead && tok - row0 >= 64)) continue;
                const f32x4 v = acc.a[mi][ni];
                if (f < 1024) { u32x2 w; w.x = pk2(v[0], v[1]); w.y = pk2(v[2], v[3]); *(u32x2*)(QRAW + (size_t)tok * 1024 + f) = w; }
                else if (f < 1280) *(f32x4*)(KRAW + (size_t)tok * 256 + (f - 1024)) = v;
                else if (f < 1536) *(u32*)(VN + (size_t)tok * 256 + (f - 1280)) = pk4_fp8(v[0], v[1], v[2], v[3]);
                else if (f < 2048) {
                    _Float16* q = QI + (size_t)tok * 512 + (f - 1536);
                    q[0] = (_Float16)v[0]; q[1] = (_Float16)v[1]; q[2] = (_Float16)v[2]; q[3] = (_Float16)v[3];
                }
                else if (f < 2112) *(f32x4*)(KIRAW + (size_t)tok * 64 + (f - 2048)) = v;
                else if (f < 2120) *(f32x4*)(WI + (size_t)tok * 8 + (f - 2112)) = v * 0.04419417382415922f;
            }
        }
    }
}

constexpr int G_KT = 0, G_QT = 17408, G_KRT = 34816, G_VRT = 53248, G_LF = 71680, G_TF = 88320, G_TMP = 104960, G_TTW = 109184, G_TTU = 118400,
              G_QKT = 127616, G_SC = 136832;
constexpr int G_WT = G_LF, G_UT = G_LF + 18432;
constexpr int G_ST = G_KRT;
static_assert(G_UT + 18432 <= G_TTW, "WT/UT alias");
DI void gdn_prep_unit(const Params& p, int bh, int ch, unsigned char* lds) {
    const int tid = tid_opaque(), lane = tid & 63, wid = tid >> 6, c = lane & 15, g = lane >> 4;
    const int b = bh >> 3, h = bh & 7;
    const size_t row0 = (size_t)b * LP + (size_t)ch * 64;
    u16* P0 = (u16*)(p.ws + WS_P0);
    const u16* HALO = (const u16*)(p.ws + WS_HALO);
    float* SC = (float*)(lds + G_SC);
    float bb = 0.f, aa = 0.f;
    if (wid == 7) { const float* BA = (const float*)(p.ws + WS_BA); bb = BA[(row0 + lane) * 16 + h]; aa = BA[(row0 + lane) * 16 + 8 + h]; }
    {
        const int cp = tid & 63, part = tid >> 6;
        u32 raw[3][11];
#pragma unroll
        for (int X = 0; X < 3; ++X) {
            const int col = X * 1024 + h * 128 + 2 * cp;
#pragma unroll
            for (int i = 0; i < 11; ++i) {
                const int rr = 8 * part - 3 + i;
                raw[X][i] = rr < 0 ? (ch == 0 ? 0u : *(const u32*)(HALO + ((size_t)(b * 129 + ch) * 3 + (rr + 3)) * 3072 + col)) : *(const u32*)(P0 + (row0 + rr) * 4096 + col);
            }
        }
        if (wid == 7) {
            const float beta = 1.f / (1.f + __expf(-bb));
            const float xs = aa + p.gdn_dt_bias[h];
            const float sp = xs > 20.f ? xs : log1pf(__expf(xs));
            const float gg = -__expf(p.gdn_a_log[h]) * sp;
            float gc = gg;
#pragma unroll
            for (int o = 1; o < 64; o <<= 1) { const float t = __shfl_up(gc, o); if (lane >= o) gc += t; }
            const float glast = __shfl(gc, 63);
            SC[lane] = gc; SC[64 + lane] = beta; SC[128 + lane] = __expf(gc); SC[192 + lane] = __expf(glast - gc);
            if (lane == 0) SC[384] = __expf(glast);
        }
#pragma unroll
        for (int X = 0; X < 3; ++X) {
            u32 o[8];
            f32x2 wv[4];
#pragma unroll
            for (int j = 0; j < 4; ++j) wv[j] = *(const f32x2*)(p.gdn_conv + j * 3072 + X * 1024 + h * 128 + 2 * cp);
#pragma unroll
            for (int i = 0; i < 8; ++i) {
                const float a0 = wv[0][0] * bflo(raw[X][i]) + wv[1][0] * bflo(raw[X][i + 1]) + wv[2][0] * bflo(raw[X][i + 2]) + wv[3][0] * bflo(raw[X][i + 3]);
                const float a1 = wv[0][1] * bfhi(raw[X][i]) + wv[1][1] * bfhi(raw[X][i + 1]) + wv[2][1] * bfhi(raw[X][i + 2]) + wv[3][1] * bfhi(raw[X][i + 3]);
                o[i] = pk2(silu(a0), silu(a1));
            }
            if (X < 2) {
                u16* T = (u16*)(lds + (X == 0 ? G_QT : G_KT));
#pragma unroll
                for (int i = 0; i < 8; ++i) *(u32*)(T + (8 * part + i) * 136 + 2 * cp) = o[i];
            }
            if (X >= 1) {
                u16* T = (u16*)(lds + (X == 1 ? G_KRT : G_VRT));
                u32x4 lo, hi;
                lo.x = (o[0] & 0xffffu) | (o[1] << 16); lo.y = (o[2] & 0xffffu) | (o[3] << 16); lo.z = (o[4] & 0xffffu) | (o[5] << 16); lo.w = (o[6] & 0xffffu) | (o[7] << 16);
                hi.x = (o[0] >> 16) | (o[1] & 0xffff0000u); hi.y = (o[2] >> 16) | (o[3] & 0xffff0000u); hi.z = (o[4] >> 16) | (o[5] & 0xffff0000u); hi.w = (o[6] >> 16) | (o[7] & 0xffff0000u);
                *(u32x4*)(T + (2 * cp) * 72 + 8 * part) = lo; *(u32x4*)(T + (2 * cp + 1) * 72 + 8 * part) = hi;
            }
        }
    }
    { float* TF = (float*)(lds + G_TF); for (int i = tid; i < 64 * 65; i += NTHREADS) TF[i] = 0.f; }
    __syncthreads();
    {
        const int rt = wid & 3;
        const unsigned char* Arow = lds + (wid < 4 ? G_KT : G_QT);
        f32x4 acc[4], qq = (f32x4){0.f, 0.f, 0.f, 0.f};
#pragma unroll
        for (int ni = 0; ni < 4; ++ni) acc[ni] = (f32x4){0.f, 0.f, 0.f, 0.f};
#pragma unroll
        for (int ks = 0; ks < 4; ++ks) {
            const bf16x8 a = ldsfrag(Arow, 16 * rt + c, 272, 32 * ks + 8 * g);
#pragma unroll
            for (int ni = 0; ni < 4; ++ni) acc[ni] = mfma16(a, ldsfrag(lds + G_KT, 16 * ni + c, 272, 32 * ks + 8 * g), acc[ni]);
            if (wid >= 4) qq = mfma16(a, a, qq);
        }
        {
            const f32x4 kd_ = rt == 0 ? acc[0] : (rt == 1 ? acc[1] : (rt == 2 ? acc[2] : acc[3]));
            const f32x4 d = (wid < 4) ? kd_ : qq;
            if (g == (c >> 2)) {
                const int r = c & 3;
                const float dv = r == 0 ? d[0] : (r == 1 ? d[1] : (r == 2 ? d[2] : d[3]));
                SC[(wid < 4 ? 256 : 320) + 16 * rt + c] = rsqrtf(dv + 1e-6f);
            }
        }
        __syncthreads();
        float* LF = (float*)(lds + G_LF);
        u16* QKT = (u16*)(lds + G_QKT);
#pragma unroll
        for (int ni = 0; ni < 4; ++ni) {
            const int j = 16 * ni + c;
            const float gcj = SC[j], rkj = SC[256 + j];
#pragma unroll
            for (int r = 0; r < 4; ++r) {
                const int i = 16 * rt + 4 * g + r;
                const float gci = SC[i];
                if (wid < 4) {
                    const float v = (i > j) ? SC[64 + i] * SC[256 + i] * rkj * acc[ni][r] * __expf(gci - gcj) : 0.f;
                    LF[i * 65 + j] = v;
                } else {
                    const float v = (i >= j) ? SC[320 + i] * 0.08838834764831845f * rkj * acc[ni][r] * __expf(gci - gcj) : 0.f;
                    QKT[i * 72 + j] = f2bf(v);
                }
            }
        }
    }
    __syncthreads();
    {
        const float* LF = (const float*)(lds + G_LF);
        float* TF = (float*)(lds + G_TF);
        float* TMP = (float*)(lds + G_TMP);
        if (wid == 0) {
            const int b4 = lane >> 4, j = lane & 15;
            float t[16];
#pragma unroll
            for (int i = 0; i < 16; ++i) {
                float s = (i == j) ? 1.f : 0.f;
#pragma unroll
                for (int m = 0; m < i; ++m) s -= LF[(16 * b4 + i) * 65 + 16 * b4 + m] * t[m];
                t[i] = s;
            }
#pragma unroll
            for (int i = 0; i < 16; ++i) TF[(16 * b4 + i) * 65 + 16 * b4 + j] = t[i];
        }
        __syncthreads();
        {
            const int pp = tid >> 8, i = (tid >> 4) & 15, j = tid & 15;
            float s = 0.f;
#pragma unroll
            for (int m = 0; m < 16; ++m) s += LF[(16 * (2 * pp + 1) + i) * 65 + 32 * pp + m] * TF[(32 * pp + m) * 65 + 32 * pp + j];
            TMP[pp * 256 + i * 16 + j] = s;
            __syncthreads();
            float x = 0.f;
#pragma unroll
            for (int m = 0; m < 16; ++m) x -= TF[(16 * (2 * pp + 1) + i) * 65 + 16 * (2 * pp + 1) + m] * TMP[pp * 256 + m * 16 + j];
            TF[(16 * (2 * pp + 1) + i) * 65 + 32 * pp + j] = x;
        }
        __syncthreads();
        {
            const int i = tid >> 4, j0 = tid & 15;
            float s0 = 0.f, s1 = 0.f;
#pragma unroll
            for (int m = 0; m < 32; ++m) { const float l = LF[(32 + i) * 65 + m]; s0 += l * TF[m * 65 + j0]; s1 += l * TF[m * 65 + j0 + 16]; }
            __syncthreads();
            TMP[i * 33 + j0] = s0; TMP[i * 33 + j0 + 16] = s1;
            __syncthreads();
            float x0 = 0.f, x1 = 0.f;
#pragma unroll
            for (int m = 0; m < 32; ++m) { const float tt = TF[(32 + i) * 65 + 32 + m]; x0 -= tt * TMP[m * 33 + j0]; x1 -= tt * TMP[m * 33 + j0 + 16]; }
            TF[(32 + i) * 65 + j0] = x0; TF[(32 + i) * 65 + j0 + 16] = x1;
        }
        __syncthreads();
        u16* TTW = (u16*)(lds + G_TTW);
        u16* TTU = (u16*)(lds + G_TTU);
#pragma unroll
        for (int i = 0; i < 8; ++i) {
            const int e = tid + NTHREADS * i, t = e >> 6, s = e & 63;
            const float tv = (s <= t) ? TF[t * 65 + s] : 0.f;
            const float bs = SC[64 + s];
            TTW[t * 72 + s] = f2bf(tv * bs * SC[256 + s] * SC[128 + s]);
            TTU[t * 72 + s] = f2bf(tv * bs);
        }
    }
    __syncthreads();
    {
        const int tt = wid & 3, isu = wid >> 2;
        f32x4 acc[8];
#pragma unroll
        for (int ni = 0; ni < 8; ++ni) acc[ni] = (f32x4){0.f, 0.f, 0.f, 0.f};
        const unsigned char* A = lds + (isu ? G_TTU : G_TTW);
        const unsigned char* Bt = lds + (isu ? G_VRT : G_KRT);
#pragma unroll
        for (int ks = 0; ks < 2; ++ks) {
            const bf16x8 a = ldsfrag(A, 16 * tt + c, 144, 32 * ks + 8 * g);
#pragma unroll
            for (int ni = 0; ni < 8; ++ni) acc[ni] = mfma16(a, ldsfrag(Bt, 16 * ni + c, 144, 32 * ks + 8 * g), acc[ni]);
        }
        __syncthreads();
        u16* WU = (u16*)(lds + (isu ? G_UT : G_WT));
        const int t0 = 16 * tt + 4 * g;
#pragma unroll
        for (int ni = 0; ni < 8; ++ni) {
            u32x2 w; w.x = pk2(acc[ni][0], acc[ni][1]); w.y = pk2(acc[ni][2], acc[ni][3]);
            *(u32x2*)(WU + (16 * ni + c) * 72 + t0) = w;
        }
    }
    __syncthreads();
    {
        f32x4 acc[4];
#pragma unroll
        for (int ni = 0; ni < 4; ++ni) acc[ni] = (f32x4){0.f, 0.f, 0.f, 0.f};
#pragma unroll
        for (int ks = 0; ks < 2; ++ks) {
            const bf16x8 a = ldsfrag(lds + G_WT, 16 * wid + c, 144, 32 * ks + 8 * g);
#pragma unroll
            for (int ni = 0; ni < 4; ++ni) acc[ni] = mfma16(a, ldsfrag(lds + G_QKT, 16 * ni + c, 144, 32 * ks + 8 * g), acc[ni]);
        }
        u16* QT = (u16*)(lds + G_QT);
#pragma unroll
        for (int ni = 0; ni < 4; ++ni) {
            const int t = 16 * ni + c, j0 = 16 * wid + 4 * g;
            const float qs = SC[320 + t] * 0.08838834764831845f * SC[128 + t];
            u32x2* qp = (u32x2*)(QT + t * 136 + j0);
            const u32x2 q = *qp;
            u32x2 w;
            w.x = pk2(bflo(q.x) * qs - acc[ni][0], bfhi(q.x) * qs - acc[ni][1]);
            w.y = pk2(bflo(q.y) * qs - acc[ni][2], bfhi(q.y) * qs - acc[ni][3]);
            *qp = w;
        }
    }
    {
        const int tt = wid & 3, dvh = wid >> 2;
        f32x4 acc[4];
#pragma unroll
        for (int ni = 0; ni < 4; ++ni) acc[ni] = (f32x4){0.f, 0.f, 0.f, 0.f};
#pragma unroll
        for (int ks = 0; ks < 2; ++ks) {
            const bf16x8 a = ldsfrag(lds + G_QKT, 16 * tt + c, 144, 32 * ks + 8 * g);
#pragma unroll
            for (int ni = 0; ni < 4; ++ni) acc[ni] = mfma16(a, ldsfrag(lds + G_UT, 16 * (4 * dvh + ni) + c, 144, 32 * ks + 8 * g), acc[ni]);
        }
        u16* KT = (u16*)(lds + G_KT);
#pragma unroll
        for (int ni = 0; ni < 4; ++ni)
#pragma unroll
            for (int r = 0; r < 4; ++r) KT[(16 * tt + 4 * g + r) * 136 + 16 * (4 * dvh + ni) + c] = f2bf(acc[ni][r]);
    }
    __syncthreads();
    {
#pragma unroll
        for (int i = 0; i < 2; ++i) {
            const int id = tid + NTHREADS * i, t = id >> 4, ck = id & 15;
            *(u32x4*)(P0 + (row0 + t) * 4096 + h * 128 + 8 * ck) = *(const u32x4*)(lds + G_QT + t * 272 + ck * 16);
            *(u32x4*)(P0 + (row0 + t) * 4096 + 1024 + h * 128 + 8 * ck) = *(const u32x4*)(lds + G_KT + t * 272 + ck * 16);
        }
        const int dim = tid >> 2, s0 = (tid & 3) * 16;
        float sc[16];
#pragma unroll
        for (int i = 0; i < 16; ++i) sc[i] = SC[256 + s0 + i] * SC[192 + s0 + i];
#pragma unroll
        for (int X = 0; X < 2; ++X) {
            u32x4* tp = (u32x4*)(lds + (X ? G_UT : G_WT) + dim * 144 + s0 * 2);
#pragma unroll
            for (int hf = 0; hf < 2; ++hf) {
                u32x4 w = tp[hf];
                w.x = pk2(bflo(w.x) * sc[8 * hf + 0], bfhi(w.x) * sc[8 * hf + 1]); w.y = pk2(bflo(w.y) * sc[8 * hf + 2], bfhi(w.y) * sc[8 * hf + 3]);
                w.z = pk2(bflo(w.z) * sc[8 * hf + 4], bfhi(w.z) * sc[8 * hf + 5]); w.w = pk2(bflo(w.w) * sc[8 * hf + 6], bfhi(w.w) * sc[8 * hf + 7]);
                tp[hf] = w;
            }
        }
    }
    LDS_BARRIER();
    {
        {
            f32x4 acc[8];
#pragma unroll
            for (int ni = 0; ni < 8; ++ni) acc[ni] = (f32x4){0.f, 0.f, 0.f, 0.f};
#pragma unroll
            for (int ks = 0; ks < 2; ++ks) {
                const bf16x8 a = ldsfrag(lds + G_WT, 16 * wid + c, 144, 32 * ks + 8 * g);
#pragma unroll
                for (int ni = 0; ni < 8; ++ni) acc[ni] = mfma16(a, ldsfrag(lds + G_KRT, 16 * ni + c, 144, 32 * ks + 8 * g), acc[ni]);
            }
            if (ch > 0) {
                u16* Mg = (u16*)((unsigned char*)p.out + DO_M) + ((size_t)bh * 128 + (ch - 1)) * 16384;
                const float cd = SC[384];
                const int gp = ((g & 1) << 1) | (g >> 1);
#pragma unroll
                for (int ni = 0; ni < 8; ++ni) {
                    const int i = 16 * ni + c, j0 = 16 * wid + 4 * g;
                    float v[4];
#pragma unroll
                    for (int r = 0; r < 4; ++r) v[r] = ((i == j0 + r) ? cd : 0.f) - acc[ni][r];
                    u32x2 w; w.x = pk2(v[0], v[1]); w.y = pk2(v[2], v[3]);
                    *(u32x2*)(Mg + (size_t)i * 128 + 16 * wid + 4 * gp) = w;
                }
            }
        }
        {
            f32x4 acc[8];
#pragma unroll
            for (int ni = 0; ni < 8; ++ni) acc[ni] = (f32x4){0.f, 0.f, 0.f, 0.f};
#pragma unroll
            for (int ks = 0; ks < 2; ++ks) {
                const bf16x8 a = ldsfrag(lds + G_KRT, 16 * wid + c, 144, 32 * ks + 8 * g);
#pragma unroll
                for (int ni = 0; ni < 8; ++ni) acc[ni] = mfma16(a, ldsfrag(lds + G_UT, 16 * ni + c, 144, 32 * ks + 8 * g), acc[ni]);
            }
            u16* NT = (u16*)(p.ws + WS_NS) + ((size_t)bh * NCH + ch) * 16384;
#pragma unroll
            for (int ni = 0; ni < 8; ++ni) {
                u32x2 w; w.x = pk2(acc[ni][0], acc[ni][1]); w.y = pk2(acc[ni][2], acc[ni][3]);
                *(u32x2*)(NT + ((size_t)(4 * wid + g) * 128 + 16 * ni + c) * 4) = w;
            }
        }
    }
    LDS_BARRIER();
}
constexpr int GO_QE = 0, GO_O0 = 17408, GO_ST = 34816, GO_SC = 69632;
DI void gdn_out_unit(const Params& p, int bh, int ch, unsigned char* lds) {
    const int tid = tid_opaque(), lane = tid & 63, wid = tid >> 6, c = lane & 15, g = lane >> 4;
    const int b = bh >> 3, h = bh & 7;
    const size_t row0 = (size_t)b * LP + (size_t)ch * 64;
    const u16* P0 = (const u16*)(p.ws + WS_P0);
    float* SC = (float*)(lds + GO_SC);
#pragma unroll
    for (int i = 0; i < 2; ++i) {
        const int id = tid + NTHREADS * i, t = id >> 4, ck = id & 15;
        *(u32x4*)(lds + GO_QE + t * 272 + ck * 16) = *(const u32x4*)(P0 + (row0 + t) * 4096 + h * 128 + 8 * ck);
        *(u32x4*)(lds + GO_O0 + t * 272 + ck * 16) = *(const u32x4*)(P0 + (row0 + t) * 4096 + 1024 + h * 128 + 8 * ck);
    }
    if (ch > 0) {
        const u16* ST = (const u16*)(p.ws + WS_NS) + ((size_t)bh * NCH + (ch - 1)) * 16384;
#pragma unroll
        for (int i = 0; i < 4; ++i) { const int id = tid + NTHREADS * i, i4 = id >> 6, dvp = id & 63;
            const u32x4 w = *(const u32x4*)(ST + (size_t)id * 8);
            *(u32x2*)(lds + GO_ST + (2 * dvp) * 272 + i4 * 8) = (u32x2){w.x, w.y};
            *(u32x2*)(lds + GO_ST + (2 * dvp + 1) * 272 + i4 * 8) = (u32x2){w.z, w.w}; }
    }
    const int tt = wid & 3, dvh = wid >> 2;
    u16 zr[4][4]; float gn[4];
#pragma unroll
    for (int ni = 0; ni < 4; ++ni) {
        const int dv = 16 * (4 * dvh + ni) + c;
        gn[ni] = p.gdn_o_norm[dv];
#pragma unroll
        for (int r = 0; r < 4; ++r) zr[ni][r] = P0[(row0 + 16 * tt + 4 * g + r) * 4096 + 3072 + h * 128 + dv];
    }
    __syncthreads();
    f32x4 acc[4];
    const u16* O0 = (const u16*)(lds + GO_O0);
#pragma unroll
    for (int ni = 0; ni < 4; ++ni)
#pragma unroll
        for (int r = 0; r < 4; ++r) acc[ni][r] = bf2f(O0[(16 * tt + 4 * g + r) * 136 + 16 * (4 * dvh + ni) + c]);
    if (ch > 0) {
#pragma unroll
        for (int ks = 0; ks < 4; ++ks) {
            const bf16x8 a = ldsfrag(lds + GO_QE, 16 * tt + c, 272, 32 * ks + 8 * g);
#pragma unroll
            for (int ni = 0; ni < 4; ++ni) acc[ni] = mfma16(a, ldsfrag(lds + GO_ST, 16 * (4 * dvh + ni) + c, 272, 32 * ks + 8 * g), acc[ni]);
        }
    }
    float ss[4];
#pragma unroll
    for (int r = 0; r < 4; ++r) {
        float s = 0.f;
#pragma unroll
        for (int ni = 0; ni < 4; ++ni) s += acc[ni][r] * acc[ni][r];
        s += __shfl_xor(s, 1); s += __shfl_xor(s, 2); s += __shfl_xor(s, 4); s += __shfl_xor(s, 8);
        ss[r] = s;
    }
    if (c == 0) {
#pragma unroll
        for (int r = 0; r < 4; ++r) SC[dvh * 64 + 16 * tt + 4 * g + r] = ss[r];
    }
    __syncthreads();
    u16* OG = (u16*)(p.ws + WS_P0) + 2048;
#pragma unroll
    for (int r = 0; r < 4; ++r) {
        const int t = 16 * tt + 4 * g + r;
        const float rstd = rsqrtf((SC[t] + SC[64 + t]) * (1.f / 128.f) + RMS_EPS);
#pragma unroll
        for (int ni = 0; ni < 4; ++ni) {
            const int dv = 16 * (4 * dvh + ni) + c;
            const float z = bf2f(zr[ni][r]);
            OG[(row0 + t) * 4096 + h * 128 + dv] = f2bf(acc[ni][r] * rstd * gn[ni] * silu(z));
        }
    }
    LDS_BARRIER();
}
DI void phase_gdn_prep(const Params& p, unsigned char* lds) {
    for (int u = blockIdx.x; u < 16 * 128; u += gridDim.x) gdn_prep_unit(p, u >> 7, u & 127, lds);
}
DI void phase_gdn_out(const Params& p, unsigned char* lds) {
    for (int u = blockIdx.x; u < 16 * NCH; u += gridDim.x) gdn_out_unit(p, u / NCH, u % NCH, lds);
}

DI void scan_loadM(u32x4 (&r)[8], const u16* Mg, int j, int t4) {
    if (j <= 127) {
        const u16* src = Mg + (size_t)(j - 1) * 16384;
#pragma unroll
        for (int i = 0; i < 8; ++i) { const int id = t4 + 256 * i; r[i] = *(const u32x4*)(src + (size_t)(id >> 4) * 128 + (id & 15) * 8); }
    }
}
DI void scan_storeM(const u32x4 (&r)[8], unsigned char* slot, int t4) {
#pragma unroll
    for (int i = 0; i < 8; ++i) { const int id = t4 + 256 * i; *(u32x4*)(slot + (id >> 4) * 272 + (id & 15) * 16) = r[i]; }
}
DI void scan_loadNq(u32x4 (&r)[8], const u16* NSb, int j, int lane) {
    if (j <= 127) {
        const u16* s0 = NSb + (size_t)j * 16384;
#pragma unroll
        for (int k = 0; k < 8; ++k) { const int id = lane + 64 * k; r[k] = *(const u32x4*)(s0 + (id >> 4) * 512 + (id & 15) * 8); }
    }
}
#define SCAN_BAR() do { asm volatile("s_waitcnt lgkmcnt(0)" ::: "memory"); __builtin_amdgcn_s_barrier(); asm volatile("" ::: "memory"); } while (0)
DI void scan_loadM2(u32x4 (&r)[16], const u16* Mg, int j, int t2) {
    if (j <= 127) {
        const u16* src = Mg + (size_t)(j - 1) * 16384;
#pragma unroll
        for (int i = 0; i < 16; ++i) { const int id = t2 + 128 * i; r[i] = *(const u32x4*)(src + (size_t)(id >> 4) * 128 + (id & 15) * 8); }
    }
}
DI void scan_storeM2(const u32x4 (&r)[16], unsigned char* slot, int t2) {
#pragma unroll
    for (int i = 0; i < 16; ++i) { const int id = t2 + 128 * i; *(u32x4*)(slot + (id >> 4) * 272 + (id & 15) * 16) = r[i]; }
}
DI void phase_gdn_scan(const Params& p, unsigned char* lds, const int C0, const int C1) {
    int bh = blockIdx.x & 15, dvq = blockIdx.x >> 4;
    asm volatile("" : "+s"(bh), "+s"(dvq));
    const int tid = tid_opaque(), lane = tid & 63, wid = __builtin_amdgcn_readfirstlane(tid >> 6), col = lane & 31, hh = lane >> 5;
    const u16* Mg = (const u16*)((unsigned char*)p.out + DO_M) + (size_t)bh * 128 * 16384;
    u16* NSb = (u16*)(p.ws + WS_NS) + (size_t)bh * NCH * 16384 + (size_t)(32 * dvq) * 4;
    unsigned char* slot0 = lds, *slot1 = lds + 34816;
    unsigned char* nb0 = lds + 69632, *nb1 = nb0 + 8192, *sb0 = nb1 + 8192, *sb1 = sb0 + 8192, *fb0 = sb1 + 8192, *fb1 = fb0 + 8192;
    if (wid >= 6) {
        const int t2 = tid - 384;
        u32x4 r0[16], r1[16], r2[16];
        scan_loadM2(r0, Mg, C0, t2); scan_storeM2(r0, (C0 & 1) ? slot1 : slot0, t2); scan_loadM2(r0, Mg, C0 + 1, t2); scan_loadM2(r1, Mg, C0 + 2, t2); scan_loadM2(r2, Mg, C0 + 3, t2);
        SCAN_BAR();
#define SCAN_LD(cc, R) do { if ((cc) <= C1) { if ((cc) + 1 <= C1) scan_storeM2(R, ((cc) + 1) & 1 ? slot1 : slot0, t2); scan_loadM2(R, Mg, (cc) + 4, t2); SCAN_BAR(); } } while (0)
#pragma unroll 1
        for (int c0 = C0; c0 <= C1; c0 += 3) { SCAN_LD(c0, r0); SCAN_LD(c0 + 1, r1); SCAN_LD(c0 + 2, r2); }
#undef SCAN_LD
    } else if (wid == 4) {
        u32x4 r0[8], r1[8], r2[8];
#define SCAN_STN(R, buf) do { _Pragma("unroll") for (int k = 0; k < 8; ++k) *(u32x4*)((buf) + (lane + 64 * k) * 16) = R[k]; } while (0)
        scan_loadNq(r0, NSb, C0, lane); SCAN_STN(r0, (C0 & 1) ? nb1 : nb0); scan_loadNq(r0, NSb, C0 + 1, lane); scan_loadNq(r1, NSb, C0 + 2, lane); scan_loadNq(r2, NSb, C0 + 3, lane);
        SCAN_BAR();
#define SCAN_LN(cc, R) do { if ((cc) <= C1) { if ((cc) + 1 <= C1) SCAN_STN(R, ((cc) + 1) & 1 ? nb1 : nb0); scan_loadNq(R, NSb, (cc) + 4, lane); SCAN_BAR(); } } while (0)
#pragma unroll 1
        for (int c0 = C0; c0 <= C1; c0 += 3) { SCAN_LN(c0, r0); SCAN_LN(c0 + 1, r1); SCAN_LN(c0 + 2, r2); }
#undef SCAN_LN
#undef SCAN_STN
    } else if (wid == 5) {
        SCAN_BAR();
#pragma unroll 1
        for (int cc = C0; cc <= C1 + 1; ++cc) {
            if (cc >= C0 + 1) {
                const unsigned char* sb = ((cc - 1) & 1) ? sb1 : sb0;
                u16* dst = NSb + (size_t)(cc - 1) * 16384;
#pragma unroll
                for (int k = 0; k < 8; ++k) { const int id = lane + 64 * k; *(u32x4*)(dst + (id >> 4) * 512 + (id & 15) * 8) = *(const u32x4*)(sb + id * 16); }
            }
            if (cc <= C1) SCAN_BAR();
        }
    } else {
        const int ob = wid;
        f32x16 acc;
#pragma unroll
        for (int q = 0; q < 4; ++q) {
            const u32x2 w = *(const u32x2*)(NSb + (size_t)(C0 - 1) * 16384 + ((8 * ob + 2 * q + hh) * 128 + col) * 4);
            acc[4 * q + 0] = bflo(w.x); acc[4 * q + 1] = bfhi(w.x); acc[4 * q + 2] = bflo(w.y); acc[4 * q + 3] = bfhi(w.y);
        }
#define SCAN_PUBF(buf) do { _Pragma("unroll") for (int s_ = 0; s_ < 2; ++s_) { bf16x8 f_; _Pragma("unroll") for (int j = 0; j < 8; ++j) f_[j] = (short)f2bf(acc[8 * s_ + j]); \
            *(bf16x8*)((buf) + ((2 * ob + s_) * 64 + lane) * 16) = f_; } } while (0)
        SCAN_PUBF((C0 & 1) ? fb1 : fb0);
        SCAN_BAR();
        const int apo = (32 * ob + col) * 272 + hh * 16;
#pragma unroll 1
        for (int cc = C0; cc <= C1; ++cc) {
            const unsigned char* cur = (cc & 1) ? slot1 : slot0;
            const unsigned char* nbuf = (cc & 1) ? nb1 : nb0;
            unsigned char* sbuf = (cc & 1) ? sb1 : sb0;
            const unsigned char* fin = (cc & 1) ? fb1 : fb0;
            unsigned char* fout = (cc & 1) ? fb0 : fb1;
            bf16x8 fa[8], fbq[8];
#pragma unroll
            for (int ks = 0; ks < 8; ++ks) { fbq[ks] = *(const bf16x8*)(fin + (ks * 64 + lane) * 16); fa[ks] = *(const bf16x8*)(cur + apo + ks * 32); }
            f32x16 nw;
#pragma unroll
            for (int q = 0; q < 4; ++q) {
                const u32x2 w = *(const u32x2*)(nbuf + ((8 * ob + 2 * q + hh) * 32 + col) * 8);
                nw[4 * q + 0] = bflo(w.x); nw[4 * q + 1] = bfhi(w.x); nw[4 * q + 2] = bflo(w.y); nw[4 * q + 3] = bfhi(w.y);
            }
#pragma unroll
            for (int ks = 0; ks < 8; ++ks) nw = __builtin_amdgcn_mfma_f32_32x32x16_bf16(fa[ks], fbq[ks], nw, 0, 0, 0);
            acc = nw;
#pragma unroll
            for (int q = 0; q < 4; ++q) {
                u32x2 w; w.x = pk2(acc[4 * q], acc[4 * q + 1]); w.y = pk2(acc[4 * q + 2], acc[4 * q + 3]);
                *(u32x2*)(sbuf + ((8 * ob + 2 * q + hh) * 32 + col) * 8) = w;
            }
            SCAN_PUBF(fout);
            SCAN_BAR();
        }
#undef SCAN_PUBF
    }
}
#undef SCAN_BAR

template <bool ADDY, bool ROUTE>
DI void phase_norm(const Params& p, const float* gain, int layer, unsigned char* lds) {
    const int tid = tid_opaque(), lane = tid & 63, wid = tid >> 6;
    float* H = (float*)(p.ws + WS_H);
    u16* HN = (u16*)(p.ws + WS_HN);
    const u16* Y = (const u16*)(p.ws + WS_P0 + P0_Y);
    float* xs = (float*)lds;
    float* part = (float*)(lds + 32768);
    float* logit = (float*)(lds + 32768 + 9216);
    int* asg = (int*)(lds + 32768 + 9216 + 1152);
    int iter = 0;
    const float* wg = p.moe_w_group + (size_t)layer * 1024 * 4;
    const float* we = p.moe_w_expert + (size_t)layer * 1024 * 32;
    float wr[128];
    if (ROUTE) {
        const float* wp = lane < 4 ? wg + lane : we + ((lane < 36 ? lane : 35) - 4);
        const int wst = lane < 4 ? 4 : 32;
#pragma unroll
        for (int k = 0; k < 128; ++k) wr[k] = wp[(size_t)(128 * wid + k) * wst];
    }
    f32x4 vn[4]; u32x2 yn0[4], yn1[4];
#define NORM_FETCH(rw) do { _Pragma("unroll") for (int i = 0; i < 4; ++i) { const int col = 4 * lane + 256 * i; vn[i] = *(const f32x4*)(H + (size_t)(rw) * DM + col); \
        if (ADDY) { yn0[i] = *(const u32x2*)(Y + (size_t)(2 * (rw)) * DM + col); yn1[i] = *(const u32x2*)(Y + (size_t)(2 * (rw) + 1) * DM + col); } } } while (0)
    if ((int)blockIdx.x * 8 < TP) NORM_FETCH(blockIdx.x * 8 + wid);
    for (int base = blockIdx.x * 8; base < TP; base += gridDim.x * 8) {
        const int row = base + wid;
        {
            f32x4 v[4];
            u32x2 yc0[4], yc1[4];
#pragma unroll
            for (int i = 0; i < 4; ++i) { v[i] = vn[i]; if (ADDY) { yc0[i] = yn0[i]; yc1[i] = yn1[i]; } }
            if (base + (int)gridDim.x * 8 < TP) NORM_FETCH(row + gridDim.x * 8);
            float ss = 0.f;
#pragma unroll
            for (int i = 0; i < 4; ++i) {
                const int col = 4 * lane + 256 * i;
                if (ADDY) {
                    const u32x2 y0 = yc0[i], y1 = yc1[i];
                    const int pp = row % LP;
                    if (pp >= 48) {
                        v[i][0] += bflo(y0.x) + bflo(y1.x); v[i][1] += bfhi(y0.x) + bfhi(y1.x); v[i][2] += bflo(y0.y) + bflo(y1.y); v[i][3] += bfhi(y0.y) + bfhi(y1.y);
                        *(f32x4*)(H + (size_t)row * DM + col) = v[i];
                    }
                }
                ss += v[i][0] * v[i][0] + v[i][1] * v[i][1] + v[i][2] * v[i][2] + v[i][3] * v[i][3];
            }
            ss = wave_sum(ss);
            const float rstd = rsqrtf(ss * (1.f / DM) + RMS_EPS);
#pragma unroll
            for (int i = 0; i < 4; ++i) {
                const int col = 4 * lane + 256 * i;
                const f32x4 gn = *(const f32x4*)(gain + col);
                const f32x4 o = (f32x4){v[i][0] * rstd * gn[0], v[i][1] * rstd * gn[1], v[i][2] * rstd * gn[2], v[i][3] * rstd * gn[3]};
                u32x2 w; w.x = pk2(o[0], o[1]); w.y = pk2(o[2], o[3]);
                *(u32x2*)(HN + (size_t)row * DM + col) = w;
                if (ROUTE) *(f32x4*)(xs + wid * 1024 + col) = o;
            }
        }
        if (ROUTE) {
            __syncthreads();
            {
                float a8[8];
#pragma unroll
                for (int r = 0; r < 8; ++r) a8[r] = 0.f;
                if (lane < 36) {
#pragma unroll
                    for (int k4 = 0; k4 < 32; ++k4) {
#pragma unroll
                        for (int r = 0; r < 8; ++r) {
                            const f32x4 x4 = *(const f32x4*)(xs + r * 1024 + 128 * wid + 4 * k4);
                            a8[r] += x4[0] * wr[4 * k4] + x4[1] * wr[4 * k4 + 1] + x4[2] * wr[4 * k4 + 2] + x4[3] * wr[4 * k4 + 3];
                        }
                    }
#pragma unroll
                    for (int r = 0; r < 8; ++r) part[(wid * 8 + r) * 36 + lane] = a8[r];
                }
            }
            __syncthreads();
            if (tid < 288) {
                const int r = tid / 36, n = tid - r * 36;
                float s = 0.f;
#pragma unroll
                for (int w = 0; w < 8; ++w) s += part[(w * 8 + r) * 36 + n];
                s += (n < 4) ? p.moe_b_group[layer * 4 + n] : p.moe_b_expert[layer * 32 + n - 4];
                logit[r * 36 + n] = s;
            }
            __syncthreads();
            if (tid < 8) {
                const int rr = base + tid, pp = rr % LP;
                if (pp >= 48) {
                    const float* lg = logit + tid * 36;
                    int gs = 0; float gm = lg[0];
#pragma unroll
                    for (int i = 1; i < 4; ++i) if (lg[i] > gm) { gm = lg[i]; gs = i; }
                    float gsum = 0.f;
#pragma unroll
                    for (int i = 0; i < 4; ++i) gsum += __expf(lg[i] - gm);
                    const float gw = 1.f / gsum;
                    const float* el = lg + 4 + 8 * gs;
                    int i0 = 0; float m0 = el[0];
#pragma unroll
                    for (int i = 1; i < 8; ++i) if (el[i] > m0) { m0 = el[i]; i0 = i; }
                    int i1 = -1; float m1 = -3.0e38f;
#pragma unroll
                    for (int i = 0; i < 8; ++i) if (i != i0 && el[i] > m1) { m1 = el[i]; i1 = i; }
                    const float e1 = __expf(m1 - m0);
                    const float c0 = gw / (1.f + e1), c1 = gw * e1 / (1.f + e1);
                    float* cw = (float*)(p.ws + WS_CW);
                    cw[2 * rr] = c0; cw[2 * rr + 1] = c1;
                    const int slot = 16 * iter + 2 * tid;
                    asg[slot] = ((8 * gs + i0) << 24) | (2 * rr); asg[slot + 1] = ((8 * gs + i1) << 24) | (2 * rr + 1);
                } else {
                    const int slot = 16 * iter + 2 * tid;
                    asg[slot] = -1; asg[slot + 1] = -1;
                }
            }
            __syncthreads();
        }
        ++iter;
    }
    if (ROUTE) {
        const int n = 16 * iter;
        unsigned* cnt = (unsigned*)(p.ws + WS_CTL) + CW_CNT + layer * 32;
        u32* list = (u32*)(p.ws + WS_LIST);
        int* ebase = asg + 256;
        if (tid < 32) {
            int cn = 0;
            for (int i = 0; i < n; ++i) cn += (asg[i] >= 0 && (asg[i] >> 24) == tid) ? 1 : 0;
            ebase[tid] = cn > 0 ? (int)atomicAdd(&cnt[tid], (unsigned)cn) : 0;
        }
        __syncthreads();
        if (tid < n) {
            const int v = asg[tid];
            if (v >= 0) {
                const int e = v >> 24;
                int rk = 0;
                for (int i = 0; i < tid; ++i) rk += (asg[i] >= 0 && (asg[i] >> 24) == e) ? 1 : 0;
                list[(size_t)e * TP + ebase[e] + rk] = (u32)(v & 0xffffff);
            }
        }
        __syncthreads();
    }
}

struct MoeSched {
    const char* A; const char* Bt; const u32* list; const int* pre;
    int K, ncol, rshift, total; size_t estride, cstride, h1;
    DI bool next(int i, pg::Unit& u) const {
        const int L = i * (int)gridDim.x + (int)blockIdx.x; if (L >= total) return false;
        const int rtile = L / ncol; u.pn = L - rtile * ncol;
        int e = 0;
        for (int j = 1; j < 32; ++j) if (pre[j] <= rtile) e = j;
        u.e = e; u.pm = rtile - pre[e]; u.n = pre[64 + e];
        return true;
    }
    DI int asg(const pg::Unit& u, int r) const { const int gi = u.pm * 256 + r; return (int)list[(size_t)u.e * TP + (gi < u.n ? gi : 0)]; }
    DI int arow(const pg::Unit& u, int r) const { return asg(u, r) >> rshift; }
    DI const char* abase() const { return A; }
    DI int lda() const { return K; }
    DI const char* bbase(const pg::Unit& u) const { return Bt + (size_t)u.e * estride + (size_t)u.pn * cstride; }
    DI size_t bh1() const { return h1; }
};
struct EpiGateUp {
    static constexpr bool PERM = true;
    const MoeSched* S; const float* cw; u16* ACT;
    DI void operator()(const pg::Acc& acc, const pg::Unit& u, int wr, int wc, int fr, int fq) const {
#pragma unroll
        for (int ai = 0; ai < 2; ++ai)
#pragma unroll
            for (int m = 0; m < 4; ++m) {
                const int r = 128 * ai + 64 * wr + 16 * m + fr;
                if (u.pm * 256 + r >= u.n) continue;
                const int a = S->asg(u, r);
                const float cwa = cw[a];
                const f32x4 g0 = acc[ai][0][m][0], g1 = acc[ai][0][m][1], u0 = acc[ai][1][m][0], u1 = acc[ai][1][m][1];
                u32x4 w;
                w.x = pk2(silu(g0[0]) * u0[0] * cwa, silu(g0[1]) * u0[1] * cwa); w.y = pk2(silu(g0[2]) * u0[2] * cwa, silu(g0[3]) * u0[3] * cwa);
                w.z = pk2(silu(g1[0]) * u1[0] * cwa, silu(g1[1]) * u1[1] * cwa); w.w = pk2(silu(g1[2]) * u1[2] * cwa, silu(g1[3]) * u1[3] * cwa);
                *(u32x4*)(ACT + (size_t)a * 256 + 128 * u.pn + 32 * wc + 8 * fq) = w;
            }
    }
};
struct EpiDown {
    static constexpr bool PERM = true;
    const MoeSched* S; u16* Y;
    DI void operator()(const pg::Acc& acc, const pg::Unit& u, int wr, int wc, int fr, int fq) const {
#pragma unroll
        for (int ai = 0; ai < 2; ++ai)
#pragma unroll
            for (int m = 0; m < 4; ++m) {
                const int r = 128 * ai + 64 * wr + 16 * m + fr;
                if (u.pm * 256 + r >= u.n) continue;
                const int a = S->asg(u, r);
#pragma unroll
                for (int bj = 0; bj < 2; ++bj) {
                    const f32x4 v0 = acc[ai][bj][m][0], v1 = acc[ai][bj][m][1];
                    u32x4 w; w.x = pk2(v0[0], v0[1]); w.y = pk2(v0[2], v0[3]); w.z = pk2(v1[0], v1[1]); w.w = pk2(v1[2], v1[3]);
                    *(u32x4*)(Y + (size_t)a * 1024 + 256 * u.pn + 128 * bj + 32 * wc + 8 * fq) = w;
                }
            }
    }
};
template <int STAGE>
DI void phase_moe(const Params& p, int layer, unsigned char* lds) {
    const int tid = tid_opaque(), lane = tid & 63, wid = tid >> 6, c = lane & 15, g = lane >> 4, wm = wid >> 2, wn = wid & 3;
    int* pre = (int*)(lds + 131072);
    int* tl = pre + 192;
    const unsigned* cnt = (const unsigned*)(p.ws + WS_CTL) + CW_CNT + layer * 32;
    if (tid < 32) pre[64 + tid] = (int)cnt[tid];
    __syncthreads();
    if (tid == 0) {
        int s = 0, s2 = 0;
        for (int e = 0; e < 32; ++e) { const int n = pre[64 + e]; pre[e] = s; s += n >> 8; pre[128 + e] = s2; s2 += ((n & 255) + 127) >> 7; }
        pre[32] = s; pre[160] = s2;
    }
    __syncthreads();
    const u32* list = (const u32*)(p.ws + WS_LIST);
    const float* cw = (const float*)(p.ws + WS_CW);
    const u16* HN = (const u16*)(p.ws + WS_HN);
    u16* ACT = (u16*)(p.ws + WS_P0 + P0_ACT);
    u16* Y = (u16*)(p.ws + WS_P0 + P0_Y);
    if (STAGE == 0) {
        MoeSched S{(const char*)HN, (const char*)(p.ws + WS_P0 + P0_WGU), list, pre, 1024, 2, 1, pre[32] * 2,
                   (size_t)512 * 1024 * 2, (size_t)128 * 1024 * 2, (size_t)256 * 1024 * 2};
        EpiGateUp E{&S, cw, ACT};
        pg::gemm((LAS unsigned char*)lds, 1024, S, E);
    } else {
        MoeSched S{(const char*)ACT, (const char*)(p.ws + WS_P0 + P0_WDN), list, pre, 256, 4, 0, pre[32] * 4,
                   (size_t)1024 * 256 * 2, (size_t)256 * 256 * 2, (size_t)128 * 256 * 2};
        EpiDown E{&S, Y};
        pg::gemm((LAS unsigned char*)lds, 256, S, E);
    }
    __syncthreads();
    constexpr int FT = STAGE == 0 ? 4 : 8;
    const int nleft = pre[160] * FT;
    for (int t = (int)gridDim.x - 1 - (int)blockIdx.x; t < nleft; t += gridDim.x) {
        const int rtile = t / FT, ft = t - rtile * FT;
        int e = 0;
        for (int i = 1; i < 32; ++i) if (pre[128 + i] <= rtile) e = i;
        const int ne = pre[64 + e], r0 = (ne & ~255) + (rtile - pre[128 + e]) * 128;
        if (tid < 128) { const int gi = r0 + tid; tl[tid] = gi < ne ? (int)list[(size_t)e * TP + gi] : -1; }
        __syncthreads();
        GemmAcc<2> acc;
        if (STAGE == 0) {
            const u16* W = (const u16*)(p.ws + WS_P0 + P0_WGU) + (size_t)e * 512 * 1024;
            const int f0 = ft * 64;
            auto pf = [=](int lr) -> u32 { const int x = lr & 63, w = lr >> 6; return (u32)((x < 32 ? f0 + w * 32 + x : 256 + f0 + w * 32 + (x - 32)) * 1024); };
            auto qf = [=](int n) -> u32 { const int a = tl[n]; return (u32)((a < 0 ? (tl[0] >> 1) : (a >> 1)) * 1024); };
            gemm_tile<2>(W, HN, 16, pf, qf, acc, lds);
#pragma unroll
            for (int ni = 0; ni < 2; ++ni) {
                const int a = tl[wn * 32 + 16 * ni + c];
                if (a < 0) continue;
                const float cwa = cw[a];
#pragma unroll
                for (int mi = 0; mi < 2; ++mi) {
                    const f32x4 gt = acc.a[mi][ni], up = acc.a[mi + 2][ni];
                    u32x2 w;
                    w.x = pk2(silu(gt[0]) * up[0] * cwa, silu(gt[1]) * up[1] * cwa);
                    w.y = pk2(silu(gt[2]) * up[2] * cwa, silu(gt[3]) * up[3] * cwa);
                    *(u32x2*)(ACT + (size_t)a * 256 + f0 + wm * 32 + 16 * mi + 4 * g) = w;
                }
            }
        } else {
            const u16* W = (const u16*)(p.ws + WS_P0 + P0_WDN) + (size_t)e * 1024 * 256;
            auto qf = [=](int n) -> u32 { const int a = tl[n]; return (u32)((a < 0 ? tl[0] : a) * 256); };
            gemm_tile<2>(W, ACT, 4, LinRow{(u32)(ft * 128) * 256u, 256u}, qf, acc, lds);
#pragma unroll
            for (int ni = 0; ni < 2; ++ni) {
                const int a = tl[wn * 32 + 16 * ni + c];
                if (a < 0) continue;
#pragma unroll
                for (int mi = 0; mi < 4; ++mi) {
                    const f32x4 v = acc.a[mi][ni];
                    u32x2 w; w.x = pk2(v[0], v[1]); w.y = pk2(v[2], v[3]);
                    *(u32x2*)(Y + (size_t)a * 1024 + ft * 128 + wm * 64 + 16 * mi + 4 * g) = w;
                }
            }
        }
        __syncthreads();
    }
}

DI void phase_post1(const Params& p, unsigned char* lds) {
    const int lane = tid_opaque() & 63, wid = tid_opaque() >> 6;
    const float* KRAW = (const float*)(p.ws + WS_P0 + P0_KRAW);
    const float* KIRAW = (const float*)((unsigned char*)p.out + DO_KIRAW);
    unsigned char* KN = (unsigned char*)p.out + DO_KN;
    _Float16* KI = (_Float16*)((unsigned char*)p.out + DO_KI);
    for (int row = blockIdx.x * 8 + wid; row < TP; row += gridDim.x * 8) {
        const f32x4 k = *(const f32x4*)(KRAW + (size_t)row * 256 + 4 * lane);
        float ss = k[0] * k[0] + k[1] * k[1] + k[2] * k[2] + k[3] * k[3];
#pragma unroll
        for (int o = 16; o >= 1; o >>= 1) ss += __shfl_xor(ss, o);
        const float rstd = rsqrtf(ss * (1.f / 128.f) + RMS_EPS);
        const int d = (4 * lane) & 127;
        const f32x4 kg = *(const f32x4*)(p.dsa_k_norm + d), qg = *(const f32x4*)(p.dsa_q_norm + d);
        *(u32*)(KN + (size_t)row * 256 + 4 * lane) = pk4_fp8(k[0] * rstd * kg[0] * qg[0], k[1] * rstd * kg[1] * qg[1], k[2] * rstd * kg[2] * qg[2], k[3] * rstd * kg[3] * qg[3]);
        const float x = KIRAW[(size_t)row * 64 + lane];
        const float mu = wave_sum(x) * (1.f / 64.f);
        const float xc = x - mu;
        const float var = wave_sum(xc * xc) * (1.f / 64.f);
        KI[(size_t)row * 64 + lane] = (_Float16)(xc * rsqrtf(var + RMS_EPS) * p.dsa_ln_g[lane] + p.dsa_ln_b[lane]);
    }
}

constexpr int IX_HIST = 0;
constexpr int IX_SEL = 65536;
constexpr int IX_CV = IX_SEL + 16384;
constexpr int IX_CI = IX_CV + 16384;
constexpr int IX_CNT = IX_CI + 8192;
constexpr int IX_QI = IX_CNT + 512;
constexpr int IX_QROW = 1296;
template <int PASS>
DI void index_pass(const _Float16* __restrict__ KIb, int ktiles, int wid, int lane, const float (&wh)[8], float sQ, unsigned char* lds) {
    const int q = lane & 31, hh = lane >> 5;
    u32* hist = (u32*)(lds + IX_HIST);
    u16* sell = (u16*)(lds + IX_SEL);
    float* cv = (float*)(lds + IX_CV);
    u16* ci = (u16*)(lds + IX_CI);
    int* cn = (int*)(lds + IX_CNT);
    const int tbq = (PASS == 1) ? cn[64 + q] : 0;
    const unsigned char* qb = lds + IX_QI + q * IX_QROW + hh * 16;
    for (int kt = 1 + wid; kt < ktiles; kt += 8) {
        f16x8 a[4];
#pragma unroll
        for (int s = 0; s < 4; ++s) a[s] = *(const f16x8*)(KIb + (size_t)(32 * kt + q) * 64 + 16 * s + 8 * hh);
        float sc[16];
        {
            f32x16 d;
#pragma unroll
            for (int r = 0; r < 16; ++r) d[r] = 0.f;
#pragma unroll
            for (int hd = 8; hd < 10; ++hd)
#pragma unroll
                for (int s = 0; s < 4; ++s) d = __builtin_amdgcn_mfma_f32_32x32x16_f16(a[s], *(const f16x8*)(qb + hd * 128 + s * 32), d, 0, 0, 0);
#pragma unroll
            for (int r = 0; r < 16; ++r) sc[r] = d[r];
        }
#pragma unroll
        for (int hd = 0; hd < 8; ++hd) {
            f32x16 d;
#pragma unroll
            for (int r = 0; r < 16; ++r) d[r] = 0.f;
#pragma unroll
            for (int s = 0; s < 4; ++s) d = __builtin_amdgcn_mfma_f32_32x32x16_f16(a[s], *(const f16x8*)(qb + hd * 128 + s * 32), d, 0, 0, 0);
#pragma unroll
            for (int r = 0; r < 16; ++r) sc[r] = fmaf(fabsf(d[r]), wh[hd], sc[r]);
            if (hd & 1) __builtin_amdgcn_sched_barrier(0);
        }
        const int kbase = 32 * kt + 4 * hh;
        if (PASS == 0) {
#pragma unroll
            for (int r = 0; r < 16; ++r) {
                const int key = kbase + (r & 3) + 8 * (r >> 2);
                const int bin = (int)fminf(fmaxf(fmaf(sc[r], sQ, 512.f), 0.f), 1023.f);
                if (key >= 48) atomicAdd(&hist[q * 512 + (bin >> 1)], 1u << (16 * (bin & 1)));
            }
        } else {
            u32 selm = 0u, candm = 0u;
#pragma unroll
            for (int r = 0; r < 16; ++r) {
                const int key = kbase + (r & 3) + 8 * (r >> 2);
                const int bin = (int)fminf(fmaxf(fmaf(sc[r], sQ, 512.f), 0.f), 1023.f);
                selm |= (key >= 48 && bin > tbq) ? (1u << r) : 0u;
                candm |= (key >= 48 && bin == tbq) ? (1u << r) : 0u;
            }
            if (selm) {
                int pos = atomicAdd(&cn[q], (int)__builtin_popcount(selm));
                while (selm) {
                    const int r = __builtin_ctz(selm); selm &= selm - 1u;
                    if (pos < 256) sell[q * 256 + pos] = (u16)(kbase + (r & 3) + 8 * (r >> 2));
                    ++pos;
                }
            }
            if (candm) {
                int pos = atomicAdd(&cn[32 + q], (int)__builtin_popcount(candm));
#pragma unroll
                for (int r = 0; r < 16; ++r) if (candm & (1u << r)) { if (pos < 128) { cv[q * 128 + pos] = sc[r]; ci[q * 128 + pos] = (u16)(kbase + (r & 3) + 8 * (r >> 2)); } ++pos; }
            }
        }
    }
}
DI void index_unit(const Params& p, int b, int ch, int half, unsigned char* lds) {
    const int tid = tid_opaque(), lane = tid & 63, wid = tid >> 6;
    u16* SEL = (u16*)((unsigned char*)p.out + DO_SEL);
    const int qrow0 = b * LP + 64 * ch + 32 * half;
    const int nkeys = 64 * (ch + 1) - 48;
    if (nkeys <= 256) {
        for (int i = tid; i < 32 * 256; i += NTHREADS) { const int qq = i >> 8, s = i & 255; SEL[(size_t)(qrow0 + qq) * 256 + s] = (u16)(s < nkeys ? 48 + s : 48); }
        return;
    }
    u32* hist = (u32*)(lds + IX_HIST);
    int* cn = (int*)(lds + IX_CNT);
    for (int i = tid; i < 32 * 512; i += NTHREADS) hist[i] = 0u;
    if (tid < 128) cn[tid] = 0;
    { u16* sell0 = (u16*)(lds + IX_SEL); for (int i = tid; i < 32 * 256; i += NTHREADS) sell0[i] = 48; }
    const _Float16* QI = (const _Float16*)(p.ws + WS_P0 + P0_QI);
    const float* WI = (const float*)((unsigned char*)p.out + DO_WI);
    const _Float16* KIb = (const _Float16*)((unsigned char*)p.out + DO_KI) + (size_t)b * LP * 64;
    const int q = lane & 31;
    float wh[8], sQ;
    {
        float n2 = 0.f;
#pragma unroll
        for (int hd = 0; hd < 8; ++hd) { const float w = WI[(size_t)(qrow0 + q) * 8 + hd]; wh[hd] = 0.5f * w; n2 += w * w; }
        sQ = 512.f / (28.f * sqrtf(n2) + 1e-20f);
    }
#pragma unroll
    for (int i = 0; i < 4; ++i) { const int id = tid + NTHREADS * i, rr = id >> 6, cc = id & 63; *(u32x4*)(lds + IX_QI + rr * IX_QROW + cc * 16) = *(const u32x4*)(QI + (size_t)(qrow0 + rr) * 512 + cc * 8); }
    const int ktiles = 2 * (ch + 1);
    __syncthreads();
    {
        const int qq = tid >> 4, dg = tid & 15;
        float c4[4] = {0.f, 0.f, 0.f, 0.f};
#pragma unroll
        for (int hd = 0; hd < 8; ++hd) {
            const float w = 0.5f * WI[(size_t)(qrow0 + qq) * 8 + hd];
            const _Float16* qp = (const _Float16*)(lds + IX_QI + qq * IX_QROW + hd * 128 + dg * 8);
#pragma unroll
            for (int k = 0; k < 4; ++k) c4[k] += w * (float)qp[k];
        }
        _Float16* ph = (_Float16*)(lds + IX_QI + qq * IX_QROW + 8 * 128 + dg * 8);
        _Float16* pl = (_Float16*)(lds + IX_QI + qq * IX_QROW + 9 * 128 + dg * 8);
#pragma unroll
        for (int k = 0; k < 4; ++k) { const _Float16 hi = (_Float16)c4[k]; ph[k] = hi; pl[k] = (_Float16)(c4[k] - (float)hi); }
    }
    __syncthreads();
    index_pass<0>(KIb, ktiles, wid, lane, wh, sQ, lds);
    __syncthreads();
    for (int qi = 0; qi < 4; ++qi) {
        const int qq = 4 * wid + qi;
        u32 hw[8];
        int cl = 0;
#pragma unroll
        for (int i = 0; i < 8; ++i) { hw[i] = hist[qq * 512 + 8 * lane + i]; cl += (int)(hw[i] & 0xffffu) + (int)(hw[i] >> 16); }
        int suf = cl;
#pragma unroll
        for (int o = 1; o < 64; o <<= 1) { const int t = __shfl_down(suf, o); if (lane + o < 64) suf += t; }
        const int above = suf - cl;
        if (above < 256 && above + cl >= 256) {
            int acc = above, tb = 16 * lane, na = above;
#pragma unroll
            for (int i = 15; i >= 0; --i) {
                const int cb = (int)((hw[i >> 1] >> (16 * (i & 1))) & 0xffffu);
                if (acc < 256 && acc + cb >= 256) { tb = 16 * lane + i; na = acc; }
                acc += cb;
            }
            cn[64 + qq] = tb; cn[96 + qq] = na;
        }
    }
    __syncthreads();
    index_pass<1>(KIb, ktiles, wid, lane, wh, sQ, lds);
    __syncthreads();
    {
        u16* sell = (u16*)(lds + IX_SEL);
        const float* cv = (const float*)(lds + IX_CV);
        const u16* ci = (const u16*)(lds + IX_CI);
        for (int qi = 0; qi < 4; ++qi) {
            const int qq = 4 * wid + qi;
            const int na = cn[96 + qq], need = 256 - na;
            int nc = cn[32 + qq]; nc = nc < 128 ? nc : 128;
#pragma unroll
            for (int half2 = 0; half2 < 2; ++half2) {
                const int i = lane + 64 * half2;
                if (i < nc) {
                    const float vi = cv[qq * 128 + i]; const int ki = ci[qq * 128 + i];
                    int rank = 0;
                    for (int j = 0; j < nc; ++j) { const float vj = cv[qq * 128 + j]; const int kj = ci[qq * 128 + j]; rank += (vj > vi || (vj == vi && kj < ki)) ? 1 : 0; }
                    if (rank < need) sell[qq * 256 + na + rank] = (u16)ki;
                }
            }
        }
    }
    __syncthreads();
    {
        const u32x4* src = (const u32x4*)(lds + IX_SEL);
        u32x4* dst = (u32x4*)(SEL + (size_t)qrow0 * 256);
        for (int i = tid; i < 1024; i += NTHREADS) dst[i] = src[i];
    }
    __syncthreads();
}
DI void phase_index(const Params& p, unsigned char* lds) {
    const int G = gridDim.x;
    for (int r = 0;; ++r) {
        const int u = (r & 1) ? r * G + (G - 1 - (int)blockIdx.x) : r * G + (int)blockIdx.x;
        if (r * G >= 516) break;
        if (u < 516) index_unit(p, (u >> 1) & 1, 128 - (u >> 2), u & 1, lds);
    }
}

DI int t5_bucket(int rel) {
    const int n = rel < 0 ? -rel : rel;
    const int base = rel > 0 ? 16 : 0;
    const int lg = 8 + (n >= 12) + (n >= 16) + (n >= 23) + (n >= 32) + (n >= 46) + (n >= 64) + (n >= 91);
    return base + (n < 8 ? n : lg);
}
constexpr int AT_ITEMS = 513;
constexpr int AT_WAVE_LDS = 11264;
DI int at_swz(int r) { return ((r >> 1) & 1) | (((r >> 3) & 1) << 1); }
DI void attn_query(const Params& p, int b, int n, int qi, unsigned char* wl) {
    const int lane = tid_opaque() & 63, c = lane & 15, g = lane >> 4;
    u32* widx = (u32*)wl;
    u16* Pb = (u16*)(wl + 1024);
    unsigned char* ring = wl + 3072;
    float* Lg = (float*)ring;
    const u16* SEL = (const u16*)((unsigned char*)p.out + DO_SEL);
    const u16* QRAW = (const u16*)(p.ws + WS_P0 + P0_QRAW);
    const unsigned char* KN = (const unsigned char*)p.out + DO_KN;
    const unsigned char* VN = p.ws + WS_P0 + P0_VN;
    u16* OA = (u16*)((unsigned char*)p.out + DO_OG);
    const int pq = 48 + qi, row = b * LP + pq;
    const int chq = pq >> 6, nkeys = 64 * (chq + 1) - 48, nsel = nkeys < 256 ? nkeys : 256, ntile = nsel >> 4;
    {
        const u32x2 w = *(const u32x2*)(SEL + (size_t)row * 256 + 4 * lane);
        u32x4 o;
        const int k0 = w.x & 0xffff, k1 = w.x >> 16, k2 = w.y & 0xffff, k3 = w.y >> 16;
        o.x = k0 | (t5_bucket(k0 - pq) << 16); o.y = k1 | (t5_bucket(k1 - pq) << 16); o.z = k2 | (t5_bucket(k2 - pq) << 16); o.w = k3 | (t5_bucket(k3 - pq) << 16);
        *(u32x4*)(widx + 4 * lane) = o;
    }
    const size_t kb = (size_t)b * LP;
    u32x4 qraw[4];
#pragma unroll
    for (int s = 0; s < 4; ++s)
        qraw[s] = (c < 4) ? *(const u32x4*)(QRAW + (size_t)row * 1024 + (4 * n + c) * 128 + 64 * (s >> 1) + 16 * g + 8 * (s & 1))
                          : (u32x4){0u, 0u, 0u, 0u};
    float rbv[8];
    {
        const float* rb = p.rel_bias + (8 * g) * 8 + 4 * n + (c & 3);
#pragma unroll
        for (int j = 0; j < 8; ++j) rbv[j] = rb[8 * j];
    }
#define ATT_LOADK(dst, oh, bt) do { _Pragma("unroll") for (int t = 0; t < 4; ++t) { const u32 e_ = widx[16 * (4 * (bt) + t) + c]; const int kid_ = e_ & 0xffff, bk_ = e_ >> 16; \
        const unsigned char* kp_ = KN + (kb + kid_) * 256 + n * 128 + 16 * g; \
        dst[t][0] = *(const u32x4*)(kp_); dst[t][1] = *(const u32x4*)(kp_ + 64); \
        const u32 hv_ = ((bk_ >> 3) == g) ? (0x3f80u << (16 * (bk_ & 1))) : 0u; const int wq_ = (bk_ & 7) >> 1; \
        u32x4 ow_; ow_.x = wq_ == 0 ? hv_ : 0u; ow_.y = wq_ == 1 ? hv_ : 0u; ow_.z = wq_ == 2 ? hv_ : 0u; ow_.w = wq_ == 3 ? hv_ : 0u; oh[t] = __builtin_bit_cast(bf16x8, ow_); } } while (0)
#define ATT_QK(src, oh, bt) do { _Pragma("unroll") for (int t = 0; t < 4; ++t) { f32x4 a4 = (f32x4){0.f, 0.f, 0.f, 0.f}; \
        a4 = __builtin_amdgcn_mfma_f32_16x16x32_fp8_fp8((long)(((unsigned long long)src[t][0].y << 32) | src[t][0].x), qf[0], a4, 0, 0, 0); \
        a4 = __builtin_amdgcn_mfma_f32_16x16x32_fp8_fp8((long)(((unsigned long long)src[t][0].w << 32) | src[t][0].z), qf[1], a4, 0, 0, 0); \
        a4 = __builtin_amdgcn_mfma_f32_16x16x32_fp8_fp8((long)(((unsigned long long)src[t][1].y << 32) | src[t][1].x), qf[2], a4, 0, 0, 0); \
        a4 = __builtin_amdgcn_mfma_f32_16x16x32_fp8_fp8((long)(((unsigned long long)src[t][1].w << 32) | src[t][1].z), qf[3], a4, 0, 0, 0); \
        { const f32x4 b4_ = mfma16(oh[t], bb, (f32x4){0.f, 0.f, 0.f, 0.f}); a4 = a4 + b4_; } \
        const bool val_ = (4 * (bt) + t) < ntile; \
        _Pragma("unroll") for (int r = 0; r < 4; ++r) { a4[r] = val_ ? a4[r] * qscale : -3.0e38f; mx = fmaxf(mx, a4[r]); } \
        lq[t] = a4; } \
        if (c < 4) { _Pragma("unroll") for (int t = 0; t < 4; ++t) *(f32x4*)(Lg + c * 256 + 16 * (4 * (bt) + t) + 4 * g) = lq[t]; } } while (0)
    u32x4 ka[4][2], kc[4][2]; bf16x8 oa[4], oc[4];
    ATT_LOADK(ka, oa, 0);
    ATT_LOADK(kc, oc, 1);
    long qf[4];
    float ssq = 0.f;
#pragma unroll
    for (int s = 0; s < 4; ++s) {
        const u32x4 w = qraw[s];
        const u32 lo8 = pk4_fp8(bflo(w.x), bfhi(w.x), bflo(w.y), bfhi(w.y)), hi8 = pk4_fp8(bflo(w.z), bfhi(w.z), bflo(w.w), bfhi(w.w));
        qf[s] = (long)(((unsigned long long)hi8 << 32) | lo8);
        ssq += bflo(w.x) * bflo(w.x) + bfhi(w.x) * bfhi(w.x) + bflo(w.y) * bflo(w.y) + bfhi(w.y) * bfhi(w.y)
             + bflo(w.z) * bflo(w.z) + bfhi(w.z) * bfhi(w.z) + bflo(w.w) * bflo(w.w) + bfhi(w.w) * bfhi(w.w);
    }
    ssq += __shfl_xor(ssq, 16); ssq += __shfl_xor(ssq, 32);
    const float qscale = rsqrtf(ssq * (1.f / 128.f) + RMS_EPS) * 0.08838834764831845f;
    bf16x8 bb;
    {
        const float iq = 1.f / qscale;
        u32x4 w;
        w.x = pk2(rbv[0] * iq, rbv[1] * iq); w.y = pk2(rbv[2] * iq, rbv[3] * iq); w.z = pk2(rbv[4] * iq, rbv[5] * iq); w.w = pk2(rbv[6] * iq, rbv[7] * iq);
        if (c >= 4) w = (u32x4){0u, 0u, 0u, 0u};
        bb = __builtin_bit_cast(bf16x8, w);
    }
    float mx = -3.0e38f;
    {
        f32x4 lq[4];
        ATT_QK(ka, oa, 0);
        ATT_LOADK(ka, oa, 2);
        ATT_QK(kc, oc, 1);
        ATT_LOADK(kc, oc, 3);
        ATT_QK(ka, oa, 2);
        ATT_QK(kc, oc, 3);
    }
#undef ATT_LOADK
#undef ATT_QK
    const int kr = lane >> 3, c8 = lane & 7;
    const unsigned char* vbase = VN + kb * 256 + n * 128 + 16 * c8;
#define ATT_SWZ2(r) (((r) & 3) | ((((r) >> 3) & 1) << 2))
#define ATT_LDV(dst, st) do { _Pragma("unroll") for (int j = 0; j < 4; ++j) { const int kid_ = widx[32 * (st) + 8 * j + kr] & 0xffff; \
        dst[j] = *(const u32x4*)(vbase + (size_t)kid_ * 256); } } while (0)
#define ATT_STV(src) do { _Pragma("unroll") for (int j = 0; j < 4; ++j) { const int r_ = 8 * j + kr; \
        unsigned char* d_ = ring + r_ * 256 + ((c8 ^ ATT_SWZ2(r_)) * 32); \
        *(bf16x8*)(d_) = fp8x8_to_bf16x8(src[j].x, src[j].y); *(bf16x8*)(d_ + 16) = fp8x8_to_bf16x8(src[j].z, src[j].w); } } while (0)
    u32x4 v0[4], v1[4], v2[4], v3[4];
    ATT_LDV(v0, 0); ATT_LDV(v1, 1); ATT_LDV(v2, 2); ATT_LDV(v3, 3);
    mx = fmaxf(mx, __shfl_xor(mx, 16)); mx = fmaxf(mx, __shfl_xor(mx, 32));
    float inv[4];
    {
#pragma unroll
        for (int hd = 0; hd < 4; ++hd) {
            const float m = __shfl(mx, hd);
            const f32x4 l4 = *(const f32x4*)(Lg + hd * 256 + 4 * lane);
            f32x4 e = (f32x4){__expf(l4[0] - m), __expf(l4[1] - m), __expf(l4[2] - m), __expf(l4[3] - m)};
            if (4 * lane >= nsel) e = (f32x4){0.f, 0.f, 0.f, 0.f};
            inv[hd] = 1.f / wave_sum(e[0] + e[1] + e[2] + e[3]);
            u32x2 w; w.x = pk2(e[0], e[1]); w.y = pk2(e[2], e[3]);
            *(u32x2*)(Pb + hd * 256 + 4 * lane) = w;
        }
    }
    f32x4 acc[8];
#pragma unroll
    for (int t = 0; t < 8; ++t) acc[t] = (f32x4){0.f, 0.f, 0.f, 0.f};
#define ATT_PVC(st) do { \
        bf16x8 pa_ = (bf16x8){0, 0, 0, 0, 0, 0, 0, 0}; if (c < 4) pa_ = *(const bf16x8*)(Pb + c * 256 + 32 * (st) + 8 * g); \
        const int r0_ = 8 * g + (c >> 2), r1_ = r0_ + 4; \
        _Pragma("unroll") for (int t = 0; t < 8; ++t) { \
            const s16x4 lo_ = __builtin_amdgcn_ds_read_tr16_b64_v4i16((LAS s16x4*)(ring + r0_ * 256 + ((t ^ ATT_SWZ2(r0_)) * 32) + (c & 3) * 8)); \
            const s16x4 hi_ = __builtin_amdgcn_ds_read_tr16_b64_v4i16((LAS s16x4*)(ring + r1_ * 256 + ((t ^ ATT_SWZ2(r1_)) * 32) + (c & 3) * 8)); \
            const bf16x8 vb_ = (bf16x8){lo_[0], lo_[1], lo_[2], lo_[3], hi_[0], hi_[1], hi_[2], hi_[3]}; \
            acc[t] = mfma16(pa_, vb_, acc[t]); } } while (0)
#define ATT_ST(st, vcur) do { ATT_STV(vcur); ATT_PVC(st); if ((st) + 4 < 8) ATT_LDV(vcur, (st) + 4); } while (0)
    ATT_ST(0, v0); ATT_ST(1, v1); ATT_ST(2, v2); ATT_ST(3, v3); ATT_ST(4, v0); ATT_ST(5, v1); ATT_ST(6, v2); ATT_ST(7, v3);
#undef ATT_ST
#undef ATT_LDV
#undef ATT_STV
#undef ATT_PVC
#undef ATT_SWZ2
    if (g == 0) {
#pragma unroll
        for (int r = 0; r < 4; ++r)
#pragma unroll
            for (int t = 0; t < 8; ++t) OA[(size_t)row * 1024 + (4 * n + r) * 128 + 16 * t + c] = f2bf(acc[t][r] * inv[r]);
    }
}
DI void phase_attn(const Params& p, unsigned xcc, unsigned char* lds) {
    const int tid = tid_opaque(), lane = tid & 63, wid = tid >> 6;
    unsigned char* wl = lds + wid * AT_WAVE_LDS;
    u16* OA = (u16*)((unsigned char*)p.out + DO_OG);
    for (int i = blockIdx.x * NTHREADS + tid; i < 96 * 128; i += gridDim.x * NTHREADS) {
        const int r = i >> 7, b = r / 48, pp = r - 48 * b;
        *(u32x4*)(OA + ((size_t)b * LP + pp) * 1024 + (i & 127) * 8) = (u32x4){0u, 0u, 0u, 0u};
    }
    unsigned* qctr = (unsigned*)(p.ws + WS_CTL) + CW_AQ;
    const int my = (int)(xcc & 3u);
    constexpr int NIT = 8208 / 2;
    int cbq = my;
    unsigned jn = 0;
    if (lane == 0) jn = atomicAdd(&qctr[cbq * 64], 1u);
    for (;;) {
        int j = (int)__builtin_amdgcn_readfirstlane(jn), cb = cbq;
        while (j >= NIT) {
            if (((cbq + 1) & 3) == my) { j = -1; break; }
            cbq = (cbq + 1) & 3; cb = cbq;
            unsigned t = 0; if (lane == 0) t = atomicAdd(&qctr[cbq * 64], 1u);
            j = (int)__builtin_amdgcn_readfirstlane(t);
        }
        if (j < 0) break;
        if (lane == 0) jn = atomicAdd(&qctr[cbq * 64], 1u);
        attn_query(p, cb >> 1, cb & 1, 2 * j, wl);
        attn_query(p, cb >> 1, cb & 1, 2 * j + 1, wl);
    }
}

DI void phase_final(const Params& p) {
    const float* H = (const float*)(p.ws + WS_H);
    const u16* Y = (const u16*)(p.ws + WS_P0 + P0_Y);
    for (size_t i = (size_t)blockIdx.x * NTHREADS + tid_opaque(); i < (size_t)2 * SEQ * 256; i += (size_t)gridDim.x * NTHREADS) {
        const size_t orow = i >> 8; const int col = (int)(i & 255) * 4;
        const int b = (int)(orow >> 13), s = (int)(orow & 8191);
        const size_t row = (size_t)b * LP + 64 + s;
        f32x4 v = *(const f32x4*)(H + row * DM + col);
        const u32x2 y0 = *(const u32x2*)(Y + (2 * row) * DM + col), y1 = *(const u32x2*)(Y + (2 * row + 1) * DM + col);
        v[0] += bflo(y0.x) + bflo(y1.x); v[1] += bfhi(y0.x) + bfhi(y1.x); v[2] += bflo(y0.y) + bflo(y1.y); v[3] += bfhi(y0.y) + bfhi(y1.y);
        *(f32x4*)(p.out + orow * DM + col) = v;
    }
}

__global__ void __launch_bounds__(NTHREADS, 2) mega(Params p) {
    extern __shared__ __attribute__((aligned(16))) unsigned char lds[];
    if (threadIdx.x < 4) ((volatile LAS unsigned*)(lds + LDS_BAR))[threadIdx.x] = 0u;
    __syncthreads();
    XcdBarrier bar = xcd_barrier_post((unsigned*)(p.ws + WS_CTL) + CW_BAR, (volatile LAS unsigned*)(lds + LDS_BAR));
    phase_prep(p, lds);                                                   xcd_barrier(bar);
    phase_gemm_in0(p, lds);                                               xcd_barrier(bar);
    phase_gdn_prep(p, lds);                                             xcd_barrier(bar);
    { int c0 = 1, c1 = 66; asm volatile("" : "+s"(c0), "+s"(c1));
      if (blockIdx.x < 64) phase_gdn_scan(p, lds, c0, c1); else if (blockIdx.x < 80) gdn_prep_unit(p, blockIdx.x - 64, 128, lds); }
    xcd_barrier(bar);
    { int c0 = 67, c1 = 127; asm volatile("" : "+s"(c0), "+s"(c1));
      if (blockIdx.x < 64) phase_gdn_scan(p, lds, c0, c1); else { for (int u = blockIdx.x - 64; u < 16 * 68; u += gridDim.x - 64) gdn_out_unit(p, u / 68, u % 68, lds); } }
    xcd_barrier(bar);
    for (int u = blockIdx.x; u < 16 * 61; u += gridDim.x) gdn_out_unit(p, u / 61, 68 + u % 61, lds);
    xcd_barrier(bar);
    phase_gemm_out(p, (const u16*)(p.ws + WS_W_OUT0), (const u16*)(p.ws + WS_P0) + 2048, 4096, lds);   xcd_barrier(bar);
    phase_norm<false, true>(p, p.norm_ffn, 0, lds);
    conv_moe_weights(p, 0, lds);                                          xcd_barrier(bar);
    phase_moe<0>(p, 0, lds);                                              xcd_barrier(bar);
    phase_moe<1>(p, 0, lds);                                              xcd_barrier(bar);
    phase_norm<true, false>(p, p.norm_mix + DM, 0, lds);
    conv_moe_weights(p, 1, lds);                                          xcd_barrier(bar);
    phase_gemm_in1(p, lds);                                               xcd_barrier(bar);
    phase_post1(p, lds);                                                  xcd_barrier(bar);
    phase_index(p, lds);                                                  xcd_barrier(bar);
    phase_attn(p, bar.x, lds);                                                   xcd_barrier(bar);
    phase_gemm_out(p, (const u16*)(p.ws + WS_W_OUT1), (const u16*)((unsigned char*)p.out + DO_OG), 1024, lds);   xcd_barrier(bar);
    phase_norm<false, true>(p, p.norm_ffn + DM, 1, lds);                  xcd_barrier(bar);
    phase_moe<0>(p, 1, lds);                                              xcd_barrier(bar);
    phase_moe<1>(p, 1, lds);                                              xcd_barrier(bar);
    phase_final(p);
}

extern "C" void kernel_launch(void* const* d_in, const int* in_sizes, int n_in, void* d_out, int out_size, void* d_ws, size_t ws_size, hipStream_t stream) {
    static int grid = 0;
    if (grid == 0) {
        if (n_in != 23 || out_size != 2 * SEQ * DM || ws_size < WS_END) { fprintf(stderr, "kernel_launch: unexpected sizes (n_in %d out %d ws %zu need %zu)\n", n_in, out_size, ws_size, (size_t)WS_END); grid = -1; return; }
        int dev = 0, cus = 0;
        if (hipGetDevice(&dev) != hipSuccess || hipDeviceGetAttribute(&cus, hipDeviceAttributeMultiprocessorCount, dev) != hipSuccess) { grid = -1; return; }
        if (hipFuncSetAttribute((const void*)mega, hipFuncAttributeMaxDynamicSharedMemorySize, LDS_BYTES) != hipSuccess) { fprintf(stderr, "kernel_launch: hipFuncSetAttribute failed\n"); grid = -1; return; }
        grid = cus > 256 ? 256 : cus;
        if (grid < 16) { grid = -1; return; }
    }
    if (grid < 0) return;
    (void)hipMemsetAsync((unsigned char*)d_ws + WS_CTL, 0, CTL_BYTES, stream);
    Params p{};
    const float** f = (const float**)&p;
    for (int i = 0; i < 23; ++i) f[i] = (const float*)d_in[i];
    p.out = (float*)d_out; p.ws = (unsigned char*)d_ws;
    hipLaunchKernelGGL(mega, dim3(grid), dim3(NTHREADS), LDS_BYTES, stream, p);
}
```

```cpp
#include <hip/hip_runtime.h>
#include <stdint.h>
#include <stdio.h>

#define DI __device__ __forceinline__
#define LAS __attribute__((address_space(3)))
typedef unsigned short u16;
typedef unsigned int u32;
typedef short bf16x8 __attribute__((ext_vector_type(8)));
typedef _Float16 f16x8 __attribute__((ext_vector_type(8)));
typedef float f32x4 __attribute__((ext_vector_type(4)));
typedef float f32x16 __attribute__((ext_vector_type(16)));
typedef u32 u32x4 __attribute__((ext_vector_type(4)));
typedef u32 u32x2 __attribute__((ext_vector_type(2)));
typedef short s16x4 __attribute__((ext_vector_type(4)));

constexpr int DM = 1024, SEQ = 8192, LP = 8256, TP = 16512, TPA = 16640, NCH = 129;
constexpr int NTHREADS = 512;
constexpr int LDS_BYTES = 155648;
constexpr int LDS_BAR = LDS_BYTES - 16;
constexpr float RMS_EPS = 1e-6f;

constexpr size_t WS_CTL = 0, CTL_BYTES = 1u << 20;
constexpr size_t WS_W_IN0 = CTL_BYTES;
constexpr size_t WS_W_OUT0 = WS_W_IN0 + (size_t)4224 * 1024 * 2;
constexpr size_t WS_W_IN1 = WS_W_OUT0 + (size_t)1024 * 1024 * 2;
constexpr size_t WS_W_OUT1 = WS_W_IN1 + (size_t)2176 * 1024 * 2;
constexpr size_t WS_BA = WS_W_OUT1 + (size_t)1024 * 1024 * 2;
constexpr size_t WS_LIST = WS_BA + (size_t)TPA * 16 * 4;
constexpr size_t WS_CW = WS_LIST + (size_t)32 * TP * 4;
constexpr size_t WS_H = WS_CW + (size_t)2 * TP * 4;
constexpr size_t WS_NS = WS_H + (size_t)TPA * 1024 * 4;
constexpr size_t WS_HN = WS_NS;
constexpr size_t WS_P0 = WS_NS + (size_t)16 * 129 * 128 * 128 * 2;
constexpr size_t WS_HALO = WS_P0 + (size_t)TPA * 4096 * 2;
constexpr size_t WS_END = WS_HALO + (size_t)2 * 129 * 3 * 3072 * 2;
constexpr size_t P0_WGU = 0;
constexpr size_t P0_WDN = P0_WGU + (size_t)32 * 512 * 1024 * 2;
constexpr size_t P0_ACT = P0_WDN + (size_t)32 * 1024 * 256 * 2;
constexpr size_t P0_Y = P0_ACT + (size_t)2 * TP * 256 * 2;
constexpr size_t P0_QRAW = P0_ACT;
constexpr size_t P0_KRAW = P0_QRAW + (size_t)TP * 1024 * 2;
constexpr size_t P0_VN = P0_KRAW + (size_t)TP * 256 * 4;
constexpr size_t P0_QI = P0_VN + (size_t)TP * 256 * 2;
static_assert(P0_Y + (size_t)2 * TP * 1024 * 2 <= (size_t)TPA * 4096 * 2, "P0 map");
static_assert(P0_QI + (size_t)TP * 512 * 2 <= (size_t)TPA * 4096 * 2, "P0 map 2");
constexpr size_t DO_M = 0;
constexpr size_t DO_OG = 0;
constexpr size_t DO_SEL = (size_t)TPA * 1024 * 2;
constexpr size_t DO_KN = DO_SEL + (size_t)TP * 256 * 2;
constexpr size_t DO_KI = DO_KN + (size_t)TP * 256 * 2;
constexpr size_t DO_WI = DO_KI + (size_t)TP * 64 * 2;
constexpr size_t DO_KIRAW = DO_WI + (size_t)TP * 8 * 4;
static_assert(DO_KIRAW + (size_t)TP * 64 * 4 <= (size_t)2 * SEQ * 1024 * 4, "d_out map");
constexpr int CW_BAR = 0;
constexpr int CW_CNT = 4096;
constexpr int CW_AQ = 4352;

struct Params {
    const float *x, *meta, *norm_mix, *norm_ffn, *rel_bias, *gdn_w_in, *gdn_conv, *gdn_a_log, *gdn_dt_bias, *gdn_o_norm, *gdn_w_out,
        *dsa_w_in, *dsa_q_norm, *dsa_k_norm, *dsa_ln_g, *dsa_ln_b, *dsa_w_out, *moe_w_group, *moe_b_group, *moe_w_expert, *moe_b_expert,
        *moe_w_gu, *moe_w_down;
    float* out;
    unsigned char* ws;
};

DI u16 f2bf(float f) { return __builtin_bit_cast(u16, (__bf16)f); }
DI float bf2f(u16 h) { return __uint_as_float(((u32)h) << 16); }
DI u32 pk2(float a, float b) { return (u32)f2bf(a) | ((u32)f2bf(b) << 16); }
DI float bflo(u32 w) { return __uint_as_float(w << 16); }
DI float bfhi(u32 w) { return __uint_as_float(w & 0xffff0000u); }
typedef float f32x2 __attribute__((ext_vector_type(2)));
DI u32 pk4_fp8(float a, float b, float c, float d) { int w = 0; w = __builtin_amdgcn_cvt_pk_fp8_f32(a, b, w, false); w = __builtin_amdgcn_cvt_pk_fp8_f32(c, d, w, true); return (u32)w; }
typedef __bf16 bf16x2v __attribute__((ext_vector_type(2)));
DI u32x2 fp8x4_to_bf16x4(u32 w) {
    u32x2 r;
    r.x = __builtin_bit_cast(u32, __builtin_amdgcn_cvt_scalef32_pk_bf16_fp8(w, 1.0f, false));
    r.y = __builtin_bit_cast(u32, __builtin_amdgcn_cvt_scalef32_pk_bf16_fp8(w, 1.0f, true));
    return r;
}
DI bf16x8 fp8x8_to_bf16x8(u32 w0, u32 w1) { const u32x2 a = fp8x4_to_bf16x4(w0), b = fp8x4_to_bf16x4(w1); return __builtin_bit_cast(bf16x8, (u32x4){a.x, a.y, b.x, b.y}); }
DI float wave_sum(float v) {
#pragma unroll
    for (int o = 32; o >= 1; o >>= 1) v += __shfl_xor(v, o);
    return v;
}
DI int tid_opaque() { int t = threadIdx.x; asm volatile("" : "+v"(t)); return t; }
#define LDS_BARRIER() do { asm volatile("s_waitcnt lgkmcnt(0)" ::: "memory"); __builtin_amdgcn_s_barrier(); asm volatile("" ::: "memory"); } while (0)
DI float silu(float x) { return x / (1.f + __expf(-x)); }
DI f32x4 mfma16(bf16x8 a, bf16x8 b, f32x4 c) { return __builtin_amdgcn_mfma_f32_16x16x32_bf16(a, b, c, 0, 0, 0); }
DI bf16x8 ldsfrag(const unsigned char* base, int row, int strideB, int kel) { return *(const bf16x8*)(base + row * strideB + kel * 2); }

#define XB_TMO      128
#define XB_XCNT(j)  (256  + 64 * (j))
#define XB_XSUB(j)  (1280 + 64 * (j))
#define XB_XGEN(j)  (2304 + 64 * (j))
#define XB_TOP      3328
#define XB_TOPGEN   3392
#define XCD_BAR_WORDS 3456
#define XB_SPIN_CAP (1u << 21)
DI unsigned xb_ld(unsigned* p) { return __hip_atomic_load(p, __ATOMIC_RELAXED, __HIP_MEMORY_SCOPE_AGENT); }
DI unsigned xb_add(unsigned* p, unsigned v) { return __hip_atomic_fetch_add(p, v, __ATOMIC_RELAXED, __HIP_MEMORY_SCOPE_AGENT); }
DI unsigned xb_xcc_id() { return (unsigned)__builtin_amdgcn_s_getreg((3 << 11) | 20) & 0xFu; }
#define XB_SPIN(cond, bar) do { unsigned _sp = 0; while (cond) { __builtin_amdgcn_s_sleep(1); \
    if ((++_sp & 255u) == 0u) { if (xb_ld(&(bar)[XB_TMO])) break; if (_sp > XB_SPIN_CAP) { atomicAdd(&(bar)[XB_TMO], 1u); break; } } } } while (0)
struct XcdBarrier { unsigned* bar; unsigned x; volatile LAS unsigned* st; };
DI XcdBarrier xcd_barrier_post(unsigned* bar, volatile LAS unsigned* st) {
    XcdBarrier b; b.bar = bar; b.x = xb_xcc_id(); b.st = st;
    if (threadIdx.x == 0) (void)xb_add(&bar[XB_XCNT(b.x)], 1u);
    return b;
}
DI void xcd_barrier_complete(unsigned* bar, unsigned x, unsigned& nloc, unsigned& nx) {
    const unsigned G = gridDim.x * gridDim.y * gridDim.z;
    unsigned sum, cnt, mine, sp = 0u;
    for (;;) {
        sum = 0u; cnt = 0u; mine = 0u;
#pragma unroll
        for (unsigned j = 0; j < 16; ++j) { const unsigned c = xb_ld(&bar[XB_XCNT(j)]); sum += c; cnt += (c > 0u) ? 1u : 0u; }
        mine = xb_ld(&bar[XB_XCNT(x)]);
        if (sum == G) break;
        __builtin_amdgcn_s_sleep(1);
        if ((++sp & 255u) == 0u) { if (xb_ld(&bar[XB_TMO])) break; if (sp > XB_SPIN_CAP) { atomicAdd(&bar[XB_TMO], 1u); break; } }
    }
    nloc = mine > 0u ? mine : 1u; nx = cnt > 0u ? cnt : 1u;
}
DI void xcd_barrier(const XcdBarrier& b) {
    asm volatile("s_waitcnt vmcnt(0)" ::: "memory");
    __syncthreads();
    if (threadIdx.x == 0) {
        unsigned* bar = b.bar;
        __builtin_amdgcn_s_waitcnt(0);
        unsigned nloc = b.st[0], nx = b.st[1];
        if (nloc == 0u) { xcd_barrier_complete(bar, b.x, nloc, nx); b.st[0] = nloc; b.st[1] = nx; }
        const unsigned old = xb_add(&bar[XB_XSUB(b.x)], 1u);
        const unsigned gen = old / nloc;
        if (old + 1u == (gen + 1u) * nloc) {
            __builtin_amdgcn_fence(__ATOMIC_RELEASE, "agent");
            asm volatile("s_waitcnt vmcnt(0)" ::: "memory");
            const unsigned og = xb_add(&bar[XB_TOP], 1u);
            const unsigned tg = og / nx;
            if (og + 1u == (tg + 1u) * nx) xb_add(&bar[XB_TOPGEN], 1u);
            else XB_SPIN(xb_ld(&bar[XB_TOPGEN]) == tg, bar);
            __builtin_amdgcn_fence(__ATOMIC_ACQUIRE, "agent");
            xb_add(&bar[XB_XGEN(b.x)], 1u);
            asm volatile("s_waitcnt vmcnt(0)" ::: "memory");
        } else {
            XB_SPIN(xb_ld(&bar[XB_XGEN(b.x)]) == gen, bar);
            __builtin_amdgcn_fence(__ATOMIC_ACQUIRE, "agent");
            asm volatile("s_waitcnt vmcnt(0)" ::: "memory");
        }
    }
    __syncthreads();
}

struct ConvJob { const float* src; u16* dst; int K, N, kt, nt; };
DI void convT_load(const ConvJob& j, float (&r)[16], int tid) {
    const int l32 = tid & 31, kb = tid >> 5;
#pragma unroll
    for (int kk = 0; kk < 4; ++kk)
#pragma unroll
        for (int q = 0; q < 4; ++q) {
            const int k = j.kt * 64 + kb + 16 * kk, n = j.nt * 128 + l32 + 32 * q;
            r[4 * kk + q] = (n < j.N) ? j.src[(size_t)k * j.N + n] : 0.f;
        }
}
DI void convT_store(const ConvJob& j, const float (&r)[16], int tid, unsigned char* lds) {
    const int l32 = tid & 31, kb = tid >> 5;
    u16* img = (u16*)lds;
#pragma unroll
    for (int kk = 0; kk < 4; ++kk)
#pragma unroll
        for (int q = 0; q < 4; ++q) img[(l32 + 32 * q) * 68 + kb + 16 * kk] = f2bf(r[4 * kk + q]);
    __syncthreads();
#pragma unroll
    for (int i = 0; i < 2; ++i) {
        const int id = tid + NTHREADS * i, n = id >> 3, ck = id & 7;
        const u32x2 a = *(const u32x2*)(lds + n * 136 + ck * 16), b2 = *(const u32x2*)(lds + n * 136 + ck * 16 + 8);
        *(u32x4*)(j.dst + (size_t)(j.nt * 128 + n) * j.K + j.kt * 64 + ck * 8) = (u32x4){a.x, a.y, b2.x, b2.y};
    }
    __syncthreads();
}
template <class DEC> DI void convT_run(DEC dec, int nunits, unsigned char* lds) {
    const int tid = tid_opaque();
    int u = blockIdx.x;
    if (u >= nunits) return;
    ConvJob cur = dec(u), nxt = cur;
    float r[16];
    convT_load(cur, r, tid);
    for (;;) {
        const int un = u + (int)gridDim.x;
        const bool more = un < nunits;
        float rn[16];
        u16* img = (u16*)lds;
        {
            const int l32 = tid & 31, kb = tid >> 5;
#pragma unroll
            for (int kk = 0; kk < 4; ++kk)
#pragma unroll
                for (int q = 0; q < 4; ++q) img[(l32 + 32 * q) * 68 + kb + 16 * kk] = f2bf(r[4 * kk + q]);
        }
        if (more) { nxt = dec(un); convT_load(nxt, rn, tid); }
        __syncthreads();
#pragma unroll
        for (int i = 0; i < 2; ++i) {
            const int id = tid + NTHREADS * i, n = id >> 3, ck = id & 7;
            const u32x2 a = *(const u32x2*)(lds + n * 136 + ck * 16), b2 = *(const u32x2*)(lds + n * 136 + ck * 16 + 8);
            *(u32x4*)(cur.dst + (size_t)(cur.nt * 128 + n) * cur.K + cur.kt * 64 + ck * 8) = (u32x4){a.x, a.y, b2.x, b2.y};
        }
        __syncthreads();
        if (!more) break;
        u = un; cur = nxt;
#pragma unroll
        for (int i = 0; i < 16; ++i) r[i] = rn[i];
    }
}

template <int NI> struct GemmAcc { f32x4 a[4][NI]; };
template <int NI, class PF, class QF>
DI void gemm_tile(const u16* __restrict__ Pb, const u16* __restrict__ Qb, int KT, PF pf, QF qf, GemmAcc<NI>& acc, unsigned char* lds) {
    constexpr int TN = 64 * NI, QC = TN * 8 / NTHREADS, BUF = (128 + TN) * 144;
    const int tid = tid_opaque(), lane = tid & 63, wid = tid >> 6, c = lane & 15, g = lane >> 4, wm = wid >> 2, wn = wid & 3;
    u32 poff[2], qoff[QC];
#pragma unroll
    for (int i = 0; i < 2; ++i) { const int id = tid + NTHREADS * i; poff[i] = pf(id >> 3) + (id & 7) * 8; }
#pragma unroll
    for (int i = 0; i < QC; ++i) { const int id = tid + NTHREADS * i; qoff[i] = qf(id >> 3) + (id & 7) * 8; }
#pragma unroll
    for (int mi = 0; mi < 4; ++mi)
#pragma unroll
        for (int ni = 0; ni < NI; ++ni) acc.a[mi][ni] = (f32x4){0.f, 0.f, 0.f, 0.f};
    u32x4 p0[2], p1[2], p2[2], p3[2], q0[QC], q1[QC], q2[QC], q3[QC];
#define GT_LOAD(P, Q, kt) do { if ((kt) < KT) { _Pragma("unroll") for (int i = 0; i < 2; ++i) P[i] = *(const u32x4*)(Pb + poff[i] + (kt) * 64); \
        _Pragma("unroll") for (int i = 0; i < QC; ++i) Q[i] = *(const u32x4*)(Qb + qoff[i] + (kt) * 64); } } while (0)
#define GT_STORE(P, Q, buf) do { _Pragma("unroll") for (int i = 0; i < 2; ++i) { const int id = tid + NTHREADS * i; *(u32x4*)((buf) + (id >> 3) * 144 + (id & 7) * 16) = P[i]; } \
        _Pragma("unroll") for (int i = 0; i < QC; ++i) { const int id = tid + NTHREADS * i; *(u32x4*)((buf) + 128 * 144 + (id >> 3) * 144 + (id & 7) * 16) = Q[i]; } } while (0)
#define GT_STEP(kt, PN, QN, PC, QC_) do { if ((kt) < KT) { const unsigned char* cur = lds + ((kt) & 1) * BUF; \
        _Pragma("unroll") for (int ks = 0; ks < 2; ++ks) { bf16x8 af[4], bfr[NI]; \
            _Pragma("unroll") for (int mi = 0; mi < 4; ++mi) af[mi] = ldsfrag(cur, wm * 64 + 16 * mi + c, 144, 32 * ks + 8 * g); \
            _Pragma("unroll") for (int ni = 0; ni < NI; ++ni) bfr[ni] = ldsfrag(cur + 128 * 144, wn * 16 * NI + 16 * ni + c, 144, 32 * ks + 8 * g); \
            _Pragma("unroll") for (int mi = 0; mi < 4; ++mi) _Pragma("unroll") for (int ni = 0; ni < NI; ++ni) acc.a[mi][ni] = mfma16(af[mi], bfr[ni], acc.a[mi][ni]); } \
        if ((kt) + 1 < KT) GT_STORE(PN, QN, lds + (((kt) + 1) & 1) * BUF); \
        GT_LOAD(PC, QC_, (kt) + 4); \
        __syncthreads(); } } while (0)
    GT_LOAD(p0, q0, 0); GT_LOAD(p1, q1, 1); GT_LOAD(p2, q2, 2); GT_LOAD(p3, q3, 3);
    GT_STORE(p0, q0, lds);
    __syncthreads();
    for (int k0 = 0; k0 < KT; k0 += 4) {
        GT_STEP(k0, p1, q1, p0, q0);
        GT_STEP(k0 + 1, p2, q2, p1, q1);
        GT_STEP(k0 + 2, p3, q3, p2, q2);
        GT_STEP(k0 + 3, p0, q0, p3, q3);
    }
#undef GT_LOAD
#undef GT_STORE
#undef GT_STEP
}
struct LinRow { u32 base, ld; DI u32 operator()(int r) const { return base + (u32)r * ld; } };

namespace pg {
constexpr int BM = 256, BK = 64, HALF = 128, HTB = HALF * BK * 2;
DI int lds_byte(int r, int c) { const int st = (r >> 4) * 2 + (c >> 5), rr = r & 15, cc = c & 31, ob = rr * 64 + cc * 2; return st * 1024 + (ob ^ (((ob >> 9) & 1) << 5)); }
DI void stage_rc(int b, int& R, int& C) { const int st = b / 1024, sb = b % 1024, swz = sb ^ (((sb >> 9) & 1) << 5); R = (st >> 1) * 16 + swz / 64; C = (st & 1) * 32 + (swz % 64) / 2; }
DI int perm32(int rho) { const int n = rho >> 4, i = rho & 15; return 8 * (i >> 2) + 4 * n + (i & 3); }
struct Unit { int pm, pn, e, n; };
typedef f32x4 Acc[2][2][4][2];
template <class Sched, class Epi>
DI void gemm(LAS unsigned char* lds, const int K, const Sched& S, const Epi& E) {
    const int tid = tid_opaque(), wid = __builtin_amdgcn_readfirstlane(tid >> 6), lane = tid & 63, wr = wid >> 2, wc = wid & 3, fr = lane & 15, fq = lane >> 4;
    const int nt = K / BK;
    int Rs[2], Cs[2];
    unsigned voffB[2];
#pragma unroll
    for (int i = 0; i < 2; ++i) { stage_rc(tid * 16 + i * 8192, Rs[i], Cs[i]); const int Rb = Epi::PERM ? ((Rs[i] & ~31) + perm32(Rs[i] & 31)) : Rs[i]; voffB[i] = (unsigned)(Rb * K + Cs[i]) * 2u; }
    const size_t kstep = (size_t)(BK * 2);
    const size_t bh1 = S.bh1();
    const unsigned ldsw = (unsigned)wid * 1024u;
    const int aoff = lds_byte(wr * 64 + fr, fq * 8), boff = lds_byte(wc * 32 + fr, fq * 8);
    const char* Ab = S.abase();
#define PG_SA(b, h) (((b) * 2 + (h)) * HTB)
#define PG_SB(b, h) ((4 + (b) * 2 + (h)) * HTB)
#define PG_STAGE(bufoff, gbase, voff) do { _Pragma("unroll") for (int _i = 0; _i < 2; ++_i) \
        __builtin_amdgcn_global_load_lds((const unsigned*)((const char*)(gbase) + (voff)[_i]), (LAS unsigned*)(lds + (bufoff) + ldsw + _i * 8192), 16, 0, 0); } while (0)
#define PG_LDA(dst, b, h) do { _Pragma("unroll") for (int m = 0; m < 4; ++m) _Pragma("unroll") for (int k = 0; k < 2; ++k) dst[m][k] = *(const LAS bf16x8*)(lds + PG_SA(b, h) + aoff + m * 2048 + k * 1024); } while (0)
#define PG_LDB(dst, b, h) do { _Pragma("unroll") for (int n = 0; n < 2; ++n) _Pragma("unroll") for (int k = 0; k < 2; ++k) dst[n][k] = *(const LAS bf16x8*)(lds + PG_SB(b, h) + boff + n * 2048 + k * 1024); } while (0)
#define PG_MMA(ai, bj, At, Bt) do { __builtin_amdgcn_s_setprio(1); _Pragma("unroll") for (int m = 0; m < 4; ++m) _Pragma("unroll") for (int n = 0; n < 2; ++n) _Pragma("unroll") for (int k = 0; k < 2; ++k) \
        acc[ai][bj][m][n] = __builtin_amdgcn_mfma_f32_16x16x32_bf16(Bt[n][k], At[m][k], acc[ai][bj][m][n], 0, 0, 0); __builtin_amdgcn_s_setprio(0); } while (0)
#define PG_WAIT_V(n) asm volatile("s_waitcnt vmcnt(" #n ")" ::: "memory")
#define PG_WAIT_L(n) asm volatile("s_waitcnt lgkmcnt(" #n ")" ::: "memory")
#define PG_BAR __builtin_amdgcn_s_barrier()
#define PG_SCHED __builtin_amdgcn_sched_barrier(0)
#define PG_AOFF(dst, u) do { _Pragma("unroll") for (int h_ = 0; h_ < 2; ++h_) _Pragma("unroll") for (int i_ = 0; i_ < 2; ++i_) dst[h_][i_] = (unsigned)(S.arow(u, h_ * HALF + Rs[i_]) * S.lda() + Cs[i_]) * 2u; } while (0)
    Unit cur, nxt; int ui = 0;
    if (!S.next(0, cur)) return;
    Acc acc;
#pragma unroll
    for (int a = 0; a < 2; ++a)
#pragma unroll
        for (int b = 0; b < 2; ++b)
#pragma unroll
            for (int m = 0; m < 4; ++m)
#pragma unroll
                for (int n = 0; n < 2; ++n) acc[a][b][m][n] = (f32x4){0.f, 0.f, 0.f, 0.f};
    bf16x8 At[4][2], B0[2][2], B1[2][2];
    unsigned aoC[2][2], aoN[2][2];
    PG_AOFF(aoC, cur);
    const char* cB = S.bbase(cur);
    PG_STAGE(PG_SB(0, 0), cB, voffB); PG_STAGE(PG_SA(0, 0), Ab, aoC[0]); PG_STAGE(PG_SB(0, 1), cB + bh1, voffB); PG_STAGE(PG_SA(0, 1), Ab, aoC[1]);
    if (wr == 1) PG_BAR;
    PG_WAIT_V(4); PG_BAR;
    PG_STAGE(PG_SB(1, 0), cB + kstep, voffB); PG_STAGE(PG_SA(1, 0), Ab + kstep, aoC[0]); PG_STAGE(PG_SB(1, 1), cB + bh1 + kstep, voffB);
    PG_WAIT_V(6); PG_BAR;
    for (;;) {
        const bool has_next = S.next(ui + 1, nxt);
        const char* nB = has_next ? S.bbase(nxt) : cB;
        if (has_next) PG_AOFF(aoN, nxt);
        else {
#pragma unroll
            for (int h_ = 0; h_ < 2; ++h_)
#pragma unroll
                for (int i_ = 0; i_ < 2; ++i_) aoN[h_][i_] = aoC[h_][i_];
        }
#pragma unroll 1
        for (int t = 0; t < nt; t += 2) {
            const bool last = (t == nt - 2);
            const char* a1 = Ab + (size_t)(t + 1) * kstep;
            const char* a2 = last ? Ab : Ab + (size_t)(t + 2) * kstep; const char* b2 = last ? nB : cB + (size_t)(t + 2) * kstep;
            const char* a3 = a2 + kstep; const char* b3 = b2 + kstep;
            unsigned o2[2][2];
#pragma unroll
            for (int h_ = 0; h_ < 2; ++h_)
#pragma unroll
                for (int i_ = 0; i_ < 2; ++i_) o2[h_][i_] = last ? aoN[h_][i_] : aoC[h_][i_];
            PG_LDB(B0, 0, 0); PG_SCHED; PG_LDA(At, 0, 0); PG_STAGE(PG_SA(1, 1), a1, aoC[1]);
            PG_WAIT_L(8); PG_BAR; PG_WAIT_L(0); PG_MMA(0, 0, At, B0); PG_BAR; PG_SCHED;
            PG_LDB(B1, 0, 1); PG_STAGE(PG_SB(0, 0), b2, voffB);
            PG_BAR; PG_WAIT_L(0); PG_MMA(0, 1, At, B1); PG_BAR;
            PG_LDA(At, 0, 1); PG_STAGE(PG_SA(0, 0), a2, o2[0]);
            PG_BAR; PG_WAIT_L(0); PG_MMA(1, 0, At, B0); PG_BAR; PG_SCHED;
            PG_STAGE(PG_SB(0, 1), b2 + bh1, voffB);
            PG_WAIT_V(6); PG_BAR; PG_MMA(1, 1, At, B1); PG_BAR;
            PG_LDB(B0, 1, 0); PG_SCHED; PG_LDA(At, 1, 0); PG_STAGE(PG_SA(0, 1), a2, o2[1]);
            PG_WAIT_L(8); PG_BAR; PG_WAIT_L(0); PG_MMA(0, 0, At, B0); PG_BAR; PG_SCHED;
            PG_LDB(B1, 1, 1); PG_STAGE(PG_SB(1, 0), b3, voffB);
            PG_BAR; PG_WAIT_L(0); PG_MMA(0, 1, At, B1); PG_BAR;
            PG_LDA(At, 1, 1); PG_STAGE(PG_SA(1, 0), a3, o2[0]);
            PG_BAR; PG_WAIT_L(0); PG_MMA(1, 0, At, B0); PG_BAR; PG_SCHED;
            PG_STAGE(PG_SB(1, 1), b3 + bh1, voffB);
            PG_WAIT_V(6); PG_BAR; PG_MMA(1, 1, At, B1); PG_BAR;
        }
        E(acc, cur, wr, wc, fr, fq);
        if (!has_next) break;
#pragma unroll
        for (int a = 0; a < 2; ++a)
#pragma unroll
            for (int b = 0; b < 2; ++b)
#pragma unroll
                for (int m = 0; m < 4; ++m)
#pragma unroll
                    for (int n = 0; n < 2; ++n) acc[a][b][m][n] = (f32x4){0.f, 0.f, 0.f, 0.f};
        cur = nxt; cB = nB; ++ui;
#pragma unroll
        for (int h_ = 0; h_ < 2; ++h_)
#pragma unroll
            for (int i_ = 0; i_ < 2; ++i_) aoC[h_][i_] = aoN[h_][i_];
    }
    PG_WAIT_V(0);
    if (wr == 0) PG_BAR;
    PG_BAR;
#undef PG_SA
#undef PG_SB
#undef PG_STAGE
#undef PG_LDA
#undef PG_LDB
#undef PG_MMA
#undef PG_WAIT_V
#undef PG_WAIT_L
#undef PG_BAR
#undef PG_SCHED
#undef PG_AOFF
}
}

DI void conv_small_weights(const Params& p, unsigned char* lds) {
    const int n0 = 16 * 33, n1 = 16 * 8, n2 = 16 * 17, n3 = 16 * 8;
    auto dec = [=](int u) -> ConvJob {
        if (u < n0) return ConvJob{p.gdn_w_in, (u16*)(p.ws + WS_W_IN0), 1024, 4112, u & 15, u >> 4};
        if (u < n0 + n1) { const int v = u - n0; return ConvJob{p.gdn_w_out, (u16*)(p.ws + WS_W_OUT0), 1024, 1024, v & 15, v >> 4}; }
        if (u < n0 + n1 + n2) { const int v = u - n0 - n1; return ConvJob{p.dsa_w_in, (u16*)(p.ws + WS_W_IN1), 1024, 2120, v & 15, v >> 4}; }
        const int v = u - n0 - n1 - n2; return ConvJob{p.dsa_w_out, (u16*)(p.ws + WS_W_OUT1), 1024, 1024, v & 15, v >> 4};
    };
    convT_run(dec, n0 + n1 + n2 + n3, lds);
}
DI void conv_moe_weights(const Params& p, int layer, unsigned char* lds) {
    const int ngu = 32 * 64, ndn = 32 * 32;
    auto dec = [=](int u) -> ConvJob {
        if (u < ngu) { const int e = u >> 6, v = u & 63;
            return ConvJob{p.moe_w_gu + ((size_t)layer * 32 + e) * 1024 * 512, (u16*)(p.ws + WS_P0 + P0_WGU) + (size_t)e * 512 * 1024, 1024, 512, v & 15, v >> 4}; }
        const int w = u - ngu, e = w >> 5, v = w & 31;
        return ConvJob{p.moe_w_down + ((size_t)layer * 32 + e) * 256 * 1024, (u16*)(p.ws + WS_P0 + P0_WDN) + (size_t)e * 1024 * 256, 256, 1024, v & 3, v >> 2};
    };
    convT_run(dec, ngu + ndn, lds);
}
DI void phase_prep(const Params& p, unsigned char* lds) {
    conv_small_weights(p, lds);
    const int lane = tid_opaque() & 63, wid = tid_opaque() >> 6;
    float* H = (float*)(p.ws + WS_H);
    u16* HN = (u16*)(p.ws + WS_HN);
    for (int row = blockIdx.x * 8 + wid; row < TPA; row += gridDim.x * 8) {
        const int b = row / LP, pp = row - b * LP;
        const bool real = row < TP && pp >= 48;
        const float* src = real ? (pp < 64 ? p.meta + (size_t)(pp - 48) * DM : p.x + ((size_t)b * SEQ + (pp - 64)) * DM) : nullptr;
        f32x4 v[4];
        float ss = 0.f;
#pragma unroll
        for (int i = 0; i < 4; ++i) {
            v[i] = real ? *(const f32x4*)(src + 4 * lane + 256 * i) : (f32x4){0.f, 0.f, 0.f, 0.f};
            ss += v[i][0] * v[i][0] + v[i][1] * v[i][1] + v[i][2] * v[i][2] + v[i][3] * v[i][3];
        }
        ss = wave_sum(ss);
        const float rstd = rsqrtf(ss * (1.f / DM) + RMS_EPS);
#pragma unroll
        for (int i = 0; i < 4; ++i) {
            const int col = 4 * lane + 256 * i;
            if (pp < 64 || row >= TP) *(f32x4*)(H + (size_t)row * DM + col) = v[i];
            const f32x4 gn = *(const f32x4*)(p.norm_mix + col);
            u32x2 w; w.x = pk2(v[i][0] * rstd * gn[0], v[i][1] * rstd * gn[1]); w.y = pk2(v[i][2] * rstd * gn[2], v[i][3] * rstd * gn[3]);
            *(u32x2*)(HN + (size_t)row * DM + col) = w;
        }
    }
}

DI int frame_row(int pm, int r) { return (pm >> 5) * LP + 64 + (pm & 31) * 256 + r; }
struct DenseSched {
    const char* A; const char* Bt; int K, npn, total, ldA;
    DI bool next(int i, pg::Unit& u) const { const int L = i * (int)gridDim.x + (int)blockIdx.x; if (L >= total) return false; u.pn = L % npn; u.pm = L / npn; u.e = 0; u.n = 256; return true; }
    DI int arow(const pg::Unit& u, int r) const { return frame_row(u.pm, r); }
    DI const char* abase() const { return A; }
    DI int lda() const { return ldA; }
    DI const char* bbase(const pg::Unit& u) const { return Bt + (size_t)u.pn * 256 * K * 2; }
    DI size_t bh1() const { return (size_t)128 * K * 2; }
};
struct EpiIn0 {
    static constexpr bool PERM = true;
    u16* P0; u16* HALO;
    DI void store(int row, int col, u32x4 w) const {
        *(u32x4*)(P0 + (size_t)row * 4096 + col) = w;
        if (col < 3072) { const int bb = row / LP, pp = row - bb * LP;
            if ((pp & 63) >= 61 && (pp >> 6) < 128) *(u32x4*)(HALO + ((size_t)(bb * 129 + (pp >> 6) + 1) * 3 + ((pp & 63) - 61)) * 3072 + col) = w; }
    }
    DI void operator()(const pg::Acc& acc, const pg::Unit& u, int wr, int wc, int fr, int fq) const {
#pragma unroll
        for (int ai = 0; ai < 2; ++ai)
#pragma unroll
            for (int m = 0; m < 4; ++m) {
                const int row = frame_row(u.pm, 128 * ai + 64 * wr + 16 * m + fr);
#pragma unroll
                for (int bj = 0; bj < 2; ++bj) {
                    const f32x4 v0 = acc[ai][bj][m][0], v1 = acc[ai][bj][m][1];
                    u32x4 w; w.x = pk2(v0[0], v0[1]); w.y = pk2(v0[2], v0[3]); w.z = pk2(v1[0], v1[1]); w.w = pk2(v1[2], v1[3]);
                    store(row, 256 * u.pn + 128 * bj + 32 * wc + 8 * fq, w);
                }
            }
    }
};
DI void phase_gemm_in0(const Params& p, unsigned char* lds) {
    const u16* W = (const u16*)(p.ws + WS_W_IN0);
    const u16* X = (const u16*)(p.ws + WS_HN);
    u16* P0 = (u16*)(p.ws + WS_P0);
    float* BA = (float*)(p.ws + WS_BA);
    u16* HALO = (u16*)(p.ws + WS_HALO);
    {
        DenseSched S{(const char*)X, (const char*)W, 1024, 16, 64 * 16, 1024};
        EpiIn0 E{P0, HALO};
        pg::gemm((LAS unsigned char*)lds, 1024, S, E);
    }
    __syncthreads();
    const int lane = tid_opaque() & 63, wid = tid_opaque() >> 6, c = lane & 15, g = lane >> 4, wm = wid >> 2, wn = wid & 3;
    for (int t = blockIdx.x; t < 64 + 130; t += gridDim.x) {
        const bool lead = t < 64;
        const int mt = lead ? (t & 31) : 32;
        const int row0 = lead ? (t >> 5) * LP : (t - 64) * 128;
        GemmAcc<2> acc;
        gemm_tile<2>(W, X, 16, LinRow{(u32)(mt * 128) * 1024u, 1024u}, LinRow{(u32)row0 * 1024u, 1024u}, acc, lds);
#pragma unroll
        for (int mi = 0; mi < 4; ++mi) {
            const int f = mt * 128 + wm * 64 + 16 * mi + 4 * g;
#pragma unroll
            for (int ni = 0; ni < 2; ++ni) {
                const int tok = row0 + wn * 32 + 16 * ni + c;
                const f32x4 v = acc.a[mi][ni];
                if (lead) { if (tok - row0 < 64) { u32x2 w; w.x = pk2(v[0], v[1]); w.y = pk2(v[2], v[3]); *(u32x2*)(P0 + (size_t)tok * 4096 + f) = w;
                        if (f < 3072 && tok - row0 >= 61) *(u32x2*)(HALO + ((size_t)((t >> 5) * 129 + 1) * 3 + (tok - row0 - 61)) * 3072 + f) = w; } }
                else if (f < 4112) *(f32x4*)(BA + (size_t)tok * 16 + (f - 4096)) = v;
            }
        }
    }
}
template <bool FROMX>
struct EpiOut {
    static constexpr bool PERM = false;
    float* H; const float* X;
    DI void operator()(const pg::Acc& acc, const pg::Unit& u, int wr, int wc, int fr, int fq) const {
#pragma unroll
        for (int ai = 0; ai < 2; ++ai)
#pragma unroll
            for (int m = 0; m < 4; ++m) {
                const int r = 128 * ai + 64 * wr + 16 * m + fr, co = 256 * u.pn + 32 * wc + 4 * fq;
                float* hp = H + (size_t)frame_row(u.pm, r) * DM + co;
                const float* sp = FROMX ? X + ((size_t)(u.pm >> 5) * SEQ + (u.pm & 31) * 256 + r) * DM + co : hp;
#pragma unroll
                for (int bj = 0; bj < 2; ++bj)
#pragma unroll
                    for (int n = 0; n < 2; ++n) { *(f32x4*)(hp + 128 * bj + 16 * n) = *(const f32x4*)(sp + 128 * bj + 16 * n) + acc[ai][bj][m][n]; }
            }
    }
};
template <bool FROMX>
DI void phase_gemm_out(const Params& p, const u16* W, const u16* X, const int ldx, unsigned char* lds) {
    float* H = (float*)(p.ws + WS_H);
    {
        DenseSched S{(const char*)X, (const char*)W, 1024, 4, 64 * 4, ldx};
        EpiOut<FROMX> E{H, p.x};
        pg::gemm((LAS unsigned char*)lds, 1024, S, E);
    }
    __syncthreads();
    const int lane = tid_opaque() & 63, wid = tid_opaque() >> 6, c = lane & 15, g = lane >> 4, wm = wid >> 2, wn = wid & 3;
    for (int t = (int)gridDim.x - 1 - (int)blockIdx.x; t < 16; t += gridDim.x) {
        const int mt = t & 7, row0 = (t >> 3) * LP;
        GemmAcc<2> acc;
        gemm_tile<2>(W, X, 16, LinRow{(u32)(mt * 128) * 1024u, 1024u}, LinRow{(u32)row0 * (u32)ldx, (u32)ldx}, acc, lds);
#pragma unroll
        for (int mi = 0; mi < 4; ++mi) {
            const int f = mt * 128 + wm * 64 + 16 * mi + 4 * g;
#pragma unroll
            for (int ni = 0; ni < 2; ++ni) {
                const int tok = row0 + wn * 32 + 16 * ni + c;
                if (tok - row0 < 64) { f32x4* hp = (f32x4*)(H + (size_t)tok * DM + f); *hp = *hp + acc.a[mi][ni]; }
            }
        }
    }
}
struct EpiIn1 {
    static constexpr bool PERM = true;
    u16* QRAW; float* KRAW; unsigned char* VN; _Float16* QI;
    DI void operator()(const pg::Acc& acc, const pg::Unit& u, int wr, int wc, int fr, int fq) const {
#pragma unroll
        for (int ai = 0; ai < 2; ++ai)
#pragma unroll
            for (int m = 0; m < 4; ++m) {
                const size_t row = (size_t)frame_row(u.pm, 128 * ai + 64 * wr + 16 * m + fr);
#pragma unroll
                for (int bj = 0; bj < 2; ++bj) {
                    const f32x4 v0 = acc[ai][bj][m][0], v1 = acc[ai][bj][m][1];
                    const int cl = 128 * bj + 32 * wc + 8 * fq;
                    if (u.pn < 4) { u32x4 w; w.x = pk2(v0[0], v0[1]); w.y = pk2(v0[2], v0[3]); w.z = pk2(v1[0], v1[1]); w.w = pk2(v1[2], v1[3]); *(u32x4*)(QRAW + row * 1024 + 256 * u.pn + cl) = w; }
                    else if (u.pn == 4) { *(f32x4*)(KRAW + row * 256 + cl) = v0; *(f32x4*)(KRAW + row * 256 + cl + 4) = v1; }
                    else if (u.pn == 5) { u32x2 w; w.x = pk4_fp8(v0[0], v0[1], v0[2], v0[3]); w.y = pk4_fp8(v1[0], v1[1], v1[2], v1[3]); *(u32x2*)(VN + row * 256 + cl) = w; }
                    else { f16x8 h8; h8[0] = (_Float16)v0[0]; h8[1] = (_Float16)v0[1]; h8[2] = (_Float16)v0[2]; h8[3] = (_Float16)v0[3]; h8[4] = (_Float16)v1[0]; h8[5] = (_Float16)v1[1]; h8[6] = (_Float16)v1[2]; h8[7] = (_Float16)v1[3];
                        *(f16x8*)(QI + row * 512 + 256 * (u.pn - 6) + cl) = h8; }
                }
            }
    }
};
DI void phase_gemm_in1(const Params& p, unsigned char* lds) {
    const u16* W = (const u16*)(p.ws + WS_W_IN1);
    const u16* X = (const u16*)(p.ws + WS_HN);
    u16* QRAW = (u16*)(p.ws + WS_P0 + P0_QRAW);
    float* KRAW = (float*)(p.ws + WS_P0 + P0_KRAW);
    unsigned char* VN = p.ws + WS_P0 + P0_VN;
    _Float16* QI = (_Float16*)(p.ws + WS_P0 + P0_QI);
    float* KIRAW = (float*)((unsigned char*)p.out + DO_KIRAW);
    float* WI = (float*)((unsigned char*)p.out + DO_WI);
    {
        DenseSched S{(const char*)X, (const char*)W, 1024, 8, 64 * 8, 1024};
        EpiIn1 E{QRAW, KRAW, VN, QI};
        pg::gemm((LAS unsigned char*)lds, 1024, S, E);
    }
    __syncthreads();
    const int lane = tid_opaque() & 63, wid = tid_opaque() >> 6, c = lane & 15, g = lane >> 4, wm = wid >> 2, wn = wid & 3;
    for (int t = blockIdx.x; t < 32 + 130; t += gridDim.x) {
        const bool lead = t < 32;
        const int mt = lead ? (t & 15) : 16;
        const int row0 = lead ? (t >> 4) * LP : (t - 32) * 128;
        GemmAcc<2> acc;
        gemm_tile<2>(W, X, 16, LinRow{(u32)(mt * 128) * 1024u, 1024u}, LinRow{(u32)row0 * 1024u, 1024u}, acc, lds);
#pragma unroll
        for (int mi = 0; mi < 4; ++mi) {
            const int f = mt * 128 + wm * 64 + 16 * mi + 4 * g;
#pragma unroll
            for (int ni = 0; ni < 2; ++ni) {
                const int tok = row0 + wn * 32 + 16 * ni + c;
                if (tok >= TP || (lead && tok - row0 >= 64)) continue;
                const f32x4 v = acc.a[mi][ni];
                if (f < 1024) { u32x2 w; w.x = pk2(v[0], v[1]); w.y = pk2(v[2], v[3]); *(u32x2*)(QRAW + (size_t)tok * 1024 + f) = w; }
                else if (f < 1280) *(f32x4*)(KRAW + (size_t)tok * 256 + (f - 1024)) = v;
                else if (f < 1536) *(u32*)(VN + (size_t)tok * 256 + (f - 1280)) = pk4_fp8(v[0], v[1], v[2], v[3]);
                else if (f < 2048) {
                    _Float16* q = QI + (size_t)tok * 512 + (f - 1536);
                    q[0] = (_Float16)v[0]; q[1] = (_Float16)v[1]; q[2] = (_Float16)v[2]; q[3] = (_Float16)v[3];
                }
                else if (f < 2112) *(f32x4*)(KIRAW + (size_t)tok * 64 + (f - 2048)) = v;
                else if (f < 2120) *(f32x4*)(WI + (size_t)tok * 8 + (f - 2112)) = v * 0.04419417382415922f;
            }
        }
    }
}

constexpr int G_KT = 0, G_QT = 17408, G_KRT = 34816, G_VRT = 53248, G_LF = 71680, G_TF = 88320, G_TMP = 104960, G_TTW = 109184, G_TTU = 118400,
              G_QKT = 127616, G_SC = 136832;
constexpr int G_WT = G_LF, G_UT = G_LF + 18432;
constexpr int G_ST = G_KRT;
static_assert(G_UT + 18432 <= G_TTW, "WT/UT alias");
DI void gdn_prep_unit(const Params& p, int bh, int ch, unsigned char* lds) {
    const int tid = tid_opaque(), lane = tid & 63, wid = tid >> 6, c = lane & 15, g = lane >> 4;
    const int b = bh >> 3, h = bh & 7;
    const size_t row0 = (size_t)b * LP + (size_t)ch * 64;
    u16* P0 = (u16*)(p.ws + WS_P0);
    const u16* HALO = (const u16*)(p.ws + WS_HALO);
    float* SC = (float*)(lds + G_SC);
    float bb = 0.f, aa = 0.f;
    if (wid == 7) { const float* BA = (const float*)(p.ws + WS_BA); bb = BA[(row0 + lane) * 16 + h]; aa = BA[(row0 + lane) * 16 + 8 + h]; }
    {
        const int cp = tid & 63, part = tid >> 6;
        u32 raw[3][11];
#pragma unroll
        for (int X = 0; X < 3; ++X) {
            const int col = X * 1024 + h * 128 + 2 * cp;
#pragma unroll
            for (int i = 0; i < 11; ++i) {
                const int rr = 8 * part - 3 + i;
                raw[X][i] = rr < 0 ? (ch == 0 ? 0u : *(const u32*)(HALO + ((size_t)(b * 129 + ch) * 3 + (rr + 3)) * 3072 + col)) : *(const u32*)(P0 + (row0 + rr) * 4096 + col);
            }
        }
        if (wid == 7) {
            const float beta = 1.f / (1.f + __expf(-bb));
            const float xs = aa + p.gdn_dt_bias[h];
            const float sp = xs > 20.f ? xs : log1pf(__expf(xs));
            const float gg = -__expf(p.gdn_a_log[h]) * sp;
            float gc = gg;
#pragma unroll
            for (int o = 1; o < 64; o <<= 1) { const float t = __shfl_up(gc, o); if (lane >= o) gc += t; }
            const float glast = __shfl(gc, 63);
            SC[lane] = gc; SC[64 + lane] = beta; SC[128 + lane] = __expf(gc); SC[192 + lane] = __expf(glast - gc);
            if (lane == 0) SC[384] = __expf(glast);
        }
#pragma unroll
        for (int X = 0; X < 3; ++X) {
            u32 o[8];
            f32x2 wv[4];
#pragma unroll
            for (int j = 0; j < 4; ++j) wv[j] = *(const f32x2*)(p.gdn_conv + j * 3072 + X * 1024 + h * 128 + 2 * cp);
#pragma unroll
            for (int i = 0; i < 8; ++i) {
                const float a0 = wv[0][0] * bflo(raw[X][i]) + wv[1][0] * bflo(raw[X][i + 1]) + wv[2][0] * bflo(raw[X][i + 2]) + wv[3][0] * bflo(raw[X][i + 3]);
                const float a1 = wv[0][1] * bfhi(raw[X][i]) + wv[1][1] * bfhi(raw[X][i + 1]) + wv[2][1] * bfhi(raw[X][i + 2]) + wv[3][1] * bfhi(raw[X][i + 3]);
                o[i] = pk2(silu(a0), silu(a1));
            }
            if (X < 2) {
                u16* T = (u16*)(lds + (X == 0 ? G_QT : G_KT));
#pragma unroll
                for (int i = 0; i < 8; ++i) *(u32*)(T + (8 * part + i) * 136 + 2 * cp) = o[i];
            }
            if (X >= 1) {
                u16* T = (u16*)(lds + (X == 1 ? G_KRT : G_VRT));
                u32x4 lo, hi;
                lo.x = (o[0] & 0xffffu) | (o[1] << 16); lo.y = (o[2] & 0xffffu) | (o[3] << 16); lo.z = (o[4] & 0xffffu) | (o[5] << 16); lo.w = (o[6] & 0xffffu) | (o[7] << 16);
                hi.x = (o[0] >> 16) | (o[1] & 0xffff0000u); hi.y = (o[2] >> 16) | (o[3] & 0xffff0000u); hi.z = (o[4] >> 16) | (o[5] & 0xffff0000u); hi.w = (o[6] >> 16) | (o[7] & 0xffff0000u);
                *(u32x4*)(T + (2 * cp) * 72 + 8 * part) = lo; *(u32x4*)(T + (2 * cp + 1) * 72 + 8 * part) = hi;
            }
        }
    }
    { float* TF = (float*)(lds + G_TF); for (int i = tid; i < 64 * 65; i += NTHREADS) TF[i] = 0.f; }
    __syncthreads();
    {
        const int rt = wid & 3;
        const unsigned char* Arow = lds + (wid < 4 ? G_KT : G_QT);
        f32x4 acc[4], qq = (f32x4){0.f, 0.f, 0.f, 0.f};
#pragma unroll
        for (int ni = 0; ni < 4; ++ni) acc[ni] = (f32x4){0.f, 0.f, 0.f, 0.f};
#pragma unroll
        for (int ks = 0; ks < 4; ++ks) {
            const bf16x8 a = ldsfrag(Arow, 16 * rt + c, 272, 32 * ks + 8 * g);
#pragma unroll
            for (int ni = 0; ni < 4; ++ni) acc[ni] = mfma16(a, ldsfrag(lds + G_KT, 16 * ni + c, 272, 32 * ks + 8 * g), acc[ni]);
            if (wid >= 4) qq = mfma16(a, a, qq);
        }
        {
            const f32x4 kd_ = rt == 0 ? acc[0] : (rt == 1 ? acc[1] : (rt == 2 ? acc[2] : acc[3]));
            const f32x4 d = (wid < 4) ? kd_ : qq;
            if (g == (c >> 2)) {
                const int r = c & 3;
                const float dv = r == 0 ? d[0] : (r == 1 ? d[1] : (r == 2 ? d[2] : d[3]));
                SC[(wid < 4 ? 256 : 320) + 16 * rt + c] = rsqrtf(dv + 1e-6f);
            }
        }
        __syncthreads();
        float* LF = (float*)(lds + G_LF);
        u16* QKT = (u16*)(lds + G_QKT);
#pragma unroll
        for (int ni = 0; ni < 4; ++ni) {
            const int j = 16 * ni + c;
            const float gcj = SC[j], rkj = SC[256 + j];
#pragma unroll
            for (int r = 0; r < 4; ++r) {
                const int i = 16 * rt + 4 * g + r;
                const float gci = SC[i];
                if (wid < 4) {
                    const float v = (i > j) ? SC[64 + i] * SC[256 + i] * rkj * acc[ni][r] * __expf(gci - gcj) : 0.f;
                    LF[i * 65 + j] = v;
                } else {
                    const float v = (i >= j) ? SC[320 + i] * 0.08838834764831845f * rkj * acc[ni][r] * __expf(gci - gcj) : 0.f;
                    QKT[i * 72 + j] = f2bf(v);
                }
            }
        }
    }
    __syncthreads();
    {
        const float* LF = (const float*)(lds + G_LF);
        float* TF = (float*)(lds + G_TF);
        float* TMP = (float*)(lds + G_TMP);
        if (wid == 0) {
            const int b4 = lane >> 4, j = lane & 15;
            float t[16];
#pragma unroll
            for (int i = 0; i < 16; ++i) {
                float s = (i == j) ? 1.f : 0.f;
#pragma unroll
                for (int m = 0; m < i; ++m) s -= LF[(16 * b4 + i) * 65 + 16 * b4 + m] * t[m];
                t[i] = s;
            }
#pragma unroll
            for (int i = 0; i < 16; ++i) TF[(16 * b4 + i) * 65 + 16 * b4 + j] = t[i];
        }
        __syncthreads();
        {
            const int pp = tid >> 8, i = (tid >> 4) & 15, j = tid & 15;
            float s = 0.f;
#pragma unroll
            for (int m = 0; m < 16; ++m) s += LF[(16 * (2 * pp + 1) + i) * 65 + 32 * pp + m] * TF[(32 * pp + m) * 65 + 32 * pp + j];
            TMP[pp * 256 + i * 16 + j] = s;
            __syncthreads();
            float x = 0.f;
#pragma unroll
            for (int m = 0; m < 16; ++m) x -= TF[(16 * (2 * pp + 1) + i) * 65 + 16 * (2 * pp + 1) + m] * TMP[pp * 256 + m * 16 + j];
            TF[(16 * (2 * pp + 1) + i) * 65 + 32 * pp + j] = x;
        }
        __syncthreads();
        {
            const int i = tid >> 4, j0 = tid & 15;
            float s0 = 0.f, s1 = 0.f;
#pragma unroll
            for (int m = 0; m < 32; ++m) { const float l = LF[(32 + i) * 65 + m]; s0 += l * TF[m * 65 + j0]; s1 += l * TF[m * 65 + j0 + 16]; }
            __syncthreads();
            TMP[i * 33 + j0] = s0; TMP[i * 33 + j0 + 16] = s1;
            __syncthreads();
            float x0 = 0.f, x1 = 0.f;
#pragma unroll
            for (int m = 0; m < 32; ++m) { const float tt = TF[(32 + i) * 65 + 32 + m]; x0 -= tt * TMP[m * 33 + j0]; x1 -= tt * TMP[m * 33 + j0 + 16]; }
            TF[(32 + i) * 65 + j0] = x0; TF[(32 + i) * 65 + j0 + 16] = x1;
        }
        __syncthreads();
        u16* TTW = (u16*)(lds + G_TTW);
        u16* TTU = (u16*)(lds + G_TTU);
#pragma unroll
        for (int i = 0; i < 8; ++i) {
            const int e = tid + NTHREADS * i, t = e >> 6, s = e & 63;
            const float tv = (s <= t) ? TF[t * 65 + s] : 0.f;
            const float bs = SC[64 + s];
            TTW[t * 72 + s] = f2bf(tv * bs * SC[256 + s] * SC[128 + s]);
            TTU[t * 72 + s] = f2bf(tv * bs);
        }
    }
    __syncthreads();
    {
        const int tt = wid & 3, isu = wid >> 2;
        f32x4 acc[8];
#pragma unroll
        for (int ni = 0; ni < 8; ++ni) acc[ni] = (f32x4){0.f, 0.f, 0.f, 0.f};
        const unsigned char* A = lds + (isu ? G_TTU : G_TTW);
        const unsigned char* Bt = lds + (isu ? G_VRT : G_KRT);
#pragma unroll
        for (int ks = 0; ks < 2; ++ks) {
            const bf16x8 a = ldsfrag(A, 16 * tt + c, 144, 32 * ks + 8 * g);
#pragma unroll
            for (int ni = 0; ni < 8; ++ni) acc[ni] = mfma16(a, ldsfrag(Bt, 16 * ni + c, 144, 32 * ks + 8 * g), acc[ni]);
        }
        __syncthreads();
        u16* WU = (u16*)(lds + (isu ? G_UT : G_WT));
        const int t0 = 16 * tt + 4 * g;
#pragma unroll
        for (int ni = 0; ni < 8; ++ni) {
            u32x2 w; w.x = pk2(acc[ni][0], acc[ni][1]); w.y = pk2(acc[ni][2], acc[ni][3]);
            *(u32x2*)(WU + (16 * ni + c) * 72 + t0) = w;
        }
    }
    __syncthreads();
    {
        f32x4 acc[4];
#pragma unroll
        for (int ni = 0; ni < 4; ++ni) acc[ni] = (f32x4){0.f, 0.f, 0.f, 0.f};
#pragma unroll
        for (int ks = 0; ks < 2; ++ks) {
            const bf16x8 a = ldsfrag(lds + G_WT, 16 * wid + c, 144, 32 * ks + 8 * g);
#pragma unroll
            for (int ni = 0; ni < 4; ++ni) acc[ni] = mfma16(a, ldsfrag(lds + G_QKT, 16 * ni + c, 144, 32 * ks + 8 * g), acc[ni]);
        }
        u16* QT = (u16*)(lds + G_QT);
#pragma unroll
        for (int ni = 0; ni < 4; ++ni) {
            const int t = 16 * ni + c, j0 = 16 * wid + 4 * g;
            const float qs = SC[320 + t] * 0.08838834764831845f * SC[128 + t];
            u32x2* qp = (u32x2*)(QT + t * 136 + j0);
            const u32x2 q = *qp;
            u32x2 w;
            w.x = pk2(bflo(q.x) * qs - acc[ni][0], bfhi(q.x) * qs - acc[ni][1]);
            w.y = pk2(bflo(q.y) * qs - acc[ni][2], bfhi(q.y) * qs - acc[ni][3]);
            *qp = w;
        }
    }
    {
        const int tt = wid & 3, dvh = wid >> 2;
        f32x4 acc[4];
#pragma unroll
        for (int ni = 0; ni < 4; ++ni) acc[ni] = (f32x4){0.f, 0.f, 0.f, 0.f};
#pragma unroll
        for (int ks = 0; ks < 2; ++ks) {
            const bf16x8 a = ldsfrag(lds + G_QKT, 16 * tt + c, 144, 32 * ks + 8 * g);
#pragma unroll
            for (int ni = 0; ni < 4; ++ni) acc[ni] = mfma16(a, ldsfrag(lds + G_UT, 16 * (4 * dvh + ni) + c, 144, 32 * ks + 8 * g), acc[ni]);
        }
        u16* KT = (u16*)(lds + G_KT);
#pragma unroll
        for (int ni = 0; ni < 4; ++ni)
#pragma unroll
            for (int r = 0; r < 4; ++r) KT[(16 * tt + 4 * g + r) * 136 + 16 * (4 * dvh + ni) + c] = f2bf(acc[ni][r]);
    }
    __syncthreads();
    {
#pragma unroll
        for (int i = 0; i < 2; ++i) {
            const int id = tid + NTHREADS * i, t = id >> 4, ck = id & 15;
            *(u32x4*)(P0 + (row0 + t) * 4096 + h * 128 + 8 * ck) = *(const u32x4*)(lds + G_QT + t * 272 + ck * 16);
            *(u32x4*)(P0 + (row0 + t) * 4096 + 1024 + h * 128 + 8 * ck) = *(const u32x4*)(lds + G_KT + t * 272 + ck * 16);
        }
        const int dim = tid >> 2, s0 = (tid & 3) * 16;
        float sc[16];
#pragma unroll
        for (int i = 0; i < 16; ++i) sc[i] = SC[256 + s0 + i] * SC[192 + s0 + i];
#pragma unroll
        for (int X = 0; X < 2; ++X) {
            u32x4* tp = (u32x4*)(lds + (X ? G_UT : G_WT) + dim * 144 + s0 * 2);
#pragma unroll
            for (int hf = 0; hf < 2; ++hf) {
                u32x4 w = tp[hf];
                w.x = pk2(bflo(w.x) * sc[8 * hf + 0], bfhi(w.x) * sc[8 * hf + 1]); w.y = pk2(bflo(w.y) * sc[8 * hf + 2], bfhi(w.y) * sc[8 * hf + 3]);
                w.z = pk2(bflo(w.z) * sc[8 * hf + 4], bfhi(w.z) * sc[8 * hf + 5]); w.w = pk2(bflo(w.w) * sc[8 * hf + 6], bfhi(w.w) * sc[8 * hf + 7]);
                tp[hf] = w;
            }
        }
    }
    LDS_BARRIER();
    {
        {
            f32x4 acc[8];
#pragma unroll
            for (int ni = 0; ni < 8; ++ni) acc[ni] = (f32x4){0.f, 0.f, 0.f, 0.f};
#pragma unroll
            for (int ks = 0; ks < 2; ++ks) {
                const bf16x8 a = ldsfrag(lds + G_WT, 16 * wid + c, 144, 32 * ks + 8 * g);
#pragma unroll
                for (int ni = 0; ni < 8; ++ni) acc[ni] = mfma16(a, ldsfrag(lds + G_KRT, 16 * ni + c, 144, 32 * ks + 8 * g), acc[ni]);
            }
            if (ch > 0) {
                u16* Mg = (u16*)((unsigned char*)p.out + DO_M) + ((size_t)bh * 128 + (ch - 1)) * 16384;
                const float cd = SC[384];
                const int gp = ((g & 1) << 1) | (g >> 1);
#pragma unroll
                for (int ni = 0; ni < 8; ++ni) {
                    const int i = 16 * ni + c, j0 = 16 * wid + 4 * g;
                    float v[4];
#pragma unroll
                    for (int r = 0; r < 4; ++r) v[r] = ((i == j0 + r) ? cd : 0.f) - acc[ni][r];
                    u32x2 w; w.x = pk2(v[0], v[1]); w.y = pk2(v[2], v[3]);
                    *(u32x2*)(Mg + (size_t)i * 128 + 16 * wid + 4 * gp) = w;
                }
            }
        }
        {
            f32x4 acc[8];
#pragma unroll
            for (int ni = 0; ni < 8; ++ni) acc[ni] = (f32x4){0.f, 0.f, 0.f, 0.f};
#pragma unroll
            for (int ks = 0; ks < 2; ++ks) {
                const bf16x8 a = ldsfrag(lds + G_KRT, 16 * wid + c, 144, 32 * ks + 8 * g);
#pragma unroll
                for (int ni = 0; ni < 8; ++ni) acc[ni] = mfma16(a, ldsfrag(lds + G_UT, 16 * ni + c, 144, 32 * ks + 8 * g), acc[ni]);
            }
            u16* NT = (u16*)(p.ws + WS_NS) + ((size_t)bh * NCH + ch) * 16384;
#pragma unroll
            for (int ni = 0; ni < 8; ++ni) {
                u32x2 w; w.x = pk2(acc[ni][0], acc[ni][1]); w.y = pk2(acc[ni][2], acc[ni][3]);
                *(u32x2*)(NT + ((size_t)(4 * wid + g) * 128 + 16 * ni + c) * 4) = w;
            }
        }
    }
    LDS_BARRIER();
}
constexpr int GO_QE = 0, GO_O0 = 17408, GO_ST = 34816, GO_SC = 69632;
DI void gdn_out_unit(const Params& p, int bh, int ch, unsigned char* lds) {
    const int tid = tid_opaque(), lane = tid & 63, wid = tid >> 6, c = lane & 15, g = lane >> 4;
    const int b = bh >> 3, h = bh & 7;
    const size_t row0 = (size_t)b * LP + (size_t)ch * 64;
    const u16* P0 = (const u16*)(p.ws + WS_P0);
    float* SC = (float*)(lds + GO_SC);
#pragma unroll
    for (int i = 0; i < 2; ++i) {
        const int id = tid + NTHREADS * i, t = id >> 4, ck = id & 15;
        *(u32x4*)(lds + GO_QE + t * 272 + ck * 16) = *(const u32x4*)(P0 + (row0 + t) * 4096 + h * 128 + 8 * ck);
        *(u32x4*)(lds + GO_O0 + t * 272 + ck * 16) = *(const u32x4*)(P0 + (row0 + t) * 4096 + 1024 + h * 128 + 8 * ck);
    }
    if (ch > 0) {
        const u16* ST = (const u16*)(p.ws + WS_NS) + ((size_t)bh * NCH + (ch - 1)) * 16384;
#pragma unroll
        for (int i = 0; i < 4; ++i) { const int id = tid + NTHREADS * i, i4 = id >> 6, dvp = id & 63;
            const u32x4 w = *(const u32x4*)(ST + (size_t)id * 8);
            *(u32x2*)(lds + GO_ST + (2 * dvp) * 272 + i4 * 8) = (u32x2){w.x, w.y};
            *(u32x2*)(lds + GO_ST + (2 * dvp + 1) * 272 + i4 * 8) = (u32x2){w.z, w.w}; }
    }
    const int tt = wid & 3, dvh = wid >> 2;
    u16 zr[4][4]; float gn[4];
#pragma unroll
    for (int ni = 0; ni < 4; ++ni) {
        const int dv = 16 * (4 * dvh + ni) + c;
        gn[ni] = p.gdn_o_norm[dv];
#pragma unroll
        for (int r = 0; r < 4; ++r) zr[ni][r] = P0[(row0 + 16 * tt + 4 * g + r) * 4096 + 3072 + h * 128 + dv];
    }
    __syncthreads();
    f32x4 acc[4];
    const u16* O0 = (const u16*)(lds + GO_O0);
#pragma unroll
    for (int ni = 0; ni < 4; ++ni)
#pragma unroll
        for (int r = 0; r < 4; ++r) acc[ni][r] = bf2f(O0[(16 * tt + 4 * g + r) * 136 + 16 * (4 * dvh + ni) + c]);
    if (ch > 0) {
#pragma unroll
        for (int ks = 0; ks < 4; ++ks) {
            const bf16x8 a = ldsfrag(lds + GO_QE, 16 * tt + c, 272, 32 * ks + 8 * g);
#pragma unroll
            for (int ni = 0; ni < 4; ++ni) acc[ni] = mfma16(a, ldsfrag(lds + GO_ST, 16 * (4 * dvh + ni) + c, 272, 32 * ks + 8 * g), acc[ni]);
        }
    }
    float ss[4];
#pragma unroll
    for (int r = 0; r < 4; ++r) {
        float s = 0.f;
#pragma unroll
        for (int ni = 0; ni < 4; ++ni) s += acc[ni][r] * acc[ni][r];
        s += __shfl_xor(s, 1); s += __shfl_xor(s, 2); s += __shfl_xor(s, 4); s += __shfl_xor(s, 8);
        ss[r] = s;
    }
    if (c == 0) {
#pragma unroll
        for (int r = 0; r < 4; ++r) SC[dvh * 64 + 16 * tt + 4 * g + r] = ss[r];
    }
    __syncthreads();
    u16* OG = (u16*)(p.ws + WS_P0) + 2048;
#pragma unroll
    for (int r = 0; r < 4; ++r) {
        const int t = 16 * tt + 4 * g + r;
        const float rstd = rsqrtf((SC[t] + SC[64 + t]) * (1.f / 128.f) + RMS_EPS);
#pragma unroll
        for (int ni = 0; ni < 4; ++ni) {
            const int dv = 16 * (4 * dvh + ni) + c;
            const float z = bf2f(zr[ni][r]);
            OG[(row0 + t) * 4096 + h * 128 + dv] = f2bf(acc[ni][r] * rstd * gn[ni] * silu(z));
        }
    }
    LDS_BARRIER();
}
DI void phase_gdn_prep(const Params& p, unsigned char* lds) {
    for (int u = blockIdx.x; u < 16 * 128; u += gridDim.x) gdn_prep_unit(p, u >> 7, u & 127, lds);
}
DI void phase_gdn_out(const Params& p, unsigned char* lds) {
    for (int u = blockIdx.x; u < 16 * NCH; u += gridDim.x) gdn_out_unit(p, u / NCH, u % NCH, lds);
}

DI void scan_loadM(u32x4 (&r)[8], const u16* Mg, int j, int t4) {
    if (j <= 127) {
        const u16* src = Mg + (size_t)(j - 1) * 16384;
#pragma unroll
        for (int i = 0; i < 8; ++i) { const int id = t4 + 256 * i; r[i] = *(const u32x4*)(src + (size_t)(id >> 4) * 128 + (id & 15) * 8); }
    }
}
DI void scan_storeM(const u32x4 (&r)[8], unsigned char* slot, int t4) {
#pragma unroll
    for (int i = 0; i < 8; ++i) { const int id = t4 + 256 * i; *(u32x4*)(slot + (id >> 4) * 272 + (id & 15) * 16) = r[i]; }
}
DI void scan_loadNq(u32x4 (&r)[8], const u16* NSb, int j, int lane) {
    if (j <= 127) {
        const u16* s0 = NSb + (size_t)j * 16384;
#pragma unroll
        for (int k = 0; k < 8; ++k) { const int id = lane + 64 * k; r[k] = *(const u32x4*)(s0 + (id >> 4) * 512 + (id & 15) * 8); }
    }
}
#define SCAN_BAR() do { asm volatile("s_waitcnt lgkmcnt(0)" ::: "memory"); __builtin_amdgcn_s_barrier(); asm volatile("" ::: "memory"); } while (0)
DI void scan_loadM2(u32x4 (&r)[16], const u16* Mg, int j, int t2) {
    if (j <= 127) {
        const u16* src = Mg + (size_t)(j - 1) * 16384;
#pragma unroll
        for (int i = 0; i < 16; ++i) { const int id = t2 + 128 * i; r[i] = *(const u32x4*)(src + (size_t)(id >> 4) * 128 + (id & 15) * 8); }
    }
}
DI void scan_storeM2(const u32x4 (&r)[16], unsigned char* slot, int t2) {
#pragma unroll
    for (int i = 0; i < 16; ++i) { const int id = t2 + 128 * i; *(u32x4*)(slot + (id >> 4) * 272 + (id & 15) * 16) = r[i]; }
}
DI void phase_gdn_scan(const Params& p, unsigned char* lds, const int C0, const int C1) {
    int bh = blockIdx.x & 15, dvq = blockIdx.x >> 4;
    asm volatile("" : "+s"(bh), "+s"(dvq));
    const int tid = tid_opaque(), lane = tid & 63, wid = __builtin_amdgcn_readfirstlane(tid >> 6), col = lane & 31, hh = lane >> 5;
    const u16* Mg = (const u16*)((unsigned char*)p.out + DO_M) + (size_t)bh * 128 * 16384;
    u16* NSb = (u16*)(p.ws + WS_NS) + (size_t)bh * NCH * 16384 + (size_t)(32 * dvq) * 4;
    unsigned char* slot0 = lds, *slot1 = lds + 34816;
    unsigned char* nb0 = lds + 69632, *nb1 = nb0 + 8192, *sb0 = nb1 + 8192, *sb1 = sb0 + 8192, *fb0 = sb1 + 8192, *fb1 = fb0 + 8192;
    if (wid >= 6) {
        const int t2 = tid - 384;
        u32x4 r0[16], r1[16], r2[16];
        scan_loadM2(r0, Mg, C0, t2); scan_storeM2(r0, (C0 & 1) ? slot1 : slot0, t2); scan_loadM2(r0, Mg, C0 + 1, t2); scan_loadM2(r1, Mg, C0 + 2, t2); scan_loadM2(r2, Mg, C0 + 3, t2);
        SCAN_BAR();
#define SCAN_LD(cc, R) do { if ((cc) <= C1) { if ((cc) + 1 <= C1) scan_storeM2(R, ((cc) + 1) & 1 ? slot1 : slot0, t2); scan_loadM2(R, Mg, (cc) + 4, t2); SCAN_BAR(); } } while (0)
#pragma unroll 1
        for (int c0 = C0; c0 <= C1; c0 += 3) { SCAN_LD(c0, r0); SCAN_LD(c0 + 1, r1); SCAN_LD(c0 + 2, r2); }
#undef SCAN_LD
    } else if (wid == 4) {
        u32x4 r0[8], r1[8], r2[8];
#define SCAN_STN(R, buf) do { _Pragma("unroll") for (int k = 0; k < 8; ++k) *(u32x4*)((buf) + (lane + 64 * k) * 16) = R[k]; } while (0)
        scan_loadNq(r0, NSb, C0, lane); SCAN_STN(r0, (C0 & 1) ? nb1 : nb0); scan_loadNq(r0, NSb, C0 + 1, lane); scan_loadNq(r1, NSb, C0 + 2, lane); scan_loadNq(r2, NSb, C0 + 3, lane);
        SCAN_BAR();
#define SCAN_LN(cc, R) do { if ((cc) <= C1) { if ((cc) + 1 <= C1) SCAN_STN(R, ((cc) + 1) & 1 ? nb1 : nb0); scan_loadNq(R, NSb, (cc) + 4, lane); SCAN_BAR(); } } while (0)
#pragma unroll 1
        for (int c0 = C0; c0 <= C1; c0 += 3) { SCAN_LN(c0, r0); SCAN_LN(c0 + 1, r1); SCAN_LN(c0 + 2, r2); }
#undef SCAN_LN
#undef SCAN_STN
    } else if (wid == 5) {
        SCAN_BAR();
#pragma unroll 1
        for (int cc = C0; cc <= C1 + 1; ++cc) {
            if (cc >= C0 + 1) {
                const unsigned char* sb = ((cc - 1) & 1) ? sb1 : sb0;
                u16* dst = NSb + (size_t)(cc - 1) * 16384;
#pragma unroll
                for (int k = 0; k < 8; ++k) { const int id = lane + 64 * k; *(u32x4*)(dst + (id >> 4) * 512 + (id & 15) * 8) = *(const u32x4*)(sb + id * 16); }
            }
            if (cc <= C1) SCAN_BAR();
        }
    } else {
        const int ob = wid;
        f32x16 acc;
#pragma unroll
        for (int q = 0; q < 4; ++q) {
            const u32x2 w = *(const u32x2*)(NSb + (size_t)(C0 - 1) * 16384 + ((8 * ob + 2 * q + hh) * 128 + col) * 4);
            acc[4 * q + 0] = bflo(w.x); acc[4 * q + 1] = bfhi(w.x); acc[4 * q + 2] = bflo(w.y); acc[4 * q + 3] = bfhi(w.y);
        }
#define SCAN_PUBF(buf) do { _Pragma("unroll") for (int s_ = 0; s_ < 2; ++s_) { bf16x8 f_; _Pragma("unroll") for (int j = 0; j < 8; ++j) f_[j] = (short)f2bf(acc[8 * s_ + j]); \
            *(bf16x8*)((buf) + ((2 * ob + s_) * 64 + lane) * 16) = f_; } } while (0)
        SCAN_PUBF((C0 & 1) ? fb1 : fb0);
        SCAN_BAR();
        const int apo = (32 * ob + col) * 272 + hh * 16;
#pragma unroll 1
        for (int cc = C0; cc <= C1; ++cc) {
            const unsigned char* cur = (cc & 1) ? slot1 : slot0;
            const unsigned char* nbuf = (cc & 1) ? nb1 : nb0;
            unsigned char* sbuf = (cc & 1) ? sb1 : sb0;
            const unsigned char* fin = (cc & 1) ? fb1 : fb0;
            unsigned char* fout = (cc & 1) ? fb0 : fb1;
            bf16x8 fa[8], fbq[8];
#pragma unroll
            for (int ks = 0; ks < 8; ++ks) { fbq[ks] = *(const bf16x8*)(fin + (ks * 64 + lane) * 16); fa[ks] = *(const bf16x8*)(cur + apo + ks * 32); }
            f32x16 nw;
#pragma unroll
            for (int q = 0; q < 4; ++q) {
                const u32x2 w = *(const u32x2*)(nbuf + ((8 * ob + 2 * q + hh) * 32 + col) * 8);
                nw[4 * q + 0] = bflo(w.x); nw[4 * q + 1] = bfhi(w.x); nw[4 * q + 2] = bflo(w.y); nw[4 * q + 3] = bfhi(w.y);
            }
#pragma unroll
            for (int ks = 0; ks < 8; ++ks) nw = __builtin_amdgcn_mfma_f32_32x32x16_bf16(fa[ks], fbq[ks], nw, 0, 0, 0);
            acc = nw;
#pragma unroll
            for (int q = 0; q < 4; ++q) {
                u32x2 w; w.x = pk2(acc[4 * q], acc[4 * q + 1]); w.y = pk2(acc[4 * q + 2], acc[4 * q + 3]);
                *(u32x2*)(sbuf + ((8 * ob + 2 * q + hh) * 32 + col) * 8) = w;
            }
            SCAN_PUBF(fout);
            SCAN_BAR();
        }
#undef SCAN_PUBF
    }
}
#undef SCAN_BAR

template <bool ADDY, bool ROUTE>
DI void phase_norm(const Params& p, const float* gain, int layer, unsigned char* lds) {
    const int tid = tid_opaque(), lane = tid & 63, wid = tid >> 6;
    float* H = (float*)(p.ws + WS_H);
    u16* HN = (u16*)(p.ws + WS_HN);
    const u16* Y = (const u16*)(p.ws + WS_P0 + P0_Y);
    float* xs = (float*)lds;
    float* part = (float*)(lds + 32768);
    float* logit = (float*)(lds + 32768 + 9216);
    int* asg = (int*)(lds + 32768 + 9216 + 1152);
    int iter = 0;
    const float* wg = p.moe_w_group + (size_t)layer * 1024 * 4;
    const float* we = p.moe_w_expert + (size_t)layer * 1024 * 32;
    float wr[128];
    if (ROUTE) {
        const float* wp = lane < 4 ? wg + lane : we + ((lane < 36 ? lane : 35) - 4);
        const int wst = lane < 4 ? 4 : 32;
#pragma unroll
        for (int k = 0; k < 128; ++k) wr[k] = wp[(size_t)(128 * wid + k) * wst];
    }
    f32x4 vn[4]; u32x2 yn0[4], yn1[4];
#define NORM_FETCH(rw) do { _Pragma("unroll") for (int i = 0; i < 4; ++i) { const int col = 4 * lane + 256 * i; vn[i] = *(const f32x4*)(H + (size_t)(rw) * DM + col); \
        if (ADDY) { yn0[i] = *(const u32x2*)(Y + (size_t)(2 * (rw)) * DM + col); yn1[i] = *(const u32x2*)(Y + (size_t)(2 * (rw) + 1) * DM + col); } } } while (0)
    if ((int)blockIdx.x * 8 < TP) NORM_FETCH(blockIdx.x * 8 + wid);
    for (int base = blockIdx.x * 8; base < TP; base += gridDim.x * 8) {
        const int row = base + wid;
        {
            f32x4 v[4];
            u32x2 yc0[4], yc1[4];
#pragma unroll
            for (int i = 0; i < 4; ++i) { v[i] = vn[i]; if (ADDY) { yc0[i] = yn0[i]; yc1[i] = yn1[i]; } }
            if (base + (int)gridDim.x * 8 < TP) NORM_FETCH(row + gridDim.x * 8);
            float ss = 0.f;
#pragma unroll
            for (int i = 0; i < 4; ++i) {
                const int col = 4 * lane + 256 * i;
                if (ADDY) {
                    const u32x2 y0 = yc0[i], y1 = yc1[i];
                    const int pp = row % LP;
                    if (pp >= 48) {
                        v[i][0] += bflo(y0.x) + bflo(y1.x); v[i][1] += bfhi(y0.x) + bfhi(y1.x); v[i][2] += bflo(y0.y) + bflo(y1.y); v[i][3] += bfhi(y0.y) + bfhi(y1.y);
                        *(f32x4*)(H + (size_t)row * DM + col) = v[i];
                    }
                }
                ss += v[i][0] * v[i][0] + v[i][1] * v[i][1] + v[i][2] * v[i][2] + v[i][3] * v[i][3];
            }
            ss = wave_sum(ss);
            const float rstd = rsqrtf(ss * (1.f / DM) + RMS_EPS);
#pragma unroll
            for (int i = 0; i < 4; ++i) {
                const int col = 4 * lane + 256 * i;
                const f32x4 gn = *(const f32x4*)(gain + col);
                const f32x4 o = (f32x4){v[i][0] * rstd * gn[0], v[i][1] * rstd * gn[1], v[i][2] * rstd * gn[2], v[i][3] * rstd * gn[3]};
                u32x2 w; w.x = pk2(o[0], o[1]); w.y = pk2(o[2], o[3]);
                *(u32x2*)(HN + (size_t)row * DM + col) = w;
                if (ROUTE) *(f32x4*)(xs + wid * 1024 + col) = o;
            }
        }
        if (ROUTE) {
            __syncthreads();
            {
                float a8[8];
#pragma unroll
                for (int r = 0; r < 8; ++r) a8[r] = 0.f;
                if (lane < 36) {
#pragma unroll
                    for (int k4 = 0; k4 < 32; ++k4) {
#pragma unroll
                        for (int r = 0; r < 8; ++r) {
                            const f32x4 x4 = *(const f32x4*)(xs + r * 1024 + 128 * wid + 4 * k4);
                            a8[r] += x4[0] * wr[4 * k4] + x4[1] * wr[4 * k4 + 1] + x4[2] * wr[4 * k4 + 2] + x4[3] * wr[4 * k4 + 3];
                        }
                    }
#pragma unroll
                    for (int r = 0; r < 8; ++r) part[(wid * 8 + r) * 36 + lane] = a8[r];
                }
            }
            __syncthreads();
            if (tid < 288) {
                const int r = tid / 36, n = tid - r * 36;
                float s = 0.f;
#pragma unroll
                for (int w = 0; w < 8; ++w) s += part[(w * 8 + r) * 36 + n];
                s += (n < 4) ? p.moe_b_group[layer * 4 + n] : p.moe_b_expert[layer * 32 + n - 4];
                logit[r * 36 + n] = s;
            }
            __syncthreads();
            if (tid < 8) {
                const int rr = base + tid, pp = rr % LP;
                if (pp >= 48) {
                    const float* lg = logit + tid * 36;
                    int gs = 0; float gm = lg[0];
#pragma unroll
                    for (int i = 1; i < 4; ++i) if (lg[i] > gm) { gm = lg[i]; gs = i; }
                    float gsum = 0.f;
#pragma unroll
                    for (int i = 0; i < 4; ++i) gsum += __expf(lg[i] - gm);
                    const float gw = 1.f / gsum;
                    const float* el = lg + 4 + 8 * gs;
                    int i0 = 0; float m0 = el[0];
#pragma unroll
                    for (int i = 1; i < 8; ++i) if (el[i] > m0) { m0 = el[i]; i0 = i; }
                    int i1 = -1; float m1 = -3.0e38f;
#pragma unroll
                    for (int i = 0; i < 8; ++i) if (i != i0 && el[i] > m1) { m1 = el[i]; i1 = i; }
                    const float e1 = __expf(m1 - m0);
                    const float c0 = gw / (1.f + e1), c1 = gw * e1 / (1.f + e1);
                    float* cw = (float*)(p.ws + WS_CW);
                    cw[2 * rr] = c0; cw[2 * rr + 1] = c1;
                    const int slot = 16 * iter + 2 * tid;
                    asg[slot] = ((8 * gs + i0) << 24) | (2 * rr); asg[slot + 1] = ((8 * gs + i1) << 24) | (2 * rr + 1);
                } else {
                    const int slot = 16 * iter + 2 * tid;
                    asg[slot] = -1; asg[slot + 1] = -1;
                }
            }
            __syncthreads();
        }
        ++iter;
    }
    if (ROUTE) {
        const int n = 16 * iter;
        unsigned* cnt = (unsigned*)(p.ws + WS_CTL) + CW_CNT + layer * 32;
        u32* list = (u32*)(p.ws + WS_LIST);
        int* ebase = asg + 256;
        if (tid < 32) {
            int cn = 0;
            for (int i = 0; i < n; ++i) cn += (asg[i] >= 0 && (asg[i] >> 24) == tid) ? 1 : 0;
            ebase[tid] = cn > 0 ? (int)atomicAdd(&cnt[tid], (unsigned)cn) : 0;
        }
        __syncthreads();
        if (tid < n) {
            const int v = asg[tid];
            if (v >= 0) {
                const int e = v >> 24;
                int rk = 0;
                for (int i = 0; i < tid; ++i) rk += (asg[i] >= 0 && (asg[i] >> 24) == e) ? 1 : 0;
                list[(size_t)e * TP + ebase[e] + rk] = (u32)(v & 0xffffff);
            }
        }
        __syncthreads();
    }
}

struct MoeSched {
    const char* A; const char* Bt; const u32* list; const int* pre;
    int K, ncol, rshift, total; size_t estride, cstride, h1;
    DI bool next(int i, pg::Unit& u) const {
        const int L = i * (int)gridDim.x + (int)blockIdx.x; if (L >= total) return false;
        const int rtile = L / ncol; u.pn = L - rtile * ncol;
        int e = 0;
        for (int j = 1; j < 32; ++j) if (pre[j] <= rtile) e = j;
        u.e = e; u.pm = rtile - pre[e]; u.n = pre[64 + e];
        return true;
    }
    DI int asg(const pg::Unit& u, int r) const { const int gi = u.pm * 256 + r; return (int)list[(size_t)u.e * TP + (gi < u.n ? gi : 0)]; }
    DI int arow(const pg::Unit& u, int r) const { return asg(u, r) >> rshift; }
    DI const char* abase() const { return A; }
    DI int lda() const { return K; }
    DI const char* bbase(const pg::Unit& u) const { return Bt + (size_t)u.e * estride + (size_t)u.pn * cstride; }
    DI size_t bh1() const { return h1; }
};
struct EpiGateUp {
    static constexpr bool PERM = true;
    const MoeSched* S; const float* cw; u16* ACT;
    DI void operator()(const pg::Acc& acc, const pg::Unit& u, int wr, int wc, int fr, int fq) const {
#pragma unroll
        for (int ai = 0; ai < 2; ++ai)
#pragma unroll
            for (int m = 0; m < 4; ++m) {
                const int r = 128 * ai + 64 * wr + 16 * m + fr;
                if (u.pm * 256 + r >= u.n) continue;
                const int a = S->asg(u, r);
                const float cwa = cw[a];
                const f32x4 g0 = acc[ai][0][m][0], g1 = acc[ai][0][m][1], u0 = acc[ai][1][m][0], u1 = acc[ai][1][m][1];
                u32x4 w;
                w.x = pk2(silu(g0[0]) * u0[0] * cwa, silu(g0[1]) * u0[1] * cwa); w.y = pk2(silu(g0[2]) * u0[2] * cwa, silu(g0[3]) * u0[3] * cwa);
                w.z = pk2(silu(g1[0]) * u1[0] * cwa, silu(g1[1]) * u1[1] * cwa); w.w = pk2(silu(g1[2]) * u1[2] * cwa, silu(g1[3]) * u1[3] * cwa);
                *(u32x4*)(ACT + (size_t)a * 256 + 128 * u.pn + 32 * wc + 8 * fq) = w;
            }
    }
};
struct EpiDown {
    static constexpr bool PERM = true;
    const MoeSched* S; u16* Y;
    DI void operator()(const pg::Acc& acc, const pg::Unit& u, int wr, int wc, int fr, int fq) const {
#pragma unroll
        for (int ai = 0; ai < 2; ++ai)
#pragma unroll
            for (int m = 0; m < 4; ++m) {
                const int r = 128 * ai + 64 * wr + 16 * m + fr;
                if (u.pm * 256 + r >= u.n) continue;
                const int a = S->asg(u, r);
#pragma unroll
                for (int bj = 0; bj < 2; ++bj) {
                    const f32x4 v0 = acc[ai][bj][m][0], v1 = acc[ai][bj][m][1];
                    u32x4 w; w.x = pk2(v0[0], v0[1]); w.y = pk2(v0[2], v0[3]); w.z = pk2(v1[0], v1[1]); w.w = pk2(v1[2], v1[3]);
                    *(u32x4*)(Y + (size_t)a * 1024 + 256 * u.pn + 128 * bj + 32 * wc + 8 * fq) = w;
                }
            }
    }
};
template <int STAGE>
DI void phase_moe(const Params& p, int layer, unsigned char* lds) {
    const int tid = tid_opaque(), lane = tid & 63, wid = tid >> 6, c = lane & 15, g = lane >> 4, wm = wid >> 2, wn = wid & 3;
    int* pre = (int*)(lds + 131072);
    int* tl = pre + 192;
    const unsigned* cnt = (const unsigned*)(p.ws + WS_CTL) + CW_CNT + layer * 32;
    if (tid < 32) pre[64 + tid] = (int)cnt[tid];
    __syncthreads();
    if (tid == 0) {
        int s = 0, s2 = 0;
        for (int e = 0; e < 32; ++e) { const int n = pre[64 + e]; pre[e] = s; s += n >> 8; pre[128 + e] = s2; s2 += ((n & 255) + 127) >> 7; }
        pre[32] = s; pre[160] = s2;
    }
    __syncthreads();
    const u32* list = (const u32*)(p.ws + WS_LIST);
    const float* cw = (const float*)(p.ws + WS_CW);
    const u16* HN = (const u16*)(p.ws + WS_HN);
    u16* ACT = (u16*)(p.ws + WS_P0 + P0_ACT);
    u16* Y = (u16*)(p.ws + WS_P0 + P0_Y);
    if (STAGE == 0) {
        MoeSched S{(const char*)HN, (const char*)(p.ws + WS_P0 + P0_WGU), list, pre, 1024, 2, 1, pre[32] * 2,
                   (size_t)512 * 1024 * 2, (size_t)128 * 1024 * 2, (size_t)256 * 1024 * 2};
        EpiGateUp E{&S, cw, ACT};
        pg::gemm((LAS unsigned char*)lds, 1024, S, E);
    } else {
        MoeSched S{(const char*)ACT, (const char*)(p.ws + WS_P0 + P0_WDN), list, pre, 256, 4, 0, pre[32] * 4,
                   (size_t)1024 * 256 * 2, (size_t)256 * 256 * 2, (size_t)128 * 256 * 2};
        EpiDown E{&S, Y};
        pg::gemm((LAS unsigned char*)lds, 256, S, E);
    }
    __syncthreads();
    constexpr int FT = STAGE == 0 ? 4 : 8;
    const int nleft = pre[160] * FT;
    for (int t = (int)gridDim.x - 1 - (int)blockIdx.x; t < nleft; t += gridDim.x) {
        const int rtile = t / FT, ft = t - rtile * FT;
        int e = 0;
        for (int i = 1; i < 32; ++i) if (pre[128 + i] <= rtile) e = i;
        const int ne = pre[64 + e], r0 = (ne & ~255) + (rtile - pre[128 + e]) * 128;
        if (tid < 128) { const int gi = r0 + tid; tl[tid] = gi < ne ? (int)list[(size_t)e * TP + gi] : -1; }
        __syncthreads();
        GemmAcc<2> acc;
        if (STAGE == 0) {
            const u16* W = (const u16*)(p.ws + WS_P0 + P0_WGU) + (size_t)e * 512 * 1024;
            const int f0 = ft * 64;
            auto pf = [=](int lr) -> u32 { const int x = lr & 63, w = lr >> 6; return (u32)((x < 32 ? f0 + w * 32 + x : 256 + f0 + w * 32 + (x - 32)) * 1024); };
            auto qf = [=](int n) -> u32 { const int a = tl[n]; return (u32)((a < 0 ? (tl[0] >> 1) : (a >> 1)) * 1024); };
            gemm_tile<2>(W, HN, 16, pf, qf, acc, lds);
#pragma unroll
            for (int ni = 0; ni < 2; ++ni) {
                const int a = tl[wn * 32 + 16 * ni + c];
                if (a < 0) continue;
                const float cwa = cw[a];
#pragma unroll
                for (int mi = 0; mi < 2; ++mi) {
                    const f32x4 gt = acc.a[mi][ni], up = acc.a[mi + 2][ni];
                    u32x2 w;
                    w.x = pk2(silu(gt[0]) * up[0] * cwa, silu(gt[1]) * up[1] * cwa);
                    w.y = pk2(silu(gt[2]) * up[2] * cwa, silu(gt[3]) * up[3] * cwa);
                    *(u32x2*)(ACT + (size_t)a * 256 + f0 + wm * 32 + 16 * mi + 4 * g) = w;
                }
            }
        } else {
            const u16* W = (const u16*)(p.ws + WS_P0 + P0_WDN) + (size_t)e * 1024 * 256;
            auto qf = [=](int n) -> u32 { const int a = tl[n]; return (u32)((a < 0 ? tl[0] : a) * 256); };
            gemm_tile<2>(W, ACT, 4, LinRow{(u32)(ft * 128) * 256u, 256u}, qf, acc, lds);
#pragma unroll
            for (int ni = 0; ni < 2; ++ni) {
                const int a = tl[wn * 32 + 16 * ni + c];
                if (a < 0) continue;
#pragma unroll
                for (int mi = 0; mi < 4; ++mi) {
                    const f32x4 v = acc.a[mi][ni];
                    u32x2 w; w.x = pk2(v[0], v[1]); w.y = pk2(v[2], v[3]);
                    *(u32x2*)(Y + (size_t)a * 1024 + ft * 128 + wm * 64 + 16 * mi + 4 * g) = w;
                }
            }
        }
        __syncthreads();
    }
}

DI void phase_post1(const Params& p, unsigned char* lds) {
    const int lane = tid_opaque() & 63, wid = tid_opaque() >> 6;
    const float* KRAW = (const float*)(p.ws + WS_P0 + P0_KRAW);
    const float* KIRAW = (const float*)((unsigned char*)p.out + DO_KIRAW);
    unsigned char* KN = (unsigned char*)p.out + DO_KN;
    _Float16* KI = (_Float16*)((unsigned char*)p.out + DO_KI);
    for (int row = blockIdx.x * 8 + wid; row < TP; row += gridDim.x * 8) {
        const f32x4 k = *(const f32x4*)(KRAW + (size_t)row * 256 + 4 * lane);
        float ss = k[0] * k[0] + k[1] * k[1] + k[2] * k[2] + k[3] * k[3];
#pragma unroll
        for (int o = 16; o >= 1; o >>= 1) ss += __shfl_xor(ss, o);
        const float rstd = rsqrtf(ss * (1.f / 128.f) + RMS_EPS);
        const int d = (4 * lane) & 127;
        const f32x4 kg = *(const f32x4*)(p.dsa_k_norm + d), qg = *(const f32x4*)(p.dsa_q_norm + d);
        *(u32*)(KN + (size_t)row * 256 + 4 * lane) = pk4_fp8(k[0] * rstd * kg[0] * qg[0], k[1] * rstd * kg[1] * qg[1], k[2] * rstd * kg[2] * qg[2], k[3] * rstd * kg[3] * qg[3]);
        const float x = KIRAW[(size_t)row * 64 + lane];
        const float mu = wave_sum(x) * (1.f / 64.f);
        const float xc = x - mu;
        const float var = wave_sum(xc * xc) * (1.f / 64.f);
        KI[(size_t)row * 64 + lane] = (_Float16)(xc * rsqrtf(var + RMS_EPS) * p.dsa_ln_g[lane] + p.dsa_ln_b[lane]);
    }
}

constexpr int IX_HIST = 0;
constexpr int IX_SEL = 65536;
constexpr int IX_CV = IX_SEL + 16384;
constexpr int IX_CI = IX_CV + 16384;
constexpr int IX_CNT = IX_CI + 8192;
constexpr int IX_QI = IX_CNT + 512;
constexpr int IX_QROW = 1296;
template <int PASS>
DI void index_pass(const _Float16* __restrict__ KIb, int ktiles, int wid, int lane, const float (&wh)[8], float sQ, unsigned char* lds) {
    const int q = lane & 31, hh = lane >> 5;
    u32* hist = (u32*)(lds + IX_HIST);
    u16* sell = (u16*)(lds + IX_SEL);
    float* cv = (float*)(lds + IX_CV);
    u16* ci = (u16*)(lds + IX_CI);
    int* cn = (int*)(lds + IX_CNT);
    const int tbq = (PASS == 1) ? cn[64 + q] : 0;
    const unsigned char* qb = lds + IX_QI + q * IX_QROW + hh * 16;
    for (int kt = 1 + wid; kt < ktiles; kt += 8) {
        f16x8 a[4];
#pragma unroll
        for (int s = 0; s < 4; ++s) a[s] = *(const f16x8*)(KIb + (size_t)(32 * kt + q) * 64 + 16 * s + 8 * hh);
        float sc[16];
        {
            f32x16 d;
#pragma unroll
            for (int r = 0; r < 16; ++r) d[r] = 0.f;
#pragma unroll
            for (int hd = 8; hd < 10; ++hd)
#pragma unroll
                for (int s = 0; s < 4; ++s) d = __builtin_amdgcn_mfma_f32_32x32x16_f16(a[s], *(const f16x8*)(qb + hd * 128 + s * 32), d, 0, 0, 0);
#pragma unroll
            for (int r = 0; r < 16; ++r) sc[r] = d[r];
        }
#pragma unroll
        for (int hd = 0; hd < 8; ++hd) {
            f32x16 d;
#pragma unroll
            for (int r = 0; r < 16; ++r) d[r] = 0.f;
#pragma unroll
            for (int s = 0; s < 4; ++s) d = __builtin_amdgcn_mfma_f32_32x32x16_f16(a[s], *(const f16x8*)(qb + hd * 128 + s * 32), d, 0, 0, 0);
#pragma unroll
            for (int r = 0; r < 16; ++r) sc[r] = fmaf(fabsf(d[r]), wh[hd], sc[r]);
            if (hd & 1) __builtin_amdgcn_sched_barrier(0);
        }
        const int kbase = 32 * kt + 4 * hh;
        if (PASS == 0) {
#pragma unroll
            for (int r = 0; r < 16; ++r) {
                const int key = kbase + (r & 3) + 8 * (r >> 2);
                const int bin = (int)fminf(fmaxf(fmaf(sc[r], sQ, 512.f), 0.f), 1023.f);
                if (key >= 48) atomicAdd(&hist[q * 512 + (bin >> 1)], 1u << (16 * (bin & 1)));
            }
        } else {
            u32 selm = 0u, candm = 0u;
#pragma unroll
            for (int r = 0; r < 16; ++r) {
                const int key = kbase + (r & 3) + 8 * (r >> 2);
                const int bin = (int)fminf(fmaxf(fmaf(sc[r], sQ, 512.f), 0.f), 1023.f);
                selm |= (key >= 48 && bin > tbq) ? (1u << r) : 0u;
                candm |= (key >= 48 && bin == tbq) ? (1u << r) : 0u;
            }
            if (selm) {
                int pos = atomicAdd(&cn[q], (int)__builtin_popcount(selm));
                while (selm) {
                    const int r = __builtin_ctz(selm); selm &= selm - 1u;
                    if (pos < 256) sell[q * 256 + pos] = (u16)(kbase + (r & 3) + 8 * (r >> 2));
                    ++pos;
                }
            }
            if (candm) {
                int pos = atomicAdd(&cn[32 + q], (int)__builtin_popcount(candm));
#pragma unroll
                for (int r = 0; r < 16; ++r) if (candm & (1u << r)) { if (pos < 128) { cv[q * 128 + pos] = sc[r]; ci[q * 128 + pos] = (u16)(kbase + (r & 3) + 8 * (r >> 2)); } ++pos; }
            }
        }
    }
}
DI void index_unit(const Params& p, int b, int ch, int half, unsigned char* lds) {
    const int tid = tid_opaque(), lane = tid & 63, wid = tid >> 6;
    u16* SEL = (u16*)((unsigned char*)p.out + DO_SEL);
    const int qrow0 = b * LP + 64 * ch + 32 * half;
    const int nkeys = 64 * (ch + 1) - 48;
    if (nkeys <= 256) {
        for (int i = tid; i < 32 * 256; i += NTHREADS) { const int qq = i >> 8, s = i & 255; SEL[(size_t)(qrow0 + qq) * 256 + s] = (u16)(s < nkeys ? 48 + s : 48); }
        return;
    }
    u32* hist = (u32*)(lds + IX_HIST);
    int* cn = (int*)(lds + IX_CNT);
    for (int i = tid; i < 32 * 512; i += NTHREADS) hist[i] = 0u;
    if (tid < 128) cn[tid] = 0;
    { u16* sell0 = (u16*)(lds + IX_SEL); for (int i = tid; i < 32 * 256; i += NTHREADS) sell0[i] = 48; }
    const _Float16* QI = (const _Float16*)(p.ws + WS_P0 + P0_QI);
    const float* WI = (const float*)((unsigned char*)p.out + DO_WI);
    const _Float16* KIb = (const _Float16*)((unsigned char*)p.out + DO_KI) + (size_t)b * LP * 64;
    const int q = lane & 31;
    float wh[8], sQ;
    {
        float n2 = 0.f;
#pragma unroll
        for (int hd = 0; hd < 8; ++hd) { const float w = WI[(size_t)(qrow0 + q) * 8 + hd]; wh[hd] = 0.5f * w; n2 += w * w; }
        sQ = 512.f / (28.f * sqrtf(n2) + 1e-20f);
    }
#pragma unroll
    for (int i = 0; i < 4; ++i) { const int id = tid + NTHREADS * i, rr = id >> 6, cc = id & 63; *(u32x4*)(lds + IX_QI + rr * IX_QROW + cc * 16) = *(const u32x4*)(QI + (size_t)(qrow0 + rr) * 512 + cc * 8); }
    const int ktiles = 2 * (ch + 1);
    __syncthreads();
    {
        const int qq = tid >> 4, dg = tid & 15;
        float c4[4] = {0.f, 0.f, 0.f, 0.f};
#pragma unroll
        for (int hd = 0; hd < 8; ++hd) {
            const float w = 0.5f * WI[(size_t)(qrow0 + qq) * 8 + hd];
            const _Float16* qp = (const _Float16*)(lds + IX_QI + qq * IX_QROW + hd * 128 + dg * 8);
#pragma unroll
            for (int k = 0; k < 4; ++k) c4[k] += w * (float)qp[k];
        }
        _Float16* ph = (_Float16*)(lds + IX_QI + qq * IX_QROW + 8 * 128 + dg * 8);
        _Float16* pl = (_Float16*)(lds + IX_QI + qq * IX_QROW + 9 * 128 + dg * 8);
#pragma unroll
        for (int k = 0; k < 4; ++k) { const _Float16 hi = (_Float16)c4[k]; ph[k] = hi; pl[k] = (_Float16)(c4[k] - (float)hi); }
    }
    __syncthreads();
    index_pass<0>(KIb, ktiles, wid, lane, wh, sQ, lds);
    __syncthreads();
    for (int qi = 0; qi < 4; ++qi) {
        const int qq = 4 * wid + qi;
        u32 hw[8];
        int cl = 0;
#pragma unroll
        for (int i = 0; i < 8; ++i) { hw[i] = hist[qq * 512 + 8 * lane + i]; cl += (int)(hw[i] & 0xffffu) + (int)(hw[i] >> 16); }
        int suf = cl;
#pragma unroll
        for (int o = 1; o < 64; o <<= 1) { const int t = __shfl_down(suf, o); if (lane + o < 64) suf += t; }
        const int above = suf - cl;
        if (above < 256 && above + cl >= 256) {
            int acc = above, tb = 16 * lane, na = above;
#pragma unroll
            for (int i = 15; i >= 0; --i) {
                const int cb = (int)((hw[i >> 1] >> (16 * (i & 1))) & 0xffffu);
                if (acc < 256 && acc + cb >= 256) { tb = 16 * lane + i; na = acc; }
                acc += cb;
            }
            cn[64 + qq] = tb; cn[96 + qq] = na;
        }
    }
    __syncthreads();
    index_pass<1>(KIb, ktiles, wid, lane, wh, sQ, lds);
    __syncthreads();
    {
        u16* sell = (u16*)(lds + IX_SEL);
        const float* cv = (const float*)(lds + IX_CV);
        const u16* ci = (const u16*)(lds + IX_CI);
        for (int qi = 0; qi < 4; ++qi) {
            const int qq = 4 * wid + qi;
            const int na = cn[96 + qq], need = 256 - na;
            int nc = cn[32 + qq]; nc = nc < 128 ? nc : 128;
#pragma unroll
            for (int half2 = 0; half2 < 2; ++half2) {
                const int i = lane + 64 * half2;
                if (i < nc) {
                    const float vi = cv[qq * 128 + i]; const int ki = ci[qq * 128 + i];
                    int rank = 0;
                    for (int j = 0; j < nc; ++j) { const float vj = cv[qq * 128 + j]; const int kj = ci[qq * 128 + j]; rank += (vj > vi || (vj == vi && kj < ki)) ? 1 : 0; }
                    if (rank < need) sell[qq * 256 + na + rank] = (u16)ki;
                }
            }
        }
    }
    __syncthreads();
    {
        const u32x4* src = (const u32x4*)(lds + IX_SEL);
        u32x4* dst = (u32x4*)(SEL + (size_t)qrow0 * 256);
        for (int i = tid; i < 1024; i += NTHREADS) dst[i] = src[i];
    }
    __syncthreads();
}
DI void phase_index(const Params& p, unsigned char* lds) {
    const int G = gridDim.x;
    for (int r = 0;; ++r) {
        const int u = (r & 1) ? r * G + (G - 1 - (int)blockIdx.x) : r * G + (int)blockIdx.x;
        if (r * G >= 516) break;
        if (u < 516) index_unit(p, (u >> 1) & 1, 128 - (u >> 2), u & 1, lds);
    }
}

DI int t5_bucket(int rel) {
    const int n = rel < 0 ? -rel : rel;
    const int base = rel > 0 ? 16 : 0;
    const int lg = 8 + (n >= 12) + (n >= 16) + (n >= 23) + (n >= 32) + (n >= 46) + (n >= 64) + (n >= 91);
    return base + (n < 8 ? n : lg);
}
constexpr int AT_ITEMS = 513;
constexpr int AT_WAVE_LDS = 11264;
DI int at_swz(int r) { return ((r >> 1) & 1) | (((r >> 3) & 1) << 1); }
DI void attn_query(const Params& p, int b, int n, int qi, unsigned char* wl) {
    const int lane = tid_opaque() & 63, c = lane & 15, g = lane >> 4;
    u32* widx = (u32*)wl;
    u16* Pb = (u16*)(wl + 1024);
    unsigned char* ring = wl + 3072;
    float* Lg = (float*)ring;
    const u16* SEL = (const u16*)((unsigned char*)p.out + DO_SEL);
    const u16* QRAW = (const u16*)(p.ws + WS_P0 + P0_QRAW);
    const unsigned char* KN = (const unsigned char*)p.out + DO_KN;
    const unsigned char* VN = p.ws + WS_P0 + P0_VN;
    u16* OA = (u16*)((unsigned char*)p.out + DO_OG);
    const int pq = 48 + qi, row = b * LP + pq;
    const int chq = pq >> 6, nkeys = 64 * (chq + 1) - 48, nsel = nkeys < 256 ? nkeys : 256, ntile = nsel >> 4;
    {
        const u32x2 w = *(const u32x2*)(SEL + (size_t)row * 256 + 4 * lane);
        u32x4 o;
        const int k0 = w.x & 0xffff, k1 = w.x >> 16, k2 = w.y & 0xffff, k3 = w.y >> 16;
        o.x = k0 | (t5_bucket(k0 - pq) << 16); o.y = k1 | (t5_bucket(k1 - pq) << 16); o.z = k2 | (t5_bucket(k2 - pq) << 16); o.w = k3 | (t5_bucket(k3 - pq) << 16);
        *(u32x4*)(widx + 4 * lane) = o;
    }
    const size_t kb = (size_t)b * LP;
    u32x4 qraw[4];
#pragma unroll
    for (int s = 0; s < 4; ++s)
        qraw[s] = (c < 4) ? *(const u32x4*)(QRAW + (size_t)row * 1024 + (4 * n + c) * 128 + 64 * (s >> 1) + 16 * g + 8 * (s & 1))
                          : (u32x4){0u, 0u, 0u, 0u};
    float rbv[8];
    {
        const float* rb = p.rel_bias + (8 * g) * 8 + 4 * n + (c & 3);
#pragma unroll
        for (int j = 0; j < 8; ++j) rbv[j] = rb[8 * j];
    }
#define ATT_LOADK(dst, oh, bt) do { _Pragma("unroll") for (int t = 0; t < 4; ++t) { const u32 e_ = widx[16 * (4 * (bt) + t) + c]; const int kid_ = e_ & 0xffff, bk_ = e_ >> 16; \
        const unsigned char* kp_ = KN + (kb + kid_) * 256 + n * 128 + 16 * g; \
        dst[t][0] = *(const u32x4*)(kp_); dst[t][1] = *(const u32x4*)(kp_ + 64); \
        const u32 hv_ = ((bk_ >> 3) == g) ? (0x3f80u << (16 * (bk_ & 1))) : 0u; const int wq_ = (bk_ & 7) >> 1; \
        u32x4 ow_; ow_.x = wq_ == 0 ? hv_ : 0u; ow_.y = wq_ == 1 ? hv_ : 0u; ow_.z = wq_ == 2 ? hv_ : 0u; ow_.w = wq_ == 3 ? hv_ : 0u; oh[t] = __builtin_bit_cast(bf16x8, ow_); } } while (0)
#define ATT_QK(src, oh, bt) do { _Pragma("unroll") for (int t = 0; t < 4; ++t) { f32x4 a4 = (f32x4){0.f, 0.f, 0.f, 0.f}; \
        a4 = __builtin_amdgcn_mfma_f32_16x16x32_fp8_fp8((long)(((unsigned long long)src[t][0].y << 32) | src[t][0].x), qf[0], a4, 0, 0, 0); \
        a4 = __builtin_amdgcn_mfma_f32_16x16x32_fp8_fp8((long)(((unsigned long long)src[t][0].w << 32) | src[t][0].z), qf[1], a4, 0, 0, 0); \
        a4 = __builtin_amdgcn_mfma_f32_16x16x32_fp8_fp8((long)(((unsigned long long)src[t][1].y << 32) | src[t][1].x), qf[2], a4, 0, 0, 0); \
        a4 = __builtin_amdgcn_mfma_f32_16x16x32_fp8_fp8((long)(((unsigned long long)src[t][1].w << 32) | src[t][1].z), qf[3], a4, 0, 0, 0); \
        { const f32x4 b4_ = mfma16(oh[t], bb, (f32x4){0.f, 0.f, 0.f, 0.f}); a4 = a4 + b4_; } \
        const bool val_ = (4 * (bt) + t) < ntile; \
        _Pragma("unroll") for (int r = 0; r < 4; ++r) { a4[r] = val_ ? a4[r] * qscale : -3.0e38f; mx = fmaxf(mx, a4[r]); } \
        lq[t] = a4; } \
        if (c < 4) { _Pragma("unroll") for (int t = 0; t < 4; ++t) *(f32x4*)(Lg + c * 256 + 16 * (4 * (bt) + t) + 4 * g) = lq[t]; } } while (0)
    u32x4 ka[4][2], kc[4][2]; bf16x8 oa[4], oc[4];
    ATT_LOADK(ka, oa, 0);
    ATT_LOADK(kc, oc, 1);
    long qf[4];
    float ssq = 0.f;
#pragma unroll
    for (int s = 0; s < 4; ++s) {
        const u32x4 w = qraw[s];
        const u32 lo8 = pk4_fp8(bflo(w.x), bfhi(w.x), bflo(w.y), bfhi(w.y)), hi8 = pk4_fp8(bflo(w.z), bfhi(w.z), bflo(w.w), bfhi(w.w));
        qf[s] = (long)(((unsigned long long)hi8 << 32) | lo8);
        ssq += bflo(w.x) * bflo(w.x) + bfhi(w.x) * bfhi(w.x) + bflo(w.y) * bflo(w.y) + bfhi(w.y) * bfhi(w.y)
             + bflo(w.z) * bflo(w.z) + bfhi(w.z) * bfhi(w.z) + bflo(w.w) * bflo(w.w) + bfhi(w.w) * bfhi(w.w);
    }
    ssq += __shfl_xor(ssq, 16); ssq += __shfl_xor(ssq, 32);
    const float qscale = rsqrtf(ssq * (1.f / 128.f) + RMS_EPS) * 0.08838834764831845f;
    bf16x8 bb;
    {
        const float iq = 1.f / qscale;
        u32x4 w;
        w.x = pk2(rbv[0] * iq, rbv[1] * iq); w.y = pk2(rbv[2] * iq, rbv[3] * iq); w.z = pk2(rbv[4] * iq, rbv[5] * iq); w.w = pk2(rbv[6] * iq, rbv[7] * iq);
        if (c >= 4) w = (u32x4){0u, 0u, 0u, 0u};
        bb = __builtin_bit_cast(bf16x8, w);
    }
    float mx = -3.0e38f;
    {
        f32x4 lq[4];
        ATT_QK(ka, oa, 0);
        ATT_LOADK(ka, oa, 2);
        ATT_QK(kc, oc, 1);
        ATT_LOADK(kc, oc, 3);
        ATT_QK(ka, oa, 2);
        ATT_QK(kc, oc, 3);
    }
#undef ATT_LOADK
#undef ATT_QK
    const int kr = lane >> 3, c8 = lane & 7;
    const unsigned char* vbase = VN + kb * 256 + n * 128 + 16 * c8;
#define ATT_SWZ2(r) (((r) & 3) | ((((r) >> 3) & 1) << 2))
#define ATT_LDV(dst, st) do { _Pragma("unroll") for (int j = 0; j < 4; ++j) { const int kid_ = widx[32 * (st) + 8 * j + kr] & 0xffff; \
        dst[j] = *(const u32x4*)(vbase + (size_t)kid_ * 256); } } while (0)
#define ATT_STV(src) do { _Pragma("unroll") for (int j = 0; j < 4; ++j) { const int r_ = 8 * j + kr; \
        unsigned char* d_ = ring + r_ * 256 + ((c8 ^ ATT_SWZ2(r_)) * 32); \
        *(bf16x8*)(d_) = fp8x8_to_bf16x8(src[j].x, src[j].y); *(bf16x8*)(d_ + 16) = fp8x8_to_bf16x8(src[j].z, src[j].w); } } while (0)
    u32x4 v0[4], v1[4], v2[4], v3[4];
    ATT_LDV(v0, 0); ATT_LDV(v1, 1); ATT_LDV(v2, 2); ATT_LDV(v3, 3);
    mx = fmaxf(mx, __shfl_xor(mx, 16)); mx = fmaxf(mx, __shfl_xor(mx, 32));
    float inv[4];
    {
#pragma unroll
        for (int hd = 0; hd < 4; ++hd) {
            const float m = __shfl(mx, hd);
            const f32x4 l4 = *(const f32x4*)(Lg + hd * 256 + 4 * lane);
            f32x4 e = (f32x4){__expf(l4[0] - m), __expf(l4[1] - m), __expf(l4[2] - m), __expf(l4[3] - m)};
            if (4 * lane >= nsel) e = (f32x4){0.f, 0.f, 0.f, 0.f};
            inv[hd] = 1.f / wave_sum(e[0] + e[1] + e[2] + e[3]);
            u32x2 w; w.x = pk2(e[0], e[1]); w.y = pk2(e[2], e[3]);
            *(u32x2*)(Pb + hd * 256 + 4 * lane) = w;
        }
    }
    f32x4 acc[8];
#pragma unroll
    for (int t = 0; t < 8; ++t) acc[t] = (f32x4){0.f, 0.f, 0.f, 0.f};
#define ATT_PVC(st) do { \
        bf16x8 pa_ = (bf16x8){0, 0, 0, 0, 0, 0, 0, 0}; if (c < 4) pa_ = *(const bf16x8*)(Pb + c * 256 + 32 * (st) + 8 * g); \
        const int r0_ = 8 * g + (c >> 2), r1_ = r0_ + 4; \
        _Pragma("unroll") for (int t = 0; t < 8; ++t) { \
            const s16x4 lo_ = __builtin_amdgcn_ds_read_tr16_b64_v4i16((LAS s16x4*)(ring + r0_ * 256 + ((t ^ ATT_SWZ2(r0_)) * 32) + (c & 3) * 8)); \
            const s16x4 hi_ = __builtin_amdgcn_ds_read_tr16_b64_v4i16((LAS s16x4*)(ring + r1_ * 256 + ((t ^ ATT_SWZ2(r1_)) * 32) + (c & 3) * 8)); \
            const bf16x8 vb_ = (bf16x8){lo_[0], lo_[1], lo_[2], lo_[3], hi_[0], hi_[1], hi_[2], hi_[3]}; \
            acc[t] = mfma16(pa_, vb_, acc[t]); } } while (0)
#define ATT_ST(st, vcur) do { ATT_STV(vcur); ATT_PVC(st); if ((st) + 4 < 8) ATT_LDV(vcur, (st) + 4); } while (0)
    ATT_ST(0, v0); ATT_ST(1, v1); ATT_ST(2, v2); ATT_ST(3, v3); ATT_ST(4, v0); ATT_ST(5, v1); ATT_ST(6, v2); ATT_ST(7, v3);
#undef ATT_ST
#undef ATT_LDV
#undef ATT_STV
#undef ATT_PVC
#undef ATT_SWZ2
    if (g == 0) {
#pragma unroll
        for (int r = 0; r < 4; ++r)
#pragma unroll
            for (int t = 0; t < 8; ++t) OA[(size_t)row * 1024 + (4 * n + r) * 128 + 16 * t + c] = f2bf(acc[t][r] * inv[r]);
    }
}
DI void phase_attn(const Params& p, unsigned xcc, unsigned char* lds) {
    const int tid = tid_opaque(), lane = tid & 63, wid = tid >> 6;
    unsigned char* wl = lds + wid * AT_WAVE_LDS;
    u16* OA = (u16*)((unsigned char*)p.out + DO_OG);
    for (int i = blockIdx.x * NTHREADS + tid; i < 96 * 128; i += gridDim.x * NTHREADS) {
        const int r = i >> 7, b = r / 48, pp = r - 48 * b;
        *(u32x4*)(OA + ((size_t)b * LP + pp) * 1024 + (i & 127) * 8) = (u32x4){0u, 0u, 0u, 0u};
    }
    unsigned* qctr = (unsigned*)(p.ws + WS_CTL) + CW_AQ;
    const int my = (int)(xcc & 3u);
    constexpr int NIT = 8208 / 2;
    int cbq = my;
    unsigned jn = 0;
    if (lane == 0) jn = atomicAdd(&qctr[cbq * 64], 1u);
    for (;;) {
        int j = (int)__builtin_amdgcn_readfirstlane(jn), cb = cbq;
        while (j >= NIT) {
            if (((cbq + 1) & 3) == my) { j = -1; break; }
            cbq = (cbq + 1) & 3; cb = cbq;
            unsigned t = 0; if (lane == 0) t = atomicAdd(&qctr[cbq * 64], 1u);
            j = (int)__builtin_amdgcn_readfirstlane(t);
        }
        if (j < 0) break;
        if (lane == 0) jn = atomicAdd(&qctr[cbq * 64], 1u);
        attn_query(p, cb >> 1, cb & 1, 2 * j, wl);
        attn_query(p, cb >> 1, cb & 1, 2 * j + 1, wl);
    }
}

DI void phase_final(const Params& p) {
    const float* H = (const float*)(p.ws + WS_H);
    const u16* Y = (const u16*)(p.ws + WS_P0 + P0_Y);
    for (size_t i = (size_t)blockIdx.x * NTHREADS + tid_opaque(); i < (size_t)2 * SEQ * 256; i += (size_t)gridDim.x * NTHREADS) {
        const size_t orow = i >> 8; const int col = (int)(i & 255) * 4;
        const int b = (int)(orow >> 13), s = (int)(orow & 8191);
        const size_t row = (size_t)b * LP + 64 + s;
        f32x4 v = *(const f32x4*)(H + row * DM + col);
        const u32x2 y0 = *(const u32x2*)(Y + (2 * row) * DM + col), y1 = *(const u32x2*)(Y + (2 * row + 1) * DM + col);
        v[0] += bflo(y0.x) + bflo(y1.x); v[1] += bfhi(y0.x) + bfhi(y1.x); v[2] += bflo(y0.y) + bflo(y1.y); v[3] += bfhi(y0.y) + bfhi(y1.y);
        *(f32x4*)(p.out + orow * DM + col) = v;
    }
}

__global__ void __launch_bounds__(NTHREADS, 2) mega(Params p) {
    extern __shared__ __attribute__((aligned(16))) unsigned char lds[];
    if (threadIdx.x < 4) ((volatile LAS unsigned*)(lds + LDS_BAR))[threadIdx.x] = 0u;
    __syncthreads();
    XcdBarrier bar = xcd_barrier_post((unsigned*)(p.ws + WS_CTL) + CW_BAR, (volatile LAS unsigned*)(lds + LDS_BAR));
    phase_prep(p, lds);                                                   xcd_barrier(bar);
    phase_gemm_in0(p, lds);                                               xcd_barrier(bar);
    phase_gdn_prep(p, lds);                                             xcd_barrier(bar);
    { int c0 = 1, c1 = 66; asm volatile("" : "+s"(c0), "+s"(c1));
      if (blockIdx.x < 64) phase_gdn_scan(p, lds, c0, c1); else if (blockIdx.x < 80) gdn_prep_unit(p, blockIdx.x - 64, 128, lds); }
    xcd_barrier(bar);
    { int c0 = 67, c1 = 127; asm volatile("" : "+s"(c0), "+s"(c1));
      if (blockIdx.x < 64) phase_gdn_scan(p, lds, c0, c1); else { for (int u = blockIdx.x - 64; u < 16 * 68; u += gridDim.x - 64) gdn_out_unit(p, u / 68, u % 68, lds); } }
    xcd_barrier(bar);
    for (int u = blockIdx.x; u < 16 * 61; u += gridDim.x) gdn_out_unit(p, u / 61, 68 + u % 61, lds);
    xcd_barrier(bar);
    phase_gemm_out<true>(p, (const u16*)(p.ws + WS_W_OUT0), (const u16*)(p.ws + WS_P0) + 2048, 4096, lds);   xcd_barrier(bar);
    phase_norm<false, true>(p, p.norm_ffn, 0, lds);
    conv_moe_weights(p, 0, lds);                                          xcd_barrier(bar);
    phase_moe<0>(p, 0, lds);                                              xcd_barrier(bar);
    phase_moe<1>(p, 0, lds);                                              xcd_barrier(bar);
    phase_norm<true, false>(p, p.norm_mix + DM, 0, lds);
    conv_moe_weights(p, 1, lds);                                          xcd_barrier(bar);
    phase_gemm_in1(p, lds);                                               xcd_barrier(bar);
    phase_post1(p, lds);                                                  xcd_barrier(bar);
    phase_index(p, lds);                                                  xcd_barrier(bar);
    phase_attn(p, bar.x, lds);                                                   xcd_barrier(bar);
    phase_gemm_out<false>(p, (const u16*)(p.ws + WS_W_OUT1), (const u16*)((unsigned char*)p.out + DO_OG), 1024, lds);   xcd_barrier(bar);
    phase_norm<false, true>(p, p.norm_ffn + DM, 1, lds);                  xcd_barrier(bar);
    phase_moe<0>(p, 1, lds);                                              xcd_barrier(bar);
    phase_moe<1>(p, 1, lds);                                              xcd_barrier(bar);
    phase_final(p);
}

extern "C" void kernel_launch(void* const* d_in, const int* in_sizes, int n_in, void* d_out, int out_size, void* d_ws, size_t ws_size, hipStream_t stream) {
    static int grid = 0;
    if (grid == 0) {
        if (n_in != 23 || out_size != 2 * SEQ * DM || ws_size < WS_END) { fprintf(stderr, "kernel_launch: unexpected sizes (n_in %d out %d ws %zu need %zu)\n", n_in, out_size, ws_size, (size_t)WS_END); grid = -1; return; }
        int dev = 0, cus = 0;
        if (hipGetDevice(&dev) != hipSuccess || hipDeviceGetAttribute(&cus, hipDeviceAttributeMultiprocessorCount, dev) != hipSuccess) { grid = -1; return; }
        if (hipFuncSetAttribute((const void*)mega, hipFuncAttributeMaxDynamicSharedMemorySize, LDS_BYTES) != hipSuccess) { fprintf(stderr, "kernel_launch: hipFuncSetAttribute failed\n"); grid = -1; return; }
        grid = cus > 256 ? 256 : cus;
        if (grid < 16) { grid = -1; return; }
    }
    if (grid < 0) return;
    (void)hipMemsetAsync((unsigned char*)d_ws + WS_CTL, 0, CTL_BYTES, stream);
    Params p{};
    const float** f = (const float**)&p;
    for (int i = 0; i < 23; ++i) f[i] = (const float*)d_in[i];
    p.out = (float*)d_out; p.ws = (unsigned char*)d_ws;
    hipLaunchKernelGGL(mega, dim3(grid), dim3(NTHREADS), LDS_BYTES, stream, p);
}
```

```cpp
#include <hip/hip_runtime.h>
#include <stdint.h>
#include <stdio.h>

#define DI __device__ __forceinline__
#define LAS __attribute__((address_space(3)))
typedef unsigned short u16;
typedef unsigned int u32;
typedef short bf16x8 __attribute__((ext_vector_type(8)));
typedef _Float16 f16x8 __attribute__((ext_vector_type(8)));
typedef float f32x4 __attribute__((ext_vector_type(4)));
typedef float f32x16 __attribute__((ext_vector_type(16)));
typedef u32 u32x4 __attribute__((ext_vector_type(4)));
typedef u32 u32x2 __attribute__((ext_vector_type(2)));
typedef short s16x4 __attribute__((ext_vector_type(4)));

constexpr int DM = 1024, SEQ = 8192, LP = 8256, TP = 16512, TPA = 16640, NCH = 129;
constexpr int NTHREADS = 512;
constexpr int LDS_BYTES = 155648;
constexpr int LDS_BAR = LDS_BYTES - 16;
constexpr float RMS_EPS = 1e-6f;

constexpr size_t WS_CTL = 0, CTL_BYTES = 1u << 20;
constexpr size_t WS_W_IN0 = CTL_BYTES;
constexpr size_t WS_W_OUT0 = WS_W_IN0 + (size_t)4224 * 1024 * 2;
constexpr size_t WS_W_IN1 = WS_W_OUT0 + (size_t)1024 * 1024 * 2;
constexpr size_t WS_W_OUT1 = WS_W_IN1 + (size_t)2176 * 1024 * 2;
constexpr size_t WS_BA = WS_W_OUT1 + (size_t)1024 * 1024 * 2;
constexpr size_t WS_LIST = WS_BA + (size_t)TPA * 16 * 4;
constexpr size_t WS_CW = WS_LIST + (size_t)32 * TP * 4;
constexpr size_t WS_H = WS_CW + (size_t)2 * TP * 4;
constexpr size_t WS_NS = WS_H + (size_t)TPA * 1024 * 4;
constexpr size_t WS_HN = WS_NS;
constexpr size_t WS_P0 = WS_NS + (size_t)16 * 129 * 128 * 128 * 2;
constexpr size_t WS_HALO = WS_P0 + (size_t)TPA * 4096 * 2;
constexpr size_t WS_WGU = WS_HALO + (size_t)2 * 129 * 3 * 3072 * 2;
constexpr size_t WGU_LAYER = (size_t)32 * 512 * 1024 * 2;
constexpr size_t WS_WDN = WS_WGU + 2 * WGU_LAYER;
constexpr size_t WDN_LAYER = (size_t)32 * 1024 * 256 * 2;
constexpr size_t WS_END = WS_WDN + 2 * WDN_LAYER;
constexpr size_t P0_WGU = 0;
constexpr size_t P0_WDN = P0_WGU + (size_t)32 * 512 * 1024 * 2;
constexpr size_t P0_ACT = P0_WDN + (size_t)32 * 1024 * 256 * 2;
constexpr size_t P0_Y = P0_ACT + (size_t)2 * TP * 256 * 2;
constexpr size_t P0_QRAW = P0_ACT;
constexpr size_t P0_KRAW = P0_QRAW + (size_t)TP * 1024 * 2;
constexpr size_t P0_VN = P0_KRAW + (size_t)TP * 256 * 4;
constexpr size_t P0_QI = P0_VN + (size_t)TP * 256 * 2;
static_assert(P0_Y + (size_t)2 * TP * 1024 * 2 <= (size_t)TPA * 4096 * 2, "P0 map");
static_assert(P0_QI + (size_t)TP * 512 * 2 <= (size_t)TPA * 4096 * 2, "P0 map 2");
constexpr size_t DO_M = 0;
constexpr size_t DO_OG = 0;
constexpr size_t DO_SEL = (size_t)TPA * 1024 * 2;
constexpr size_t DO_KN = DO_SEL + (size_t)TP * 256 * 2;
constexpr size_t DO_KI = DO_KN + (size_t)TP * 256 * 2;
constexpr size_t DO_WI = DO_KI + (size_t)TP * 64 * 2;
constexpr size_t DO_KIRAW = DO_WI + (size_t)TP * 8 * 4;
static_assert(DO_KIRAW + (size_t)TP * 64 * 4 <= (size_t)2 * SEQ * 1024 * 4, "d_out map");
constexpr int CW_BAR = 0;
constexpr int CW_CNT = 4096;
constexpr int CW_AQ = 4352;

struct Params {
    const float *x, *meta, *norm_mix, *norm_ffn, *rel_bias, *gdn_w_in, *gdn_conv, *gdn_a_log, *gdn_dt_bias, *gdn_o_norm, *gdn_w_out,
        *dsa_w_in, *dsa_q_norm, *dsa_k_norm, *dsa_ln_g, *dsa_ln_b, *dsa_w_out, *moe_w_group, *moe_b_group, *moe_w_expert, *moe_b_expert,
        *moe_w_gu, *moe_w_down;
    float* out;
    unsigned char* ws;
};

DI u16 f2bf(float f) { return __builtin_bit_cast(u16, (__bf16)f); }
DI float bf2f(u16 h) { return __uint_as_float(((u32)h) << 16); }
DI u32 pk2(float a, float b) { return (u32)f2bf(a) | ((u32)f2bf(b) << 16); }
DI float bflo(u32 w) { return __uint_as_float(w << 16); }
DI float bfhi(u32 w) { return __uint_as_float(w & 0xffff0000u); }
typedef float f32x2 __attribute__((ext_vector_type(2)));
DI u32 pk4_fp8(float a, float b, float c, float d) { int w = 0; w = __builtin_amdgcn_cvt_pk_fp8_f32(a, b, w, false); w = __builtin_amdgcn_cvt_pk_fp8_f32(c, d, w, true); return (u32)w; }
typedef __bf16 bf16x2v __attribute__((ext_vector_type(2)));
DI u32x2 fp8x4_to_bf16x4(u32 w) {
    u32x2 r;
    r.x = __builtin_bit_cast(u32, __builtin_amdgcn_cvt_scalef32_pk_bf16_fp8(w, 1.0f, false));
    r.y = __builtin_bit_cast(u32, __builtin_amdgcn_cvt_scalef32_pk_bf16_fp8(w, 1.0f, true));
    return r;
}
DI bf16x8 fp8x8_to_bf16x8(u32 w0, u32 w1) { const u32x2 a = fp8x4_to_bf16x4(w0), b = fp8x4_to_bf16x4(w1); return __builtin_bit_cast(bf16x8, (u32x4){a.x, a.y, b.x, b.y}); }
DI float wave_sum(float v) {
#pragma unroll
    for (int o = 32; o >= 1; o >>= 1) v += __shfl_xor(v, o);
    return v;
}
DI int tid_opaque() { int t = threadIdx.x; asm volatile("" : "+v"(t)); return t; }
#define LDS_BARRIER() do { asm volatile("s_waitcnt lgkmcnt(0)" ::: "memory"); __builtin_amdgcn_s_barrier(); asm volatile("" ::: "memory"); } while (0)
DI float silu(float x) { return x / (1.f + __expf(-x)); }
DI f32x4 mfma16(bf16x8 a, bf16x8 b, f32x4 c) { return __builtin_amdgcn_mfma_f32_16x16x32_bf16(a, b, c, 0, 0, 0); }
DI bf16x8 ldsfrag(const unsigned char* base, int row, int strideB, int kel) { return *(const bf16x8*)(base + row * strideB + kel * 2); }

#define XB_TMO      128
#define XB_XCNT(j)  (256  + 64 * (j))
#define XB_XSUB(j)  (1280 + 64 * (j))
#define XB_XGEN(j)  (2304 + 64 * (j))
#define XB_TOP      3328
#define XB_TOPGEN   3392
#define XCD_BAR_WORDS 3456
#define XB_SPIN_CAP (1u << 21)
DI unsigned xb_ld(unsigned* p) { return __hip_atomic_load(p, __ATOMIC_RELAXED, __HIP_MEMORY_SCOPE_AGENT); }
DI unsigned xb_add(unsigned* p, unsigned v) { return __hip_atomic_fetch_add(p, v, __ATOMIC_RELAXED, __HIP_MEMORY_SCOPE_AGENT); }
DI unsigned xb_xcc_id() { return (unsigned)__builtin_amdgcn_s_getreg((3 << 11) | 20) & 0xFu; }
#define XB_SPIN(cond, bar) do { unsigned _sp = 0; while (cond) { __builtin_amdgcn_s_sleep(1); \
    if ((++_sp & 255u) == 0u) { if (xb_ld(&(bar)[XB_TMO])) break; if (_sp > XB_SPIN_CAP) { atomicAdd(&(bar)[XB_TMO], 1u); break; } } } } while (0)
struct XcdBarrier { unsigned* bar; unsigned x; volatile LAS unsigned* st; };
DI XcdBarrier xcd_barrier_post(unsigned* bar, volatile LAS unsigned* st) {
    XcdBarrier b; b.bar = bar; b.x = xb_xcc_id(); b.st = st;
    if (threadIdx.x == 0) (void)xb_add(&bar[XB_XCNT(b.x)], 1u);
    return b;
}
DI void xcd_barrier_complete(unsigned* bar, unsigned x, unsigned& nloc, unsigned& nx) {
    const unsigned G = gridDim.x * gridDim.y * gridDim.z;
    unsigned sum, cnt, mine, sp = 0u;
    for (;;) {
        sum = 0u; cnt = 0u; mine = 0u;
#pragma unroll
        for (unsigned j = 0; j < 16; ++j) { const unsigned c = xb_ld(&bar[XB_XCNT(j)]); sum += c; cnt += (c > 0u) ? 1u : 0u; }
        mine = xb_ld(&bar[XB_XCNT(x)]);
        if (sum == G) break;
        __builtin_amdgcn_s_sleep(1);
        if ((++sp & 255u) == 0u) { if (xb_ld(&bar[XB_TMO])) break; if (sp > XB_SPIN_CAP) { atomicAdd(&bar[XB_TMO], 1u); break; } }
    }
    nloc = mine > 0u ? mine : 1u; nx = cnt > 0u ? cnt : 1u;
}
DI void xcd_barrier(const XcdBarrier& b) {
    asm volatile("s_waitcnt vmcnt(0)" ::: "memory");
    __syncthreads();
    if (threadIdx.x == 0) {
        unsigned* bar = b.bar;
        __builtin_amdgcn_s_waitcnt(0);
        unsigned nloc = b.st[0], nx = b.st[1];
        if (nloc == 0u) { xcd_barrier_complete(bar, b.x, nloc, nx); b.st[0] = nloc; b.st[1] = nx; }
        const unsigned old = xb_add(&bar[XB_XSUB(b.x)], 1u);
        const unsigned gen = old / nloc;
        if (old + 1u == (gen + 1u) * nloc) {
            __builtin_amdgcn_fence(__ATOMIC_RELEASE, "agent");
            asm volatile("s_waitcnt vmcnt(0)" ::: "memory");
            const unsigned og = xb_add(&bar[XB_TOP], 1u);
            const unsigned tg = og / nx;
            if (og + 1u == (tg + 1u) * nx) xb_add(&bar[XB_TOPGEN], 1u);
            else XB_SPIN(xb_ld(&bar[XB_TOPGEN]) == tg, bar);
            __builtin_amdgcn_fence(__ATOMIC_ACQUIRE, "agent");
            xb_add(&bar[XB_XGEN(b.x)], 1u);
            asm volatile("s_waitcnt vmcnt(0)" ::: "memory");
        } else {
            XB_SPIN(xb_ld(&bar[XB_XGEN(b.x)]) == gen, bar);
            __builtin_amdgcn_fence(__ATOMIC_ACQUIRE, "agent");
            asm volatile("s_waitcnt vmcnt(0)" ::: "memory");
        }
    }
    __syncthreads();
}

struct ConvJob { const float* src; u16* dst; int K, N, kt, nt; };
DI void convT_load(const ConvJob& j, float (&r)[16], int tid) {
    const int l32 = tid & 31, kb = tid >> 5;
#pragma unroll
    for (int kk = 0; kk < 4; ++kk)
#pragma unroll
        for (int q = 0; q < 4; ++q) {
            const int k = j.kt * 64 + kb + 16 * kk, n = j.nt * 128 + l32 + 32 * q;
            r[4 * kk + q] = (n < j.N) ? j.src[(size_t)k * j.N + n] : 0.f;
        }
}
DI void convT_store(const ConvJob& j, const float (&r)[16], int tid, unsigned char* lds) {
    const int l32 = tid & 31, kb = tid >> 5;
    u16* img = (u16*)lds;
#pragma unroll
    for (int kk = 0; kk < 4; ++kk)
#pragma unroll
        for (int q = 0; q < 4; ++q) img[(l32 + 32 * q) * 68 + kb + 16 * kk] = f2bf(r[4 * kk + q]);
    __syncthreads();
#pragma unroll
    for (int i = 0; i < 2; ++i) {
        const int id = tid + NTHREADS * i, n = id >> 3, ck = id & 7;
        const u32x2 a = *(const u32x2*)(lds + n * 136 + ck * 16), b2 = *(const u32x2*)(lds + n * 136 + ck * 16 + 8);
        *(u32x4*)(j.dst + (size_t)(j.nt * 128 + n) * j.K + j.kt * 64 + ck * 8) = (u32x4){a.x, a.y, b2.x, b2.y};
    }
    __syncthreads();
}
template <class DEC> DI void convT_run(DEC dec, int u, const int nunits, const int stride, unsigned char* lds) {
    const int tid = tid_opaque();
    if (u >= nunits) return;
    ConvJob cur = dec(u), nxt = cur;
    float r[16];
    convT_load(cur, r, tid);
    for (;;) {
        const int un = u + stride;
        const bool more = un < nunits;
        float rn[16];
        u16* img = (u16*)lds;
        {
            const int l32 = tid & 31, kb = tid >> 5;
#pragma unroll
            for (int kk = 0; kk < 4; ++kk)
#pragma unroll
                for (int q = 0; q < 4; ++q) img[(l32 + 32 * q) * 68 + kb + 16 * kk] = f2bf(r[4 * kk + q]);
        }
        if (more) { nxt = dec(un); convT_load(nxt, rn, tid); }
        __syncthreads();
#pragma unroll
        for (int i = 0; i < 2; ++i) {
            const int id = tid + NTHREADS * i, n = id >> 3, ck = id & 7;
            const u32x2 a = *(const u32x2*)(lds + n * 136 + ck * 16), b2 = *(const u32x2*)(lds + n * 136 + ck * 16 + 8);
            *(u32x4*)(cur.dst + (size_t)(cur.nt * 128 + n) * cur.K + cur.kt * 64 + ck * 8) = (u32x4){a.x, a.y, b2.x, b2.y};
        }
        __syncthreads();
        if (!more) break;
        u = un; cur = nxt;
#pragma unroll
        for (int i = 0; i < 16; ++i) r[i] = rn[i];
    }
}

template <int NI> struct GemmAcc { f32x4 a[4][NI]; };
template <int NI, class PF, class QF>
DI void gemm_tile(const u16* __restrict__ Pb, const u16* __restrict__ Qb, int KT, PF pf, QF qf, GemmAcc<NI>& acc, unsigned char* lds) {
    constexpr int TN = 64 * NI, QC = TN * 8 / NTHREADS, BUF = (128 + TN) * 144;
    const int tid = tid_opaque(), lane = tid & 63, wid = tid >> 6, c = lane & 15, g = lane >> 4, wm = wid >> 2, wn = wid & 3;
    u32 poff[2], qoff[QC];
#pragma unroll
    for (int i = 0; i < 2; ++i) { const int id = tid + NTHREADS * i; poff[i] = pf(id >> 3) + (id & 7) * 8; }
#pragma unroll
    for (int i = 0; i < QC; ++i) { const int id = tid + NTHREADS * i; qoff[i] = qf(id >> 3) + (id & 7) * 8; }
#pragma unroll
    for (int mi = 0; mi < 4; ++mi)
#pragma unroll
        for (int ni = 0; ni < NI; ++ni) acc.a[mi][ni] = (f32x4){0.f, 0.f, 0.f, 0.f};
    u32x4 p0[2], p1[2], p2[2], p3[2], q0[QC], q1[QC], q2[QC], q3[QC];
#define GT_LOAD(P, Q, kt) do { if ((kt) < KT) { _Pragma("unroll") for (int i = 0; i < 2; ++i) P[i] = *(const u32x4*)(Pb + poff[i] + (kt) * 64); \
        _Pragma("unroll") for (int i = 0; i < QC; ++i) Q[i] = *(const u32x4*)(Qb + qoff[i] + (kt) * 64); } } while (0)
#define GT_STORE(P, Q, buf) do { _Pragma("unroll") for (int i = 0; i < 2; ++i) { const int id = tid + NTHREADS * i; *(u32x4*)((buf) + (id >> 3) * 144 + (id & 7) * 16) = P[i]; } \
        _Pragma("unroll") for (int i = 0; i < QC; ++i) { const int id = tid + NTHREADS * i; *(u32x4*)((buf) + 128 * 144 + (id >> 3) * 144 + (id & 7) * 16) = Q[i]; } } while (0)
#define GT_STEP(kt, PN, QN, PC, QC_) do { if ((kt) < KT) { const unsigned char* cur = lds + ((kt) & 1) * BUF; \
        _Pragma("unroll") for (int ks = 0; ks < 2; ++ks) { bf16x8 af[4], bfr[NI]; \
            _Pragma("unroll") for (int mi = 0; mi < 4; ++mi) af[mi] = ldsfrag(cur, wm * 64 + 16 * mi + c, 144, 32 * ks + 8 * g); \
            _Pragma("unroll") for (int ni = 0; ni < NI; ++ni) bfr[ni] = ldsfrag(cur + 128 * 144, wn * 16 * NI + 16 * ni + c, 144, 32 * ks + 8 * g); \
            _Pragma("unroll") for (int mi = 0; mi < 4; ++mi) _Pragma("unroll") for (int ni = 0; ni < NI; ++ni) acc.a[mi][ni] = mfma16(af[mi], bfr[ni], acc.a[mi][ni]); } \
        if ((kt) + 1 < KT) GT_STORE(PN, QN, lds + (((kt) + 1) & 1) * BUF); \
        GT_LOAD(PC, QC_, (kt) + 4); \
        __syncthreads(); } } while (0)
    GT_LOAD(p0, q0, 0); GT_LOAD(p1, q1, 1); GT_LOAD(p2, q2, 2); GT_LOAD(p3, q3, 3);
    GT_STORE(p0, q0, lds);
    __syncthreads();
    for (int k0 = 0; k0 < KT; k0 += 4) {
        GT_STEP(k0, p1, q1, p0, q0);
        GT_STEP(k0 + 1, p2, q2, p1, q1);
        GT_STEP(k0 + 2, p3, q3, p2, q2);
        GT_STEP(k0 + 3, p0, q0, p3, q3);
    }
#undef GT_LOAD
#undef GT_STORE
#undef GT_STEP
}
struct LinRow { u32 base, ld; DI u32 operator()(int r) const { return base + (u32)r * ld; } };

namespace pg {
constexpr int BM = 256, BK = 64, HALF = 128, HTB = HALF * BK * 2;
DI int lds_byte(int r, int c) { const int st = (r >> 4) * 2 + (c >> 5), rr = r & 15, cc = c & 31, ob = rr * 64 + cc * 2; return st * 1024 + (ob ^ (((ob >> 9) & 1) << 5)); }
DI void stage_rc(int b, int& R, int& C) { const int st = b / 1024, sb = b % 1024, swz = sb ^ (((sb >> 9) & 1) << 5); R = (st >> 1) * 16 + swz / 64; C = (st & 1) * 32 + (swz % 64) / 2; }
DI int perm32(int rho) { const int n = rho >> 4, i = rho & 15; return 8 * (i >> 2) + 4 * n + (i & 3); }
struct Unit { int pm, pn, e, n; };
typedef f32x4 Acc[2][2][4][2];
template <class Sched, class Epi>
DI void gemm(LAS unsigned char* lds, const int K, const Sched& S, const Epi& E) {
    const int tid = tid_opaque(), wid = __builtin_amdgcn_readfirstlane(tid >> 6), lane = tid & 63, wr = wid >> 2, wc = wid & 3, fr = lane & 15, fq = lane >> 4;
    const int nt = K / BK;
    int Rs[2], Cs[2];
    unsigned voffB[2];
#pragma unroll
    for (int i = 0; i < 2; ++i) { stage_rc(tid * 16 + i * 8192, Rs[i], Cs[i]); const int Rb = Epi::PERM ? ((Rs[i] & ~31) + perm32(Rs[i] & 31)) : Rs[i]; voffB[i] = (unsigned)(Rb * K + Cs[i]) * 2u; }
    const size_t kstep = (size_t)(BK * 2);
    const size_t bh1 = S.bh1();
    const unsigned ldsw = (unsigned)wid * 1024u;
    const int aoff = lds_byte(wr * 64 + fr, fq * 8), boff = lds_byte(wc * 32 + fr, fq * 8);
    const char* Ab = S.abase();
#define PG_SA(b, h) (((b) * 2 + (h)) * HTB)
#define PG_SB(b, h) ((4 + (b) * 2 + (h)) * HTB)
#define PG_STAGE(bufoff, gbase, voff) do { _Pragma("unroll") for (int _i = 0; _i < 2; ++_i) \
        __builtin_amdgcn_global_load_lds((const unsigned*)((const char*)(gbase) + (voff)[_i]), (LAS unsigned*)(lds + (bufoff) + ldsw + _i * 8192), 16, 0, 0); } while (0)
#define PG_LDA(dst, b, h) do { _Pragma("unroll") for (int m = 0; m < 4; ++m) _Pragma("unroll") for (int k = 0; k < 2; ++k) dst[m][k] = *(const LAS bf16x8*)(lds + PG_SA(b, h) + aoff + m * 2048 + k * 1024); } while (0)
#define PG_LDB(dst, b, h) do { _Pragma("unroll") for (int n = 0; n < 2; ++n) _Pragma("unroll") for (int k = 0; k < 2; ++k) dst[n][k] = *(const LAS bf16x8*)(lds + PG_SB(b, h) + boff + n * 2048 + k * 1024); } while (0)
#define PG_MMA(ai, bj, At, Bt) do { __builtin_amdgcn_s_setprio(1); _Pragma("unroll") for (int m = 0; m < 4; ++m) _Pragma("unroll") for (int n = 0; n < 2; ++n) _Pragma("unroll") for (int k = 0; k < 2; ++k) \
        acc[ai][bj][m][n] = __builtin_amdgcn_mfma_f32_16x16x32_bf16(Bt[n][k], At[m][k], acc[ai][bj][m][n], 0, 0, 0); __builtin_amdgcn_s_setprio(0); } while (0)
#define PG_WAIT_V(n) asm volatile("s_waitcnt vmcnt(" #n ")" ::: "memory")
#define PG_WAIT_L(n) asm volatile("s_waitcnt lgkmcnt(" #n ")" ::: "memory")
#define PG_BAR __builtin_amdgcn_s_barrier()
#define PG_SCHED __builtin_amdgcn_sched_barrier(0)
#define PG_AOFF(dst, u) do { _Pragma("unroll") for (int h_ = 0; h_ < 2; ++h_) _Pragma("unroll") for (int i_ = 0; i_ < 2; ++i_) dst[h_][i_] = (unsigned)(S.arow(u, h_ * HALF + Rs[i_]) * S.lda() + Cs[i_]) * 2u; } while (0)
    Unit cur, nxt; int ui = 0;
    if (!S.next(0, cur)) return;
    Acc acc;
#pragma unroll
    for (int a = 0; a < 2; ++a)
#pragma unroll
        for (int b = 0; b < 2; ++b)
#pragma unroll
            for (int m = 0; m < 4; ++m)
#pragma unroll
                for (int n = 0; n < 2; ++n) acc[a][b][m][n] = (f32x4){0.f, 0.f, 0.f, 0.f};
    bf16x8 At[4][2], B0[2][2], B1[2][2];
    unsigned aoC[2][2], aoN[2][2];
    PG_AOFF(aoC, cur);
    const char* cB = S.bbase(cur);
    PG_STAGE(PG_SB(0, 0), cB, voffB); PG_STAGE(PG_SA(0, 0), Ab, aoC[0]); PG_STAGE(PG_SB(0, 1), cB + bh1, voffB); PG_STAGE(PG_SA(0, 1), Ab, aoC[1]);
    if (wr == 1) PG_BAR;
    PG_WAIT_V(4); PG_BAR;
    PG_STAGE(PG_SB(1, 0), cB + kstep, voffB); PG_STAGE(PG_SA(1, 0), Ab + kstep, aoC[0]); PG_STAGE(PG_SB(1, 1), cB + bh1 + kstep, voffB);
    PG_WAIT_V(6); PG_BAR;
    for (;;) {
        const bool has_next = S.next(ui + 1, nxt);
        const char* nB = has_next ? S.bbase(nxt) : cB;
        if (has_next) PG_AOFF(aoN, nxt);
        else {
#pragma unroll
            for (int h_ = 0; h_ < 2; ++h_)
#pragma unroll
                for (int i_ = 0; i_ < 2; ++i_) aoN[h_][i_] = aoC[h_][i_];
        }
#pragma unroll 1
        for (int t = 0; t < nt; t += 2) {
            const bool last = (t == nt - 2);
            const char* a1 = Ab + (size_t)(t + 1) * kstep;
            const char* a2 = last ? Ab : Ab + (size_t)(t + 2) * kstep; const char* b2 = last ? nB : cB + (size_t)(t + 2) * kstep;
            const char* a3 = a2 + kstep; const char* b3 = b2 + kstep;
            unsigned o2[2][2];
#pragma unroll
            for (int h_ = 0; h_ < 2; ++h_)
#pragma unroll
                for (int i_ = 0; i_ < 2; ++i_) o2[h_][i_] = last ? aoN[h_][i_] : aoC[h_][i_];
            PG_LDB(B0, 0, 0); PG_SCHED; PG_LDA(At, 0, 0); PG_STAGE(PG_SA(1, 1), a1, aoC[1]);
            PG_WAIT_L(8); PG_BAR; PG_WAIT_L(0); PG_MMA(0, 0, At, B0); PG_BAR; PG_SCHED;
            PG_LDB(B1, 0, 1); PG_STAGE(PG_SB(0, 0), b2, voffB);
            PG_BAR; PG_WAIT_L(0); PG_MMA(0, 1, At, B1); PG_BAR;
            PG_LDA(At, 0, 1); PG_STAGE(PG_SA(0, 0), a2, o2[0]);
            PG_BAR; PG_WAIT_L(0); PG_MMA(1, 0, At, B0); PG_BAR; PG_SCHED;
            PG_STAGE(PG_SB(0, 1), b2 + bh1, voffB);
            PG_WAIT_V(6); PG_BAR; PG_MMA(1, 1, At, B1); PG_BAR;
            PG_LDB(B0, 1, 0); PG_SCHED; PG_LDA(At, 1, 0); PG_STAGE(PG_SA(0, 1), a2, o2[1]);
            PG_WAIT_L(8); PG_BAR; PG_WAIT_L(0); PG_MMA(0, 0, At, B0); PG_BAR; PG_SCHED;
            PG_LDB(B1, 1, 1); PG_STAGE(PG_SB(1, 0), b3, voffB);
            PG_BAR; PG_WAIT_L(0); PG_MMA(0, 1, At, B1); PG_BAR;
            PG_LDA(At, 1, 1); PG_STAGE(PG_SA(1, 0), a3, o2[0]);
            PG_BAR; PG_WAIT_L(0); PG_MMA(1, 0, At, B0); PG_BAR; PG_SCHED;
            PG_STAGE(PG_SB(1, 1), b3 + bh1, voffB);
            PG_WAIT_V(6); PG_BAR; PG_MMA(1, 1, At, B1); PG_BAR;
        }
        E(acc, cur, wr, wc, fr, fq);
        if (!has_next) break;
#pragma unroll
        for (int a = 0; a < 2; ++a)
#pragma unroll
            for (int b = 0; b < 2; ++b)
#pragma unroll
                for (int m = 0; m < 4; ++m)
#pragma unroll
                    for (int n = 0; n < 2; ++n) acc[a][b][m][n] = (f32x4){0.f, 0.f, 0.f, 0.f};
        cur = nxt; cB = nB; ++ui;
#pragma unroll
        for (int h_ = 0; h_ < 2; ++h_)
#pragma unroll
            for (int i_ = 0; i_ < 2; ++i_) aoC[h_][i_] = aoN[h_][i_];
    }
    PG_WAIT_V(0);
    if (wr == 0) PG_BAR;
    PG_BAR;
#undef PG_SA
#undef PG_SB
#undef PG_STAGE
#undef PG_LDA
#undef PG_LDB
#undef PG_MMA
#undef PG_WAIT_V
#undef PG_WAIT_L
#undef PG_BAR
#undef PG_SCHED
#undef PG_AOFF
}
}

DI void conv_small_weights(const Params& p, int u0, int u1, int first, int stride, unsigned char* lds) {
    const int n0 = 16 * 33, n1 = 16 * 8, n2 = 16 * 17, n3 = 16 * 8;
    auto dec = [=](int u) -> ConvJob {
        if (u < n0) return ConvJob{p.gdn_w_in, (u16*)(p.ws + WS_W_IN0), 1024, 4112, u & 15, u >> 4};
        if (u < n0 + n1) { const int v = u - n0; return ConvJob{p.gdn_w_out, (u16*)(p.ws + WS_W_OUT0), 1024, 1024, v & 15, v >> 4}; }
        if (u < n0 + n1 + n2) { const int v = u - n0 - n1; return ConvJob{p.dsa_w_in, (u16*)(p.ws + WS_W_IN1), 1024, 2120, v & 15, v >> 4}; }
        const int v = u - n0 - n1 - n2; return ConvJob{p.dsa_w_out, (u16*)(p.ws + WS_W_OUT1), 1024, 1024, v & 15, v >> 4};
    };
    convT_run(dec, u0 + first, u1 < 0 ? n0 + n1 + n2 + n3 : u1, stride, lds);
}
constexpr int CONV_MOE_LAYER = 3072, CONV_SCAN_UNITS = 3072 + 3072;
DI void conv_moe_weights(const Params& p, int u0, int u1, int first, int stride, unsigned char* lds) {
    const int ngu = 32 * 64;
    auto dec = [=](int uu) -> ConvJob {
        const int layer = uu >= CONV_MOE_LAYER ? 1 : 0, u = uu - layer * CONV_MOE_LAYER;
        if (u < ngu) { const int e = u >> 6, v = u & 63;
            return ConvJob{p.moe_w_gu + ((size_t)layer * 32 + e) * 1024 * 512, (u16*)(p.ws + WS_WGU + layer * WGU_LAYER) + (size_t)e * 512 * 1024, 1024, 512, v & 15, v >> 4}; }
        const int w = u - ngu, e = w >> 5, v = w & 31;
        return ConvJob{p.moe_w_down + ((size_t)layer * 32 + e) * 256 * 1024, (u16*)(p.ws + WS_WDN + layer * WDN_LAYER) + (size_t)e * 1024 * 256, 256, 1024, v & 3, v >> 2};
    };
    convT_run(dec, u0 + first, u1, stride, lds);
}
DI void phase_prep(const Params& p, unsigned char* lds) {
    conv_small_weights(p, 0, 16 * 33, (int)blockIdx.x, (int)gridDim.x, lds);
    const int lane = tid_opaque() & 63, wid = tid_opaque() >> 6;
    float* H = (float*)(p.ws + WS_H);
    u16* HN = (u16*)(p.ws + WS_HN);
    for (int row = blockIdx.x * 8 + wid; row < TPA; row += gridDim.x * 8) {
        const int b = row / LP, pp = row - b * LP;
        const bool real = row < TP && pp >= 48;
        const float* src = real ? (pp < 64 ? p.meta + (size_t)(pp - 48) * DM : p.x + ((size_t)b * SEQ + (pp - 64)) * DM) : nullptr;
        f32x4 v[4];
        float ss = 0.f;
#pragma unroll
        for (int i = 0; i < 4; ++i) {
            v[i] = real ? *(const f32x4*)(src + 4 * lane + 256 * i) : (f32x4){0.f, 0.f, 0.f, 0.f};
            ss += v[i][0] * v[i][0] + v[i][1] * v[i][1] + v[i][2] * v[i][2] + v[i][3] * v[i][3];
        }
        ss = wave_sum(ss);
        const float rstd = rsqrtf(ss * (1.f / DM) + RMS_EPS);
#pragma unroll
        for (int i = 0; i < 4; ++i) {
            const int col = 4 * lane + 256 * i;
            if (pp < 64 || row >= TP) *(f32x4*)(H + (size_t)row * DM + col) = v[i];
            const f32x4 gn = *(const f32x4*)(p.norm_mix + col);
            u32x2 w; w.x = pk2(v[i][0] * rstd * gn[0], v[i][1] * rstd * gn[1]); w.y = pk2(v[i][2] * rstd * gn[2], v[i][3] * rstd * gn[3]);
            *(u32x2*)(HN + (size_t)row * DM + col) = w;
        }
    }
}

DI int frame_row(int pm, int r) { return (pm >> 5) * LP + 64 + (pm & 31) * 256 + r; }
struct DenseSched {
    const char* A; const char* Bt; int K, npn, total, ldA;
    DI bool next(int i, pg::Unit& u) const { const int L = i * (int)gridDim.x + (int)blockIdx.x; if (L >= total) return false; u.pn = L % npn; u.pm = L / npn; u.e = 0; u.n = 256; return true; }
    DI int arow(const pg::Unit& u, int r) const { return frame_row(u.pm, r); }
    DI const char* abase() const { return A; }
    DI int lda() const { return ldA; }
    DI const char* bbase(const pg::Unit& u) const { return Bt + (size_t)u.pn * 256 * K * 2; }
    DI size_t bh1() const { return (size_t)128 * K * 2; }
};
struct EpiIn0 {
    static constexpr bool PERM = true;
    u16* P0; u16* HALO;
    DI void store(int row, int col, u32x4 w) const {
        *(u32x4*)(P0 + (size_t)row * 4096 + col) = w;
        if (col < 3072) { const int bb = row / LP, pp = row - bb * LP;
            if ((pp & 63) >= 61 && (pp >> 6) < 128) *(u32x4*)(HALO + ((size_t)(bb * 129 + (pp >> 6) + 1) * 3 + ((pp & 63) - 61)) * 3072 + col) = w; }
    }
    DI void operator()(const pg::Acc& acc, const pg::Unit& u, int wr, int wc, int fr, int fq) const {
#pragma unroll
        for (int ai = 0; ai < 2; ++ai)
#pragma unroll
            for (int m = 0; m < 4; ++m) {
                const int row = frame_row(u.pm, 128 * ai + 64 * wr + 16 * m + fr);
#pragma unroll
                for (int bj = 0; bj < 2; ++bj) {
                    const f32x4 v0 = acc[ai][bj][m][0], v1 = acc[ai][bj][m][1];
                    u32x4 w; w.x = pk2(v0[0], v0[1]); w.y = pk2(v0[2], v0[3]); w.z = pk2(v1[0], v1[1]); w.w = pk2(v1[2], v1[3]);
                    store(row, 256 * u.pn + 128 * bj + 32 * wc + 8 * fq, w);
                }
            }
    }
};
DI void phase_gemm_in0(const Params& p, unsigned char* lds) {
    const u16* W = (const u16*)(p.ws + WS_W_IN0);
    const u16* X = (const u16*)(p.ws + WS_HN);
    u16* P0 = (u16*)(p.ws + WS_P0);
    float* BA = (float*)(p.ws + WS_BA);
    u16* HALO = (u16*)(p.ws + WS_HALO);
    {
        DenseSched S{(const char*)X, (const char*)W, 1024, 16, 64 * 16, 1024};
        EpiIn0 E{P0, HALO};
        pg::gemm((LAS unsigned char*)lds, 1024, S, E);
    }
    __syncthreads();
    const int lane = tid_opaque() & 63, wid = tid_opaque() >> 6, c = lane & 15, g = lane >> 4, wm = wid >> 2, wn = wid & 3;
    for (int t = blockIdx.x; t < 64 + 130; t += gridDim.x) {
        const bool lead = t < 64;
        const int mt = lead ? (t & 31) : 32;
        const int row0 = lead ? (t >> 5) * LP : (t - 64) * 128;
        GemmAcc<2> acc;
        gemm_tile<2>(W, X, 16, LinRow{(u32)(mt * 128) * 1024u, 1024u}, LinRow{(u32)row0 * 1024u, 1024u}, acc, lds);
#pragma unroll
        for (int mi = 0; mi < 4; ++mi) {
            const int f = mt * 128 + wm * 64 + 16 * mi + 4 * g;
#pragma unroll
            for (int ni = 0; ni < 2; ++ni) {
                const int tok = row0 + wn * 32 + 16 * ni + c;
                const f32x4 v = acc.a[mi][ni];
                if (lead) { if (tok - row0 < 64) { u32x2 w; w.x = pk2(v[0], v[1]); w.y = pk2(v[2], v[3]); *(u32x2*)(P0 + (size_t)tok * 4096 + f) = w;
                        if (f < 3072 && tok - row0 >= 61) *(u32x2*)(HALO + ((size_t)((t >> 5) * 129 + 1) * 3 + (tok - row0 - 61)) * 3072 + f) = w; } }
                else if (f < 4112) *(f32x4*)(BA + (size_t)tok * 16 + (f - 4096)) = v;
            }
        }
    }
}
template <bool FROMX>
struct EpiOut {
    static constexpr bool PERM = false;
    float* H; const float* X;
    DI void operator()(const pg::Acc& acc, const pg::Unit& u, int wr, int wc, int fr, int fq) const {
#pragma unroll
        for (int ai = 0; ai < 2; ++ai)
#pragma unroll
            for (int m = 0; m < 4; ++m) {
                const int r = 128 * ai + 64 * wr + 16 * m + fr, co = 256 * u.pn + 32 * wc + 4 * fq;
                float* hp = H + (size_t)frame_row(u.pm, r) * DM + co;
                const float* sp = FROMX ? X + ((size_t)(u.pm >> 5) * SEQ + (u.pm & 31) * 256 + r) * DM + co : hp;
#pragma unroll
                for (int bj = 0; bj < 2; ++bj)
#pragma unroll
                    for (int n = 0; n < 2; ++n) { *(f32x4*)(hp + 128 * bj + 16 * n) = *(const f32x4*)(sp + 128 * bj + 16 * n) + acc[ai][bj][m][n]; }
            }
    }
};
template <bool FROMX>
DI void phase_gemm_out(const Params& p, const u16* W, const u16* X, const int ldx, unsigned char* lds) {
    float* H = (float*)(p.ws + WS_H);
    {
        DenseSched S{(const char*)X, (const char*)W, 1024, 4, 64 * 4, ldx};
        EpiOut<FROMX> E{H, p.x};
        pg::gemm((LAS unsigned char*)lds, 1024, S, E);
    }
    __syncthreads();
    const int lane = tid_opaque() & 63, wid = tid_opaque() >> 6, c = lane & 15, g = lane >> 4, wm = wid >> 2, wn = wid & 3;
    for (int t = (int)gridDim.x - 1 - (int)blockIdx.x; t < 16; t += gridDim.x) {
        const int mt = t & 7, row0 = (t >> 3) * LP;
        GemmAcc<2> acc;
        gemm_tile<2>(W, X, 16, LinRow{(u32)(mt * 128) * 1024u, 1024u}, LinRow{(u32)row0 * (u32)ldx, (u32)ldx}, acc, lds);
#pragma unroll
        for (int mi = 0; mi < 4; ++mi) {
            const int f = mt * 128 + wm * 64 + 16 * mi + 4 * g;
#pragma unroll
            for (int ni = 0; ni < 2; ++ni) {
                const int tok = row0 + wn * 32 + 16 * ni + c;
                if (tok - row0 < 64) { f32x4* hp = (f32x4*)(H + (size_t)tok * DM + f); *hp = *hp + acc.a[mi][ni]; }
            }
        }
    }
}
struct EpiIn1 {
    static constexpr bool PERM = true;
    u16* QRAW; float* KRAW; unsigned char* VN; _Float16* QI;
    DI void operator()(const pg::Acc& acc, const pg::Unit& u, int wr, int wc, int fr, int fq) const {
#pragma unroll
        for (int ai = 0; ai < 2; ++ai)
#pragma unroll
            for (int m = 0; m < 4; ++m) {
                const size_t row = (size_t)frame_row(u.pm, 128 * ai + 64 * wr + 16 * m + fr);
#pragma unroll
                for (int bj = 0; bj < 2; ++bj) {
                    const f32x4 v0 = acc[ai][bj][m][0], v1 = acc[ai][bj][m][1];
                    const int cl = 128 * bj + 32 * wc + 8 * fq;
                    if (u.pn < 4) { u32x4 w; w.x = pk2(v0[0], v0[1]); w.y = pk2(v0[2], v0[3]); w.z = pk2(v1[0], v1[1]); w.w = pk2(v1[2], v1[3]); *(u32x4*)(QRAW + row * 1024 + 256 * u.pn + cl) = w; }
                    else if (u.pn == 4) { *(f32x4*)(KRAW + row * 256 + cl) = v0; *(f32x4*)(KRAW + row * 256 + cl + 4) = v1; }
                    else if (u.pn == 5) { u32x2 w; w.x = pk4_fp8(v0[0], v0[1], v0[2], v0[3]); w.y = pk4_fp8(v1[0], v1[1], v1[2], v1[3]); *(u32x2*)(VN + row * 256 + cl) = w; }
                    else { f16x8 h8; h8[0] = (_Float16)v0[0]; h8[1] = (_Float16)v0[1]; h8[2] = (_Float16)v0[2]; h8[3] = (_Float16)v0[3]; h8[4] = (_Float16)v1[0]; h8[5] = (_Float16)v1[1]; h8[6] = (_Float16)v1[2]; h8[7] = (_Float16)v1[3];
                        *(f16x8*)(QI + row * 512 + 256 * (u.pn - 6) + cl) = h8; }
                }
            }
    }
};
DI void phase_gemm_in1(const Params& p, unsigned char* lds) {
    const u16* W = (const u16*)(p.ws + WS_W_IN1);
    const u16* X = (const u16*)(p.ws + WS_HN);
    u16* QRAW = (u16*)(p.ws + WS_P0 + P0_QRAW);
    float* KRAW = (float*)(p.ws + WS_P0 + P0_KRAW);
    unsigned char* VN = p.ws + WS_P0 + P0_VN;
    _Float16* QI = (_Float16*)(p.ws + WS_P0 + P0_QI);
    float* KIRAW = (float*)((unsigned char*)p.out + DO_KIRAW);
    float* WI = (float*)((unsigned char*)p.out + DO_WI);
    {
        DenseSched S{(const char*)X, (const char*)W, 1024, 8, 64 * 8, 1024};
        EpiIn1 E{QRAW, KRAW, VN, QI};
        pg::gemm((LAS unsigned char*)lds, 1024, S, E);
    }
    __syncthreads();
    const int lane = tid_opaque() & 63, wid = tid_opaque() >> 6, c = lane & 15, g = lane >> 4, wm = wid >> 2, wn = wid & 3;
    for (int t = blockIdx.x; t < 32 + 130; t += gridDim.x) {
        const bool lead = t < 32;
        const int mt = lead ? (t & 15) : 16;
        const int row0 = lead ? (t >> 4) * LP : (t - 32) * 128;
        GemmAcc<2> acc;
        gemm_tile<2>(W, X, 16, LinRow{(u32)(mt * 128) * 1024u, 1024u}, LinRow{(u32)row0 * 1024u, 1024u}, acc, lds);
#pragma unroll
        for (int mi = 0; mi < 4; ++mi) {
            const int f = mt * 128 + wm * 64 + 16 * mi + 4 * g;
#pragma unroll
            for (int ni = 0; ni < 2; ++ni) {
                const int tok = row0 + wn * 32 + 16 * ni + c;
                if (tok >= TP || (lead && tok - row0 >= 64)) continue;
                const f32x4 v = acc.a[mi][ni];
                if (f < 1024) { u32x2 w; w.x = pk2(v[0], v[1]); w.y = pk2(v[2], v[3]); *(u32x2*)(QRAW + (size_t)tok * 1024 + f) = w; }
                else if (f < 1280) *(f32x4*)(KRAW + (size_t)tok * 256 + (f - 1024)) = v;
                else if (f < 1536) *(u32*)(VN + (size_t)tok * 256 + (f - 1280)) = pk4_fp8(v[0], v[1], v[2], v[3]);
                else if (f < 2048) {
                    _Float16* q = QI + (size_t)tok * 512 + (f - 1536);
                    q[0] = (_Float16)v[0]; q[1] = (_Float16)v[1]; q[2] = (_Float16)v[2]; q[3] = (_Float16)v[3];
                }
                else if (f < 2112) *(f32x4*)(KIRAW + (size_t)tok * 64 + (f - 2048)) = v;
                else if (f < 2120) *(f32x4*)(WI + (size_t)tok * 8 + (f - 2112)) = v * 0.04419417382415922f;
            }
        }
    }
}

constexpr int G_KT = 0, G_QT = 17408, G_KRT = 34816, G_VRT = 53248, G_LF = 71680, G_TF = 88320, G_TMP = 104960, G_TTW = 109184, G_TTU = 118400,
              G_QKT = 127616, G_SC = 136832;
constexpr int G_WT = G_LF, G_UT = G_LF + 18432;
constexpr int G_ST = G_KRT;
static_assert(G_UT + 18432 <= G_TTW, "WT/UT alias");
DI void gdn_prep_unit(const Params& p, int bh, int ch, unsigned char* lds) {
    const int tid = tid_opaque(), lane = tid & 63, wid = tid >> 6, c = lane & 15, g = lane >> 4;
    const int b = bh >> 3, h = bh & 7;
    const size_t row0 = (size_t)b * LP + (size_t)ch * 64;
    u16* P0 = (u16*)(p.ws + WS_P0);
    const u16* HALO = (const u16*)(p.ws + WS_HALO);
    float* SC = (float*)(lds + G_SC);
    float bb = 0.f, aa = 0.f;
    if (wid == 7) { const float* BA = (const float*)(p.ws + WS_BA); bb = BA[(row0 + lane) * 16 + h]; aa = BA[(row0 + lane) * 16 + 8 + h]; }
    {
        const int cp = tid & 63, part = tid >> 6;
        u32 raw[3][11];
#pragma unroll
        for (int X = 0; X < 3; ++X) {
            const int col = X * 1024 + h * 128 + 2 * cp;
#pragma unroll
            for (int i = 0; i < 11; ++i) {
                const int rr = 8 * part - 3 + i;
                raw[X][i] = rr < 0 ? (ch == 0 ? 0u : *(const u32*)(HALO + ((size_t)(b * 129 + ch) * 3 + (rr + 3)) * 3072 + col)) : *(const u32*)(P0 + (row0 + rr) * 4096 + col);
            }
        }
        if (wid == 7) {
            const float beta = 1.f / (1.f + __expf(-bb));
            const float xs = aa + p.gdn_dt_bias[h];
            const float sp = xs > 20.f ? xs : log1pf(__expf(xs));
            const float gg = -__expf(p.gdn_a_log[h]) * sp;
            float gc = gg;
#pragma unroll
            for (int o = 1; o < 64; o <<= 1) { const float t = __shfl_up(gc, o); if (lane >= o) gc += t; }
            const float glast = __shfl(gc, 63);
            SC[lane] = gc; SC[64 + lane] = beta; SC[128 + lane] = __expf(gc); SC[192 + lane] = __expf(glast - gc);
            if (lane == 0) SC[384] = __expf(glast);
        }
#pragma unroll
        for (int X = 0; X < 3; ++X) {
            u32 o[8];
            f32x2 wv[4];
#pragma unroll
            for (int j = 0; j < 4; ++j) wv[j] = *(const f32x2*)(p.gdn_conv + j * 3072 + X * 1024 + h * 128 + 2 * cp);
#pragma unroll
            for (int i = 0; i < 8; ++i) {
                const float a0 = wv[0][0] * bflo(raw[X][i]) + wv[1][0] * bflo(raw[X][i + 1]) + wv[2][0] * bflo(raw[X][i + 2]) + wv[3][0] * bflo(raw[X][i + 3]);
                const float a1 = wv[0][1] * bfhi(raw[X][i]) + wv[1][1] * bfhi(raw[X][i + 1]) + wv[2][1] * bfhi(raw[X][i + 2]) + wv[3][1] * bfhi(raw[X][i + 3]);
                o[i] = pk2(silu(a0), silu(a1));
            }
            if (X < 2) {
                u16* T = (u16*)(lds + (X == 0 ? G_QT : G_KT));
#pragma unroll
                for (int i = 0; i < 8; ++i) *(u32*)(T + (8 * part + i) * 136 + 2 * cp) = o[i];
            }
            if (X >= 1) {
                u16* T = (u16*)(lds + (X == 1 ? G_KRT : G_VRT));
                u32x4 lo, hi;
                lo.x = (o[0] & 0xffffu) | (o[1] << 16); lo.y = (o[2] & 0xffffu) | (o[3] << 16); lo.z = (o[4] & 0xffffu) | (o[5] << 16); lo.w = (o[6] & 0xffffu) | (o[7] << 16);
                hi.x = (o[0] >> 16) | (o[1] & 0xffff0000u); hi.y = (o[2] >> 16) | (o[3] & 0xffff0000u); hi.z = (o[4] >> 16) | (o[5] & 0xffff0000u); hi.w = (o[6] >> 16) | (o[7] & 0xffff0000u);
                *(u32x4*)(T + (2 * cp) * 72 + 8 * part) = lo; *(u32x4*)(T + (2 * cp + 1) * 72 + 8 * part) = hi;
            }
        }
    }
    { float* TF = (float*)(lds + G_TF); for (int i = tid; i < 64 * 65; i += NTHREADS) TF[i] = 0.f; }
    __syncthreads();
    {
        const int rt = wid & 3;
        const unsigned char* Arow = lds + (wid < 4 ? G_KT : G_QT);
        f32x4 acc[4], qq = (f32x4){0.f, 0.f, 0.f, 0.f};
#pragma unroll
        for (int ni = 0; ni < 4; ++ni) acc[ni] = (f32x4){0.f, 0.f, 0.f, 0.f};
#pragma unroll
        for (int ks = 0; ks < 4; ++ks) {
            const bf16x8 a = ldsfrag(Arow, 16 * rt + c, 272, 32 * ks + 8 * g);
#pragma unroll
            for (int ni = 0; ni < 4; ++ni) acc[ni] = mfma16(a, ldsfrag(lds + G_KT, 16 * ni + c, 272, 32 * ks + 8 * g), acc[ni]);
            if (wid >= 4) qq = mfma16(a, a, qq);
        }
        {
            const f32x4 kd_ = rt == 0 ? acc[0] : (rt == 1 ? acc[1] : (rt == 2 ? acc[2] : acc[3]));
            const f32x4 d = (wid < 4) ? kd_ : qq;
            if (g == (c >> 2)) {
                const int r = c & 3;
                const float dv = r == 0 ? d[0] : (r == 1 ? d[1] : (r == 2 ? d[2] : d[3]));
                SC[(wid < 4 ? 256 : 320) + 16 * rt + c] = rsqrtf(dv + 1e-6f);
            }
        }
        __syncthreads();
        float* LF = (float*)(lds + G_LF);
        u16* QKT = (u16*)(lds + G_QKT);
#pragma unroll
        for (int ni = 0; ni < 4; ++ni) {
            const int j = 16 * ni + c;
            const float gcj = SC[j], rkj = SC[256 + j];
#pragma unroll
            for (int r = 0; r < 4; ++r) {
                const int i = 16 * rt + 4 * g + r;
                const float gci = SC[i];
                if (wid < 4) {
                    const float v = (i > j) ? SC[64 + i] * SC[256 + i] * rkj * acc[ni][r] * __expf(gci - gcj) : 0.f;
                    LF[i * 65 + j] = v;
                } else {
                    const float v = (i >= j) ? SC[320 + i] * 0.08838834764831845f * rkj * acc[ni][r] * __expf(gci - gcj) : 0.f;
                    QKT[i * 72 + j] = f2bf(v);
                }
            }
        }
    }
    __syncthreads();
    {
        const float* LF = (const float*)(lds + G_LF);
        float* TF = (float*)(lds + G_TF);
        float* TMP = (float*)(lds + G_TMP);
        if (wid == 0) {
            const int b4 = lane >> 4, j = lane & 15;
            float t[16];
#pragma unroll
            for (int i = 0; i < 16; ++i) {
                float s = (i == j) ? 1.f : 0.f;
#pragma unroll
                for (int m = 0; m < i; ++m) s -= LF[(16 * b4 + i) * 65 + 16 * b4 + m] * t[m];
                t[i] = s;
            }
#pragma unroll
            for (int i = 0; i < 16; ++i) TF[(16 * b4 + i) * 65 + 16 * b4 + j] = t[i];
        }
        __syncthreads();
        {
            const int pp = tid >> 8, i = (tid >> 4) & 15, j = tid & 15;
            float s = 0.f;
#pragma unroll
            for (int m = 0; m < 16; ++m) s += LF[(16 * (2 * pp + 1) + i) * 65 + 32 * pp + m] * TF[(32 * pp + m) * 65 + 32 * pp + j];
            TMP[pp * 256 + i * 16 + j] = s;
            __syncthreads();
            float x = 0.f;
#pragma unroll
            for (int m = 0; m < 16; ++m) x -= TF[(16 * (2 * pp + 1) + i) * 65 + 16 * (2 * pp + 1) + m] * TMP[pp * 256 + m * 16 + j];
            TF[(16 * (2 * pp + 1) + i) * 65 + 32 * pp + j] = x;
        }
        __syncthreads();
        {
            const int i = tid >> 4, j0 = tid & 15;
            float s0 = 0.f, s1 = 0.f;
#pragma unroll
            for (int m = 0; m < 32; ++m) { const float l = LF[(32 + i) * 65 + m]; s0 += l * TF[m * 65 + j0]; s1 += l * TF[m * 65 + j0 + 16]; }
            __syncthreads();
            TMP[i * 33 + j0] = s0; TMP[i * 33 + j0 + 16] = s1;
            __syncthreads();
            float x0 = 0.f, x1 = 0.f;
#pragma unroll
            for (int m = 0; m < 32; ++m) { const float tt = TF[(32 + i) * 65 + 32 + m]; x0 -= tt * TMP[m * 33 + j0]; x1 -= tt * TMP[m * 33 + j0 + 16]; }
            TF[(32 + i) * 65 + j0] = x0; TF[(32 + i) * 65 + j0 + 16] = x1;
        }
        __syncthreads();
        u16* TTW = (u16*)(lds + G_TTW);
        u16* TTU = (u16*)(lds + G_TTU);
#pragma unroll
        for (int i = 0; i < 8; ++i) {
            const int e = tid + NTHREADS * i, t = e >> 6, s = e & 63;
            const float tv = (s <= t) ? TF[t * 65 + s] : 0.f;
            const float bs = SC[64 + s];
            TTW[t * 72 + s] = f2bf(tv * bs * SC[256 + s] * SC[128 + s]);
            TTU[t * 72 + s] = f2bf(tv * bs);
        }
    }
    __syncthreads();
    {
        const int tt = wid & 3, isu = wid >> 2;
        f32x4 acc[8];
#pragma unroll
        for (int ni = 0; ni < 8; ++ni) acc[ni] = (f32x4){0.f, 0.f, 0.f, 0.f};
        const unsigned char* A = lds + (isu ? G_TTU : G_TTW);
        const unsigned char* Bt = lds + (isu ? G_VRT : G_KRT);
#pragma unroll
        for (int ks = 0; ks < 2; ++ks) {
            const bf16x8 a = ldsfrag(A, 16 * tt + c, 144, 32 * ks + 8 * g);
#pragma unroll
            for (int ni = 0; ni < 8; ++ni) acc[ni] = mfma16(a, ldsfrag(Bt, 16 * ni + c, 144, 32 * ks + 8 * g), acc[ni]);
        }
        __syncthreads();
        u16* WU = (u16*)(lds + (isu ? G_UT : G_WT));
        const int t0 = 16 * tt + 4 * g;
#pragma unroll
        for (int ni = 0; ni < 8; ++ni) {
            u32x2 w; w.x = pk2(acc[ni][0], acc[ni][1]); w.y = pk2(acc[ni][2], acc[ni][3]);
            *(u32x2*)(WU + (16 * ni + c) * 72 + t0) = w;
        }
    }
    __syncthreads();
    {
        f32x4 acc[4];
#pragma unroll
        for (int ni = 0; ni < 4; ++ni) acc[ni] = (f32x4){0.f, 0.f, 0.f, 0.f};
#pragma unroll
        for (int ks = 0; ks < 2; ++ks) {
            const bf16x8 a = ldsfrag(lds + G_WT, 16 * wid + c, 144, 32 * ks + 8 * g);
#pragma unroll
            for (int ni = 0; ni < 4; ++ni) acc[ni] = mfma16(a, ldsfrag(lds + G_QKT, 16 * ni + c, 144, 32 * ks + 8 * g), acc[ni]);
        }
        u16* QT = (u16*)(lds + G_QT);
#pragma unroll
        for (int ni = 0; ni < 4; ++ni) {
            const int t = 16 * ni + c, j0 = 16 * wid + 4 * g;
            const float qs = SC[320 + t] * 0.08838834764831845f * SC[128 + t];
            u32x2* qp = (u32x2*)(QT + t * 136 + j0);
            const u32x2 q = *qp;
            u32x2 w;
            w.x = pk2(bflo(q.x) * qs - acc[ni][0], bfhi(q.x) * qs - acc[ni][1]);
            w.y = pk2(bflo(q.y) * qs - acc[ni][2], bfhi(q.y) * qs - acc[ni][3]);
            *qp = w;
        }
    }
    {
        const int tt = wid & 3, dvh = wid >> 2;
        f32x4 acc[4];
#pragma unroll
        for (int ni = 0; ni < 4; ++ni) acc[ni] = (f32x4){0.f, 0.f, 0.f, 0.f};
#pragma unroll
        for (int ks = 0; ks < 2; ++ks) {
            const bf16x8 a = ldsfrag(lds + G_QKT, 16 * tt + c, 144, 32 * ks + 8 * g);
#pragma unroll
            for (int ni = 0; ni < 4; ++ni) acc[ni] = mfma16(a, ldsfrag(lds + G_UT, 16 * (4 * dvh + ni) + c, 144, 32 * ks + 8 * g), acc[ni]);
        }
        u16* KT = (u16*)(lds + G_KT);
#pragma unroll
        for (int ni = 0; ni < 4; ++ni)
#pragma unroll
            for (int r = 0; r < 4; ++r) KT[(16 * tt + 4 * g + r) * 136 + 16 * (4 * dvh + ni) + c] = f2bf(acc[ni][r]);
    }
    __syncthreads();
    {
#pragma unroll
        for (int i = 0; i < 2; ++i) {
            const int id = tid + NTHREADS * i, t = id >> 4, ck = id & 15;
            *(u32x4*)(P0 + (row0 + t) * 4096 + h * 128 + 8 * ck) = *(const u32x4*)(lds + G_QT + t * 272 + ck * 16);
            *(u32x4*)(P0 + (row0 + t) * 4096 + 1024 + h * 128 + 8 * ck) = *(const u32x4*)(lds + G_KT + t * 272 + ck * 16);
        }
        const int dim = tid >> 2, s0 = (tid & 3) * 16;
        float sc[16];
#pragma unroll
        for (int i = 0; i < 16; ++i) sc[i] = SC[256 + s0 + i] * SC[192 + s0 + i];
#pragma unroll
        for (int X = 0; X < 2; ++X) {
            u32x4* tp = (u32x4*)(lds + (X ? G_UT : G_WT) + dim * 144 + s0 * 2);
#pragma unroll
            for (int hf = 0; hf < 2; ++hf) {
                u32x4 w = tp[hf];
                w.x = pk2(bflo(w.x) * sc[8 * hf + 0], bfhi(w.x) * sc[8 * hf + 1]); w.y = pk2(bflo(w.y) * sc[8 * hf + 2], bfhi(w.y) * sc[8 * hf + 3]);
                w.z = pk2(bflo(w.z) * sc[8 * hf + 4], bfhi(w.z) * sc[8 * hf + 5]); w.w = pk2(bflo(w.w) * sc[8 * hf + 6], bfhi(w.w) * sc[8 * hf + 7]);
                tp[hf] = w;
            }
        }
    }
    LDS_BARRIER();
    {
        {
            f32x4 acc[8];
#pragma unroll
            for (int ni = 0; ni < 8; ++ni) acc[ni] = (f32x4){0.f, 0.f, 0.f, 0.f};
#pragma unroll
            for (int ks = 0; ks < 2; ++ks) {
                const bf16x8 a = ldsfrag(lds + G_WT, 16 * wid + c, 144, 32 * ks + 8 * g);
#pragma unroll
                for (int ni = 0; ni < 8; ++ni) acc[ni] = mfma16(a, ldsfrag(lds + G_KRT, 16 * ni + c, 144, 32 * ks + 8 * g), acc[ni]);
            }
            if (ch > 0) {
                u16* Mg = (u16*)((unsigned char*)p.out + DO_M) + ((size_t)bh * 128 + (ch - 1)) * 16384;
                const float cd = SC[384];
                const int gp = ((g & 1) << 1) | (g >> 1);
#pragma unroll
                for (int ni = 0; ni < 8; ++ni) {
                    const int i = 16 * ni + c, j0 = 16 * wid + 4 * g;
                    float v[4];
#pragma unroll
                    for (int r = 0; r < 4; ++r) v[r] = ((i == j0 + r) ? cd : 0.f) - acc[ni][r];
                    u32x2 w; w.x = pk2(v[0], v[1]); w.y = pk2(v[2], v[3]);
                    *(u32x2*)(Mg + (size_t)i * 128 + 16 * wid + 4 * gp) = w;
                }
            }
        }
        {
            f32x4 acc[8];
#pragma unroll
            for (int ni = 0; ni < 8; ++ni) acc[ni] = (f32x4){0.f, 0.f, 0.f, 0.f};
#pragma unroll
            for (int ks = 0; ks < 2; ++ks) {
                const bf16x8 a = ldsfrag(lds + G_KRT, 16 * wid + c, 144, 32 * ks + 8 * g);
#pragma unroll
                for (int ni = 0; ni < 8; ++ni) acc[ni] = mfma16(a, ldsfrag(lds + G_UT, 16 * ni + c, 144, 32 * ks + 8 * g), acc[ni]);
            }
            u16* NT = (u16*)(p.ws + WS_NS) + ((size_t)bh * NCH + ch) * 16384;
#pragma unroll
            for (int ni = 0; ni < 8; ++ni) {
                u32x2 w; w.x = pk2(acc[ni][0], acc[ni][1]); w.y = pk2(acc[ni][2], acc[ni][3]);
                *(u32x2*)(NT + ((size_t)(4 * wid + g) * 128 + 16 * ni + c) * 4) = w;
            }
        }
    }
    LDS_BARRIER();
}
constexpr int GO_QE = 0, GO_O0 = 17408, GO_ST = 34816, GO_SC = 69632;
DI void gdn_out_unit(const Params& p, int bh, int ch, unsigned char* lds) {
    const int tid = tid_opaque(), lane = tid & 63, wid = tid >> 6, c = lane & 15, g = lane >> 4;
    const int b = bh >> 3, h = bh & 7;
    const size_t row0 = (size_t)b * LP + (size_t)ch * 64;
    const u16* P0 = (const u16*)(p.ws + WS_P0);
    float* SC = (float*)(lds + GO_SC);
#pragma unroll
    for (int i = 0; i < 2; ++i) {
        const int id = tid + NTHREADS * i, t = id >> 4, ck = id & 15;
        *(u32x4*)(lds + GO_QE + t * 272 + ck * 16) = *(const u32x4*)(P0 + (row0 + t) * 4096 + h * 128 + 8 * ck);
        *(u32x4*)(lds + GO_O0 + t * 272 + ck * 16) = *(const u32x4*)(P0 + (row0 + t) * 4096 + 1024 + h * 128 + 8 * ck);
    }
    if (ch > 0) {
        const u16* ST = (const u16*)(p.ws + WS_NS) + ((size_t)bh * NCH + (ch - 1)) * 16384;
#pragma unroll
        for (int i = 0; i < 4; ++i) { const int id = tid + NTHREADS * i, i4 = id >> 6, dvp = id & 63;
            const u32x4 w = *(const u32x4*)(ST + (size_t)id * 8);
            *(u32x2*)(lds + GO_ST + (2 * dvp) * 272 + i4 * 8) = (u32x2){w.x, w.y};
            *(u32x2*)(lds + GO_ST + (2 * dvp + 1) * 272 + i4 * 8) = (u32x2){w.z, w.w}; }
    }
    const int tt = wid & 3, dvh = wid >> 2;
    u16 zr[4][4]; float gn[4];
#pragma unroll
    for (int ni = 0; ni < 4; ++ni) {
        const int dv = 16 * (4 * dvh + ni) + c;
        gn[ni] = p.gdn_o_norm[dv];
#pragma unroll
        for (int r = 0; r < 4; ++r) zr[ni][r] = P0[(row0 + 16 * tt + 4 * g + r) * 4096 + 3072 + h * 128 + dv];
    }
    __syncthreads();
    f32x4 acc[4];
    const u16* O0 = (const u16*)(lds + GO_O0);
#pragma unroll
    for (int ni = 0; ni < 4; ++ni)
#pragma unroll
        for (int r = 0; r < 4; ++r) acc[ni][r] = bf2f(O0[(16 * tt + 4 * g + r) * 136 + 16 * (4 * dvh + ni) + c]);
    if (ch > 0) {
#pragma unroll
        for (int ks = 0; ks < 4; ++ks) {
            const bf16x8 a = ldsfrag(lds + GO_QE, 16 * tt + c, 272, 32 * ks + 8 * g);
#pragma unroll
            for (int ni = 0; ni < 4; ++ni) acc[ni] = mfma16(a, ldsfrag(lds + GO_ST, 16 * (4 * dvh + ni) + c, 272, 32 * ks + 8 * g), acc[ni]);
        }
    }
    float ss[4];
#pragma unroll
    for (int r = 0; r < 4; ++r) {
        float s = 0.f;
#pragma unroll
        for (int ni = 0; ni < 4; ++ni) s += acc[ni][r] * acc[ni][r];
        s += __shfl_xor(s, 1); s += __shfl_xor(s, 2); s += __shfl_xor(s, 4); s += __shfl_xor(s, 8);
        ss[r] = s;
    }
    if (c == 0) {
#pragma unroll
        for (int r = 0; r < 4; ++r) SC[dvh * 64 + 16 * tt + 4 * g + r] = ss[r];
    }
    __syncthreads();
    u16* OG = (u16*)(p.ws + WS_P0) + 2048;
#pragma unroll
    for (int r = 0; r < 4; ++r) {
        const int t = 16 * tt + 4 * g + r;
        const float rstd = rsqrtf((SC[t] + SC[64 + t]) * (1.f / 128.f) + RMS_EPS);
#pragma unroll
        for (int ni = 0; ni < 4; ++ni) {
            const int dv = 16 * (4 * dvh + ni) + c;
            const float z = bf2f(zr[ni][r]);
            OG[(row0 + t) * 4096 + h * 128 + dv] = f2bf(acc[ni][r] * rstd * gn[ni] * silu(z));
        }
    }
    LDS_BARRIER();
}
DI void phase_gdn_prep(const Params& p, unsigned char* lds) {
    for (int u = blockIdx.x; u < 16 * 128; u += gridDim.x) gdn_prep_unit(p, u >> 7, u & 127, lds);
}
DI void phase_gdn_out(const Params& p, unsigned char* lds) {
    for (int u = blockIdx.x; u < 16 * NCH; u += gridDim.x) gdn_out_unit(p, u / NCH, u % NCH, lds);
}

DI void scan_loadM(u32x4 (&r)[8], const u16* Mg, int j, int t4) {
    if (j <= 127) {
        const u16* src = Mg + (size_t)(j - 1) * 16384;
#pragma unroll
        for (int i = 0; i < 8; ++i) { const int id = t4 + 256 * i; r[i] = *(const u32x4*)(src + (size_t)(id >> 4) * 128 + (id & 15) * 8); }
    }
}
DI void scan_storeM(const u32x4 (&r)[8], unsigned char* slot, int t4) {
#pragma unroll
    for (int i = 0; i < 8; ++i) { const int id = t4 + 256 * i; *(u32x4*)(slot + (id >> 4) * 272 + (id & 15) * 16) = r[i]; }
}
DI void scan_loadNq(u32x4 (&r)[8], const u16* NSb, int j, int lane) {
    if (j <= 127) {
        const u16* s0 = NSb + (size_t)j * 16384;
#pragma unroll
        for (int k = 0; k < 8; ++k) { const int id = lane + 64 * k; r[k] = *(const u32x4*)(s0 + (id >> 4) * 512 + (id & 15) * 8); }
    }
}
#define SCAN_BAR() do { asm volatile("s_waitcnt lgkmcnt(0)" ::: "memory"); __builtin_amdgcn_s_barrier(); asm volatile("" ::: "memory"); } while (0)
DI void scan_loadM2(u32x4 (&r)[16], const u16* Mg, int j, int t2) {
    if (j <= 127) {
        const u16* src = Mg + (size_t)(j - 1) * 16384;
#pragma unroll
        for (int i = 0; i < 16; ++i) { const int id = t2 + 128 * i; r[i] = *(const u32x4*)(src + (size_t)(id >> 4) * 128 + (id & 15) * 8); }
    }
}
DI void scan_storeM2(const u32x4 (&r)[16], unsigned char* slot, int t2) {
#pragma unroll
    for (int i = 0; i < 16; ++i) { const int id = t2 + 128 * i; *(u32x4*)(slot + (id >> 4) * 272 + (id & 15) * 16) = r[i]; }
}
DI void phase_gdn_scan(const Params& p, unsigned char* lds, const int C0, const int C1) {
    int bh = blockIdx.x & 15, dvq = blockIdx.x >> 4;
    asm volatile("" : "+s"(bh), "+s"(dvq));
    const int tid = tid_opaque(), lane = tid & 63, wid = __builtin_amdgcn_readfirstlane(tid >> 6), col = lane & 31, hh = lane >> 5;
    const u16* Mg = (const u16*)((unsigned char*)p.out + DO_M) + (size_t)bh * 128 * 16384;
    u16* NSb = (u16*)(p.ws + WS_NS) + (size_t)bh * NCH * 16384 + (size_t)(32 * dvq) * 4;
    unsigned char* slot0 = lds, *slot1 = lds + 34816;
    unsigned char* nb0 = lds + 69632, *nb1 = nb0 + 8192, *sb0 = nb1 + 8192, *sb1 = sb0 + 8192, *fb0 = sb1 + 8192, *fb1 = fb0 + 8192;
    if (wid >= 6) {
        const int t2 = tid - 384;
        u32x4 r0[16], r1[16], r2[16];
        scan_loadM2(r0, Mg, C0, t2); scan_storeM2(r0, (C0 & 1) ? slot1 : slot0, t2); scan_loadM2(r0, Mg, C0 + 1, t2); scan_loadM2(r1, Mg, C0 + 2, t2); scan_loadM2(r2, Mg, C0 + 3, t2);
        SCAN_BAR();
#define SCAN_LD(cc, R) do { if ((cc) <= C1) { if ((cc) + 1 <= C1) scan_storeM2(R, ((cc) + 1) & 1 ? slot1 : slot0, t2); scan_loadM2(R, Mg, (cc) + 4, t2); SCAN_BAR(); } } while (0)
#pragma unroll 1
        for (int c0 = C0; c0 <= C1; c0 += 3) { SCAN_LD(c0, r0); SCAN_LD(c0 + 1, r1); SCAN_LD(c0 + 2, r2); }
#undef SCAN_LD
    } else if (wid == 4) {
        u32x4 r0[8], r1[8], r2[8];
#define SCAN_STN(R, buf) do { _Pragma("unroll") for (int k = 0; k < 8; ++k) *(u32x4*)((buf) + (lane + 64 * k) * 16) = R[k]; } while (0)
        scan_loadNq(r0, NSb, C0, lane); SCAN_STN(r0, (C0 & 1) ? nb1 : nb0); scan_loadNq(r0, NSb, C0 + 1, lane); scan_loadNq(r1, NSb, C0 + 2, lane); scan_loadNq(r2, NSb, C0 + 3, lane);
        SCAN_BAR();
#define SCAN_LN(cc, R) do { if ((cc) <= C1) { if ((cc) + 1 <= C1) SCAN_STN(R, ((cc) + 1) & 1 ? nb1 : nb0); scan_loadNq(R, NSb, (cc) + 4, lane); SCAN_BAR(); } } while (0)
#pragma unroll 1
        for (int c0 = C0; c0 <= C1; c0 += 3) { SCAN_LN(c0, r0); SCAN_LN(c0 + 1, r1); SCAN_LN(c0 + 2, r2); }
#undef SCAN_LN
#undef SCAN_STN
    } else if (wid == 5) {
        SCAN_BAR();
#pragma unroll 1
        for (int cc = C0; cc <= C1 + 1; ++cc) {
            if (cc >= C0 + 1) {
                const unsigned char* sb = ((cc - 1) & 1) ? sb1 : sb0;
                u16* dst = NSb + (size_t)(cc - 1) * 16384;
#pragma unroll
                for (int k = 0; k < 8; ++k) { const int id = lane + 64 * k; *(u32x4*)(dst + (id >> 4) * 512 + (id & 15) * 8) = *(const u32x4*)(sb + id * 16); }
            }
            if (cc <= C1) SCAN_BAR();
        }
    } else {
        const int ob = wid;
        f32x16 acc;
#pragma unroll
        for (int q = 0; q < 4; ++q) {
            const u32x2 w = *(const u32x2*)(NSb + (size_t)(C0 - 1) * 16384 + ((8 * ob + 2 * q + hh) * 128 + col) * 4);
            acc[4 * q + 0] = bflo(w.x); acc[4 * q + 1] = bfhi(w.x); acc[4 * q + 2] = bflo(w.y); acc[4 * q + 3] = bfhi(w.y);
        }
#define SCAN_PUBF(buf) do { _Pragma("unroll") for (int s_ = 0; s_ < 2; ++s_) { bf16x8 f_; _Pragma("unroll") for (int j = 0; j < 8; ++j) f_[j] = (short)f2bf(acc[8 * s_ + j]); \
            *(bf16x8*)((buf) + ((2 * ob + s_) * 64 + lane) * 16) = f_; } } while (0)
        SCAN_PUBF((C0 & 1) ? fb1 : fb0);
        SCAN_BAR();
        const int apo = (32 * ob + col) * 272 + hh * 16;
#pragma unroll 1
        for (int cc = C0; cc <= C1; ++cc) {
            const unsigned char* cur = (cc & 1) ? slot1 : slot0;
            const unsigned char* nbuf = (cc & 1) ? nb1 : nb0;
            unsigned char* sbuf = (cc & 1) ? sb1 : sb0;
            const unsigned char* fin = (cc & 1) ? fb1 : fb0;
            unsigned char* fout = (cc & 1) ? fb0 : fb1;
            bf16x8 fa[8], fbq[8];
#pragma unroll
            for (int ks = 0; ks < 8; ++ks) { fbq[ks] = *(const bf16x8*)(fin + (ks * 64 + lane) * 16); fa[ks] = *(const bf16x8*)(cur + apo + ks * 32); }
            f32x16 nw;
#pragma unroll
            for (int q = 0; q < 4; ++q) {
                const u32x2 w = *(const u32x2*)(nbuf + ((8 * ob + 2 * q + hh) * 32 + col) * 8);
                nw[4 * q + 0] = bflo(w.x); nw[4 * q + 1] = bfhi(w.x); nw[4 * q + 2] = bflo(w.y); nw[4 * q + 3] = bfhi(w.y);
            }
#pragma unroll
            for (int ks = 0; ks < 8; ++ks) nw = __builtin_amdgcn_mfma_f32_32x32x16_bf16(fa[ks], fbq[ks], nw, 0, 0, 0);
            acc = nw;
#pragma unroll
            for (int q = 0; q < 4; ++q) {
                u32x2 w; w.x = pk2(acc[4 * q], acc[4 * q + 1]); w.y = pk2(acc[4 * q + 2], acc[4 * q + 3]);
                *(u32x2*)(sbuf + ((8 * ob + 2 * q + hh) * 32 + col) * 8) = w;
            }
            SCAN_PUBF(fout);
            SCAN_BAR();
        }
#undef SCAN_PUBF
    }
}
#undef SCAN_BAR

template <bool ADDY, bool ROUTE>
DI void phase_norm(const Params& p, const float* gain, int layer, unsigned char* lds) {
    const int tid = tid_opaque(), lane = tid & 63, wid = tid >> 6;
    float* H = (float*)(p.ws + WS_H);
    u16* HN = (u16*)(p.ws + WS_HN);
    const u16* Y = (const u16*)(p.ws + WS_P0 + P0_Y);
    float* xs = (float*)lds;
    float* part = (float*)(lds + 32768);
    float* logit = (float*)(lds + 32768 + 9216);
    int* asg = (int*)(lds + 32768 + 9216 + 1152);
    int iter = 0;
    const float* wg = p.moe_w_group + (size_t)layer * 1024 * 4;
    const float* we = p.moe_w_expert + (size_t)layer * 1024 * 32;
    float wr[128];
    if (ROUTE) {
        const float* wp = lane < 4 ? wg + lane : we + ((lane < 36 ? lane : 35) - 4);
        const int wst = lane < 4 ? 4 : 32;
#pragma unroll
        for (int k = 0; k < 128; ++k) wr[k] = wp[(size_t)(128 * wid + k) * wst];
    }
    f32x4 vn[4]; u32x2 yn0[4], yn1[4];
#define NORM_FETCH(rw) do { _Pragma("unroll") for (int i = 0; i < 4; ++i) { const int col = 4 * lane + 256 * i; vn[i] = *(const f32x4*)(H + (size_t)(rw) * DM + col); \
        if (ADDY) { yn0[i] = *(const u32x2*)(Y + (size_t)(2 * (rw)) * DM + col); yn1[i] = *(const u32x2*)(Y + (size_t)(2 * (rw) + 1) * DM + col); } } } while (0)
    if ((int)blockIdx.x * 8 < TP) NORM_FETCH(blockIdx.x * 8 + wid);
    for (int base = blockIdx.x * 8; base < TP; base += gridDim.x * 8) {
        const int row = base + wid;
        {
            f32x4 v[4];
            u32x2 yc0[4], yc1[4];
#pragma unroll
            for (int i = 0; i < 4; ++i) { v[i] = vn[i]; if (ADDY) { yc0[i] = yn0[i]; yc1[i] = yn1[i]; } }
            if (base + (int)gridDim.x * 8 < TP) NORM_FETCH(row + gridDim.x * 8);
            float ss = 0.f;
#pragma unroll
            for (int i = 0; i < 4; ++i) {
                const int col = 4 * lane + 256 * i;
                if (ADDY) {
                    const u32x2 y0 = yc0[i], y1 = yc1[i];
                    const int pp = row % LP;
                    if (pp >= 48) {
                        v[i][0] += bflo(y0.x) + bflo(y1.x); v[i][1] += bfhi(y0.x) + bfhi(y1.x); v[i][2] += bflo(y0.y) + bflo(y1.y); v[i][3] += bfhi(y0.y) + bfhi(y1.y);
                        *(f32x4*)(H + (size_t)row * DM + col) = v[i];
                    }
                }
                ss += v[i][0] * v[i][0] + v[i][1] * v[i][1] + v[i][2] * v[i][2] + v[i][3] * v[i][3];
            }
            ss = wave_sum(ss);
            const float rstd = rsqrtf(ss * (1.f / DM) + RMS_EPS);
#pragma unroll
            for (int i = 0; i < 4; ++i) {
                const int col = 4 * lane + 256 * i;
                const f32x4 gn = *(const f32x4*)(gain + col);
                const f32x4 o = (f32x4){v[i][0] * rstd * gn[0], v[i][1] * rstd * gn[1], v[i][2] * rstd * gn[2], v[i][3] * rstd * gn[3]};
                u32x2 w; w.x = pk2(o[0], o[1]); w.y = pk2(o[2], o[3]);
                *(u32x2*)(HN + (size_t)row * DM + col) = w;
                if (ROUTE) *(f32x4*)(xs + wid * 1024 + col) = o;
            }
        }
        if (ROUTE) {
            __syncthreads();
            {
                float a8[8];
#pragma unroll
                for (int r = 0; r < 8; ++r) a8[r] = 0.f;
                if (lane < 36) {
#pragma unroll
                    for (int k4 = 0; k4 < 32; ++k4) {
#pragma unroll
                        for (int r = 0; r < 8; ++r) {
                            const f32x4 x4 = *(const f32x4*)(xs + r * 1024 + 128 * wid + 4 * k4);
                            a8[r] += x4[0] * wr[4 * k4] + x4[1] * wr[4 * k4 + 1] + x4[2] * wr[4 * k4 + 2] + x4[3] * wr[4 * k4 + 3];
                        }
                    }
#pragma unroll
                    for (int r = 0; r < 8; ++r) part[(wid * 8 + r) * 36 + lane] = a8[r];
                }
            }
            __syncthreads();
            if (tid < 288) {
                const int r = tid / 36, n = tid - r * 36;
                float s = 0.f;
#pragma unroll
                for (int w = 0; w < 8; ++w) s += part[(w * 8 + r) * 36 + n];
                s += (n < 4) ? p.moe_b_group[layer * 4 + n] : p.moe_b_expert[layer * 32 + n - 4];
                logit[r * 36 + n] = s;
            }
            __syncthreads();
            if (tid < 8) {
                const int rr = base + tid, pp = rr % LP;
                if (pp >= 48) {
                    const float* lg = logit + tid * 36;
                    int gs = 0; float gm = lg[0];
#pragma unroll
                    for (int i = 1; i < 4; ++i) if (lg[i] > gm) { gm = lg[i]; gs = i; }
                    float gsum = 0.f;
#pragma unroll
                    for (int i = 0; i < 4; ++i) gsum += __expf(lg[i] - gm);
                    const float gw = 1.f / gsum;
                    const float* el = lg + 4 + 8 * gs;
                    int i0 = 0; float m0 = el[0];
#pragma unroll
                    for (int i = 1; i < 8; ++i) if (el[i] > m0) { m0 = el[i]; i0 = i; }
                    int i1 = -1; float m1 = -3.0e38f;
#pragma unroll
                    for (int i = 0; i < 8; ++i) if (i != i0 && el[i] > m1) { m1 = el[i]; i1 = i; }
                    const float e1 = __expf(m1 - m0);
                    const float c0 = gw / (1.f + e1), c1 = gw * e1 / (1.f + e1);
                    float* cw = (float*)(p.ws + WS_CW);
                    cw[2 * rr] = c0; cw[2 * rr + 1] = c1;
                    const int slot = 16 * iter + 2 * tid;
                    asg[slot] = ((8 * gs + i0) << 24) | (2 * rr); asg[slot + 1] = ((8 * gs + i1) << 24) | (2 * rr + 1);
                } else {
                    const int slot = 16 * iter + 2 * tid;
                    asg[slot] = -1; asg[slot + 1] = -1;
                }
            }
            __syncthreads();
        }
        ++iter;
    }
    if (ROUTE) {
        const int n = 16 * iter;
        unsigned* cnt = (unsigned*)(p.ws + WS_CTL) + CW_CNT + layer * 32;
        u32* list = (u32*)(p.ws + WS_LIST);
        int* ebase = asg + 256;
        if (tid < 32) {
            int cn = 0;
            for (int i = 0; i < n; ++i) cn += (asg[i] >= 0 && (asg[i] >> 24) == tid) ? 1 : 0;
            ebase[tid] = cn > 0 ? (int)atomicAdd(&cnt[tid], (unsigned)cn) : 0;
        }
        __syncthreads();
        if (tid < n) {
            const int v = asg[tid];
            if (v >= 0) {
                const int e = v >> 24;
                int rk = 0;
                for (int i = 0; i < tid; ++i) rk += (asg[i] >= 0 && (asg[i] >> 24) == e) ? 1 : 0;
                list[(size_t)e * TP + ebase[e] + rk] = (u32)(v & 0xffffff);
            }
        }
        __syncthreads();
    }
}

struct MoeSched {
    const char* A; const char* Bt; const u32* list; const int* pre;
    int K, ncol, rshift, total; size_t estride, cstride, h1;
    DI bool next(int i, pg::Unit& u) const {
        const int L = i * (int)gridDim.x + (int)blockIdx.x; if (L >= total) return false;
        const int rtile = L / ncol; u.pn = L - rtile * ncol;
        int e = 0;
        for (int j = 1; j < 32; ++j) if (pre[j] <= rtile) e = j;
        u.e = e; u.pm = rtile - pre[e]; u.n = pre[64 + e];
        return true;
    }
    DI int asg(const pg::Unit& u, int r) const { const int gi = u.pm * 256 + r; return (int)list[(size_t)u.e * TP + (gi < u.n ? gi : 0)]; }
    DI int arow(const pg::Unit& u, int r) const { return asg(u, r) >> rshift; }
    DI const char* abase() const { return A; }
    DI int lda() const { return K; }
    DI const char* bbase(const pg::Unit& u) const { return Bt + (size_t)u.e * estride + (size_t)u.pn * cstride; }
    DI size_t bh1() const { return h1; }
};
struct EpiGateUp {
    static constexpr bool PERM = true;
    const MoeSched* S; const float* cw; u16* ACT;
    DI void operator()(const pg::Acc& acc, const pg::Unit& u, int wr, int wc, int fr, int fq) const {
#pragma unroll
        for (int ai = 0; ai < 2; ++ai)
#pragma unroll
            for (int m = 0; m < 4; ++m) {
                const int r = 128 * ai + 64 * wr + 16 * m + fr;
                if (u.pm * 256 + r >= u.n) continue;
                const int a = S->asg(u, r);
                const float cwa = cw[a];
                const f32x4 g0 = acc[ai][0][m][0], g1 = acc[ai][0][m][1], u0 = acc[ai][1][m][0], u1 = acc[ai][1][m][1];
                u32x4 w;
                w.x = pk2(silu(g0[0]) * u0[0] * cwa, silu(g0[1]) * u0[1] * cwa); w.y = pk2(silu(g0[2]) * u0[2] * cwa, silu(g0[3]) * u0[3] * cwa);
                w.z = pk2(silu(g1[0]) * u1[0] * cwa, silu(g1[1]) * u1[1] * cwa); w.w = pk2(silu(g1[2]) * u1[2] * cwa, silu(g1[3]) * u1[3] * cwa);
                *(u32x4*)(ACT + (size_t)a * 256 + 128 * u.pn + 32 * wc + 8 * fq) = w;
            }
    }
};
struct EpiDown {
    static constexpr bool PERM = true;
    const MoeSched* S; u16* Y;
    DI void operator()(const pg::Acc& acc, const pg::Unit& u, int wr, int wc, int fr, int fq) const {
#pragma unroll
        for (int ai = 0; ai < 2; ++ai)
#pragma unroll
            for (int m = 0; m < 4; ++m) {
                const int r = 128 * ai + 64 * wr + 16 * m + fr;
                if (u.pm * 256 + r >= u.n) continue;
                const int a = S->asg(u, r);
#pragma unroll
                for (int bj = 0; bj < 2; ++bj) {
                    const f32x4 v0 = acc[ai][bj][m][0], v1 = acc[ai][bj][m][1];
                    u32x4 w; w.x = pk2(v0[0], v0[1]); w.y = pk2(v0[2], v0[3]); w.z = pk2(v1[0], v1[1]); w.w = pk2(v1[2], v1[3]);
                    *(u32x4*)(Y + (size_t)a * 1024 + 256 * u.pn + 128 * bj + 32 * wc + 8 * fq) = w;
                }
            }
    }
};
template <int STAGE>
DI void phase_moe(const Params& p, int layer, unsigned char* lds) {
    const int tid = tid_opaque(), lane = tid & 63, wid = tid >> 6, c = lane & 15, g = lane >> 4, wm = wid >> 2, wn = wid & 3;
    int* pre = (int*)(lds + 131072);
    int* tl = pre + 192;
    const unsigned* cnt = (const unsigned*)(p.ws + WS_CTL) + CW_CNT + layer * 32;
    if (tid < 32) pre[64 + tid] = (int)cnt[tid];
    __syncthreads();
    if (tid == 0) {
        int s = 0, s2 = 0;
        for (int e = 0; e < 32; ++e) { const int n = pre[64 + e]; pre[e] = s; s += n >> 8; pre[128 + e] = s2; s2 += ((n & 255) + 127) >> 7; }
        pre[32] = s; pre[160] = s2;
    }
    __syncthreads();
    const u32* list = (const u32*)(p.ws + WS_LIST);
    const float* cw = (const float*)(p.ws + WS_CW);
    const u16* HN = (const u16*)(p.ws + WS_HN);
    u16* ACT = (u16*)(p.ws + WS_P0 + P0_ACT);
    u16* Y = (u16*)(p.ws + WS_P0 + P0_Y);
    if (STAGE == 0) {
        MoeSched S{(const char*)HN, (const char*)(p.ws + WS_WGU + layer * WGU_LAYER), list, pre, 1024, 2, 1, pre[32] * 2,
                   (size_t)512 * 1024 * 2, (size_t)128 * 1024 * 2, (size_t)256 * 1024 * 2};
        EpiGateUp E{&S, cw, ACT};
        pg::gemm((LAS unsigned char*)lds, 1024, S, E);
    } else {
        MoeSched S{(const char*)ACT, (const char*)(p.ws + WS_WDN + layer * WDN_LAYER), list, pre, 256, 4, 0, pre[32] * 4,
                   (size_t)1024 * 256 * 2, (size_t)256 * 256 * 2, (size_t)128 * 256 * 2};
        EpiDown E{&S, Y};
        pg::gemm((LAS unsigned char*)lds, 256, S, E);
    }
    __syncthreads();
    constexpr int FT = STAGE == 0 ? 4 : 8;
    const int nleft = pre[160] * FT;
    for (int t = (int)gridDim.x - 1 - (int)blockIdx.x; t < nleft; t += gridDim.x) {
        const int rtile = t / FT, ft = t - rtile * FT;
        int e = 0;
        for (int i = 1; i < 32; ++i) if (pre[128 + i] <= rtile) e = i;
        const int ne = pre[64 + e], r0 = (ne & ~255) + (rtile - pre[128 + e]) * 128;
        if (tid < 128) { const int gi = r0 + tid; tl[tid] = gi < ne ? (int)list[(size_t)e * TP + gi] : -1; }
        __syncthreads();
        GemmAcc<2> acc;
        if (STAGE == 0) {
            const u16* W = (const u16*)(p.ws + WS_WGU + layer * WGU_LAYER) + (size_t)e * 512 * 1024;
            const int f0 = ft * 64;
            auto pf = [=](int lr) -> u32 { const int x = lr & 63, w = lr >> 6; return (u32)((x < 32 ? f0 + w * 32 + x : 256 + f0 + w * 32 + (x - 32)) * 1024); };
            auto qf = [=](int n) -> u32 { const int a = tl[n]; return (u32)((a < 0 ? (tl[0] >> 1) : (a >> 1)) * 1024); };
            gemm_tile<2>(W, HN, 16, pf, qf, acc, lds);
#pragma unroll
            for (int ni = 0; ni < 2; ++ni) {
                const int a = tl[wn * 32 + 16 * ni + c];
                if (a < 0) continue;
                const float cwa = cw[a];
#pragma unroll
                for (int mi = 0; mi < 2; ++mi) {
                    const f32x4 gt = acc.a[mi][ni], up = acc.a[mi + 2][ni];
                    u32x2 w;
                    w.x = pk2(silu(gt[0]) * up[0] * cwa, silu(gt[1]) * up[1] * cwa);
                    w.y = pk2(silu(gt[2]) * up[2] * cwa, silu(gt[3]) * up[3] * cwa);
                    *(u32x2*)(ACT + (size_t)a * 256 + f0 + wm * 32 + 16 * mi + 4 * g) = w;
                }
            }
        } else {
            const u16* W = (const u16*)(p.ws + WS_WDN + layer * WDN_LAYER) + (size_t)e * 1024 * 256;
            auto qf = [=](int n) -> u32 { const int a = tl[n]; return (u32)((a < 0 ? tl[0] : a) * 256); };
            gemm_tile<2>(W, ACT, 4, LinRow{(u32)(ft * 128) * 256u, 256u}, qf, acc, lds);
#pragma unroll
            for (int ni = 0; ni < 2; ++ni) {
                const int a = tl[wn * 32 + 16 * ni + c];
                if (a < 0) continue;
#pragma unroll
                for (int mi = 0; mi < 4; ++mi) {
                    const f32x4 v = acc.a[mi][ni];
                    u32x2 w; w.x = pk2(v[0], v[1]); w.y = pk2(v[2], v[3]);
                    *(u32x2*)(Y + (size_t)a * 1024 + ft * 128 + wm * 64 + 16 * mi + 4 * g) = w;
                }
            }
        }
        __syncthreads();
    }
}

DI void phase_post1(const Params& p, unsigned char* lds) {
    const int lane = tid_opaque() & 63, wid = tid_opaque() >> 6;
    const float* KRAW = (const float*)(p.ws + WS_P0 + P0_KRAW);
    const float* KIRAW = (const float*)((unsigned char*)p.out + DO_KIRAW);
    unsigned char* KN = (unsigned char*)p.out + DO_KN;
    _Float16* KI = (_Float16*)((unsigned char*)p.out + DO_KI);
    for (int row = blockIdx.x * 8 + wid; row < TP; row += gridDim.x * 8) {
        const f32x4 k = *(const f32x4*)(KRAW + (size_t)row * 256 + 4 * lane);
        float ss = k[0] * k[0] + k[1] * k[1] + k[2] * k[2] + k[3] * k[3];
#pragma unroll
        for (int o = 16; o >= 1; o >>= 1) ss += __shfl_xor(ss, o);
        const float rstd = rsqrtf(ss * (1.f / 128.f) + RMS_EPS);
        const int d = (4 * lane) & 127;
        const f32x4 kg = *(const f32x4*)(p.dsa_k_norm + d), qg = *(const f32x4*)(p.dsa_q_norm + d);
        *(u32*)(KN + (size_t)row * 256 + 4 * lane) = pk4_fp8(k[0] * rstd * kg[0] * qg[0], k[1] * rstd * kg[1] * qg[1], k[2] * rstd * kg[2] * qg[2], k[3] * rstd * kg[3] * qg[3]);
        const float x = KIRAW[(size_t)row * 64 + lane];
        const float mu = wave_sum(x) * (1.f / 64.f);
        const float xc = x - mu;
        const float var = wave_sum(xc * xc) * (1.f / 64.f);
        KI[(size_t)row * 64 + lane] = (_Float16)(xc * rsqrtf(var + RMS_EPS) * p.dsa_ln_g[lane] + p.dsa_ln_b[lane]);
    }
}

constexpr int IX_HIST = 0;
constexpr int IX_SEL = 65536;
constexpr int IX_CV = IX_SEL + 16384;
constexpr int IX_CI = IX_CV + 16384;
constexpr int IX_CNT = IX_CI + 8192;
constexpr int IX_QI = IX_CNT + 512;
constexpr int IX_QROW = 1296;
template <int PASS>
DI void index_pass(const _Float16* __restrict__ KIb, int ktiles, int wid, int lane, const float (&wh)[8], float sQ, unsigned char* lds) {
    const int q = lane & 31, hh = lane >> 5;
    u32* hist = (u32*)(lds + IX_HIST);
    u16* sell = (u16*)(lds + IX_SEL);
    float* cv = (float*)(lds + IX_CV);
    u16* ci = (u16*)(lds + IX_CI);
    int* cn = (int*)(lds + IX_CNT);
    const int tbq = (PASS == 1) ? cn[64 + q] : 0;
    const unsigned char* qb = lds + IX_QI + q * IX_QROW + hh * 16;
    for (int kt = 1 + wid; kt < ktiles; kt += 8) {
        f16x8 a[4];
#pragma unroll
        for (int s = 0; s < 4; ++s) a[s] = *(const f16x8*)(KIb + (size_t)(32 * kt + q) * 64 + 16 * s + 8 * hh);
        float sc[16];
        {
            f32x16 d;
#pragma unroll
            for (int r = 0; r < 16; ++r) d[r] = 0.f;
#pragma unroll
            for (int hd = 8; hd < 10; ++hd)
#pragma unroll
                for (int s = 0; s < 4; ++s) d = __builtin_amdgcn_mfma_f32_32x32x16_f16(a[s], *(const f16x8*)(qb + hd * 128 + s * 32), d, 0, 0, 0);
#pragma unroll
            for (int r = 0; r < 16; ++r) sc[r] = d[r];
        }
#pragma unroll
        for (int hd = 0; hd < 8; ++hd) {
            f32x16 d;
#pragma unroll
            for (int r = 0; r < 16; ++r) d[r] = 0.f;
#pragma unroll
            for (int s = 0; s < 4; ++s) d = __builtin_amdgcn_mfma_f32_32x32x16_f16(a[s], *(const f16x8*)(qb + hd * 128 + s * 32), d, 0, 0, 0);
#pragma unroll
            for (int r = 0; r < 16; ++r) sc[r] = fmaf(fabsf(d[r]), wh[hd], sc[r]);
            if (hd & 1) __builtin_amdgcn_sched_barrier(0);
        }
        const int kbase = 32 * kt + 4 * hh;
        if (PASS == 0) {
#pragma unroll
            for (int r = 0; r < 16; ++r) {
                const int key = kbase + (r & 3) + 8 * (r >> 2);
                const int bin = (int)fminf(fmaxf(fmaf(sc[r], sQ, 512.f), 0.f), 1023.f);
                if (key >= 48) atomicAdd(&hist[q * 512 + (bin >> 1)], 1u << (16 * (bin & 1)));
            }
        } else {
            u32 selm = 0u, candm = 0u;
#pragma unroll
            for (int r = 0; r < 16; ++r) {
                const int key = kbase + (r & 3) + 8 * (r >> 2);
                const int bin = (int)fminf(fmaxf(fmaf(sc[r], sQ, 512.f), 0.f), 1023.f);
                selm |= (key >= 48 && bin > tbq) ? (1u << r) : 0u;
                candm |= (key >= 48 && bin == tbq) ? (1u << r) : 0u;
            }
            if (selm) {
                int pos = atomicAdd(&cn[q], (int)__builtin_popcount(selm));
                while (selm) {
                    const int r = __builtin_ctz(selm); selm &= selm - 1u;
                    if (pos < 256) sell[q * 256 + pos] = (u16)(kbase + (r & 3) + 8 * (r >> 2));
                    ++pos;
                }
            }
            if (candm) {
                int pos = atomicAdd(&cn[32 + q], (int)__builtin_popcount(candm));
#pragma unroll
                for (int r = 0; r < 16; ++r) if (candm & (1u << r)) { if (pos < 128) { cv[q * 128 + pos] = sc[r]; ci[q * 128 + pos] = (u16)(kbase + (r & 3) + 8 * (r >> 2)); } ++pos; }
            }
        }
    }
}
DI void index_unit(const Params& p, int b, int ch, int half, unsigned char* lds) {
    const int tid = tid_opaque(), lane = tid & 63, wid = tid >> 6;
    u16* SEL = (u16*)((unsigned char*)p.out + DO_SEL);
    const int qrow0 = b * LP + 64 * ch + 32 * half;
    const int nkeys = 64 * (ch + 1) - 48;
    if (nkeys <= 256) {
        for (int i = tid; i < 32 * 256; i += NTHREADS) { const int qq = i >> 8, s = i & 255; SEL[(size_t)(qrow0 + qq) * 256 + s] = (u16)(s < nkeys ? 48 + s : 48); }
        return;
    }
    u32* hist = (u32*)(lds + IX_HIST);
    int* cn = (int*)(lds + IX_CNT);
    for (int i = tid; i < 32 * 512; i += NTHREADS) hist[i] = 0u;
    if (tid < 128) cn[tid] = 0;
    { u16* sell0 = (u16*)(lds + IX_SEL); for (int i = tid; i < 32 * 256; i += NTHREADS) sell0[i] = 48; }
    const _Float16* QI = (const _Float16*)(p.ws + WS_P0 + P0_QI);
    const float* WI = (const float*)((unsigned char*)p.out + DO_WI);
    const _Float16* KIb = (const _Float16*)((unsigned char*)p.out + DO_KI) + (size_t)b * LP * 64;
    const int q = lane & 31;
    float wh[8], sQ;
    {
        float n2 = 0.f;
#pragma unroll
        for (int hd = 0; hd < 8; ++hd) { const float w = WI[(size_t)(qrow0 + q) * 8 + hd]; wh[hd] = 0.5f * w; n2 += w * w; }
        sQ = 512.f / (28.f * sqrtf(n2) + 1e-20f);
    }
#pragma unroll
    for (int i = 0; i < 4; ++i) { const int id = tid + NTHREADS * i, rr = id >> 6, cc = id & 63; *(u32x4*)(lds + IX_QI + rr * IX_QROW + cc * 16) = *(const u32x4*)(QI + (size_t)(qrow0 + rr) * 512 + cc * 8); }
    const int ktiles = 2 * (ch + 1);
    __syncthreads();
    {
        const int qq = tid >> 4, dg = tid & 15;
        float c4[4] = {0.f, 0.f, 0.f, 0.f};
#pragma unroll
        for (int hd = 0; hd < 8; ++hd) {
            const float w = 0.5f * WI[(size_t)(qrow0 + qq) * 8 + hd];
            const _Float16* qp = (const _Float16*)(lds + IX_QI + qq * IX_QROW + hd * 128 + dg * 8);
#pragma unroll
            for (int k = 0; k < 4; ++k) c4[k] += w * (float)qp[k];
        }
        _Float16* ph = (_Float16*)(lds + IX_QI + qq * IX_QROW + 8 * 128 + dg * 8);
        _Float16* pl = (_Float16*)(lds + IX_QI + qq * IX_QROW + 9 * 128 + dg * 8);
#pragma unroll
        for (int k = 0; k < 4; ++k) { const _Float16 hi = (_Float16)c4[k]; ph[k] = hi; pl[k] = (_Float16)(c4[k] - (float)hi); }
    }
    __syncthreads();
    index_pass<0>(KIb, ktiles, wid, lane, wh, sQ, lds);
    __syncthreads();
    for (int qi = 0; qi < 4; ++qi) {
        const int qq = 4 * wid + qi;
        u32 hw[8];
        int cl = 0;
#pragma unroll
        for (int i = 0; i < 8; ++i) { hw[i] = hist[qq * 512 + 8 * lane + i]; cl += (int)(hw[i] & 0xffffu) + (int)(hw[i] >> 16); }
        int suf = cl;
#pragma unroll
        for (int o = 1; o < 64; o <<= 1) { const int t = __shfl_down(suf, o); if (lane + o < 64) suf += t; }
        const int above = suf - cl;
        if (above < 256 && above + cl >= 256) {
            int acc = above, tb = 16 * lane, na = above;
#pragma unroll
            for (int i = 15; i >= 0; --i) {
                const int cb = (int)((hw[i >> 1] >> (16 * (i & 1))) & 0xffffu);
                if (acc < 256 && acc + cb >= 256) { tb = 16 * lane + i; na = acc; }
                acc += cb;
            }
            cn[64 + qq] = tb; cn[96 + qq] = na;
        }
    }
    __syncthreads();
    index_pass<1>(KIb, ktiles, wid, lane, wh, sQ, lds);
    __syncthreads();
    {
        u16* sell = (u16*)(lds + IX_SEL);
        const float* cv = (const float*)(lds + IX_CV);
        const u16* ci = (const u16*)(lds + IX_CI);
        for (int qi = 0; qi < 4; ++qi) {
            const int qq = 4 * wid + qi;
            const int na = cn[96 + qq], need = 256 - na;
            int nc = cn[32 + qq]; nc = nc < 128 ? nc : 128;
#pragma unroll
            for (int half2 = 0; half2 < 2; ++half2) {
                const int i = lane + 64 * half2;
                if (i < nc) {
                    const float vi = cv[qq * 128 + i]; const int ki = ci[qq * 128 + i];
                    int rank = 0;
                    for (int j = 0; j < nc; ++j) { const float vj = cv[qq * 128 + j]; const int kj = ci[qq * 128 + j]; rank += (vj > vi || (vj == vi && kj < ki)) ? 1 : 0; }
                    if (rank < need) sell[qq * 256 + na + rank] = (u16)ki;
                }
            }
        }
    }
    __syncthreads();
    {
        const u32x4* src = (const u32x4*)(lds + IX_SEL);
        u32x4* dst = (u32x4*)(SEL + (size_t)qrow0 * 256);
        for (int i = tid; i < 1024; i += NTHREADS) dst[i] = src[i];
    }
    __syncthreads();
}
DI void phase_index(const Params& p, unsigned char* lds) {
    const int G = gridDim.x;
    for (int r = 0;; ++r) {
        const int u = (r & 1) ? r * G + (G - 1 - (int)blockIdx.x) : r * G + (int)blockIdx.x;
        if (r * G >= 516) break;
        if (u < 516) index_unit(p, (u >> 1) & 1, 128 - (u >> 2), u & 1, lds);
    }
}

DI int t5_bucket(int rel) {
    const int n = rel < 0 ? -rel : rel;
    const int base = rel > 0 ? 16 : 0;
    const int lg = 8 + (n >= 12) + (n >= 16) + (n >= 23) + (n >= 32) + (n >= 46) + (n >= 64) + (n >= 91);
    return base + (n < 8 ? n : lg);
}
constexpr int AT_ITEMS = 513;
constexpr int AT_WAVE_LDS = 11264;
DI int at_swz(int r) { return ((r >> 1) & 1) | (((r >> 3) & 1) << 1); }
DI void attn_query(const Params& p, int b, int n, int qi, unsigned char* wl) {
    const int lane = tid_opaque() & 63, c = lane & 15, g = lane >> 4;
    u32* widx = (u32*)wl;
    u16* Pb = (u16*)(wl + 1024);
    unsigned char* ring = wl + 3072;
    float* Lg = (float*)ring;
    const u16* SEL = (const u16*)((unsigned char*)p.out + DO_SEL);
    const u16* QRAW = (const u16*)(p.ws + WS_P0 + P0_QRAW);
    const unsigned char* KN = (const unsigned char*)p.out + DO_KN;
    const unsigned char* VN = p.ws + WS_P0 + P0_VN;
    u16* OA = (u16*)((unsigned char*)p.out + DO_OG);
    const int pq = 48 + qi, row = b * LP + pq;
    const int chq = pq >> 6, nkeys = 64 * (chq + 1) - 48, nsel = nkeys < 256 ? nkeys : 256, ntile = nsel >> 4;
    {
        const u32x2 w = *(const u32x2*)(SEL + (size_t)row * 256 + 4 * lane);
        u32x4 o;
        const int k0 = w.x & 0xffff, k1 = w.x >> 16, k2 = w.y & 0xffff, k3 = w.y >> 16;
        o.x = k0 | (t5_bucket(k0 - pq) << 16); o.y = k1 | (t5_bucket(k1 - pq) << 16); o.z = k2 | (t5_bucket(k2 - pq) << 16); o.w = k3 | (t5_bucket(k3 - pq) << 16);
        *(u32x4*)(widx + 4 * lane) = o;
    }
    const size_t kb = (size_t)b * LP;
    u32x4 qraw[4];
#pragma unroll
    for (int s = 0; s < 4; ++s)
        qraw[s] = (c < 4) ? *(const u32x4*)(QRAW + (size_t)row * 1024 + (4 * n + c) * 128 + 64 * (s >> 1) + 16 * g + 8 * (s & 1))
                          : (u32x4){0u, 0u, 0u, 0u};
    float rbv[8];
    {
        const float* rb = p.rel_bias + (8 * g) * 8 + 4 * n + (c & 3);
#pragma unroll
        for (int j = 0; j < 8; ++j) rbv[j] = rb[8 * j];
    }
#define ATT_LOADK(dst, oh, bt) do { _Pragma("unroll") for (int t = 0; t < 4; ++t) { const u32 e_ = widx[16 * (4 * (bt) + t) + c]; const int kid_ = e_ & 0xffff, bk_ = e_ >> 16; \
        const unsigned char* kp_ = KN + (kb + kid_) * 256 + n * 128 + 16 * g; \
        dst[t][0] = *(const u32x4*)(kp_); dst[t][1] = *(const u32x4*)(kp_ + 64); \
        const u32 hv_ = ((bk_ >> 3) == g) ? (0x3f80u << (16 * (bk_ & 1))) : 0u; const int wq_ = (bk_ & 7) >> 1; \
        u32x4 ow_; ow_.x = wq_ == 0 ? hv_ : 0u; ow_.y = wq_ == 1 ? hv_ : 0u; ow_.z = wq_ == 2 ? hv_ : 0u; ow_.w = wq_ == 3 ? hv_ : 0u; oh[t] = __builtin_bit_cast(bf16x8, ow_); } } while (0)
#define ATT_QK(src, oh, bt) do { _Pragma("unroll") for (int t = 0; t < 4; ++t) { f32x4 a4 = (f32x4){0.f, 0.f, 0.f, 0.f}; \
        a4 = __builtin_amdgcn_mfma_f32_16x16x32_fp8_fp8((long)(((unsigned long long)src[t][0].y << 32) | src[t][0].x), qf[0], a4, 0, 0, 0); \
        a4 = __builtin_amdgcn_mfma_f32_16x16x32_fp8_fp8((long)(((unsigned long long)src[t][0].w << 32) | src[t][0].z), qf[1], a4, 0, 0, 0); \
        a4 = __builtin_amdgcn_mfma_f32_16x16x32_fp8_fp8((long)(((unsigned long long)src[t][1].y << 32) | src[t][1].x), qf[2], a4, 0, 0, 0); \
        a4 = __builtin_amdgcn_mfma_f32_16x16x32_fp8_fp8((long)(((unsigned long long)src[t][1].w << 32) | src[t][1].z), qf[3], a4, 0, 0, 0); \
        { const f32x4 b4_ = mfma16(oh[t], bb, (f32x4){0.f, 0.f, 0.f, 0.f}); a4 = a4 + b4_; } \
        const bool val_ = (4 * (bt) + t) < ntile; \
        _Pragma("unroll") for (int r = 0; r < 4; ++r) { a4[r] = val_ ? a4[r] * qscale : -3.0e38f; mx = fmaxf(mx, a4[r]); } \
        lq[t] = a4; } \
        if (c < 4) { _Pragma("unroll") for (int t = 0; t < 4; ++t) *(f32x4*)(Lg + c * 256 + 16 * (4 * (bt) + t) + 4 * g) = lq[t]; } } while (0)
    u32x4 ka[4][2], kc[4][2]; bf16x8 oa[4], oc[4];
    ATT_LOADK(ka, oa, 0);
    ATT_LOADK(kc, oc, 1);
    long qf[4];
    float ssq = 0.f;
#pragma unroll
    for (int s = 0; s < 4; ++s) {
        const u32x4 w = qraw[s];
        const u32 lo8 = pk4_fp8(bflo(w.x), bfhi(w.x), bflo(w.y), bfhi(w.y)), hi8 = pk4_fp8(bflo(w.z), bfhi(w.z), bflo(w.w), bfhi(w.w));
        qf[s] = (long)(((unsigned long long)hi8 << 32) | lo8);
        ssq += bflo(w.x) * bflo(w.x) + bfhi(w.x) * bfhi(w.x) + bflo(w.y) * bflo(w.y) + bfhi(w.y) * bfhi(w.y)
             + bflo(w.z) * bflo(w.z) + bfhi(w.z) * bfhi(w.z) + bflo(w.w) * bflo(w.w) + bfhi(w.w) * bfhi(w.w);
    }
    ssq += __shfl_xor(ssq, 16); ssq += __shfl_xor(ssq, 32);
    const float qscale = rsqrtf(ssq * (1.f / 128.f) + RMS_EPS) * 0.08838834764831845f;
    bf16x8 bb;
    {
        const float iq = 1.f / qscale;
        u32x4 w;
        w.x = pk2(rbv[0] * iq, rbv[1] * iq); w.y = pk2(rbv[2] * iq, rbv[3] * iq); w.z = pk2(rbv[4] * iq, rbv[5] * iq); w.w = pk2(rbv[6] * iq, rbv[7] * iq);
        if (c >= 4) w = (u32x4){0u, 0u, 0u, 0u};
        bb = __builtin_bit_cast(bf16x8, w);
    }
    float mx = -3.0e38f;
    {
        f32x4 lq[4];
        ATT_QK(ka, oa, 0);
        ATT_LOADK(ka, oa, 2);
        ATT_QK(kc, oc, 1);
        ATT_LOADK(kc, oc, 3);
        ATT_QK(ka, oa, 2);
        ATT_QK(kc, oc, 3);
    }
#undef ATT_LOADK
#undef ATT_QK
    const int kr = lane >> 3, c8 = lane & 7;
    const unsigned char* vbase = VN + kb * 256 + n * 128 + 16 * c8;
#define ATT_SWZ2(r) (((r) & 3) | ((((r) >> 3) & 1) << 2))
#define ATT_LDV(dst, st) do { _Pragma("unroll") for (int j = 0; j < 4; ++j) { const int kid_ = widx[32 * (st) + 8 * j + kr] & 0xffff; \
        dst[j] = *(const u32x4*)(vbase + (size_t)kid_ * 256); } } while (0)
#define ATT_STV(src) do { _Pragma("unroll") for (int j = 0; j < 4; ++j) { const int r_ = 8 * j + kr; \
        unsigned char* d_ = ring + r_ * 256 + ((c8 ^ ATT_SWZ2(r_)) * 32); \
        *(bf16x8*)(d_) = fp8x8_to_bf16x8(src[j].x, src[j].y); *(bf16x8*)(d_ + 16) = fp8x8_to_bf16x8(src[j].z, src[j].w); } } while (0)
    u32x4 v0[4], v1[4], v2[4], v3[4];
    ATT_LDV(v0, 0); ATT_LDV(v1, 1); ATT_LDV(v2, 2); ATT_LDV(v3, 3);
    mx = fmaxf(mx, __shfl_xor(mx, 16)); mx = fmaxf(mx, __shfl_xor(mx, 32));
    float inv[4];
    {
#pragma unroll
        for (int hd = 0; hd < 4; ++hd) {
            const float m = __shfl(mx, hd);
            const f32x4 l4 = *(const f32x4*)(Lg + hd * 256 + 4 * lane);
            f32x4 e = (f32x4){__expf(l4[0] - m), __expf(l4[1] - m), __expf(l4[2] - m), __expf(l4[3] - m)};
            if (4 * lane >= nsel) e = (f32x4){0.f, 0.f, 0.f, 0.f};
            inv[hd] = 1.f / wave_sum(e[0] + e[1] + e[2] + e[3]);
            u32x2 w; w.x = pk2(e[0], e[1]); w.y = pk2(e[2], e[3]);
            *(u32x2*)(Pb + hd * 256 + 4 * lane) = w;
        }
    }
    f32x4 acc[8];
#pragma unroll
    for (int t = 0; t < 8; ++t) acc[t] = (f32x4){0.f, 0.f, 0.f, 0.f};
#define ATT_PVC(st) do { \
        bf16x8 pa_ = (bf16x8){0, 0, 0, 0, 0, 0, 0, 0}; if (c < 4) pa_ = *(const bf16x8*)(Pb + c * 256 + 32 * (st) + 8 * g); \
        const int r0_ = 8 * g + (c >> 2), r1_ = r0_ + 4; \
        _Pragma("unroll") for (int t = 0; t < 8; ++t) { \
            const s16x4 lo_ = __builtin_amdgcn_ds_read_tr16_b64_v4i16((LAS s16x4*)(ring + r0_ * 256 + ((t ^ ATT_SWZ2(r0_)) * 32) + (c & 3) * 8)); \
            const s16x4 hi_ = __builtin_amdgcn_ds_read_tr16_b64_v4i16((LAS s16x4*)(ring + r1_ * 256 + ((t ^ ATT_SWZ2(r1_)) * 32) + (c & 3) * 8)); \
            const bf16x8 vb_ = (bf16x8){lo_[0], lo_[1], lo_[2], lo_[3], hi_[0], hi_[1], hi_[2], hi_[3]}; \
            acc[t] = mfma16(pa_, vb_, acc[t]); } } while (0)
#define ATT_ST(st, vcur) do { ATT_STV(vcur); ATT_PVC(st); if ((st) + 4 < 8) ATT_LDV(vcur, (st) + 4); } while (0)
    ATT_ST(0, v0); ATT_ST(1, v1); ATT_ST(2, v2); ATT_ST(3, v3); ATT_ST(4, v0); ATT_ST(5, v1); ATT_ST(6, v2); ATT_ST(7, v3);
#undef ATT_ST
#undef ATT_LDV
#undef ATT_STV
#undef ATT_PVC
#undef ATT_SWZ2
    if (g == 0) {
#pragma unroll
        for (int r = 0; r < 4; ++r)
#pragma unroll
            for (int t = 0; t < 8; ++t) OA[(size_t)row * 1024 + (4 * n + r) * 128 + 16 * t + c] = f2bf(acc[t][r] * inv[r]);
    }
}
DI void phase_attn(const Params& p, unsigned xcc, unsigned char* lds) {
    const int tid = tid_opaque(), lane = tid & 63, wid = tid >> 6;
    unsigned char* wl = lds + wid * AT_WAVE_LDS;
    u16* OA = (u16*)((unsigned char*)p.out + DO_OG);
    for (int i = blockIdx.x * NTHREADS + tid; i < 96 * 128; i += gridDim.x * NTHREADS) {
        const int r = i >> 7, b = r / 48, pp = r - 48 * b;
        *(u32x4*)(OA + ((size_t)b * LP + pp) * 1024 + (i & 127) * 8) = (u32x4){0u, 0u, 0u, 0u};
    }
    unsigned* qctr = (unsigned*)(p.ws + WS_CTL) + CW_AQ;
    const int my = (int)(xcc & 3u);
    constexpr int NIT = 8208 / 2;
    int cbq = my;
    unsigned jn = 0;
    if (lane == 0) jn = atomicAdd(&qctr[cbq * 64], 1u);
    for (;;) {
        int j = (int)__builtin_amdgcn_readfirstlane(jn), cb = cbq;
        while (j >= NIT) {
            if (((cbq + 1) & 3) == my) { j = -1; break; }
            cbq = (cbq + 1) & 3; cb = cbq;
            unsigned t = 0; if (lane == 0) t = atomicAdd(&qctr[cbq * 64], 1u);
            j = (int)__builtin_amdgcn_readfirstlane(t);
        }
        if (j < 0) break;
        if (lane == 0) jn = atomicAdd(&qctr[cbq * 64], 1u);
        attn_query(p, cb >> 1, cb & 1, 2 * j, wl);
        attn_query(p, cb >> 1, cb & 1, 2 * j + 1, wl);
    }
}

DI void phase_final(const Params& p) {
    const float* H = (const float*)(p.ws + WS_H);
    const u16* Y = (const u16*)(p.ws + WS_P0 + P0_Y);
    for (size_t i = (size_t)blockIdx.x * NTHREADS + tid_opaque(); i < (size_t)2 * SEQ * 256; i += (size_t)gridDim.x * NTHREADS) {
        const size_t orow = i >> 8; const int col = (int)(i & 255) * 4;
        const int b = (int)(orow >> 13), s = (int)(orow & 8191);
        const size_t row = (size_t)b * LP + 64 + s;
        f32x4 v = *(const f32x4*)(H + row * DM + col);
        const u32x2 y0 = *(const u32x2*)(Y + (2 * row) * DM + col), y1 = *(const u32x2*)(Y + (2 * row + 1) * DM + col);
        v[0] += bflo(y0.x) + bflo(y1.x); v[1] += bfhi(y0.x) + bfhi(y1.x); v[2] += bflo(y0.y) + bflo(y1.y); v[3] += bfhi(y0.y) + bfhi(y1.y);
        *(f32x4*)(p.out + orow * DM + col) = v;
    }
}

__global__ void __launch_bounds__(NTHREADS, 2) mega(Params p) {
    extern __shared__ __attribute__((aligned(16))) unsigned char lds[];
    if (threadIdx.x < 4) ((volatile LAS unsigned*)(lds + LDS_BAR))[threadIdx.x] = 0u;
    __syncthreads();
    XcdBarrier bar = xcd_barrier_post((unsigned*)(p.ws + WS_CTL) + CW_BAR, (volatile LAS unsigned*)(lds + LDS_BAR));
    phase_prep(p, lds);                                                   xcd_barrier(bar);
    phase_gemm_in0(p, lds);                                               xcd_barrier(bar);
    phase_gdn_prep(p, lds);                                             xcd_barrier(bar);
    { int c0 = 1, c1 = 66; asm volatile("" : "+s"(c0), "+s"(c1));
      if (blockIdx.x < 64) phase_gdn_scan(p, lds, c0, c1); else if (blockIdx.x < 80) gdn_prep_unit(p, blockIdx.x - 64, 128, lds);
      else { conv_small_weights(p, 16 * 33, -1, (int)blockIdx.x - 80, (int)gridDim.x - 80, lds); conv_moe_weights(p, 0, CONV_SCAN_UNITS, (int)blockIdx.x - 80, (int)gridDim.x - 80, lds); } }
    xcd_barrier(bar);
    { int c0 = 67, c1 = 127; asm volatile("" : "+s"(c0), "+s"(c1));
      if (blockIdx.x < 64) phase_gdn_scan(p, lds, c0, c1); else { for (int u = blockIdx.x - 64; u < 16 * 68; u += gridDim.x - 64) gdn_out_unit(p, u / 68, u % 68, lds); } }
    xcd_barrier(bar);
    for (int u = blockIdx.x; u < 16 * 61; u += gridDim.x) gdn_out_unit(p, u / 61, 68 + u % 61, lds);
    xcd_barrier(bar);
    phase_gemm_out<true>(p, (const u16*)(p.ws + WS_W_OUT0), (const u16*)(p.ws + WS_P0) + 2048, 4096, lds);   xcd_barrier(bar);
    phase_norm<false, true>(p, p.norm_ffn, 0, lds);
                                                                          xcd_barrier(bar);
    phase_moe<0>(p, 0, lds);                                              xcd_barrier(bar);
    phase_moe<1>(p, 0, lds);                                              xcd_barrier(bar);
    phase_norm<true, false>(p, p.norm_mix + DM, 0, lds);
    conv_moe_weights(p, CONV_SCAN_UNITS, 2 * CONV_MOE_LAYER, (int)blockIdx.x, (int)gridDim.x, lds);   xcd_barrier(bar);
    phase_gemm_in1(p, lds);                                               xcd_barrier(bar);
    phase_post1(p, lds);                                                  xcd_barrier(bar);
    phase_index(p, lds);                                                  xcd_barrier(bar);
    phase_attn(p, bar.x, lds);                                                   xcd_barrier(bar);
    phase_gemm_out<false>(p, (const u16*)(p.ws + WS_W_OUT1), (const u16*)((unsigned char*)p.out + DO_OG), 1024, lds);   xcd_barrier(bar);
    phase_norm<false, true>(p, p.norm_ffn + DM, 1, lds);                  xcd_barrier(bar);
    phase_moe<0>(p, 1, lds);                                              xcd_barrier(bar);
    phase_moe<1>(p, 1, lds);                                              xcd_barrier(bar);
    phase_final(p);
}

extern "C" void kernel_launch(void* const* d_in, const int* in_sizes, int n_in, void* d_out, int out_size, void* d_ws, size_t ws_size, hipStream_t stream) {
    static int grid = 0;
    if (grid == 0) {
        if (n_in != 23 || out_size != 2 * SEQ * DM || ws_size < WS_END) { fprintf(stderr, "kernel_launch: unexpected sizes (n_in %d out %d ws %zu need %zu)\n", n_in, out_size, ws_size, (size_t)WS_END); grid = -1; return; }
        int dev = 0, cus = 0;
        if (hipGetDevice(&dev) != hipSuccess || hipDeviceGetAttribute(&cus, hipDeviceAttributeMultiprocessorCount, dev) != hipSuccess) { grid = -1; return; }
        if (hipFuncSetAttribute((const void*)mega, hipFuncAttributeMaxDynamicSharedMemorySize, LDS_BYTES) != hipSuccess) { fprintf(stderr, "kernel_launch: hipFuncSetAttribute failed\n"); grid = -1; return; }
        grid = cus > 256 ? 256 : cus;
        if (grid < 16) { grid = -1; return; }
    }
    if (grid < 0) return;
    (void)hipMemsetAsync((unsigned char*)d_ws + WS_CTL, 0, CTL_BYTES, stream);
    Params p{};
    const float** f = (const float**)&p;
    for (int i = 0; i < 23; ++i) f[i] = (const float*)d_in[i];
    p.out = (float*)d_out; p.ws = (unsigned char*)d_ws;
    hipLaunchKernelGGL(mega, dim3(grid), dim3(NTHREADS), LDS_BYTES, stream, p);
}
```
